# Optimizing an MI355X kernel written in HIP

```python
import math
import jax, jax.numpy as jnp
from jax import lax
import numpy as np

D_MODEL = 1024
BATCH = 4
SEQ = 8192
DEPTH = 1

D_SSM = D_MODEL // 2
SSM_GROUP = 16
SSM_GROUPS = D_SSM // SSM_GROUP
SSM_STATE = 64
SSM_DT_MIN = 0.001
SSM_DT_MAX = 0.1
N_HEADS = 8
HEAD_DIM = 64
D_ATT = N_HEADS * HEAD_DIM
ROT_DIM = HEAD_DIM // 4
ROPE_THETA = 500000.0
MOBA_BLOCK = 256
MOBA_TOPK = 3
Q_CHUNK = 128
D_IN = D_SSM + 3 * D_ATT + 2 * D_MODEL
PEER_HEADS = 8
PEER_KEYS = 128
PEER_EXPERTS = PEER_KEYS * PEER_KEYS
PEER_QDIM = 256
PEER_HALF = PEER_QDIM // 2
PEER_TOPK = 16
PEER_CHUNK = 128
D_PLE = 256
EPS = 1e-6
NEG = -1e30

kernel_name = "hybrid_s5_moba_peer_block"


def rmsnorm(x, g):
    x32 = x.astype(jnp.float32)
    y = x32 * lax.rsqrt(jnp.mean(x32 * x32, axis=-1, keepdims=True) + EPS)
    return (y * g.astype(jnp.float32)).astype(x.dtype)


def rotary_tables(positions):
    inv_freq = ROPE_THETA ** (-jnp.arange(0, ROT_DIM, 2, dtype=jnp.float32) / ROT_DIM)
    ang = positions.astype(jnp.float32)[..., None] * inv_freq
    return jnp.cos(ang)[:, None], jnp.sin(ang)[:, None]


def apply_partial_rope(t, cos, sin):
    half = ROT_DIM // 2
    t32 = t[..., :ROT_DIM].astype(jnp.float32)
    t1, t2 = t32[..., :half], t32[..., half:]
    rot = jnp.concatenate([t1 * cos - t2 * sin, t2 * cos + t1 * sin], axis=-1).astype(t.dtype)
    return jnp.concatenate([rot, t[..., ROT_DIM:]], axis=-1)


def s5_mixer(u, log_dt, a_re, a_im, b_re, b_im, c_re, c_im, d_skip, w_glu):
    f32 = jnp.float32
    Bsz, S, _ = u.shape
    u32 = u.astype(f32)
    ut = u32.reshape(Bsz, S, SSM_GROUPS, SSM_GROUP).transpose(1, 0, 2, 3)
    dt = jnp.exp(log_dt.astype(f32))[:, None]
    ar, ai = a_re.astype(f32), a_im.astype(f32)
    mag = jnp.exp(dt * ar)
    abar_re, abar_im = mag * jnp.cos(dt * ai), mag * jnp.sin(dt * ai)
    den = ar * ar + ai * ai
    nr, ni = abar_re - 1.0, abar_im
    f_re = (nr * ar + ni * ai) / den
    f_im = (ni * ar - nr * ai) / den
    br, bi = b_re.astype(f32), b_im.astype(f32)
    bb_re = f_re[..., None] * br - f_im[..., None] * bi
    bb_im = f_re[..., None] * bi + f_im[..., None] * br
    xin_re = jnp.einsum('sbgc,gnc->sbgn', ut, bb_re)
    xin_im = jnp.einsum('sbgc,gnc->sbgn', ut, bb_im)
    a_s_re = jnp.broadcast_to(abar_re[None, None], (S, 1, SSM_GROUPS, SSM_STATE))
    a_s_im = jnp.broadcast_to(abar_im[None, None], (S, 1, SSM_GROUPS, SSM_STATE))

    def combine(e1, e2):
        a1r, a1i, b1r, b1i = e1
        a2r, a2i, b2r, b2i = e2
        return (a2r * a1r - a2i * a1i,
                a2r * a1i + a2i * a1r,
                a2r * b1r - a2i * b1i + b2r,
                a2r * b1i + a2i * b1r + b2i)

    _, _, h_re, h_im = lax.associative_scan(combine, (a_s_re, a_s_im, xin_re, xin_im), axis=0)
    y = (jnp.einsum('sbgn,gcn->bsgc', h_re, c_re.astype(f32))
         - jnp.einsum('sbgn,gcn->bsgc', h_im, c_im.astype(f32)))
    y = y.reshape(Bsz, S, D_SSM) + d_skip.astype(f32) * u32
    y = jax.nn.gelu(y)
    y = y * jax.nn.sigmoid(y @ w_glu.astype(f32))
    return y.astype(u.dtype)


def moba_attention(q, k, v):
    f32 = jnp.float32
    Bsz, H, S, hd = q.shape
    nb = -(-S // MOBA_BLOCK)
    pad = nb * MOBA_BLOCK - S
    kp = jnp.pad(k, ((0, 0), (0, 0), (0, pad), (0, 0)))
    vp = jnp.pad(v, ((0, 0), (0, 0), (0, pad), (0, 0)))
    kb = kp.reshape(Bsz, H, nb, MOBA_BLOCK, hd)
    vb = vp.reshape(Bsz, H, nb, MOBA_BLOCK, hd)
    kmean = jnp.mean(kb.astype(f32), axis=3)
    qblk = jnp.arange(S) // MOBA_BLOCK
    gate = jnp.einsum('bhsd,bhnd->bhsn', q.astype(f32), kmean)
    past = jnp.arange(nb)[None, :] < qblk[:, None]
    gate = jnp.where(past, gate, NEG)
    k_sel = min(MOBA_TOPK, nb)
    _, sel = lax.top_k(gate, k_sel)
    sel_ok = sel < qblk[:, None]
    nc = S // Q_CHUNK
    scale = hd ** -0.5
    h_idx = jnp.arange(H)[:, None, None]

    def chunk(i):
        b = i // nc
        start = (i % nc) * Q_CHUNK
        qc = lax.dynamic_slice(q, (b, 0, start, 0), (1, H, Q_CHUNK, hd))[0]
        selc = lax.dynamic_slice(sel, (b, 0, start, 0), (1, H, Q_CHUNK, k_sel))[0]
        okc = lax.dynamic_slice(sel_ok, (b, 0, start, 0), (1, H, Q_CHUNK, k_sel))[0]
        kb_b = lax.dynamic_index_in_dim(kb, b, 0, keepdims=False)
        vb_b = lax.dynamic_index_in_dim(vb, b, 0, keepdims=False)
        kg = kb_b[h_idx, selc]
        vg = vb_b[h_idx, selc]
        own = (start // MOBA_BLOCK) * MOBA_BLOCK
        k_own = lax.dynamic_slice(kp, (b, 0, own, 0), (1, H, MOBA_BLOCK, hd))[0]
        v_own = lax.dynamic_slice(vp, (b, 0, own, 0), (1, H, MOBA_BLOCK, hd))[0]
        qpos = start + jnp.arange(Q_CHUNK)
        kpos = own + jnp.arange(MOBA_BLOCK)
        s_sel = jnp.einsum('hqd,hqjkd->hqjk', qc, kg).astype(f32) * scale
        s_sel = jnp.where(okc[..., None], s_sel, NEG).reshape(H, Q_CHUNK, k_sel * MOBA_BLOCK)
        s_own = jnp.einsum('hqd,hkd->hqk', qc, k_own).astype(f32) * scale
        s_own = jnp.where(kpos[None, :] <= qpos[:, None], s_own, NEG)
        probs = jax.nn.softmax(jnp.concatenate([s_sel, s_own], axis=-1), axis=-1).astype(v.dtype)
        p_sel = probs[..., :k_sel * MOBA_BLOCK].reshape(H, Q_CHUNK, k_sel, MOBA_BLOCK)
        p_own = probs[..., k_sel * MOBA_BLOCK:]
        return (jnp.einsum('hqjk,hqjkd->hqd', p_sel, vg)
                + jnp.einsum('hqk,hkd->hqd', p_own, v_own))

    out = lax.map(chunk, jnp.arange(Bsz * nc))
    return out.reshape(Bsz, nc, H, Q_CHUNK, hd).transpose(0, 2, 1, 3, 4).reshape(Bsz, H, S, hd)


def peer_ffn(h, w_q, keys1, keys2, u_tab, v_tab):
    f32 = jnp.float32
    Bsz, S, D = h.shape
    q = (h @ w_q).astype(f32).reshape(Bsz, S, PEER_HEADS, 2, PEER_HALF)
    s1 = jnp.einsum('bshd,hnd->bshn', q[..., 0, :], keys1.astype(f32))
    s2 = jnp.einsum('bshd,hnd->bshn', q[..., 1, :], keys2.astype(f32))
    v1, i1 = lax.top_k(s1, PEER_TOPK)
    v2, i2 = lax.top_k(s2, PEER_TOPK)
    cand = (v1[..., :, None] + v2[..., None, :]).reshape(Bsz, S, PEER_HEADS, PEER_TOPK * PEER_TOPK)
    top, flat = lax.top_k(cand, PEER_TOPK)
    e1 = jnp.take_along_axis(i1, flat // PEER_TOPK, axis=-1)
    e2 = jnp.take_along_axis(i2, flat % PEER_TOPK, axis=-1)
    experts = e1 * PEER_KEYS + e2
    gates = jax.nn.softmax(top, axis=-1).astype(h.dtype)
    T = Bsz * S
    nct = T // PEER_CHUNK
    hf = h.reshape(nct, PEER_CHUNK, D)
    ef = experts.reshape(nct, PEER_CHUNK, PEER_HEADS, PEER_TOPK)
    gf = gates.reshape(nct, PEER_CHUNK, PEER_HEADS, PEER_TOPK)

    def chunk(args):
        hc, ec, gc = args
        act = jax.nn.gelu(jnp.einsum('td,thkd->thk', hc, u_tab[ec]))
        return jnp.einsum('thk,thkd->td', gc * act, v_tab[ec])

    return lax.map(chunk, (hf, ef, gf)).reshape(Bsz, S, D)


def setup_inputs(seed: int = 0) -> dict:
    key = jax.random.key(seed)
    ks = jax.random.split(key, 32)
    nrm = lambda k, shape, s: jax.random.normal(k, shape, jnp.float32) * s
    L = DEPTH
    n_idx = jnp.arange(SSM_STATE, dtype=jnp.float32)
    return {
        "x": nrm(ks[0], (BATCH, SEQ, D_MODEL), 1.0),
        "p": nrm(ks[1], (DEPTH, BATCH, SEQ, D_PLE), 1.0),
        "positions": jnp.broadcast_to(jnp.arange(SEQ, dtype=jnp.int32), (BATCH, SEQ)),
        "g_mix": 1.0 + nrm(ks[2], (L, D_MODEL), 0.01),
        "w_in": nrm(ks[3], (L, D_MODEL, D_IN), D_MODEL ** -0.5),
        "ssm_log_dt": jax.random.uniform(ks[4], (L, SSM_GROUPS), jnp.float32,
                                         math.log(SSM_DT_MIN), math.log(SSM_DT_MAX)),
        "ssm_a_re": -0.5 + nrm(ks[5], (L, SSM_GROUPS, SSM_STATE), 0.01),
        "ssm_a_im": math.pi * n_idx + nrm(ks[6], (L, SSM_GROUPS, SSM_STATE), 0.01),
        "ssm_b_re": nrm(ks[7], (L, SSM_GROUPS, SSM_STATE, SSM_GROUP), (2 * SSM_GROUP) ** -0.5),
        "ssm_b_im": nrm(ks[8], (L, SSM_GROUPS, SSM_STATE, SSM_GROUP), (2 * SSM_GROUP) ** -0.5),
        "ssm_c_re": nrm(ks[9], (L, SSM_GROUPS, SSM_GROUP, SSM_STATE), SSM_STATE ** -0.5),
        "ssm_c_im": nrm(ks[10], (L, SSM_GROUPS, SSM_GROUP, SSM_STATE), SSM_STATE ** -0.5),
        "ssm_d": nrm(ks[11], (L, D_SSM), 1.0),
        "ssm_w_glu": nrm(ks[12], (L, D_SSM, D_SSM), D_SSM ** -0.5),
        "w_proj_ssm": nrm(ks[13], (L, D_SSM, D_MODEL), D_SSM ** -0.5),
        "w_proj_att": nrm(ks[14], (L, D_ATT, D_MODEL), D_ATT ** -0.5),
        "w_out": nrm(ks[15], (L, D_MODEL, D_MODEL), D_MODEL ** -0.5),
        "g_ffn": 1.0 + nrm(ks[16], (L, D_MODEL), 0.01),
        "peer_w_q": nrm(ks[17], (L, D_MODEL, PEER_HEADS * PEER_QDIM), D_MODEL ** -0.5),
        "peer_keys1": nrm(ks[18], (L, PEER_HEADS, PEER_KEYS, PEER_HALF), PEER_HALF ** -0.5),
        "peer_keys2": nrm(ks[19], (L, PEER_HEADS, PEER_KEYS, PEER_HALF), PEER_HALF ** -0.5),
        "peer_u": nrm(ks[20], (L, PEER_EXPERTS, D_MODEL), D_MODEL ** -0.5),
        "peer_v": nrm(ks[21], (L, PEER_EXPERTS, D_MODEL), PEER_HEADS ** -0.5),
        "g_ple": 1.0 + nrm(ks[22], (L, D_MODEL), 0.01),
        "ple_w_gate": nrm(ks[23], (L, D_MODEL, D_MODEL), D_MODEL ** -0.5),
        "ple_w_proj": nrm(ks[24], (L, D_PLE, D_MODEL), D_PLE ** -0.5),
        "g_final": 1.0 + nrm(ks[25], (D_MODEL,), 0.01),
    }


def reference(x, p, positions, g_mix, w_in, ssm_log_dt, ssm_a_re, ssm_a_im, ssm_b_re, ssm_b_im,
              ssm_c_re, ssm_c_im, ssm_d, ssm_w_glu, w_proj_ssm, w_proj_att, w_out, g_ffn,
              peer_w_q, peer_keys1, peer_keys2, peer_u, peer_v, g_ple, ple_w_gate, ple_w_proj,
              g_final):
    Bsz, S, _ = x.shape
    cos, sin = rotary_tables(positions)
    splits = [D_SSM, D_SSM + D_ATT, D_SSM + 2 * D_ATT, D_SSM + 3 * D_ATT, D_SSM + 3 * D_ATT + D_MODEL]

    def heads(t):
        return t.reshape(Bsz, S, N_HEADS, HEAD_DIM).transpose(0, 2, 1, 3)

    for i in range(DEPTH):
        h = rmsnorm(x, g_mix[i])
        z = h @ w_in[i]
        u_ssm, q, k, v, z_ga, z_gb = jnp.split(z, splits, axis=-1)
        y_a = s5_mixer(u_ssm, ssm_log_dt[i], ssm_a_re[i], ssm_a_im[i], ssm_b_re[i], ssm_b_im[i],
                       ssm_c_re[i], ssm_c_im[i], ssm_d[i], ssm_w_glu[i]) @ w_proj_ssm[i]
        qh = apply_partial_rope(heads(q), cos, sin)
        kh = apply_partial_rope(heads(k), cos, sin)
        att = moba_attention(qh, kh, heads(v))
        y_b = att.transpose(0, 2, 1, 3).reshape(Bsz, S, D_ATT) @ w_proj_att[i]
        merged = jax.nn.sigmoid(z_ga) * y_a + jax.nn.sigmoid(z_gb) * y_b
        x = x + merged @ w_out[i]
        x = x + peer_ffn(rmsnorm(x, g_ffn[i]), peer_w_q[i], peer_keys1[i], peer_keys2[i],
                         peer_u[i], peer_v[i])
        e = p[i] @ ple_w_proj[i]
        x = x + jax.nn.sigmoid(rmsnorm(x, g_ple[i]) @ ple_w_gate[i]) * e
    return rmsnorm(x, g_final)
```

```cpp
#include <hip/hip_runtime.h>
#include <hip/hip_bf16.h>
#include <cstdio>
#include <cstdint>
#include <cmath>
namespace pg8 {
#define PG8_LAS __attribute__((address_space(3)))
typedef unsigned short bf16_t;
typedef short bf16x8 __attribute__((ext_vector_type(8)));
typedef float f32x4 __attribute__((ext_vector_type(4)));
typedef unsigned u32x4 __attribute__((ext_vector_type(4)));
constexpr int BM = 256, BK = 64, HALF = 128, HTB = HALF * BK * 2  , STAGE_BYTES = 8 * HTB, NXCD = 8, WGM = 8;

__host__ __device__ __forceinline__ int lds_byte(int r, int c) { const int st = (r >> 4) * 2 + (c >> 5), rr = r & 15, cc = c & 31, ob = rr * 64 + cc * 2; return st * 1024 + (ob ^ (((ob >> 9) & 1) << 5)); }
__host__ __device__ __forceinline__ void stage_rc(int b, int& R, int& C) { const int st = b / 1024, sb = b % 1024, swz = sb ^ (((sb >> 9) & 1) << 5); R = (st >> 1) * 16 + swz / 64; C = (st & 1) * 32 + (swz % 64) / 2; }
__host__ __device__ __forceinline__ int perm32(int rho) { const int n = rho >> 4, i = rho & 15; return 8 * (i >> 2) + 4 * n + (i & 3); }

struct Unit { int pm, pn; };
struct Gemm { const bf16_t* A; const bf16_t* Bt; int M, N, K; };

struct StaticOrder {
    int nM, nN, nwg, G, c;
    __host__ __device__ void init(int M, int N, int G_, int c_) { nM = M / BM; nN = N / BM; nwg = nM * nN; G = G_; c = c_; }
    __host__ __device__ bool next(int i, Unit& u) const {
        const long L = (long)i * G + c; if (L >= nwg) return false;
        int wgid = (int)L; { const int q = nwg / NXCD, r = nwg % NXCD, xcd = wgid % NXCD, off = wgid / NXCD; wgid = (xcd < r ? xcd * (q + 1) : r * (q + 1) + (xcd - r) * q) + off; }
        const int nig = WGM * nN, gid = wgid / nig, fm = gid * WGM, gsz = (nM - fm) < WGM ? (nM - fm) : WGM;
        u.pm = fm + ((wgid % nig) % gsz); u.pn = (wgid % nig) / gsz; return true;
    }
    __device__ __forceinline__ void a_ready(const Unit&) const {}
    __device__ __forceinline__ void done(const Unit&) const {}
};

__device__ __forceinline__ unsigned cvt_pk_bf16(float lo, float hi) { unsigned r; asm volatile("v_cvt_pk_bf16_f32 %0, %1, %2" : "=v"(r) : "v"(lo), "v"(hi)); return r; }
typedef float f32x2 __attribute__((ext_vector_type(2)));
typedef unsigned u32x2 __attribute__((ext_vector_type(2)));
typedef __bf16 bf16x2_t __attribute__((ext_vector_type(2)));
__device__ __forceinline__ unsigned pkbf(float lo, float hi) { f32x2 v = {lo, hi}; bf16x2_t b = __builtin_convertvector(v, bf16x2_t); return __builtin_bit_cast(unsigned, b); }
__device__ __forceinline__ float bflo(unsigned w) { return __uint_as_float(w << 16); }
__device__ __forceinline__ float bfhi(unsigned w) { return __uint_as_float(w & 0xffff0000u); }
__device__ __forceinline__ unsigned pkf8(float a, float b, float c, float d) {
    a = __builtin_amdgcn_fmed3f(a, -448.f, 448.f); b = __builtin_amdgcn_fmed3f(b, -448.f, 448.f); c = __builtin_amdgcn_fmed3f(c, -448.f, 448.f); d = __builtin_amdgcn_fmed3f(d, -448.f, 448.f);
    int w = __builtin_amdgcn_cvt_pk_fp8_f32(a, b, 0, false); w = __builtin_amdgcn_cvt_pk_fp8_f32(c, d, w, true); return (unsigned)w; }
__device__ __forceinline__ float sigmoidf_(float x) { return __builtin_amdgcn_rcpf(1.0f + __expf(-x)); }
__device__ __forceinline__ float gelu_tanh(float x) { const float t = 1.5957691216057308f * (x + 0.044715f * x * x * x); return x * __builtin_amdgcn_rcpf(1.0f + __expf(-t)); }
__device__ __forceinline__ u32x4 pack8(const f32x4 a, const f32x4 b) { u32x4 w; w.x = pkbf(a[0], a[1]); w.y = pkbf(a[2], a[3]); w.z = pkbf(b[0], b[1]); w.w = pkbf(b[2], b[3]); return w; }
__device__ __forceinline__ void unpack8(const u32x4 w, f32x4& a, f32x4& b) { a = (f32x4){bflo(w.x), bfhi(w.x), bflo(w.y), bfhi(w.y)}; b = (f32x4){bflo(w.z), bfhi(w.z), bflo(w.w), bfhi(w.w)}; }

template <int M> __device__ __forceinline__ float shx(float v, int lane) {
    const int iv = __builtin_bit_cast(int, v); int r;
    if (M == 1) r = __builtin_amdgcn_mov_dpp(iv, 0xB1, 0xf, 0xf, true);
    else if (M == 2) r = __builtin_amdgcn_mov_dpp(iv, 0x4E, 0xf, 0xf, true);
    else if (M == 4) r = __builtin_amdgcn_ds_swizzle(iv, 0x101F);
    else if (M == 8) r = __builtin_amdgcn_ds_swizzle(iv, 0x201F);
    else if (M == 16) r = __builtin_amdgcn_ds_swizzle(iv, 0x401F);
    else r = __builtin_amdgcn_ds_bpermute((lane ^ M) << 2, iv);
    return __builtin_bit_cast(float, r);
}
__device__ __forceinline__ float bperm(float v, int srclane) { return __builtin_bit_cast(float, __builtin_amdgcn_ds_bpermute(srclane << 2, __builtin_bit_cast(int, v))); }
__device__ __forceinline__ int bpermi(int v, int srclane) { return __builtin_amdgcn_ds_bpermute(srclane << 2, v); }
__device__ __forceinline__ int lane_id_opaque() { unsigned m = ~0u; asm volatile("" : "+s"(m)); return (int)__builtin_amdgcn_mbcnt_hi(m, __builtin_amdgcn_mbcnt_lo(m, 0u)); }

#define EPI_IDS() int frq_ = fr | (fq << 4); asm volatile("" : "+v"(frq_)); fr = frq_ & 15; fq = frq_ >> 4; (void)frq_; \
        const int row0 = u.pm * BM + wr * 64 + fr, col0 = u.pn * BM + wc * 64 + 16 * fq; (void)row0; (void)col0
constexpr int CBJ = 8;
__device__ __forceinline__ void store_pair(bf16_t* rowp, long offA, long offB, const u32x4 p0, const u32x4 p1, bool up) {
    u32x4 recv, dA, dB;
#pragma unroll
    for (int k = 0; k < 4; ++k) { const unsigned send = up ? p0[k] : p1[k]; recv[k] = (unsigned)__builtin_amdgcn_update_dpp(0, (int)send, 0x128, 0xf, 0xf, true); dA[k] = up ? recv[k] : p0[k]; dB[k] = up ? p1[k] : recv[k]; }
    *(u32x4*)(rowp + offA) = dA; *(u32x4*)(rowp + offB) = dB;
}
#define EPI_PAIR_OFFS(pitch) const bool up_ = (fr & 8) != 0; const long offA_ = up_ ? (long)8 - 8 * (long)(pitch) : 0, offB_ = up_ ? 8 : 8 * (long)(pitch)

struct EpiPlain {
    static constexpr bool PERM = true, PERM2 = true, AFTER_DRAIN = false;
    bf16_t* O; int ldc;
    __device__ __forceinline__ void operator()(const f32x4 (&acc)[2][2][4][2], const Unit& u, int wr, int wc, int fr, int fq) const {
        EPI_IDS(); EPI_PAIR_OFFS(ldc);
#pragma unroll
        for (int ai = 0; ai < 2; ++ai)
#pragma unroll
            for (int m = 0; m < 4; ++m) { bf16_t* rowp = O + (size_t)(row0 + ai * HALF + m * 16) * ldc + col0;
                store_pair(rowp, offA_, offB_, pack8(acc[ai][0][m][0], acc[ai][0][m][1]), pack8(acc[ai][1][m][0], acc[ai][1][m][1]), up_); }
    }
};

struct EpiWin {
    static constexpr bool PERM = true, PERM2 = true, AFTER_DRAIN = false;
    bf16_t *U, *Q, *K, *V, *SGA, *SGB; float* kmean; const float* rope;
    float qscale;
    __device__ __forceinline__ void operator()(const f32x4 (&acc)[2][2][4][2], const Unit& u, int wr, int wc, int fr, int fq) const {
        EPI_IDS();
        const int pn = u.pn;
        if (pn < 2) {
            const int g = (pn * 256 + wc * 64) / 16 + fq;
#pragma unroll
            for (int ai = 0; ai < 2; ++ai)
#pragma unroll
                for (int m = 0; m < 4; ++m) { const int row = row0 + ai * HALF + m * 16, b = row >> 13, t = row & 8191; bf16_t* up = U + ((size_t)(b * 32 + g) * 8192 + t) * 16;
#pragma unroll
                    for (int bj = 0; bj < 2; ++bj) *(u32x4*)(up + 8 * bj) = pack8(acc[ai][bj][m][0], acc[ai][bj][m][1]); }
        } else if (pn < 6) {
            const bool isq = pn < 4; bf16_t* dst = isq ? Q : K; const int cb = (pn - (isq ? 2 : 4)) * 256 + wc * 64 + 16 * fq;
            const float sc = isq ? qscale : 1.0f;
            float cs[2][8];
#pragma unroll
            for (int bj = 0; bj < 2; ++bj)
#pragma unroll
                for (int i = 0; i < 8; ++i) cs[bj][i] = 0.f;
#pragma unroll
            for (int ai = 0; ai < 2; ++ai)
#pragma unroll
                for (int m = 0; m < 4; ++m) { const int row = row0 + ai * HALF + m * 16;
                    f32x4 v[2][2];
#pragma unroll
                    for (int bj = 0; bj < 2; ++bj) { v[bj][0] = acc[ai][bj][m][0]; v[bj][1] = acc[ai][bj][m][1]; }
                    { const f32x4* cp = (const f32x4*)(rope + (size_t)row * 16);
                      const f32x4 c01 = cp[0], c23 = cp[1], c45 = cp[2], c67 = cp[3];
                      const float co[8] = {c01[0], c01[2], c23[0], c23[2], c45[0], c45[2], c67[0], c67[2]};
                      const float si[8] = {c01[1], c01[3], c23[1], c23[3], c45[1], c45[3], c67[1], c67[3]};
#pragma unroll
                      for (int n = 0; n < 2; ++n)
#pragma unroll
                          for (int e = 0; e < 4; ++e) { const float a = v[0][n][e], b = v[1][n][e];
                              const float ra = a * co[4 * n + e] - b * si[4 * n + e], rb = b * co[4 * n + e] + a * si[4 * n + e];
                              v[0][n][e] = (fq == 0) ? ra : a; v[1][n][e] = (fq == 0) ? rb : b; } }
#pragma unroll
                    for (int bj = 0; bj < 2; ++bj) {
                        if (!isq) {
#pragma unroll
                            for (int n = 0; n < 2; ++n)
#pragma unroll
                                for (int e = 0; e < 4; ++e) cs[bj][4 * n + e] += v[bj][n][e]; } }
                    { EPI_PAIR_OFFS(512); store_pair(dst + (size_t)row * 512 + cb, offA_, offB_, pack8(v[0][0] * sc, v[0][1] * sc), pack8(v[1][0] * sc, v[1][1] * sc), up_); }
                }
            if (!isq) {
#pragma unroll
                for (int bj = 0; bj < 2; ++bj)
#pragma unroll
                    for (int i = 0; i < 8; ++i) { float s = cs[bj][i]; s += shx<1>(s, frq_); s += shx<2>(s, frq_); s += shx<4>(s, frq_); s += shx<8>(s, frq_);
                        if (fr == 0) atomicAdd(kmean + (size_t)u.pm * 512 + cb + bj * CBJ + i, s); }
            }
        } else if (pn < 8) {
            const int cb = (pn - 6) * 256 + wc * 64 + 16 * fq;
#pragma unroll
            for (int ai = 0; ai < 2; ++ai)
#pragma unroll
                for (int m = 0; m < 4; ++m) { const int row = row0 + ai * HALF + m * 16; EPI_PAIR_OFFS(512);
                    store_pair(V + (size_t)row * 512 + cb, offA_, offB_, pack8(acc[ai][0][m][0], acc[ai][0][m][1]), pack8(acc[ai][1][m][0], acc[ai][1][m][1]), up_); }
        } else {
            bf16_t* dst = pn < 12 ? SGA : SGB; const int cb = (pn - (pn < 12 ? 8 : 12)) * 256 + wc * 64 + 16 * fq;
#pragma unroll
            for (int ai = 0; ai < 2; ++ai)
#pragma unroll
                for (int m = 0; m < 4; ++m) { const int row = row0 + ai * HALF + m * 16; u32x4 pk[2]; EPI_PAIR_OFFS(1024);
#pragma unroll
                    for (int bj = 0; bj < 2; ++bj) { f32x4 a = acc[ai][bj][m][0], b = acc[ai][bj][m][1];
#pragma unroll
                        for (int e = 0; e < 4; ++e) { a[e] = sigmoidf_(a[e]); b[e] = sigmoidf_(b[e]); }
                        pk[bj] = pack8(a, b); }
                    store_pair(dst + (size_t)row * 1024 + cb, offA_, offB_, pk[0], pk[1], up_); }
        }
    }
};

struct EpiGlu {
    static constexpr bool PERM = true, PERM2 = true, AFTER_DRAIN = false;
    const bf16_t* YP; bf16_t* YS;
    __device__ __forceinline__ void operator()(const f32x4 (&acc)[2][2][4][2], const Unit& u, int wr, int wc, int fr, int fq) const {
        EPI_IDS();
#pragma unroll
        for (int ai = 0; ai < 2; ++ai)
#pragma unroll
            for (int m = 0; m < 4; ++m) { const size_t off = (size_t)(row0 + ai * HALF + m * 16) * 512 + col0; u32x4 o8;
#pragma unroll
                for (int bj = 0; bj < 2; ++bj) { const u32x4 w = *(const u32x4*)(YP + off + bj * CBJ); f32x4 ya, yb; unpack8(w, ya, yb);
                    f32x4 a = acc[ai][bj][m][0], b = acc[ai][bj][m][1];
#pragma unroll
                    for (int e = 0; e < 4; ++e) { a[e] = ya[e] * sigmoidf_(a[e]); b[e] = yb[e] * sigmoidf_(b[e]); }
                    o8[2 * bj] = pkf8(a[0], a[1], a[2], a[3]); o8[2 * bj + 1] = pkf8(b[0], b[1], b[2], b[3]); }
                *(u32x4*)((unsigned char*)YS + off) = o8; }
    }
};

template <int MODE> struct EpiMerge {
    static constexpr bool PERM = true, PERM2 = true, AFTER_DRAIN = false;
    bf16_t* G; const bf16_t* SG2; unsigned char* M8;
    __device__ __forceinline__ void operator()(const f32x4 (&acc)[2][2][4][2], const Unit& u, int wr, int wc, int fr, int fq) const {
        EPI_IDS();
#pragma unroll
        for (int ai = 0; ai < 2; ++ai)
#pragma unroll
            for (int m = 0; m < 4; ++m) { const size_t off = (size_t)(row0 + ai * HALF + m * 16) * 1024 + col0; u32x4 o8, pk[2]; EPI_PAIR_OFFS(1024);
#pragma unroll
                for (int bj = 0; bj < 2; ++bj) { const u32x4 w = *(const u32x4*)(G + off + bj * CBJ); f32x4 ga, gb; unpack8(w, ga, gb);
                    f32x4 a = acc[ai][bj][m][0], b = acc[ai][bj][m][1];
                    if (MODE == 0) { a = ga * a; b = gb * b; pk[bj] = pack8(a, b); }
                    else { const u32x4 w2 = *(const u32x4*)(SG2 + off + bj * CBJ); f32x4 sa, sb; unpack8(w2, sa, sb); a = ga + sa * a; b = gb + sb * b;
                        o8[2 * bj] = pkf8(a[0], a[1], a[2], a[3]); o8[2 * bj + 1] = pkf8(b[0], b[1], b[2], b[3]); } }
                if (MODE == 1) *(u32x4*)(M8 + off) = o8; else store_pair(G + off, offA_, offB_, pk[0], pk[1], up_); }
    }
};

struct EpiResid {
    static constexpr bool PERM = true, PERM2 = true, AFTER_DRAIN = false;
    const float* X; bf16_t* X1B; float* sumsq;
    __device__ __forceinline__ void operator()(const f32x4 (&acc)[2][2][4][2], const Unit& u, int wr, int wc, int fr, int fq) const {
        EPI_IDS();
#pragma unroll
        for (int ai = 0; ai < 2; ++ai)
#pragma unroll
            for (int m = 0; m < 4; ++m) { const int row = row0 + ai * HALF + m * 16; const size_t off = (size_t)row * 1024 + col0; float ss = 0.f; u32x4 pk[2]; EPI_PAIR_OFFS(1024);
#pragma unroll
                for (int bj = 0; bj < 2; ++bj) { const f32x4 xa = *(const f32x4*)(X + off + bj * CBJ), xb = *(const f32x4*)(X + off + bj * CBJ + 4);
                    const f32x4 a = xa + acc[ai][bj][m][0], b = xb + acc[ai][bj][m][1];
                    pk[bj] = pack8(a, b);
                    ss += (a[0] * a[0] + a[1] * a[1]) + (a[2] * a[2] + a[3] * a[3]) + (b[0] * b[0] + b[1] * b[1]) + (b[2] * b[2] + b[3] * b[3]); }
                store_pair(X1B + off, offA_, offB_, pk[0], pk[1], up_);
                ss += shx<16>(ss, frq_); ss += shx<32>(ss, frq_);
                if (fq == 0) atomicAdd(sumsq + row, ss); }
    }
};

struct EpiScores {
    static constexpr bool PERM = true, PERM2 = true, AFTER_DRAIN = false;
    bf16_t* S; const float* sumsq;
    __device__ __forceinline__ void operator()(const f32x4 (&acc)[2][2][4][2], const Unit& u, int wr, int wc, int fr, int fq) const {
        EPI_IDS(); EPI_PAIR_OFFS(2048);
#pragma unroll
        for (int ai = 0; ai < 2; ++ai)
#pragma unroll
            for (int m = 0; m < 4; ++m) { const int row = row0 + ai * HALF + m * 16; const size_t off = (size_t)row * 2048 + col0;
                const float rs = 1.0f / sqrtf(sumsq[row] * (1.0f / 1024.0f) + 1e-6f);
                store_pair(S + off, offA_, offB_, pack8(acc[ai][0][m][0] * rs, acc[ai][0][m][1] * rs), pack8(acc[ai][1][m][0] * rs, acc[ai][1][m][1] * rs), up_); }
    }
};

struct EpiPle {
    static constexpr bool PERM = true, PERM2 = true, AFTER_DRAIN = false;
    const bf16_t* X2B; bf16_t* E; const float* rs2; float* sumsq;
    __device__ __forceinline__ void operator()(const f32x4 (&acc)[2][2][4][2], const Unit& u, int wr, int wc, int fr, int fq) const {
        EPI_IDS();
#pragma unroll
        for (int ai = 0; ai < 2; ++ai)
#pragma unroll
            for (int m = 0; m < 4; ++m) { const int row = row0 + ai * HALF + m * 16; const size_t off = (size_t)row * 1024 + col0; float ss = 0.f; const float rs = rs2[row]; u32x4 pk[2]; EPI_PAIR_OFFS(1024);
#pragma unroll
                for (int bj = 0; bj < 2; ++bj) { const u32x4 wx = *(const u32x4*)(X2B + off + bj * CBJ); f32x4 xa, xb; unpack8(wx, xa, xb);
                    const u32x4 w = *(const u32x4*)(E + off + bj * CBJ); f32x4 ea, eb; unpack8(w, ea, eb);
                    f32x4 a = acc[ai][bj][m][0], b = acc[ai][bj][m][1];
#pragma unroll
                    for (int e = 0; e < 4; ++e) { a[e] = xa[e] + sigmoidf_(rs * a[e]) * ea[e]; b[e] = xb[e] + sigmoidf_(rs * b[e]) * eb[e]; }
                    pk[bj] = pack8(a, b);
                    ss += (a[0] * a[0] + a[1] * a[1]) + (a[2] * a[2] + a[3] * a[3]) + (b[0] * b[0] + b[1] * b[1]) + (b[2] * b[2] + b[3] * b[3]); }
                store_pair(E + off, offA_, offB_, pk[0], pk[1], up_);
                ss += shx<16>(ss, frq_); ss += shx<32>(ss, frq_);
                if (fq == 0) atomicAdd(sumsq + row, ss); }
    }
};
#undef EPI_IDS
#undef EPI_PAIR_OFFS
typedef int v4i_t __attribute__((ext_vector_type(4)));
constexpr int W8_SHIFT = 6;
template <class Epi, class Sched, bool ALIGN_EPI = false, bool SP2 = false, bool FP8 = false, int KC = 0>
__device__ __forceinline__ void gemm_phase(PG8_LAS unsigned char* lds, const Gemm g, const Sched& S, const Epi& E, const int wave_s) {
    int tid_o = wave_s * 64 + lane_id_opaque(); asm volatile("" : "+v"(tid_o)); const int tid = tid_o, wid = __builtin_amdgcn_readfirstlane(tid >> 6), lane = tid & 63, wr = wid >> 2, wc = wid & 3, fr = lane & 15, fq = lane >> 4;
    const int K = KC ? KC : g.K, nt = FP8 ? K / 128 : K / BK;
    unsigned voffA[2], voffB[2]; int aoff, boff;
#define PG8_LANE_SETUP() do { int t_ = wave_s * 64 + lane_id_opaque(); asm volatile("" : "+v"(t_)); const int l_ = t_ & 63, fr_ = l_ & 15, fq_ = l_ >> 4; \
        _Pragma("unroll") for (int i = 0; i < 2; ++i) { int R, C; stage_rc(t_ * 16 + i * 8192, R, C); const int Rb = Epi::PERM2 ? (64 * (R >> 5) + 16 * ((R >> 2) & 3) + 4 * ((R >> 4) & 1) + (R & 3)) : Epi::PERM ? ((R & ~31) + perm32(R & 31)) : R;     \
            voffA[i] = FP8 ? (unsigned)(R * K + 2 * C) : (unsigned)(R * K + C) * 2u; voffB[i] = FP8 ? (unsigned)(Rb * K + 2 * C) : (unsigned)(Rb * K + C) * 2u; } \
        aoff = lds_byte(wr * 64 + fr_, fq_ * 8); boff = lds_byte(wc * 32 + fr_, fq_ * 8); } while (0)
    PG8_LANE_SETUP();
#if 0
    for (int i = 0; i < 2; ++i) { int R, C; stage_rc(tid * 16 + i * 8192, R, C); const int Rb = Epi::PERM ? ((R & ~31) + perm32(R & 31)) : R;
        voffA[i] = FP8 ? (unsigned)(R * K + 2 * C) : (unsigned)(R * K + C) * 2u; voffB[i] = FP8 ? (unsigned)(Rb * K + 2 * C) : (unsigned)(Rb * K + C) * 2u; }
#endif
    const size_t kstep = (size_t)(BK * 2);
    const size_t hstep = (size_t)HALF * K * (FP8 ? 1 : 2); const size_t hstepB = Epi::PERM2 ? (size_t)8 * K * (FP8 ? 1 : 2) : hstep;
    const size_t tstep = 2 * hstep;
    const unsigned ldsw = (unsigned)wid * 1024u;
#define PG8_SA(b, h) (((b) * 2 + (h)) * HTB)
#define PG8_SB(b, h) ((4 + (b) * 2 + (h)) * HTB)
#define PG8_STAGE(bufoff, gbase, voff) do { const char* gb_ = (const char*)(gbase); asm volatile("" : "+s"(gb_)); _Pragma("unroll") for (int _i = 0; _i < 2; ++_i) \
        __builtin_amdgcn_global_load_lds((const unsigned*)(gb_ + (voff)[_i]), (PG8_LAS unsigned*)(lds + (bufoff) + ldsw + _i * 8192), 16, 0, 0); } while (0)
#define PG8_LDA(dst, b, h) do { _Pragma("unroll") for (int m = 0; m < 4; ++m) _Pragma("unroll") for (int k = 0; k < 2; ++k) dst[m][k] = *(const PG8_LAS bf16x8*)(lds + PG8_SA(b, h) + aoff + m * 2048 + k * 1024); } while (0)
#define PG8_LDB(dst, b, h) do { _Pragma("unroll") for (int n = 0; n < 2; ++n) _Pragma("unroll") for (int k = 0; k < 2; ++k) dst[n][k] = *(const PG8_LAS bf16x8*)(lds + PG8_SB(b, h) + boff + n * 2048 + k * 1024); } while (0)
#define PG8_CAT8(x0, x1) __builtin_shufflevector(__builtin_bit_cast(v4i_t, x0), __builtin_bit_cast(v4i_t, x1), 0, 1, 2, 3, 4, 5, 6, 7)
#define PG8_MMA(ai, bj, At, Bt) do { __builtin_amdgcn_s_setprio(1); _Pragma("unroll") for (int m = 0; m < 4; ++m) _Pragma("unroll") for (int n = 0; n < 2; ++n) { \
        if constexpr (FP8) acc[ai][bj][m][n] = __builtin_amdgcn_mfma_scale_f32_16x16x128_f8f6f4(PG8_CAT8(Bt[n][0], Bt[n][1]), PG8_CAT8(At[m][0], At[m][1]), acc[ai][bj][m][n], 0, 0, 0, 0, 0, 0); \
        else { _Pragma("unroll") for (int k = 0; k < 2; ++k) acc[ai][bj][m][n] = __builtin_amdgcn_mfma_f32_16x16x32_bf16(Bt[n][k], At[m][k], acc[ai][bj][m][n], 0, 0, 0); } } __builtin_amdgcn_s_setprio(0); } while (0)
#define PG8_WAIT_V(n) asm volatile("s_waitcnt vmcnt(" #n ")" ::: "memory")
#define PG8_WAIT_L(n) asm volatile("s_waitcnt lgkmcnt(" #n ")" ::: "memory")
#define PG8_BAR __builtin_amdgcn_s_barrier()
#define PG8_SCHED __builtin_amdgcn_sched_barrier(0)
    Unit cur, nxt; int ui = 0;
    if (!S.next(0, cur)) return;
    f32x4 acc[2][2][4][2];
#pragma unroll
    for (int a = 0; a < 2; ++a)
#pragma unroll
        for (int b = 0; b < 2; ++b)
#pragma unroll
            for (int m = 0; m < 4; ++m)
#pragma unroll
                for (int n = 0; n < 2; ++n) acc[a][b][m][n] = (f32x4){0.f, 0.f, 0.f, 0.f};
    bf16x8 At[4][2], B0[2][2], B1[2][2];
    const char* cA = (const char*)g.A + (size_t)cur.pm * tstep; const char* cB = (const char*)g.Bt + (size_t)cur.pn * tstep;
    S.a_ready(cur);
    if constexpr (SP2) {
        PG8_STAGE(PG8_SB(0, 0), cB, voffB); PG8_STAGE(PG8_SB(0, 1), cB + hstepB, voffB); PG8_STAGE(PG8_SA(0, 0), cA, voffA); PG8_STAGE(PG8_SA(0, 1), cA + hstep, voffA);
        if (wr == 1) PG8_BAR;
        PG8_WAIT_V(2); PG8_BAR;
        PG8_STAGE(PG8_SB(1, 0), cB + kstep, voffB); PG8_STAGE(PG8_SA(1, 0), cA + kstep, voffA); PG8_STAGE(PG8_SB(1, 1), cB + hstepB + kstep, voffB);
        PG8_WAIT_V(6); PG8_BAR;
    } else {
        PG8_STAGE(PG8_SB(0, 0), cB, voffB); PG8_STAGE(PG8_SA(0, 0), cA, voffA); PG8_STAGE(PG8_SB(0, 1), cB + hstepB, voffB); PG8_STAGE(PG8_SA(0, 1), cA + hstep, voffA);
        if (wr == 1) PG8_BAR;
        PG8_WAIT_V(4); PG8_BAR;
        PG8_STAGE(PG8_SB(1, 0), cB + kstep, voffB); PG8_STAGE(PG8_SA(1, 0), cA + kstep, voffA); PG8_STAGE(PG8_SB(1, 1), cB + hstepB + kstep, voffB);
        PG8_WAIT_V(6); PG8_BAR;
    }
    for (;;) {
        const bool has_next = S.next(ui + 1, nxt);
        const char* nA = has_next ? (const char*)g.A + (size_t)nxt.pm * tstep : cA; const char* nB = has_next ? (const char*)g.Bt + (size_t)nxt.pn * tstep : cB;
#pragma nounroll
        for (int t = 0; t < nt; t += 2) {
            const bool last = (t == nt - 2);
            const char* a1 = cA + (size_t)(t + 1) * kstep;
            const char* a2 = last ? nA : cA + (size_t)(t + 2) * kstep; const char* b2 = last ? nB : cB + (size_t)(t + 2) * kstep;
            const char* a3 = a2 + kstep; const char* b3 = b2 + kstep;
            if (last && has_next) S.a_ready(nxt);
            if constexpr (SP2) {
            PG8_LDB(B0, 0, 0); PG8_LDB(B1, 0, 1); PG8_SCHED; PG8_LDA(At, 0, 0); PG8_STAGE(PG8_SA(1, 1), a1 + hstep, voffA);
            PG8_WAIT_V(8); PG8_WAIT_L(0); PG8_BAR; PG8_MMA(0, 0, At, B0); PG8_MMA(0, 1, At, B1); PG8_BAR; PG8_SCHED;
            PG8_LDA(At, 0, 1); PG8_STAGE(PG8_SB(0, 0), b2, voffB); PG8_STAGE(PG8_SB(0, 1), b2 + hstepB, voffB); PG8_STAGE(PG8_SA(0, 0), a2, voffA);
            PG8_WAIT_V(8); PG8_WAIT_L(0); PG8_BAR; PG8_MMA(1, 0, At, B0); PG8_MMA(1, 1, At, B1); PG8_BAR; PG8_SCHED;
            PG8_LDB(B0, 1, 0); PG8_LDB(B1, 1, 1); PG8_SCHED; PG8_LDA(At, 1, 0); PG8_STAGE(PG8_SA(0, 1), a2 + hstep, voffA);
            PG8_WAIT_V(8); PG8_WAIT_L(0); PG8_BAR; PG8_MMA(0, 0, At, B0); PG8_MMA(0, 1, At, B1); PG8_BAR; PG8_SCHED;
            PG8_LDA(At, 1, 1); PG8_STAGE(PG8_SB(1, 0), b3, voffB); PG8_STAGE(PG8_SB(1, 1), b3 + hstepB, voffB); PG8_STAGE(PG8_SA(1, 0), a3, voffA);
            PG8_WAIT_V(8); PG8_WAIT_L(0); PG8_BAR; PG8_MMA(1, 0, At, B0); PG8_MMA(1, 1, At, B1); PG8_BAR; PG8_SCHED;
            } else {
            PG8_LDB(B0, 0, 0); PG8_SCHED; PG8_LDA(At, 0, 0); PG8_STAGE(PG8_SA(1, 1), a1 + hstep, voffA);
            PG8_WAIT_L(8); PG8_BAR; PG8_WAIT_L(0); PG8_MMA(0, 0, At, B0); PG8_BAR; PG8_SCHED;
            PG8_LDB(B1, 0, 1); PG8_STAGE(PG8_SB(0, 0), b2, voffB);
            PG8_BAR; PG8_WAIT_L(0); PG8_MMA(0, 1, At, B1); PG8_BAR;
            PG8_LDA(At, 0, 1); PG8_STAGE(PG8_SA(0, 0), a2, voffA);
            PG8_BAR; PG8_WAIT_L(0); PG8_MMA(1, 0, At, B0); PG8_BAR; PG8_SCHED;
            PG8_STAGE(PG8_SB(0, 1), b2 + hstepB, voffB);
            PG8_WAIT_V(6); PG8_BAR; PG8_MMA(1, 1, At, B1); PG8_BAR;
            PG8_LDB(B0, 1, 0); PG8_SCHED; PG8_LDA(At, 1, 0); PG8_STAGE(PG8_SA(0, 1), a2 + hstep, voffA);
            PG8_WAIT_L(8); PG8_BAR; PG8_WAIT_L(0); PG8_MMA(0, 0, At, B0); PG8_BAR; PG8_SCHED;
            PG8_LDB(B1, 1, 1); PG8_STAGE(PG8_SB(1, 0), b3, voffB);
            PG8_BAR; PG8_WAIT_L(0); PG8_MMA(0, 1, At, B1); PG8_BAR;
            PG8_LDA(At, 1, 1); PG8_STAGE(PG8_SA(1, 0), a3, voffA);
            PG8_BAR; PG8_WAIT_L(0); PG8_MMA(1, 0, At, B0); PG8_BAR; PG8_SCHED;
            PG8_STAGE(PG8_SB(1, 1), b3 + hstepB, voffB);
            PG8_WAIT_V(6); PG8_BAR; PG8_MMA(1, 1, At, B1); PG8_BAR;
            }
        }
        if constexpr (ALIGN_EPI) { if (wr == 0) PG8_BAR; }
        if constexpr (FP8) {
#pragma unroll
            for (int a = 0; a < 2; ++a)
#pragma unroll
                for (int b = 0; b < 2; ++b)
#pragma unroll
                    for (int m = 0; m < 4; ++m)
#pragma unroll
                        for (int n = 0; n < 2; ++n) acc[a][b][m][n] *= (1.0f / (float)(1 << W8_SHIFT)); }
        if constexpr (!Epi::AFTER_DRAIN) { E(acc, cur, wr, wc, fr, fq); S.done(cur); }
        if (!has_next) break;
#pragma unroll
        for (int a = 0; a < 2; ++a)
#pragma unroll
            for (int b = 0; b < 2; ++b)
#pragma unroll
                for (int m = 0; m < 4; ++m)
#pragma unroll
                    for (int n = 0; n < 2; ++n) acc[a][b][m][n] = (f32x4){0.f, 0.f, 0.f, 0.f};
        cur = nxt; cA = nA; cB = nB; ++ui;
        PG8_LANE_SETUP();
        if constexpr (ALIGN_EPI) { if (wr == 1) PG8_BAR; }
    }
    PG8_WAIT_V(0);
    if constexpr (!ALIGN_EPI) { if (wr == 0) PG8_BAR; }
    PG8_BAR;
    if constexpr (Epi::AFTER_DRAIN) { E.fused(acc, cur, wr, wc, fr, fq, lds, wid, lane); S.done(cur); }
#undef PG8_SA
#undef PG8_SB
#undef PG8_STAGE
#undef PG8_LDA
#undef PG8_LDB
#undef PG8_LANE_SETUP
#undef PG8_MMA
#undef PG8_CAT8
#undef PG8_WAIT_V
#undef PG8_WAIT_L
#undef PG8_BAR
#undef PG8_SCHED
}
}

#include <hip/hip_bf16.h>
namespace moba {
using bf16=__hip_bfloat16;
using bf16x8=__attribute__((ext_vector_type(8)))short;
using s16x4=__attribute__((ext_vector_type(4)))short;
using f32x16=__attribute__((ext_vector_type(16)))float;
using u32x4=__attribute__((ext_vector_type(4)))unsigned;
using f32x4_m=__attribute__((ext_vector_type(4)))float;
constexpr int BATCH=4,NHEAD=8,SEQ=8192,D=64,DM=NHEAD*D;
constexpr int NW=8,QBLK=32,QB=QBLK*NW,KVBLK=64,NQB=SEQ/QB;
constexpr int ATTN_PITCH=DM, ATTN_UNIT_ROWS=QB;
__device__ __forceinline__ int crow(int r,int hi){return (r&3)+8*(r>>2)+4*hi;}
#define SBAR() __builtin_amdgcn_sched_barrier(0)
__device__ __forceinline__ void cmask(f32x16&p0,f32x16&p1,int jb,int qrel,int hi){
  const float NEG=-INFINITY; int kb=64*jb+4*hi;
  #pragma unroll
  for(int r=0;r<16;++r){int kv=kb+(r&3)+8*(r>>2); if(kv>qrel)p0[r]=NEG; if(kv+32>qrel)p1[r]=NEG;}
}

constexpr int NSLOT=3, SLOTB=8192;
constexpr int LDS_K=0, LDS_V=NSLOT*SLOTB, LDS_WS=2*NSLOT*SLOTB, LDS_OST=LDS_WS+NW*64*4, LDS_BYTES=LDS_OST+NW*4096;
constexpr float C2=0.125f*1.4426950408889634f;
__device__ __forceinline__ void glds16(const void*gsrc,unsigned lds_dst){unsigned keep;
  asm volatile("s_mov_b32 %0, m0\n\ts_mov_b32 m0, %2\n\ts_nop 0\n\tglobal_load_lds_dwordx4 %1, off\n\ts_mov_b32 m0, %0":"=&s"(keep):"v"(gsrc),"s"(lds_dst):"memory");}
__device__ __forceinline__ float max3f(float a,float b,float c){float r;asm("v_max3_f32 %0, %1, %2, %3":"=v"(r):"v"(a),"v"(b),"v"(c));return r;}
__device__ __forceinline__ float max2f(float a,float b){float r;asm("v_max_f32_e32 %0, %1, %2":"=v"(r):"v"(a),"v"(b));return r;}
__device__ __forceinline__ float fadd_s(float a,float b){float r;asm("v_add_f32_e32 %0, %1, %2":"=v"(r):"v"(a),"v"(b));return r;}
__device__ __forceinline__ float fsub_s(float a,float b){float r;asm("v_sub_f32_e32 %0, %1, %2":"=v"(r):"v"(a),"v"(b));return r;}
typedef float f32x2_t __attribute__((ext_vector_type(2))); typedef __bf16 bf16x2_t __attribute__((ext_vector_type(2)));
__device__ __forceinline__ unsigned cvtpk_s(float lo,float hi){f32x2_t v={lo,hi};bf16x2_t b=__builtin_convertvector(v,bf16x2_t);return __builtin_bit_cast(unsigned,b);}
#define WAIT_BAR(N) asm volatile("s_waitcnt vmcnt(" #N ") lgkmcnt(0)\n\ts_barrier":::"memory")

__device__ __forceinline__ void qkt(f32x16&p0,f32x16&p1,const char*Kslot,const bf16x8*qr,const f32x16&negm,int r32,int hi){
  const char*kb=Kslot+hi*1024+r32*16;
  #pragma unroll
  for(int d0=0;d0<4;++d0){
    const bf16x8 b0=*reinterpret_cast<const bf16x8*>(kb+d0*2048);
    const bf16x8 b1=*reinterpret_cast<const bf16x8*>(kb+d0*2048+512);
    if(d0==0){p0=__builtin_amdgcn_mfma_f32_32x32x16_bf16(b0,qr[0],negm,0,0,0);p1=__builtin_amdgcn_mfma_f32_32x32x16_bf16(b1,qr[0],negm,0,0,0);}
    else{p0=__builtin_amdgcn_mfma_f32_32x32x16_bf16(b0,qr[d0],p0,0,0,0);p1=__builtin_amdgcn_mfma_f32_32x32x16_bf16(b1,qr[d0],p1,0,0,0);}}
}
typedef __attribute__((address_space(3))) const char* lds_cptr;
typedef short v4i16_t __attribute__((ext_vector_type(4)));
__device__ __forceinline__ void kload8(bf16x8*kf,lds_cptr kp){
  kf[0]=*(const __attribute__((address_space(3))) bf16x8*)(kp);      kf[1]=*(const __attribute__((address_space(3))) bf16x8*)(kp+512);
  kf[2]=*(const __attribute__((address_space(3))) bf16x8*)(kp+2048); kf[3]=*(const __attribute__((address_space(3))) bf16x8*)(kp+2560);
  kf[4]=*(const __attribute__((address_space(3))) bf16x8*)(kp+4096); kf[5]=*(const __attribute__((address_space(3))) bf16x8*)(kp+4608);
  kf[6]=*(const __attribute__((address_space(3))) bf16x8*)(kp+6144); kf[7]=*(const __attribute__((address_space(3))) bf16x8*)(kp+6656);
}
__device__ __forceinline__ void kload2(bf16x8*kf,lds_cptr kp,int j){ kf[2*j]=*(const __attribute__((address_space(3))) bf16x8*)(kp+j*2048); kf[2*j+1]=*(const __attribute__((address_space(3))) bf16x8*)(kp+j*2048+512); }
__device__ __forceinline__ s16x4 vtr(lds_cptr p){ return __builtin_bit_cast(s16x4,__builtin_amdgcn_ds_read_tr16_b64_v4i16((__attribute__((address_space(3))) v4i16_t*)p)); }
__device__ __forceinline__ float rowmax(const f32x16&p0,const f32x16&p1){
  float a=max3f(p0[0],p0[1],p1[0]),b=max3f(p0[2],p0[3],p1[1]);a=max3f(a,p1[2],p1[3]);
  #pragma unroll
  for(int r=4;r<16;r+=4){a=max3f(a,p0[r],p0[r+1]);b=max3f(b,p0[r+2],p0[r+3]);a=max3f(a,p1[r],p1[r+1]);b=max3f(b,p1[r+2],p1[r+3]);}
  const float m=max2f(a,b);
  auto rr=__builtin_amdgcn_permlane32_swap(__float_as_uint(m),__float_as_uint(m),false,false);
  return max2f(__uint_as_float(rr[0]),__uint_as_float(rr[1]));
}
__device__ __forceinline__ void pv(f32x16*o,int vb,bf16x8 pa0,bf16x8 pa1,bf16x8 pa2,bf16x8 pa3){
  #pragma unroll
  for(int d0=0;d0<2;++d0){s16x4 lo[4],hi[4];
    #pragma unroll
    for(int ks=0;ks<4;++ks){
      asm volatile("ds_read_b64_tr_b16 %0,%1 offset:%c2":"=&v"(lo[ks]):"v"(vb),"i"(d0*4096+ks*1024):"memory");
      asm volatile("ds_read_b64_tr_b16 %0,%1 offset:%c2":"=&v"(hi[ks]):"v"(vb),"i"(d0*4096+ks*1024+512):"memory");}
    asm volatile("s_waitcnt lgkmcnt(0)":::"memory");SBAR();
    #define PK(k) (bf16x8){lo[k][0],lo[k][1],lo[k][2],lo[k][3],hi[k][0],hi[k][1],hi[k][2],hi[k][3]}
    o[d0]=__builtin_amdgcn_mfma_f32_32x32x16_bf16(pa0,PK(0),o[d0],0,0,0);
    o[d0]=__builtin_amdgcn_mfma_f32_32x32x16_bf16(pa1,PK(1),o[d0],0,0,0);
    o[d0]=__builtin_amdgcn_mfma_f32_32x32x16_bf16(pa2,PK(2),o[d0],0,0,0);
    o[d0]=__builtin_amdgcn_mfma_f32_32x32x16_bf16(pa3,PK(3),o[d0],0,0,0);
    #undef PK
  }
}

#ifndef ATTN_STORE16
#define ATTN_STORE16(p,v) (*(u32x4*)(p)=(v))
#endif
constexpr int QIDX_OFF=86016;
template<int THRL,bool CAUSAL> __device__ __forceinline__ void attn_unit(int b,int h,int kvb,int qoff,const bf16*Q,const bf16*K,const bf16*V,bf16*PART,float*LSE,bf16*O,char*shm,const int wave_s){
  int tid_o=wave_s*64+pg8::lane_id_opaque(); asm volatile("":"+v"(tid_o)); const int tid=tid_o,lane=tid&63,r32=lane&31,hi=lane>>5; const int wid=__builtin_amdgcn_readfirstlane(tid>>6);
  const long rowbase=(long)b*SEQ; const int bh=b*NHEAD+h;
  const __attribute__((address_space(3))) int*qlist=(const __attribute__((address_space(3))) int*)((lds_cptr)shm+qoff);
  const int qent=CAUSAL?((kvb*QB+wid*QBLK+r32)|(3<<16)):qlist[wid*QBLK+r32]; const int qrow=qent<0?kvb*QB:(qent&0xffff);
  const bf16*Qw=Q+(rowbase+qrow)*DM+h*D;
  const bf16*Kh=K+(rowbase+(long)kvb*QB)*DM+h*D,*Vh=V+(rowbase+(long)kvb*QB)*DM+h*D;
  const unsigned lds0=(unsigned)(uintptr_t)shm;
  float*wsf=(float*)(shm+LDS_WS)+wid*64;
  const bf16*ksrc=Kh+(long)lane*DM+wid*8;
  const bf16*vsrc=Vh+(long)(16*(wid&3)+(lane>>2))*DM+(wid>>2)*32+(lane&3)*8;
  const unsigned kdst=lds0+LDS_K+wid*1024, vdst=lds0+LDS_V+wid*1024;
  #define DMA_K(t,slot) glds16(ksrc+(long)(t)*KVBLK*DM,(unsigned)__builtin_amdgcn_readfirstlane(kdst+(slot)))
  #define DMA_V(t,slot) glds16(vsrc+(long)(t)*KVBLK*DM,(unsigned)__builtin_amdgcn_readfirstlane(vdst+(slot)))
  const int vb0=(int)(lds0+LDS_V)+((lane>>4)&1)*32+(lane&3)*8+(4*hi+((lane&15)>>2))*64;
  const char*Kbase=shm+LDS_K; bf16x8 kf[8];
  const lds_cptr shm3=(lds_cptr)shm; const lds_cptr kp0=shm3+LDS_K+hi*1024+r32*16; const lds_cptr vp0=shm3+LDS_V+((lane>>4)&1)*32+(lane&3)*8+(4*hi+((lane&15)>>2))*64;
  constexpr int NT=4;
  DMA_K(0,0);DMA_V(0,0);DMA_K(1,SLOTB);
  bf16x8 qr[4];
  #pragma unroll
  for(int d0=0;d0<4;++d0)qr[d0]=*reinterpret_cast<const bf16x8*>(&Qw[d0*16+hi*8]);
  float mhat=0.f,l_reg=0.f;f32x16 o[2];o[0]=f32x16{};o[1]=f32x16{};f32x16 negm=f32x16{};asm volatile("":"+v"(negm));
  const int qrel=wid*QBLK+r32;
  #define CMASK(P0,P1,t) do{ if(CAUSAL){int jb_=(t)-(NT-4); if(jb_>=0)cmask(P0,P1,jb_,qrel,hi);} }while(0)
  bool resc=false;
  #define START(P0,P1) do{ const float rm=rowmax(P0,P1); resc=false; \
    { const float dl=__builtin_fmaxf(rm,0.f); mhat=fadd_s(mhat,dl); \
      _Pragma("unroll") for(int r=0;r<16;++r){P0[r]=fsub_s(P0[r],dl);P1[r]=fsub_s(P1[r],dl);} \
      _Pragma("unroll") for(int r=0;r<16;++r)negm[r]=-mhat; asm volatile("":"+v"(negm)); } \
    _Pragma("unroll") for(int r=0;r<16;++r)P0[r]=__builtin_amdgcn_exp2f(P0[r]); }while(0)
  #define RESC() do{ if(resc){ asm volatile("s_waitcnt lgkmcnt(0)":::"memory"); \
      _Pragma("unroll") for(int d_=0;d_<2;++d_) _Pragma("unroll") for(int r=0;r<16;++r)o[d_][r]*=wsf[crow(r,hi)]; } }while(0)
  f32x16 pA0,pA1,pB0,pB1;
  int sl_prev=0,sl_cur=0,sl_next=SLOTB;
  #define ROT() do{sl_prev=sl_cur;sl_cur=sl_next;sl_next=(sl_next==(NSLOT-1)*SLOTB)?0:sl_next+SLOTB;}while(0)
  DMA_K(2,2*SLOTB);
  WAIT_BAR(3);
  qkt(pA0,pA1,Kbase,qr,negm,r32,hi);asm volatile("s_nop 15\n\ts_nop 7":"+v"(pA0),"+v"(pA1));CMASK(pA0,pA1,0);
  START(pA0,pA1);
  _Pragma("unroll") for(int r=0;r<16;++r)pA1[r]=__builtin_amdgcn_exp2f(pA1[r]);
  WAIT_BAR(0);
  DMA_K(3,0);DMA_V(1,SLOTB);
  ROT();
  kload8(kf,kp0+sl_cur);
  WAIT_BAR(2);
  s16x4 vlo[8],vhi[8]; u32x4 pw0,pw1,pw2,pw3;
  #define PKW(P,B) cvtpk_s(P[B],P[B+1])
  #define PAF(k) __builtin_bit_cast(bf16x8,pw##k)
  #define VFR(i) (bf16x8){vlo[i][0],vlo[i][1],vlo[i][2],vlo[i][3],vhi[i][0],vhi[i][1],vhi[i][2],vhi[i][3]}
  #define PIN(x) asm volatile("":"+v"(x))
  #define MX3(a,b,c) __builtin_fmaxf(__builtin_fmaxf((a),(b)),(c))
  #define GAPA(MF,A0,A1,A2,A3,W0,W1,PW) do{ MF; sacc+=A0; sacc+=A1; sacc+=A2; sacc+=A3; PIN(sacc); W0; W1; PIN(PW); SBAR(); }while(0)
  #define EX(v) __builtin_amdgcn_exp2f(v)
  #define GAPB(MF,X,B) do{ MF; X[B]=EX(X[B]); X[B+1]=EX(X[B+1]); X[B+2]=EX(X[B+2]); X[B+3]=EX(X[B+3]); PIN(X); SBAR(); }while(0)
  #define VRD(i) do{ vlo[i]=vtr(vp_+(((i)>>2)*4096+((i)&3)*1024)); vhi[i]=vtr(vp_+(((i)>>2)*4096+((i)&3)*1024+512)); }while(0)
  #define KRD(G,j) do{ if(G){ kload2(kf,kp0+sl_next,j); SBAR(); } }while(0)
  #define STEP(C0,C1,P0,P1,t,GK,GV,GL) do{ SBAR(); \
    const lds_cptr vp_=vp0+sl_prev; \
    VRD(0); SBAR(); float sacc=(P0[0]+P0[1]); \
    GAPA(C0=__builtin_amdgcn_mfma_f32_32x32x16_bf16(kf[0],qr[0],negm,0,0,0), P0[2],P0[3],P0[4],P0[5],     pw0[0]=PKW(P0,0), pw0[1]=PKW(P0,2), pw0); \
    VRD(4); SBAR(); GAPA(C1=__builtin_amdgcn_mfma_f32_32x32x16_bf16(kf[1],qr[0],negm,0,0,0), P0[6],P0[7],P0[8],P0[9],     pw0[2]=PKW(P0,4), pw0[3]=PKW(P0,6), pw0); \
    VRD(1); SBAR(); GAPA(C0=__builtin_amdgcn_mfma_f32_32x32x16_bf16(kf[2],qr[1],C0,0,0,0),   P0[10],P0[11],P0[12],P0[13], pw1[0]=PKW(P0,8), pw1[1]=PKW(P0,10), pw1); \
    VRD(5); SBAR(); GAPA(C1=__builtin_amdgcn_mfma_f32_32x32x16_bf16(kf[3],qr[1],C1,0,0,0),   P0[14],P0[15],P1[0],P1[1],   pw1[2]=PKW(P0,12),pw1[3]=PKW(P0,14), pw1); \
    VRD(2); SBAR(); GAPA(C0=__builtin_amdgcn_mfma_f32_32x32x16_bf16(kf[4],qr[2],C0,0,0,0),   P1[2],P1[3],P1[4],P1[5],     pw2[0]=PKW(P1,0), pw2[1]=PKW(P1,2), pw2); \
    VRD(6); SBAR(); GAPA(C1=__builtin_amdgcn_mfma_f32_32x32x16_bf16(kf[5],qr[2],C1,0,0,0),   P1[6],P1[7],P1[8],P1[9],     pw2[2]=PKW(P1,4), pw2[3]=PKW(P1,6), pw2); \
    VRD(3); SBAR(); GAPA(C0=__builtin_amdgcn_mfma_f32_32x32x16_bf16(kf[6],qr[3],C0,0,0,0),   P1[10],P1[11],P1[12],P1[13], pw3[0]=PKW(P1,8), pw3[1]=PKW(P1,10), pw3); \
    VRD(7); SBAR(); GAPA(C1=__builtin_amdgcn_mfma_f32_32x32x16_bf16(kf[7],qr[3],C1,0,0,0),   P1[14],P1[15],0.f,0.f,       pw3[2]=PKW(P1,12),pw3[3]=PKW(P1,14), pw3); \
    l_reg+=sacc; \
    if(GK){DMA_K((t)+3,sl_cur);} if(GV){DMA_V((t)+1,sl_next);} \
    CMASK(C0,C1,t); \
    { float a=MX3(C0[0],C0[1],C1[0]),b=MX3(C0[2],C0[3],C1[1]); a=MX3(a,C1[2],C1[3]); \
      _Pragma("unroll") for(int r=4;r<16;r+=4){a=MX3(a,C0[r],C0[r+1]);b=MX3(b,C0[r+2],C0[r+3]);a=MX3(a,C1[r],C1[r+1]);b=MX3(b,C1[r+2],C1[r+3]);} \
      float rm=__builtin_fmaxf(a,b); { auto rr=__builtin_amdgcn_permlane32_swap(__float_as_uint(rm),__float_as_uint(rm),false,false); rm=__builtin_fmaxf(__uint_as_float(rr[0]),__uint_as_float(rr[1])); } \
      resc=false; \
      if(__builtin_expect(__any(rm>(float)THRL),0)){ const float dl=__builtin_fmaxf(rm,0.f); mhat+=dl; \
        _Pragma("unroll") for(int r=0;r<16;++r){C0[r]-=dl;C1[r]-=dl;} \
        _Pragma("unroll") for(int r=0;r<16;++r)negm[r]=-mhat; asm volatile("":"+v"(negm)); \
        const float f=__builtin_amdgcn_exp2f(-dl); l_reg*=f; if(hi==0)wsf[r32]=f; resc=true; } } \
    SBAR(); \
    GAPB(o[0]=__builtin_amdgcn_mfma_f32_32x32x16_bf16(PAF(0),VFR(0),o[0],0,0,0), C0,0); \
    GAPB(o[1]=__builtin_amdgcn_mfma_f32_32x32x16_bf16(PAF(0),VFR(4),o[1],0,0,0), C0,4); \
    KRD(GL,0); GAPB(o[0]=__builtin_amdgcn_mfma_f32_32x32x16_bf16(PAF(1),VFR(1),o[0],0,0,0), C0,8); \
    KRD(GL,1); GAPB(o[1]=__builtin_amdgcn_mfma_f32_32x32x16_bf16(PAF(1),VFR(5),o[1],0,0,0), C0,12); \
    KRD(GL,2); GAPB(o[0]=__builtin_amdgcn_mfma_f32_32x32x16_bf16(PAF(2),VFR(2),o[0],0,0,0), C1,0); \
    KRD(GL,3); GAPB(o[1]=__builtin_amdgcn_mfma_f32_32x32x16_bf16(PAF(2),VFR(6),o[1],0,0,0), C1,4); \
    GAPB(o[0]=__builtin_amdgcn_mfma_f32_32x32x16_bf16(PAF(3),VFR(3),o[0],0,0,0), C1,8); \
    GAPB(o[1]=__builtin_amdgcn_mfma_f32_32x32x16_bf16(PAF(3),VFR(7),o[1],0,0,0), C1,12); \
    }while(0)
  int t=1;
  #undef CMASK
  #define CMASK(P0,P1,t) do{}while(0)
  for(;t+5<NT;t+=2){
    STEP(pB0,pB1,pA0,pA1,t,true,true,true);     WAIT_BAR(2); RESC(); ROT();
    STEP(pA0,pA1,pB0,pB1,t+1,true,true,true);   WAIT_BAR(2); RESC(); ROT();
  }
  #undef CMASK
  #define CMASK(P0,P1,t) do{ if(CAUSAL){int jb_=(t)-(NT-4); if(jb_>=0)cmask(P0,P1,jb_,qrel,hi);} }while(0)
  #define ENDW(tt) do{ if((tt)+3<NT){WAIT_BAR(2);} else if((tt)+2<NT){WAIT_BAR(1);} else {WAIT_BAR(0);} }while(0)
  for(;t+1<NT;t+=2){
    STEP(pB0,pB1,pA0,pA1,t,(t+3<NT),(t+1<NT),(t+1<NT));       ENDW(t);   RESC(); ROT();
    STEP(pA0,pA1,pB0,pB1,t+1,(t+4<NT),(t+2<NT),(t+2<NT));     ENDW(t+1); RESC(); ROT();
  }
  STEP(pB0,pB1,pA0,pA1,NT-1,false,false,false); RESC();
  { float sacc=pB0[0]+pB0[1]; _Pragma("unroll") for(int r=2;r<16;++r)sacc+=pB0[r]; _Pragma("unroll") for(int r=0;r<16;++r)sacc+=pB1[r]; l_reg+=sacc;
    pw0=(u32x4){PKW(pB0,0),PKW(pB0,2),PKW(pB0,4),PKW(pB0,6)};pw1=(u32x4){PKW(pB0,8),PKW(pB0,10),PKW(pB0,12),PKW(pB0,14)};pw2=(u32x4){PKW(pB1,0),PKW(pB1,2),PKW(pB1,4),PKW(pB1,6)};pw3=(u32x4){PKW(pB1,8),PKW(pB1,10),PKW(pB1,12),PKW(pB1,14)};
    SBAR(); pv(o,vb0+sl_cur,PAF(0),PAF(1),PAF(2),PAF(3)); }
  #undef PKW
  #undef PAF
  #undef VFR
  #undef PIN
  #undef MX3
  #undef GAPA
  #undef GAPB
  #undef EX
  #undef VRD
  #undef KRD
  #undef STEP
  #undef ENDW
  f32x4_m pls[4]; u32x4 ppv[4][3];
  if(CAUSAL){
    _Pragma("unroll") for(int i=0;i<4;++i){ const size_t rid=(size_t)bh*SEQ+kvb*QB+wid*QBLK+i*8+(lane>>3); pls[i]=*(const f32x4_m*)(LSE+rid*4);
      _Pragma("unroll") for(int s_=0;s_<3;++s_) ppv[i][s_]=*(const u32x4*)(PART+(rid*4+s_)*64+(lane&7)*8); } }
  {auto rr=__builtin_amdgcn_permlane32_swap(__float_as_uint(l_reg),__float_as_uint(l_reg),false,false);l_reg=__uint_as_float(rr[0])+__uint_as_float(rr[1]);}
  if(hi==0)wsf[32+r32]=l_reg;asm volatile("s_waitcnt lgkmcnt(0)":::"memory");
  float rli[16];
  #pragma unroll
  for(int r=0;r<16;++r)rli[r]=__builtin_amdgcn_rcpf(wsf[32+crow(r,hi)]);
  if(CAUSAL){ if(hi==0) wsf[r32]=mhat+__builtin_amdgcn_logf(l_reg); }
  else if(hi==0&&qent>=0) LSE[((size_t)bh*SEQ+qrow)*4+(qent>>16)]=mhat+__builtin_amdgcn_logf(l_reg);
  { bf16*stg=(bf16*)(shm+LDS_OST)+wid*2048;
    #pragma unroll
    for(int r=0;r<16;++r){const int orow=crow(r,hi);
      #pragma unroll
      for(int d0=0;d0<2;++d0)stg[orow*64+d0*32+r32]=__float2bfloat16(o[d0][r]*rli[r]);}
    asm volatile("s_waitcnt lgkmcnt(0)":::"memory");
    #pragma unroll
    for(int i=0;i<4;++i){const int row=i*8+(lane>>3),ch=lane&7; const u32x4 v=*(const u32x4*)(stg+row*64+ch*8); if(CAUSAL){ const int qr_=kvb*QB+wid*QBLK+row; const float lown=wsf[row]; const f32x4_m ls=pls[i];
        const float L=__builtin_fmaxf(__builtin_fmaxf(lown,ls[0]),__builtin_fmaxf(ls[1],ls[2]));
        const float wo=__builtin_amdgcn_exp2f(lown-L),w0=__builtin_amdgcn_exp2f(ls[0]-L),w1=__builtin_amdgcn_exp2f(ls[1]-L),w2=__builtin_amdgcn_exp2f(ls[2]-L); const float inv=__builtin_amdgcn_rcpf(wo+w0+w1+w2);
        float ac[8]; { const float ww=wo*inv; ac[0]=ww*__uint_as_float(v.x<<16); ac[1]=ww*__uint_as_float(v.x&0xffff0000u); ac[2]=ww*__uint_as_float(v.y<<16); ac[3]=ww*__uint_as_float(v.y&0xffff0000u);
          ac[4]=ww*__uint_as_float(v.z<<16); ac[5]=ww*__uint_as_float(v.z&0xffff0000u); ac[6]=ww*__uint_as_float(v.w<<16); ac[7]=ww*__uint_as_float(v.w&0xffff0000u); }
        _Pragma("unroll") for(int s_=0;s_<3;++s_){ const float ws_=(s_==0?w0:s_==1?w1:w2)*inv; const bool on_=ws_>0.f; u32x4 pv_=ppv[i][s_]; pv_.x=on_?pv_.x:0u; pv_.y=on_?pv_.y:0u; pv_.z=on_?pv_.z:0u; pv_.w=on_?pv_.w:0u;
          ac[0]+=ws_*__uint_as_float(pv_.x<<16); ac[1]+=ws_*__uint_as_float(pv_.x&0xffff0000u); ac[2]+=ws_*__uint_as_float(pv_.y<<16); ac[3]+=ws_*__uint_as_float(pv_.y&0xffff0000u);
          ac[4]+=ws_*__uint_as_float(pv_.z<<16); ac[5]+=ws_*__uint_as_float(pv_.z&0xffff0000u); ac[6]+=ws_*__uint_as_float(pv_.w<<16); ac[7]+=ws_*__uint_as_float(pv_.w&0xffff0000u); }
        pg8::u32x2 ov; ov.x=pg8::pkf8(ac[0],ac[1],ac[2],ac[3]); ov.y=pg8::pkf8(ac[4],ac[5],ac[6],ac[7]);
        *(pg8::u32x2*)((unsigned char*)O+(rowbase+qr_)*DM+h*D+ch*8)=ov; }
      else {const int qe=qlist[wid*QBLK+row]; if(qe>=0)ATTN_STORE16(PART+(((size_t)bh*SEQ+(qe&0xffff))*4+(qe>>16))*64+ch*8,v);}} }
  asm volatile("s_waitcnt lgkmcnt(0)\n\ts_barrier":::"memory");
  #undef DMA_K
  #undef DMA_V
  #undef CMASK
  #undef START
  #undef RESC
  #undef ROT
}
constexpr int ATTN_LDS_BYTES=LDS_BYTES;

typedef __attribute__((address_space(3))) float lds_f; typedef __attribute__((address_space(3))) unsigned lds_u; typedef __attribute__((address_space(3))) int lds_i; typedef __attribute__((address_space(3))) unsigned short lds_h;
typedef __attribute__((ext_vector_type(4))) float f4_t;
constexpr int SEL_KM = 0, SEL_GT = 8192, SEL_SUB = SEL_GT + 256 * 33 * 4, SEL_CNT = SEL_SUB + 32 * 256 * 2, SEL_END = SEL_CNT + 128;
constexpr int UP_OFF = 88064, QP_OFF = UP_OFF + 1040 * 4, UI_OFF = QP_OFF + 8 * 36 * 4, QL_OFF = 94208, QL_MAX = 32;
static_assert(UI_OFF + 128 <= QL_OFF && QL_OFF + QL_MAX * 1024 <= 131072 && QIDX_OFF + 1024 <= UP_OFF, "moba LDS map");

constexpr int SEL_HALF = 59392;
static_assert(SEL_END <= SEL_HALF && 2 * SEL_HALF <= 131072, "selection LDS map");
__device__ __forceinline__ void select_pair(int uA, int uB, const bf16* Q, const float* kmean, unsigned short* SUB, unsigned* CNT, float* LSE, char* shm, int tid) {
    const int half = tid >> 8, lt = tid & 255, u = half ? uB : uA;
    const int bh = u >> 5, qb = u & 31, b = bh / NHEAD, h = bh % NHEAD;
    const lds_cptr base = (lds_cptr)shm + half * SEL_HALF;
    lds_h* sub = (lds_h*)(base + SEL_SUB); lds_u* cnt = (lds_u*)(base + SEL_CNT);
    const long rowbase = (long)b * SEQ; const int q0 = qb * QB;
    if (lt < 32) cnt[lt] = 0u;
    const int lane = lt & 63, wq = lt >> 6, r32 = lane & 31, hi = lane >> 5;
    bf16x8 af[4];
#pragma unroll
    for (int kk = 0; kk < 4; ++kk) { const float* kp = kmean + ((size_t)(b * 32 + r32)) * 512 + h * 64 + 16 * kk + 8 * hi; const f4_t k0 = *(const f4_t*)kp, k1 = *(const f4_t*)(kp + 4);
        const pg8::u32x4 w = pg8::pack8(__builtin_bit_cast(pg8::f32x4, k0), __builtin_bit_cast(pg8::f32x4, k1)); af[kk] = __builtin_bit_cast(bf16x8, w); }
    __syncthreads();
#pragma unroll
    for (int c = 0; c < 2; ++c) {
        const int ql = 64 * wq + 32 * c + r32;
        const bf16* qp = Q + (rowbase + q0 + ql) * DM + h * D + 8 * hi;
        f32x16 g = f32x16{};
#pragma unroll
        for (int kk = 0; kk < 4; ++kk) { const bf16x8 bq = *reinterpret_cast<const bf16x8*>(qp + 16 * kk); g = __builtin_amdgcn_mfma_f32_32x32x16_bf16(af[kk], bq, g, 0, 0, 0); }
        float v0 = -INFINITY, v1 = -INFINITY, v2 = -INFINITY; int i0 = -1, i1 = -1, i2 = -1;
#pragma unroll
        for (int r = 0; r < 16; ++r) { const int j = (r & 3) + 8 * (r >> 2) + 4 * hi; const float x = j < qb ? g[r] : -INFINITY;
            const bool c0 = x > v0, c1 = x > v1, c2 = x > v2;
            v2 = c1 ? v1 : (c2 ? x : v2); i2 = c1 ? i1 : (c2 ? j : i2);
            v1 = c0 ? v0 : (c1 ? x : v1); i1 = c0 ? i0 : (c1 ? j : i1);
            v0 = c0 ? x : v0; i0 = c0 ? j : i0; }
        { float pv[3]; int pi[3];
          pv[0] = pg8::shx<32>(v0, lane); pv[1] = pg8::shx<32>(v1, lane); pv[2] = pg8::shx<32>(v2, lane);
          pi[0] = __builtin_amdgcn_ds_bpermute((lane ^ 32) << 2, i0); pi[1] = __builtin_amdgcn_ds_bpermute((lane ^ 32) << 2, i1); pi[2] = __builtin_amdgcn_ds_bpermute((lane ^ 32) << 2, i2);
#pragma unroll
          for (int t = 0; t < 3; ++t) { const float x = pv[t]; const int j = pi[t];
              const bool c0 = x > v0 || (x == v0 && j >= 0 && j < i0), c1 = x > v1 || (x == v1 && j >= 0 && j < i1), c2 = x > v2 || (x == v2 && j >= 0 && j < i2);
              v2 = c1 ? v1 : (c2 ? x : v2); i2 = c1 ? i1 : (c2 ? j : i2);
              v1 = c0 ? v0 : (c1 ? x : v1); i1 = c0 ? i0 : (c1 ? j : i1);
              v0 = c0 ? x : v0; i0 = c0 ? j : i0; } }
        if (hi == 0) {
            if (i0 >= 0) { const unsigned p = __hip_atomic_fetch_add(cnt + i0, 1u, __ATOMIC_RELAXED, __HIP_MEMORY_SCOPE_WORKGROUP); sub[i0 * 256 + p] = (unsigned short)(ql | (0 << 8)); }
            if (i1 >= 0) { const unsigned p = __hip_atomic_fetch_add(cnt + i1, 1u, __ATOMIC_RELAXED, __HIP_MEMORY_SCOPE_WORKGROUP); sub[i1 * 256 + p] = (unsigned short)(ql | (1 << 8)); }
            if (i2 >= 0) { const unsigned p = __hip_atomic_fetch_add(cnt + i2, 1u, __ATOMIC_RELAXED, __HIP_MEMORY_SCOPE_WORKGROUP); sub[i2 * 256 + p] = (unsigned short)(ql | (2 << 8)); }
            float* ls = LSE + ((size_t)bh * SEQ + q0 + ql) * 4; *(f4_t*)ls = (f4_t){-INFINITY, -INFINITY, -INFINITY, -INFINITY}; }
    }
    __syncthreads();
    if (lt < 32) CNT[((size_t)bh * 32 + lt) * 32 + qb] = cnt[lt];
    for (int idx = lt; idx < 32 * 256; idx += 256) { const int j = idx >> 8, i = idx & 255; if ((unsigned)i < cnt[j]) SUB[(((size_t)bh * 32 + j) * 32 + qb) * 256 + i] = sub[idx]; }
    __syncthreads();
}

__device__ __forceinline__ void sparse_phase(const bf16* Q, const bf16* K, const bf16* V, const unsigned short* SUB, const unsigned* CNT, bf16* PART, float* LSE, char* shm, int G, int bx, int tid, int wave_s) {
    lds_i* UP = (lds_i*)((lds_cptr)shm + UP_OFF); lds_i* QP = (lds_i*)((lds_cptr)shm + QP_OFF); lds_i* QI = (lds_i*)((lds_cptr)shm + QIDX_OFF);
    for (int it = tid; it < 1024; it += 512) { const unsigned* c = CNT + (size_t)it * 32; unsigned len = 0u;
#pragma unroll 8
        for (int qb = 0; qb < 32; ++qb) len += c[qb];
        UP[it + 1] = (int)((len + 255u) >> 8); }
    if (tid == 0) UP[0] = 0;
    __syncthreads();
    for (int off = 1; off < 1024; off <<= 1) {
        int a0 = 0, a1 = 0; const int i0 = tid + 1, i1 = tid + 513;
        if (i0 > off) a0 = UP[i0 - off]; if (i1 > off) a1 = UP[i1 - off];
        __syncthreads();
        UP[i0] += a0; UP[i1] += a1;
        __syncthreads();
    }
    const int U = UP[1024];
    lds_i* UI = (lds_i*)((lds_cptr)shm + UI_OFF);
    const int lane = tid & 63, wv = __builtin_amdgcn_readfirstlane(tid >> 6);
    int nloc = bx < U ? (U - bx + G - 1) / G : 0; if (nloc > QL_MAX) nloc = QL_MAX;
    for (int k = wv; k < nloc; k += 8) {
        const int u = bx + k * G;
        int lo_ = 0, hi_ = 1024;
        while (hi_ - lo_ > 1) { const int mid = (lo_ + hi_) >> 1; if (UP[mid] <= u) lo_ = mid; else hi_ = mid; }
        const int item = lo_, t = u - UP[item];
        lds_i* QPw = QP + wv * 36;
        { const int qb = lane & 31; int x = (int)CNT[(size_t)item * 32 + qb];
#pragma unroll
          for (int o = 1; o < 32; o <<= 1) { const int y = __builtin_amdgcn_ds_bpermute(((lane & 32) + ((qb - o) & 31)) << 2, x); if (qb >= o) x += y; }
          if (lane < 32) { QPw[qb + 1] = x; if (qb == 0) QPw[0] = 0; } }
        asm volatile("s_waitcnt lgkmcnt(0)" ::: "memory");
        const int len = QPw[32];
        lds_i* ql = (lds_i*)((lds_cptr)shm + QL_OFF) + k * 256;
#pragma unroll
        for (int i = 0; i < 4; ++i) { const int sidx = lane + 64 * i, g = 256 * t + sidx; int ent = -1;
            if (g < len) { int a_ = 0, bnd = 32; while (bnd - a_ > 1) { const int mid = (a_ + bnd) >> 1; if (QPw[mid] <= g) a_ = mid; else bnd = mid; }
                const unsigned e = SUB[((size_t)item * 32 + a_) * 256 + (g - QPw[a_])]; ent = (a_ * 256 + (int)(e & 255u)) | ((int)(e >> 8) << 16); }
            ql[sidx] = ent; }
        if (lane == 0) UI[k] = item;
    }
    __syncthreads();
    for (int k = 0; k < nloc; ++k) { const int item = UI[k], bh = item >> 5, j = item & 31;
        attn_unit<8, false>(bh / NHEAD, bh % NHEAD, j, QL_OFF + k * 1024, Q, K, V, PART, LSE, nullptr, shm, wave_s); }
    for (int u = bx + QL_MAX * G; u < U; u += G) {
        int lo_ = 0, hi_ = 1024; while (hi_ - lo_ > 1) { const int mid = (lo_ + hi_) >> 1; if (UP[mid] <= u) lo_ = mid; else hi_ = mid; }
        const int item = lo_, t = u - UP[item], bh = item >> 5, j = item & 31;
        if (tid < 64) { const int qb = tid & 31; int x = (int)CNT[(size_t)item * 32 + qb];
#pragma unroll
            for (int o = 1; o < 32; o <<= 1) { const int y = __builtin_amdgcn_ds_bpermute(((tid & 32) + ((qb - o) & 31)) << 2, x); if (qb >= o) x += y; }
            if (tid < 32) { QP[qb + 1] = x; if (qb == 0) QP[0] = 0; } }
        __syncthreads();
        if (tid < 256) { const int g = 256 * t + tid; int ent = -1;
            if (g < QP[32]) { int a_ = 0, bnd = 32; while (bnd - a_ > 1) { const int mid = (a_ + bnd) >> 1; if (QP[mid] <= g) a_ = mid; else bnd = mid; }
                const unsigned e = SUB[((size_t)item * 32 + a_) * 256 + (g - QP[a_])]; ent = (a_ * 256 + (int)(e & 255u)) | ((int)(e >> 8) << 16); }
            QI[tid] = ent; }
        __syncthreads();
        attn_unit<8, false>(bh / NHEAD, bh % NHEAD, j, QIDX_OFF, Q, K, V, PART, LSE, nullptr, shm, wave_s);
    }
}

__device__ __forceinline__ void own_phase(const bf16* Q, const bf16* K, const bf16* V, const bf16* PART, const float* LSE, bf16* O, char* shm, int G, int bx, int wave_s) {
    for (int u = bx; u < BATCH * NHEAD * NQB; u += G) { const int bh = u >> 5, qb = u & 31;
        attn_unit<8, true>(bh / NHEAD, bh % NHEAD, qb, 0, Q, K, V, (bf16*)PART, (float*)LSE, O, shm, wave_s); }
}
#undef SBAR
#undef WAIT_BAR
}

constexpr int NWAVES = 8;
constexpr int NB = 4, SEQ = 8192, T = NB * SEQ, D = 1024;
constexpr int D_SSM = 512, NG = 32, NS = 64;
constexpr int D_ATT = 512;
constexpr int D_IN = 4096;
constexpr int PH = 8, PQD = 256, NEXP = 16384;
constexpr int D_PLE = 256;
constexpr float EPS = 1e-6f;

constexpr size_t MiB = 1u << 20, KiB = 1u << 10;
constexpr size_t WS_CTL = 0, CTL_ZERO_BYTES = 1 * MiB;
constexpr int CW_BAR = 4096;
constexpr size_t CTL_KMEAN = 64 * KiB;
constexpr size_t CTL_SS1 = 320 * KiB;
constexpr size_t CTL_SS3 = 448 * KiB;
constexpr size_t WS_WIN = 1 * MiB;
constexpr size_t WS_WGLU = 9 * MiB;
constexpr size_t WS_WPS = 9 * MiB + 512 * KiB;
constexpr size_t WS_WPA = 10 * MiB + 512 * KiB;
constexpr size_t WS_WOUT = 11 * MiB + 512 * KiB;
constexpr size_t WS_WS = 13 * MiB + 512 * KiB;
constexpr size_t WS_WGATE = 17 * MiB + 512 * KiB;
constexpr size_t WS_WPP = 19 * MiB + 512 * KiB;
constexpr size_t WS_ROPE = 20 * MiB;
constexpr size_t WS_S5P = 22 * MiB;
constexpr size_t WS_RS2 = 23 * MiB;
constexpr size_t WS_UT = 24 * MiB;
constexpr size_t WS_S5W = 40 * MiB;
constexpr size_t WS_VT = 40 * MiB;
constexpr size_t WS_SU = 48 * MiB, WS_SV = 48 * MiB + 64 * KiB;
constexpr size_t WS_X8 = 56 * MiB;
constexpr size_t WS_XN = 88 * MiB;
constexpr size_t WS_MSUB = 88 * MiB, WS_MCNT = 104 * MiB, WS_MLSE = 105 * MiB;
constexpr size_t WS_YP = 112 * MiB;
constexpr size_t WS_PB = 152 * MiB;
constexpr size_t WS_E = 168 * MiB;
constexpr size_t WS_U = 232 * MiB;
constexpr size_t WS_Q = 264 * MiB;
constexpr size_t WS_K = 296 * MiB;
constexpr size_t WS_V = 328 * MiB;
constexpr size_t WS_SGA = 360 * MiB;
constexpr size_t WS_SGB = 424 * MiB;
constexpr size_t WS_SC = 232 * MiB;
constexpr size_t WS_HLOC = 488 * MiB;
constexpr size_t WS_END = 496 * MiB;
constexpr size_t S5_ABR = 0, S5_ABI = 8 * KiB, S5_ALR = 16 * KiB, S5_ALI = 24 * KiB;
constexpr size_t S5_BRE = 32 * KiB, S5_BIM = 160 * KiB;
constexpr size_t S5_CM = 288 * KiB;

constexpr int RING_OFF = 0, RING_BYTES = 131072;
constexpr int LDSCTL_OFF = RING_BYTES, MISC_OFF = LDSCTL_OFF + 320;
constexpr int LDS_BYTES = 147456;

#define GAS __attribute__((address_space(1)))
#define LAS __attribute__((address_space(3)))
typedef unsigned short bf16;
typedef unsigned v4u __attribute__((ext_vector_type(4)));
typedef unsigned v2u __attribute__((ext_vector_type(2)));
typedef float f32x4 __attribute__((ext_vector_type(4)));
typedef float f32x2 __attribute__((ext_vector_type(2)));
typedef short bf16x8 __attribute__((ext_vector_type(8)));
using pg8::shx; using pg8::bperm; using pg8::bpermi; using pg8::lane_id_opaque;
using pg8::pkbf; using pg8::bflo; using pg8::bfhi; using pg8::gelu_tanh; using pg8::sigmoidf_;
#define LDS_WAIT() asm volatile("s_waitcnt lgkmcnt(0)" ::: "memory")

#define XB_TMO      128
#define XB_XCNT(j)  (256  + 64 * (j))
#define XB_XSUB(j)  (1280 + 64 * (j))
#define XB_XGEN(j)  (2304 + 64 * (j))
#define XB_TOP      3328
#define XB_TOPGEN   3392
#define XCD_BAR_WORDS 3456
#define XB_SPIN_CAP (1u << 22)
__device__ __forceinline__ unsigned xb_ld(unsigned* p)              { return __hip_atomic_load(p, __ATOMIC_RELAXED, __HIP_MEMORY_SCOPE_AGENT); }
__device__ __forceinline__ unsigned xb_add(unsigned* p, unsigned v) { return __hip_atomic_fetch_add(p, v, __ATOMIC_RELAXED, __HIP_MEMORY_SCOPE_AGENT); }
__device__ __forceinline__ unsigned xb_xcc_id() { return (unsigned)__builtin_amdgcn_s_getreg((3 << 11) | 20) & 0xFu; }
#define XB_SPIN(cond, bar) do { unsigned _sp = 0; while (cond) { __builtin_amdgcn_s_sleep(1); \
    if ((++_sp & 255u) == 0u) { if (xb_ld(&(bar)[XB_TMO])) break; if (_sp > XB_SPIN_CAP) { atomicAdd(&(bar)[XB_TMO], 1u); break; } } } } while (0)
struct XcdBarrier { unsigned* bar; unsigned x; volatile LAS unsigned* st; };
__device__ __forceinline__ bool is_thread0(int wave_s) { return wave_s == 0 && lane_id_opaque() == 0; }
__device__ __forceinline__ XcdBarrier xcd_barrier_post(unsigned* bar, volatile LAS unsigned* st, int wave_s) {
    XcdBarrier b; b.bar = bar; b.x = xb_xcc_id(); b.st = st;
    if (is_thread0(wave_s)) (void)xb_add(&bar[XB_XCNT(b.x)], 1u);
    return b;
}
__device__ __forceinline__ void xcd_barrier_complete(unsigned* bar, unsigned x, unsigned& nloc, unsigned& nx) {
    const unsigned G = gridDim.x * gridDim.y * gridDim.z;
    unsigned sum, cnt, mine, sp = 0u;
    for (;;) {
        sum = 0u; cnt = 0u; mine = 0u;
#pragma unroll
        for (unsigned j = 0; j < 16; ++j) { const unsigned c = xb_ld(&bar[XB_XCNT(j)]); sum += c; cnt += (c > 0u) ? 1u : 0u; mine = (j == x) ? c : mine; }
        if (sum == G) break;
        __builtin_amdgcn_s_sleep(1);
        if ((++sp & 255u) == 0u) { if (xb_ld(&bar[XB_TMO])) break; if (sp > XB_SPIN_CAP) { atomicAdd(&bar[XB_TMO], 1u); break; } }
    }
    nloc = mine > 0u ? mine : 1u; nx = cnt > 0u ? cnt : 1u;
}
__device__ __forceinline__ void xcd_barrier(const XcdBarrier& b, int wave_s) {
    asm volatile("s_waitcnt vmcnt(0)" ::: "memory");
    __syncthreads();
    if (is_thread0(wave_s)) {
        unsigned* bar = b.bar;
        __builtin_amdgcn_s_waitcnt(0);
        unsigned nloc = b.st[0], nx = b.st[1];
        if (nloc == 0u) { xcd_barrier_complete(bar, b.x, nloc, nx); b.st[0] = nloc; b.st[1] = nx; }
        const unsigned old = xb_add(&bar[XB_XSUB(b.x)], 1u);
        const unsigned gen = old / nloc;
        if (old + 1u == (gen + 1u) * nloc) {
            __builtin_amdgcn_fence(__ATOMIC_RELEASE, "agent");
            asm volatile("s_waitcnt vmcnt(0)" ::: "memory");
            const unsigned og = xb_add(&bar[XB_TOP], 1u);
            const unsigned tg = og / nx;
            if (og + 1u == (tg + 1u) * nx) xb_add(&bar[XB_TOPGEN], 1u);
            else XB_SPIN(xb_ld(&bar[XB_TOPGEN]) == tg, bar);
            __builtin_amdgcn_fence(__ATOMIC_ACQUIRE, "agent");
            xb_add(&bar[XB_XGEN(b.x)], 1u);
            asm volatile("s_waitcnt vmcnt(0)" ::: "memory");
        } else {
            XB_SPIN(xb_ld(&bar[XB_XGEN(b.x)]) == gen, bar);
            __builtin_amdgcn_fence(__ATOMIC_ACQUIRE, "agent");
            asm volatile("s_waitcnt vmcnt(0)" ::: "memory");
        }
    }
    __syncthreads();
}

struct Args { const float* in[27]; float* out; unsigned char* ws; };
enum { I_X = 0, I_P, I_POS, I_GMIX, I_WIN, I_LOGDT, I_ARE, I_AIM, I_BRE, I_BIM, I_CRE, I_CIM, I_DSK, I_WGLU, I_WPS, I_WPA, I_WOUT, I_GFFN, I_WQ, I_KEY1, I_KEY2, I_PU, I_PV, I_GPLE, I_WGATE, I_WPP, I_GFIN };

__device__ __forceinline__ float wave_sum(float v, int lane) {
    v += shx<1>(v, lane); v += shx<2>(v, lane); v += shx<4>(v, lane); v += shx<8>(v, lane); v += shx<16>(v, lane); v += shx<32>(v, lane);
    return v;
}

template <bool F8 = false>
__device__ __forceinline__ void p0_transpose_item(const float* W, const float* ks, int K, int N, bf16* WT, LAS float* scr, int item, int lane) {
    const int nblk = N / 32, kb = item / nblk, nb = item % nblk, k0 = 64 * kb, n0 = 32 * nb;
    { f32x4 w4[8]; float sc[8];
#pragma unroll
      for (int i = 0; i < 8; ++i) { const int kk = 8 * i + (lane >> 3); w4[i] = *(const f32x4*)(W + (size_t)(k0 + kk) * N + n0 + 4 * (lane & 7)); sc[i] = ks ? ks[k0 + kk] : 1.0f; }
#pragma unroll
      for (int i = 0; i < 8; ++i) { const int kk = 8 * i + (lane >> 3); LAS float* d = scr + kk * 33 + 4 * (lane & 7); d[0] = w4[i][0] * sc[i]; d[1] = w4[i][1] * sc[i]; d[2] = w4[i][2] * sc[i]; d[3] = w4[i][3] * sc[i]; } }
    LDS_WAIT(); asm volatile("" ::: "memory");
    const int c = lane & 7;
#pragma unroll
    for (int j = 0; j < 4; ++j) { const int n = (lane >> 3) + 8 * j; const LAS float* s = scr + (8 * c) * 33 + n;
        if (F8) { constexpr float sc8 = (float)(1 << pg8::W8_SHIFT); v2u o; o.x = pg8::pkf8(s[0 * 33] * sc8, s[1 * 33] * sc8, s[2 * 33] * sc8, s[3 * 33] * sc8); o.y = pg8::pkf8(s[4 * 33] * sc8, s[5 * 33] * sc8, s[6 * 33] * sc8, s[7 * 33] * sc8);
            *(v2u*)((unsigned char*)WT + (size_t)(n0 + n) * K + k0 + 8 * c) = o; }
        else { v4u o; o.x = pkbf(s[0 * 33], s[1 * 33]); o.y = pkbf(s[2 * 33], s[3 * 33]); o.z = pkbf(s[4 * 33], s[5 * 33]); o.w = pkbf(s[6 * 33], s[7 * 33]);
            *(v4u*)(WT + (size_t)(n0 + n) * K + k0 + 8 * c) = o; } }
    LDS_WAIT(); asm volatile("" ::: "memory");
}

__device__ __forceinline__ void cs_reduced(double ang, float& c, float& s) {
    const double r = ang * 0.15915494309189535; double fr = r - floor(r); if (fr > 0.5) fr -= 1.0;
    const float y = (float)(fr * 6.283185307179586);
    c = cosf(y); s = sinf(y);
}

__device__ __forceinline__ void p0_ws_item(const float* Wq, const float* gffn, const float* key1, const float* key2, bf16* WsT, LAS unsigned char* lds, int item, int tid) {
    constexpr int P = 132;
    LAS float* wq = (LAS float*)lds;
    LAS float* ky = (LAS float*)(lds + 64 * P * 4);
    const int hh = item >> 4, kb = item & 15, h = hh >> 1, half = hh & 1, k0 = 64 * kb;
    const float* keys = (half ? key2 : key1) + (size_t)h * 128 * 128;
#pragma unroll
    for (int i = 0; i < 4; ++i) { const int idx = tid + 512 * i, kk = idx >> 5, d4 = idx & 31;
        f32x4 v = *(const f32x4*)(Wq + (size_t)(k0 + kk) * 2048 + h * 256 + half * 128 + 4 * d4); v = v * gffn[k0 + kk];
        *(LAS f32x4*)(wq + kk * P + 4 * d4) = v; }
#pragma unroll
    for (int i = 0; i < 8; ++i) { const int idx = tid + 512 * i, n = idx >> 5, d4 = idx & 31;
        *(LAS f32x4*)(ky + n * P + 4 * d4) = *(const f32x4*)(keys + (size_t)n * 128 + 4 * d4); }
    __syncthreads();
    const int kq = tid & 15, nq = tid >> 4;
    float acc[4][4];
#pragma unroll
    for (int a = 0; a < 4; ++a)
#pragma unroll
        for (int b = 0; b < 4; ++b) acc[a][b] = 0.f;
    for (int d4 = 0; d4 < 32; ++d4) {
        f32x4 wv[4], kv[4];
#pragma unroll
        for (int a = 0; a < 4; ++a) { wv[a] = *(const LAS f32x4*)(wq + (4 * kq + a) * P + 4 * d4); kv[a] = *(const LAS f32x4*)(ky + (4 * nq + a) * P + 4 * d4); }
#pragma unroll
        for (int a = 0; a < 4; ++a)
#pragma unroll
            for (int b = 0; b < 4; ++b)
                acc[a][b] += (kv[a][0] * wv[b][0] + kv[a][1] * wv[b][1]) + (kv[a][2] * wv[b][2] + kv[a][3] * wv[b][3]);
    }
#pragma unroll
    for (int a = 0; a < 4; ++a) { v2u o; o.x = pkbf(acc[a][0], acc[a][1]); o.y = pkbf(acc[a][2], acc[a][3]);
        *(v2u*)(WsT + (size_t)(h * 256 + half * 128 + 4 * nq + a) * 1024 + k0 + 4 * kq) = o; }
    __syncthreads();
}

namespace s5 {
constexpr long YP8_DELTA = (long)WS_MSUB - (long)WS_YP;
constexpr int L = 64, NCH = SEQ / L, HP = 136, XP = 132;
constexpr int X_BYTES = 16 * XP * 4, WAVE_LDS = X_BYTES + 16 * HP * 2;
constexpr int ITEMS_PER_BG = 8, CH_STRIDE = NCH / ITEMS_PER_BG;

template <int PASS> struct Loads { v4u uf[4]; v2u uw[4]; float hlr[16], hli[16]; };
constexpr size_t HPLANE = (size_t)NB * NG * NCH * 64;

template <int PASS>
__device__ __forceinline__ void issue(Loads<PASS>& ld, const bf16* Ub, const float* Hb, int ch, int q, int nl, int lane) {
#pragma unroll
    for (int blk = 0; blk < 4; ++blk) { ld.uf[blk] = *(const v4u*)(Ub + (blk * 16 + nl) * 16 + 8 * (q & 1));
        if (PASS == 2) ld.uw[blk] = *(const v2u*)(Ub + (blk * 16 + nl) * 16 + 4 * q); }
    if (PASS == 2) {
#pragma unroll
        for (int j = 0; j < 16; ++j) { const int c = ch - 16 + j; const float* hp = Hb + (size_t)(c < 0 ? 0 : c) * 64 + lane; ld.hlr[j] = hp[0]; ld.hli[j] = hp[HPLANE]; }
    }
}

template <int PASS>
__device__ __forceinline__ void run(LAS unsigned char* ldsw, const unsigned char* s5p, const bf16* U, float* Hloc, const float* dskip, bf16* YP, int gw, int ngw, int lane) {
    const int q = lane >> 4, nl = lane & 15;
    LAS float* Xt = (LAS float*)ldsw;
    LAS bf16* Ht = (LAS bf16*)(ldsw + X_BYTES);
    for (int wv = gw; wv < NB * NG * CH_STRIDE; wv += ngw) {
        const int g = wv & 31, b = (wv >> 5) & 3, ch0 = wv >> 7;
        bf16x8 af[8];
#pragma unroll
        for (int j = 0; j < 8; ++j) {
            const float* src = (const float*)(s5p + (j < 4 ? S5_BRE : S5_BIM)) + (size_t)(g * 64 + 16 * (j & 3) + nl) * 16 + 8 * (q & 1);
            const f32x4 a = *(const f32x4*)src, bb = *(const f32x4*)(src + 4);
            v4u w = pg8::pack8(a, bb); if (q >= 2) w = (v4u){0u, 0u, 0u, 0u};
            af[j] = __builtin_bit_cast(bf16x8, w);
        }
        const float ar = ((const float*)(s5p + S5_ABR))[g * 64 + lane], ai = ((const float*)(s5p + S5_ABI))[g * 64 + lane];
        const float aLr = ((const float*)(s5p + S5_ALR))[g * 64 + lane], aLi = ((const float*)(s5p + S5_ALI))[g * 64 + lane];
        bf16x8 cf[4]; float dsk[4];
        if (PASS == 2) {
#pragma unroll
            for (int kk = 0; kk < 4; ++kk) cf[kk] = *(const bf16x8*)((const bf16*)(s5p + S5_CM) + (size_t)(g * 16 + nl) * 128 + 32 * kk + 8 * q);
#pragma unroll
            for (int r = 0; r < 4; ++r) dsk[r] = dskip[g * 16 + 4 * q + r];
        }
        const bf16* Ubg = U + (size_t)(b * 32 + g) * SEQ * 16;
        float* Hbg = Hloc + (size_t)(b * 32 + g) * NCH * 64;
        float cr = 0.f, ci = 0.f;
        Loads<PASS> cur, nxt;
        issue<PASS>(cur, Ubg + (size_t)ch0 * L * 16, Hbg, ch0, q, nl, lane);
#pragma unroll 1
        for (int i = 0; i < ITEMS_PER_BG; ++i) {
            const int ch = ch0 + CH_STRIDE * i;
            if (i + 1 < ITEMS_PER_BG) issue<PASS>(nxt, Ubg + (size_t)(ch + CH_STRIDE) * L * 16, Hbg, ch + CH_STRIDE, q, nl, lane);
            float hr = 0.f, hi = 0.f;
            if (PASS == 2) {
#pragma unroll
                for (int j = 0; j < 16; ++j) { const bool ok = (ch - 16 + j) >= 0; const float lr = ok ? cur.hlr[j] : 0.f, li = ok ? cur.hli[j] : 0.f;
                    const float ncr = fmaf(aLr, cr, fmaf(-aLi, ci, lr)), nci = fmaf(aLr, ci, fmaf(aLi, cr, li)); cr = ok ? ncr : cr; ci = ok ? nci : ci; }
                hr = cr; hi = ci;
            }
#pragma unroll
            for (int blk = 0; blk < L / 16; ++blk) {
                v4u uw4 = cur.uf[blk]; if (q >= 2) uw4 = (v4u){0u, 0u, 0u, 0u};
                const bf16x8 uf = __builtin_bit_cast(bf16x8, uw4);
#pragma unroll
                for (int j = 0; j < 8; ++j) { const f32x4 d = __builtin_amdgcn_mfma_f32_16x16x32_bf16(af[j], uf, (f32x4){0.f, 0.f, 0.f, 0.f}, 0, 0, 0);
                    *(LAS f32x4*)(Xt + nl * XP + 16 * j + 4 * q) = d; }
#pragma unroll
                for (int tt = 0; tt < 16; ++tt) {
                    const float xr = Xt[tt * XP + lane], xi = Xt[tt * XP + 64 + lane];
                    const float nhr = fmaf(ar, hr, fmaf(-ai, hi, xr)), nhi = fmaf(ar, hi, fmaf(ai, hr, xi));
                    hr = nhr; hi = nhi;
                    if (PASS == 2) { const unsigned pw = pkbf(hr, hi); Ht[tt * HP + lane] = (bf16)(pw & 0xffffu); Ht[tt * HP + 64 + lane] = (bf16)(pw >> 16); }
                }
                if (PASS == 2) {
                    f32x4 acc = {0.f, 0.f, 0.f, 0.f};
#pragma unroll
                    for (int kk = 0; kk < 4; ++kk) { const bf16x8 hf = *(const LAS bf16x8*)(Ht + nl * HP + 32 * kk + 8 * q);
                        acc = __builtin_amdgcn_mfma_f32_16x16x32_bf16(cf[kk], hf, acc, 0, 0, 0); }
                    const int tl = blk * 16 + nl;
                    const v2u uw = cur.uw[blk];
                    const float y0 = gelu_tanh(acc[0] + dsk[0] * bflo(uw.x)), y1 = gelu_tanh(acc[1] + dsk[1] * bfhi(uw.x));
                    const float y2 = gelu_tanh(acc[2] + dsk[2] * bflo(uw.y)), y3 = gelu_tanh(acc[3] + dsk[3] * bfhi(uw.y));
                    v2u o; o.x = pkbf(y0, y1); o.y = pkbf(y2, y3);
                    *(v2u*)(YP + ((size_t)b * SEQ + (size_t)ch * L + tl) * 512 + g * 16 + 4 * q) = o;
                    *(unsigned*)((unsigned char*)YP + YP8_DELTA + ((size_t)b * SEQ + (size_t)ch * L + tl) * 512 + g * 16 + 4 * q) = pg8::pkf8(y0, y1, y2, y3);
                }
            }
            if (PASS == 1) { Hbg[(size_t)ch * 64 + lane] = hr; Hbg[HPLANE + (size_t)ch * 64 + lane] = hi; }
            cur = nxt;
        }
    }
}


__device__ __forceinline__ void pass1_gemm(LAS unsigned char* lds, const bf16* W, const bf16* U, float* Hloc, int G, int bx, int tid, int wave) {
    constexpr int PITCH = 528, A_OFF = 0, B_OFF = 128 * PITCH;
    const int lane = tid & 63, fr = lane & 15, fq = lane >> 4;
    for (int task = bx; task < NG * 8; task += G) {
        const int g = task >> 3, c8 = task & 7, b = c8 >> 1, ch0 = 64 * (c8 & 1);
        const bf16* Wg = W + (size_t)g * 128 * 1024;
        const bf16* Ub = U + ((size_t)(b * 32 + g) * SEQ + (size_t)ch0 * L) * 16;
        f32x4 acc[4];
#pragma unroll
        for (int nt = 0; nt < 4; ++nt) acc[nt] = (f32x4){0.f, 0.f, 0.f, 0.f};
#pragma unroll 1
        for (int slab = 0; slab < 4; ++slab) {
            v4u ta[8], tb[4];
#pragma unroll
            for (int i = 0; i < 8; ++i) { const int p = tid + 512 * i; ta[i] = *(const v4u*)((const unsigned char*)Wg + (size_t)(p >> 5) * 2048 + slab * 512 + 16 * (p & 31)); }
#pragma unroll
            for (int i = 0; i < 4; ++i) { const int p = tid + 512 * i; tb[i] = *(const v4u*)((const unsigned char*)Ub + (size_t)(p >> 5) * 2048 + slab * 512 + 16 * (p & 31)); }
            __syncthreads();
#pragma unroll
            for (int i = 0; i < 8; ++i) { const int p = tid + 512 * i; *(LAS v4u*)(lds + A_OFF + (p >> 5) * PITCH + 16 * (p & 31)) = ta[i]; }
#pragma unroll
            for (int i = 0; i < 4; ++i) { const int p = tid + 512 * i; *(LAS v4u*)(lds + B_OFF + (p >> 5) * PITCH + 16 * (p & 31)) = tb[i]; }
            __syncthreads();
#pragma unroll
            for (int kk = 0; kk < 8; ++kk) { const bf16x8 wf = *(const LAS bf16x8*)(lds + A_OFF + (16 * wave + fr) * PITCH + 64 * kk + 16 * fq);
#pragma unroll
                for (int nt = 0; nt < 4; ++nt) { const bf16x8 uf = *(const LAS bf16x8*)(lds + B_OFF + (16 * nt + fr) * PITCH + 64 * kk + 16 * fq); acc[nt] = __builtin_amdgcn_mfma_f32_16x16x32_bf16(wf, uf, acc[nt], 0, 0, 0); } }
        }
        const int np = 16 * wave + 4 * fq;
        float* Hp = Hloc + (size_t)(np >> 6) * HPLANE + ((size_t)(b * 32 + g) * NCH + ch0 + fr) * 64 + (np & 63);
#pragma unroll
        for (int nt = 0; nt < 4; ++nt) *(f32x4*)(Hp + (size_t)(16 * nt) * 64) = acc[nt];
        __syncthreads();
    }
}
}

namespace peer {
template <int M> __device__ __forceinline__ int shxi(int v, int lane) { return __builtin_bit_cast(int, shx<M>(__builtin_bit_cast(float, v), lane)); }
__device__ __forceinline__ float hmax32(float m, int lane) { m = fmaxf(m, shx<1>(m, lane)); m = fmaxf(m, shx<2>(m, lane)); m = fmaxf(m, shx<4>(m, lane)); m = fmaxf(m, shx<8>(m, lane)); m = fmaxf(m, shx<16>(m, lane)); return m; }
__device__ __forceinline__ unsigned f2o(float f) { const unsigned b = __float_as_uint(f); return b ^ ((unsigned)((int)b >> 31) | 0x80000000u); }
__device__ __forceinline__ float o2f(unsigned k) { return __uint_as_float(k ^ ((~(unsigned)((int)k >> 31)) | 0x80000000u)); }
template <int CTRL> __device__ __forceinline__ unsigned dppmax(unsigned x) { const unsigned y = (unsigned)__builtin_amdgcn_update_dpp(0, (int)x, CTRL, 0xf, 0xf, true); return x > y ? x : y; }
__device__ __forceinline__ unsigned rowmax16(unsigned x) { x = dppmax<0xB1>(x); x = dppmax<0x4E>(x); x = dppmax<0x141>(x); x = dppmax<0x140>(x); return x; }
__device__ __forceinline__ unsigned wrlane(unsigned v, unsigned val, int sel) { unsigned keep;
    asm("s_mov_b32 %1, m0\n\ts_mov_b32 m0, %3\n\ts_nop 0\n\tv_writelane_b32 %0, %2, m0\n\ts_mov_b32 m0, %1" : "+v"(v), "=&s"(keep) : "s"(val), "s"(sel)); return v; }
__device__ __forceinline__ void cex(unsigned& a, unsigned& b) { const unsigned hi = a > b ? a : b, lo = a > b ? b : a; a = hi; b = lo; }
__device__ __forceinline__ unsigned qpack4(const f32x4 v, float inv, int ob) { const int a = (int)rintf(v[0] * inv) + ob, b = (int)rintf(v[1] * inv) + ob, c = (int)rintf(v[2] * inv) + ob, d = (int)rintf(v[3] * inv) + ob;
    return ((unsigned)a & 0xffu) | (((unsigned)b & 0xffu) << 8) | (((unsigned)c & 0xffu) << 16) | (((unsigned)d & 0xffu) << 24); }
__device__ __forceinline__ float sel8(const float (&a)[8], int h) { float r = a[0];
#pragma unroll
    for (int q = 1; q < 8; ++q) r = (h == q) ? a[q] : r;
    return r; }
__device__ __forceinline__ unsigned sel8u(const unsigned (&a)[8], int h) { unsigned r = a[0];
#pragma unroll
    for (int q = 1; q < 8; ++q) r = (h == q) ? a[q] : r;
    return r; }

struct Pre { v2u sc[8]; v4u xr[2]; };
__device__ __forceinline__ void load_pre(Pre& p, const float* S, const bf16* XB, int tkn, int lane) {
    const v2u* Sp = (const v2u*)((const bf16*)S + (size_t)tkn * 2048) + lane;
#pragma unroll
    for (int h = 0; h < 8; ++h) p.sc[h] = Sp[64 * h];
    const v4u* xp = (const v4u*)(XB + (size_t)tkn * 1024 + lane * 16);
    p.xr[0] = xp[0]; p.xr[1] = xp[1];
}

struct Row4 { f32x4 v[4]; };
__device__ __forceinline__ void load_row(Row4& r, const float* src, int lane) {
#pragma unroll
    for (int j = 0; j < 4; ++j) r.v[j] = *(const f32x4*)(src + 256 * j + 4 * lane); }
__device__ __forceinline__ void load_row16(Row4& r, const float* src, int lane) {
#pragma unroll
    for (int j = 0; j < 4; ++j) r.v[j] = *(const f32x4*)(src + 16 * lane + 4 * j); }
__device__ __forceinline__ void quant_row(const Row4& r, const f32x4 (&gf)[4], bool use_gf, unsigned char* dst, float* scale_out, bool offset_binary, int lane) {
    f32x4 v[4]; float m = 0.f;
#pragma unroll
    for (int j = 0; j < 4; ++j) { v[j] = r.v[j]; if (use_gf) v[j] = v[j] * gf[j];
        m = fmaxf(fmaxf(m, fmaxf(fabsf(v[j][0]), fabsf(v[j][1]))), fmaxf(fabsf(v[j][2]), fabsf(v[j][3]))); }
    m = hmax32(m, lane); m = fmaxf(m, shx<32>(m, lane));
    const float inv = m > 0.f ? 127.0f / m : 0.f; const int ob = offset_binary ? 128 : 0;
#pragma unroll
    for (int j = 0; j < 4; ++j) *(unsigned*)(dst + 256 * j + 4 * lane) = qpack4(v[j], inv, ob);
    if (lane == 0) *scale_out = m * (1.0f / 127.0f);
}
__device__ __forceinline__ void quant_row4(Row4 r, const f32x4 (&gf)[4], bool use_gf, unsigned char* dst, float* scale_out, int lane, bool signed_hi = false) {
    if (use_gf) {
#pragma unroll
        for (int j = 0; j < 4; ++j) r.v[j] = r.v[j] * gf[j]; }
    float ssq = 0.f;
#pragma unroll
    for (int j = 0; j < 4; ++j) ssq += (r.v[j][0] * r.v[j][0] + r.v[j][1] * r.v[j][1]) + (r.v[j][2] * r.v[j][2] + r.v[j][3] * r.v[j][3]);
    ssq = wave_sum(ssq, lane);
    const float step = 0.3352f * sqrtf(ssq * (1.0f / 1024.0f)), inv = step > 0.f ? 1.0f / step : 0.f;
    v2u o;
#pragma unroll
    for (int g = 0; g < 2; ++g) { unsigned w = 0u;
#pragma unroll
        for (int j = 0; j < 4; ++j) { const int a = (int)floorf(r.v[2 * g][j] * inv) + 8, b = (int)floorf(r.v[2 * g + 1][j] * inv) + 8;
            const unsigned lo4 = (unsigned)(a < 0 ? 0 : a > 15 ? 15 : a); unsigned hi4 = (unsigned)(b < 0 ? 0 : b > 15 ? 15 : b); if (signed_hi) hi4 = (hi4 - 8u) & 15u; w |= (lo4 | (hi4 << 4)) << (8 * j); }
        if (g == 0) o.x = w; else o.y = w; }
    *(v2u*)(dst + 16 * lane) = o;
    if (lane == 0) *scale_out = step;
}
}

namespace peer {
struct TK { unsigned eidP0, eidP1; float cAP0, cAP1, cBP0, cBP1; };

__device__ __forceinline__ void sort8(unsigned (&v)[8]) {
    cex(v[0], v[1]); cex(v[2], v[3]); cex(v[4], v[5]); cex(v[6], v[7]); cex(v[0], v[2]); cex(v[1], v[3]); cex(v[4], v[6]); cex(v[5], v[7]);
    cex(v[1], v[2]); cex(v[5], v[6]); cex(v[0], v[4]); cex(v[3], v[7]); cex(v[1], v[5]); cex(v[2], v[6]); cex(v[1], v[4]); cex(v[3], v[6]); cex(v[2], v[4]); cex(v[3], v[5]); cex(v[3], v[4]);
}
__device__ __forceinline__ float rowsum16(float x) {
#define PEER_RS(CTRL) x += __builtin_bit_cast(float, __builtin_amdgcn_update_dpp(0, __builtin_bit_cast(int, x), CTRL, 0xf, 0xf, true))
    PEER_RS(0xB1); PEER_RS(0x4E); PEER_RS(0x141); PEER_RS(0x140);
#undef PEER_RS
    return x; }
__device__ __forceinline__ void prep_keys(const Pre& pre, unsigned (&kk)[4][8], int hl) {
#pragma unroll
    for (int p = 0; p < 4; ++p) { const v2u wa = pre.sc[2 * p], wb = pre.sc[2 * p + 1];
        const f32x4 sa = {pg8::bflo(wa.x), pg8::bfhi(wa.x), pg8::bflo(wa.y), pg8::bfhi(wa.y)}, sb = {pg8::bflo(wb.x), pg8::bfhi(wb.x), pg8::bflo(wb.y), pg8::bfhi(wb.y)};
#pragma unroll
        for (int e = 0; e < 4; ++e) { const unsigned ka = (f2o(sa[e]) & ~127u) | (unsigned)(4 * hl + e), kb = (f2o(sb[e]) & ~127u) | (unsigned)(4 * hl + e);
            const auto r = __builtin_amdgcn_permlane16_swap(ka, kb, false, false);
            kk[p][e] = (unsigned)r[0]; kk[p][4 + e] = (unsigned)r[1]; }
        sort8(kk[p]); }
}
__device__ __forceinline__ void quant_x(const Pre& pre, v4u& xq, float& sx, int& sumx, int lane) {
    f32x4 xf[4]; pg8::unpack8(pre.xr[0], xf[0], xf[1]); pg8::unpack8(pre.xr[1], xf[2], xf[3]);
    float m = 0.f;
#pragma unroll
    for (int e = 0; e < 4; ++e) m = fmaxf(fmaxf(m, fabsf(xf[0][e])), fmaxf(fmaxf(fabsf(xf[1][e]), fabsf(xf[2][e])), fabsf(xf[3][e])));
    unsigned am = rowmax16(__float_as_uint(m)); am = dppmax<0x142>(am); am = dppmax<0x143>(am);
    m = __uint_as_float((unsigned)__builtin_amdgcn_readlane((int)am, 63));
    sx = m * (1.0f / 127.0f); const float inv = m > 0.f ? 127.0f / m : 0.f;
    xq.x = qpack4(xf[0], inv, 0); xq.y = qpack4(xf[1], inv, 0); xq.z = qpack4(xf[2], inv, 0); xq.w = qpack4(xf[3], inv, 0);
    int t = __builtin_amdgcn_sdot4((int)xq.x, 0x01010101, 0, false); t = __builtin_amdgcn_sdot4((int)xq.y, 0x01010101, t, false); t = __builtin_amdgcn_sdot4((int)xq.z, 0x01010101, t, false); t = __builtin_amdgcn_sdot4((int)xq.w, 0x01010101, t, false);
    t += shxi<1>(t, lane); t += shxi<2>(t, lane); t += shxi<4>(t, lane); t += shxi<8>(t, lane); t += shxi<16>(t, lane); t += shxi<32>(t, lane); sumx = t;
}
__device__ __forceinline__ void s1_round(unsigned (&kk)[4][8], unsigned (&mine)[4], bool sel) {
    unsigned x[4];
#pragma unroll
    for (int p = 0; p < 4; ++p) x[p] = rowmax16(kk[p][0]);
#pragma unroll
    for (int p = 0; p < 4; ++p) { const bool win = kk[p][0] == x[p];
#pragma unroll
        for (int j = 0; j < 7; ++j) kk[p][j] = win ? kk[p][j + 1] : kk[p][j];
        kk[p][7] = win ? 0u : kk[p][7];
        mine[p] = sel ? x[p] : mine[p]; }
}
__device__ __forceinline__ void s2_setup(const unsigned (&mine)[4], unsigned (&MA)[2], unsigned (&MB)[2], unsigned (&ck)[2][4], unsigned (&top)[2], unsigned ciP, unsigned cjP, int li) {
#pragma unroll
    for (int q = 0; q < 2; ++q) { const auto r = __builtin_amdgcn_permlane32_swap(mine[2 * q], mine[2 * q + 1], false, false);
        MA[q] = (unsigned)r[0]; MB[q] = (unsigned)r[1];
#pragma unroll
        for (int k = 0; k < 4; ++k) { const int la = (int)((ciP >> (8 * k)) & 255u), lb = (int)((cjP >> (8 * k)) & 255u);
            const float av = o2f((unsigned)bpermi((int)MA[q], la)), bv = o2f((unsigned)bpermi((int)MB[q], lb));
            const int c = li + 16 * k;
            ck[q][k] = (c < 50) ? ((f2o(av + bv) & ~63u) | (unsigned)c) : 0u; }
        cex(ck[q][0], ck[q][1]); cex(ck[q][2], ck[q][3]); cex(ck[q][0], ck[q][2]); cex(ck[q][1], ck[q][3]); cex(ck[q][1], ck[q][2]);
        top[q] = 0u; }
}
__device__ __forceinline__ void s2_round(unsigned (&ck)[2][4], unsigned (&top)[2], bool sel) {
    unsigned x[2];
#pragma unroll
    for (int q = 0; q < 2; ++q) x[q] = rowmax16(ck[q][0]);
#pragma unroll
    for (int q = 0; q < 2; ++q) { const bool win = ck[q][0] == x[q];
        ck[q][0] = win ? ck[q][1] : ck[q][0]; ck[q][1] = win ? ck[q][2] : ck[q][1]; ck[q][2] = win ? ck[q][3] : ck[q][2]; ck[q][3] = win ? 0u : ck[q][3];
        top[q] = sel ? x[q] : top[q]; }
}
__device__ __forceinline__ void finalize(const unsigned (&top)[2], const unsigned (&MA)[2], const unsigned (&MB)[2], int cij, float rs1, float sx, const float* SU, const float* SV, int lane, TK& o) {
    const int rb = lane & 48;
    unsigned ex_id[2]; float gate[2], su[2], sv[2];
#pragma unroll
    for (int q = 0; q < 2; ++q) { const int c = (int)(top[q] & 63u); const int t = bpermi(cij, c); const int ci = t & 255, cj = t >> 8;
        const unsigned e1 = (unsigned)bpermi((int)MA[q], rb + ci) & 127u, e2 = (unsigned)bpermi((int)MB[q], rb + cj) & 127u; ex_id[q] = e1 * 128u + e2; }
#pragma unroll
    for (int q = 0; q < 2; ++q) { su[q] = SU[ex_id[q]]; sv[q] = SV[ex_id[q]]; }
#pragma unroll
    for (int q = 0; q < 2; ++q) { const float topf = o2f(top[q]), mx = o2f(rowmax16(top[q]));
        const float ex = __expf(topf - mx); const float sm = rowsum16(ex);
        gate[q] = ex * __builtin_amdgcn_rcpf(fmaxf(sm, 1e-30f)); }
    o.eidP0 = ex_id[0]; o.eidP1 = ex_id[1];
    o.cAP0 = 0.5f * rs1 * sx * su[0]; o.cAP1 = 0.5f * rs1 * sx * su[1];
    o.cBP0 = gate[0] * sv[0]; o.cBP1 = gate[1] * sv[1];
}
#define PEER_ROWUV(id) __builtin_amdgcn_raw_buffer_load_b128(rsUV, lo, (int)((id) * 1024u), 0)
__device__ __forceinline__ void load_t_head(v4u (&tq)[16], unsigned esrc, int l0, __amdgpu_buffer_rsrc_t rsUV, int lo) {
#pragma unroll
    for (int e = 0; e < 16; ++e) { const unsigned id = (unsigned)__builtin_amdgcn_readlane((int)esrc, l0 + e); tq[e] = PEER_ROWUV(id); }
}
struct GH { int p[16]; int cq; float cscale; int accI[16]; int sumcq; };
template <bool NEXTU>
__device__ __forceinline__ void gh_a(GH& g, int h, const TK& t, const v4u xq, v4u (&tq)[16], v2u (&vq)[16], __amdgpu_buffer_rsrc_t rsUV, int lo) {
#pragma unroll
    for (int e = 0; e < 16; ++e) { int d = __builtin_amdgcn_sdot4((int)(tq[e].x & 0x0f0f0f0fu), (int)xq.x, 0, false); d = __builtin_amdgcn_sdot4((int)((tq[e].x >> 4) & 0x0f0f0f0fu), (int)xq.y, d, false);
        d = __builtin_amdgcn_sdot4((int)(tq[e].y & 0x0f0f0f0fu), (int)xq.z, d, false); g.p[e] = __builtin_amdgcn_sdot4((int)((tq[e].y >> 4) & 0x0f0f0f0fu), (int)xq.w, d, false);
        vq[e].x = tq[e].z; vq[e].y = tq[e].w; }
    if (NEXTU) { const unsigned en = (h + 1 < 4) ? t.eidP0 : t.eidP1; load_t_head(tq, en, ((h + 1) & 3) * 16, rsUV, lo); }
}
__device__ __forceinline__ void gh_b(GH& g, int h, const TK& t, int lane, int sumx) {
    const float cAh = (h < 4) ? t.cAP0 : t.cAP1, cBh = (h < 4) ? t.cBP0 : t.cBP1; const int l0 = (h & 3) * 16;
    int q8[8], r4[4], s2[2], s1;
#pragma unroll
    for (int e = 0; e < 8; ++e) { const auto r = __builtin_amdgcn_permlane32_swap(g.p[e], g.p[e + 8], false, false); q8[e] = (int)r[0] + (int)r[1]; }
#pragma unroll
    for (int e = 0; e < 4; ++e) { const auto r = __builtin_amdgcn_permlane16_swap(q8[e], q8[e + 4], false, false); r4[e] = (int)r[0] + (int)r[1]; }
    { const bool up = (lane & 8) != 0;
#pragma unroll
      for (int e = 0; e < 2; ++e) { const int send = up ? r4[e] : r4[e + 2], keep = up ? r4[e + 2] : r4[e]; s2[e] = keep + __builtin_amdgcn_update_dpp(0, send, 0x128, 0xf, 0xf, true); } }
    { const bool up = (lane & 4) != 0; const int send = up ? s2[0] : s2[1], keep = up ? s2[1] : s2[0];
      int recv = __builtin_amdgcn_update_dpp(send, send, 0x104, 0xf, 0x5, false); recv = __builtin_amdgcn_update_dpp(recv, send, 0x114, 0xf, 0xa, false);
      s1 = keep + recv; }
    s1 += __builtin_amdgcn_update_dpp(0, s1, 0x4E, 0xf, 0xf, true); s1 += __builtin_amdgcn_update_dpp(0, s1, 0xB1, 0xf, 0xf, true);
    const int eb = lane >> 2;
    const float cf = bperm(cBh, l0 + eb) * gelu_tanh((float)(2 * s1 - 15 * sumx) * bperm(cAh, l0 + eb));
    unsigned am = rowmax16(__float_as_uint(cf) & 0x7fffffffu); am = dppmax<0x142>(am); am = dppmax<0x143>(am);
    const float amax = __uint_as_float((unsigned)__builtin_amdgcn_readlane((int)am, 63));
    const float cinv = amax > 0.f ? 127.0f / amax : 0.f; g.cscale = amax * (1.0f / 127.0f);
    g.cq = (int)rintf(cf * cinv);
#pragma unroll
    for (int i = 0; i < 16; ++i) g.accI[i] = 0;
    g.sumcq = 0;
}
template <int GQ0>
__device__ __forceinline__ void gh_c(GH& g, const v2u (&vq)[16]) {
#pragma unroll
    for (int gq = GQ0; gq < GQ0 + 2; ++gq) {
        const int q0 = __builtin_amdgcn_readlane(g.cq, 16 * gq), q1 = __builtin_amdgcn_readlane(g.cq, 16 * gq + 4), q2 = __builtin_amdgcn_readlane(g.cq, 16 * gq + 8), q3 = __builtin_amdgcn_readlane(g.cq, 16 * gq + 12);
        g.sumcq += (q0 + q1) + (q2 + q3);
        const int cw = (int)(((unsigned)q0 & 0xffu) | (((unsigned)q1 & 0xffu) << 8) | (((unsigned)q2 & 0xffu) << 16) | (((unsigned)q3 & 0xffu) << 24));
#pragma unroll
        for (int wg = 0; wg < 2; ++wg) {
            const unsigned r0 = wg ? vq[4 * gq].y : vq[4 * gq].x, r1 = wg ? vq[4 * gq + 1].y : vq[4 * gq + 1].x, r2 = wg ? vq[4 * gq + 2].y : vq[4 * gq + 2].x, r3 = wg ? vq[4 * gq + 3].y : vq[4 * gq + 3].x;
            const unsigned t0 = __builtin_amdgcn_perm(r1, r0, 0x05010400u), t1 = __builtin_amdgcn_perm(r1, r0, 0x07030602u);
            const unsigned t2 = __builtin_amdgcn_perm(r3, r2, 0x05010400u), t3 = __builtin_amdgcn_perm(r3, r2, 0x07030602u);
            unsigned o[4]; o[0] = __builtin_amdgcn_perm(t2, t0, 0x05040100u); o[1] = __builtin_amdgcn_perm(t2, t0, 0x07060302u);
            o[2] = __builtin_amdgcn_perm(t3, t1, 0x05040100u); o[3] = __builtin_amdgcn_perm(t3, t1, 0x07060302u);
#pragma unroll
            for (int j = 0; j < 4; ++j) {
                g.accI[8 * wg + j] = __builtin_amdgcn_sdot4((int)(o[j] & 0x0f0f0f0fu), cw, g.accI[8 * wg + j], false);
                g.accI[8 * wg + 4 + j] = __builtin_amdgcn_sdot4((int)o[j], cw, g.accI[8 * wg + 4 + j], false);
            }
        }
    }
}
__device__ __forceinline__ void gh_d(const GH& g, float (&acc)[16]) {
    const int offI = 15 * g.sumcq, offH = 8 * g.sumcq;
#pragma unroll
    for (int wg = 0; wg < 2; ++wg)
#pragma unroll
        for (int j = 0; j < 4; ++j) { const int Ls = g.accI[8 * wg + j], Fs = g.accI[8 * wg + 4 + j];
            acc[8 * wg + j] = fmaf((float)(2 * Ls - offI), 0.5f * g.cscale, acc[8 * wg + j]);
            acc[8 * wg + 4 + j] = fmaf((float)(Fs - Ls + offH), 0.0625f * g.cscale, acc[8 * wg + 4 + j]); }
}

template <long X8D>
__device__ __forceinline__ void run_wave(const float* S, bf16* XB, const unsigned char* UQ, const unsigned char* VQ, const float* SU, const float* SV, const float* ss1, float* rs2, int gw, int ngw, int ntok, int lane_in) {
    int lane = lane_in; asm volatile("" : "+v"(lane));
    const int hl = lane & 31, li = lane & 15;
    auto slot_ij = [](int l, int& ci, int& cj) { if (l < 16) { ci = 0; cj = l; } else if (l < 24) { ci = 1; cj = l - 16; } else if (l < 29) { ci = 2; cj = l - 24; } else if (l < 33) { ci = 3; cj = l - 29; }
      else if (l < 36) { ci = 4; cj = l - 33; } else if (l < 42) { ci = 5 + ((l - 36) >> 1); cj = (l - 36) & 1; } else if (l < 50) { ci = 8 + (l - 42); cj = 0; } else { ci = 0; cj = 0; } };
    int cij; unsigned ciP = 0u, cjP = 0u;
    { int ci, cj; slot_ij(lane, ci, cj); cij = ci | (cj << 8);
#pragma unroll
      for (int k = 0; k < 4; ++k) { slot_ij(li + 16 * k, ci, cj); ciP |= (unsigned)((lane & 48) + ci) << (8 * k); cjP |= (unsigned)((lane & 48) + cj) << (8 * k); } }
    const __amdgpu_buffer_rsrc_t rsUV = __builtin_amdgcn_make_buffer_rsrc((void*)UQ, 0, NEXP * 1024, 0x00020000); (void)VQ;
    const int lo = lane * 16;
    if (gw >= ntok) return;
    Pre pre; unsigned kk[4][8], mine[4], MA[2], MB[2], ck[2][4], top[2];
    int sumx_cur = 0, sumx_nxt = 0;
    TK cur, nxt; v4u xq_cur, xq_nxt; float sx;
    load_pre(pre, S, XB, gw, lane);
    prep_keys(pre, kk, hl); quant_x(pre, xq_cur, sx, sumx_cur, lane);
#pragma unroll
    for (int p = 0; p < 4; ++p) mine[p] = 0u;
#pragma unroll 1
    for (int it = 0; it < 16; ++it) s1_round(kk, mine, li == it);
    s2_setup(mine, MA, MB, ck, top, ciP, cjP, li);
#pragma unroll 1
    for (int it = 0; it < 16; ++it) s2_round(ck, top, li == it);
    finalize(top, MA, MB, cij, 1.0f / sqrtf(ss1[gw] * (1.0f / 1024.0f) + EPS), sx, SU, SV, lane, cur);
    { const int t1 = (gw + ngw < ntok) ? gw + ngw : gw; load_pre(pre, S, XB, t1, lane); }
    v4u tq[16]; v2u vq[16];
    load_t_head(tq, cur.eidP0, 0, rsUV, lo);
#define PEER_HEAD(H, VCUR, VNEXT, NEXTU, R0, R1, R2, R3) { GH g; \
        gh_a<NEXTU>(g, H, cur, xq_cur, tq, vq, rsUV, lo); R0; \
        gh_b(g, H, cur, lane, sumx_cur);                          R1; \
        gh_c<0>(g, vq);                                           R2; \
        gh_c<2>(g, vq); gh_d(g, acc);                             R3; }
#pragma unroll 1
    for (int tkn = gw; tkn < ntok; tkn += ngw) {
        asm volatile("" : "+v"(lane)); const int hl = lane & 31, li = lane & 15, lo = lane * 16; (void)hl; (void)li; (void)lo;
        const int tn1 = (tkn + ngw < ntok) ? tkn + ngw : tkn, tn2 = (tn1 + ngw < ntok) ? tn1 + ngw : tn1;
        prep_keys(pre, kk, hl); quant_x(pre, xq_nxt, sx, sumx_nxt, lane);
        const float rs1n = 1.0f / sqrtf(ss1[tn1] * (1.0f / 1024.0f) + EPS);
#pragma unroll
        for (int p = 0; p < 4; ++p) mine[p] = 0u;
        float acc[16];
#pragma unroll
        for (int i = 0; i < 16; ++i) acc[i] = 0.f;
#pragma unroll 1
        for (int hh = 0; hh < 2; ++hh) {
            PEER_HEAD(2 * hh, va, vb, true, s1_round(kk, mine, li == 8 * hh + 0), s1_round(kk, mine, li == 8 * hh + 1), s1_round(kk, mine, li == 8 * hh + 2), s1_round(kk, mine, li == 8 * hh + 3))
            PEER_HEAD(2 * hh + 1, vb, va, true, s1_round(kk, mine, li == 8 * hh + 4), s1_round(kk, mine, li == 8 * hh + 5), s1_round(kk, mine, li == 8 * hh + 6), s1_round(kk, mine, li == 8 * hh + 7))
        }
        s2_setup(mine, MA, MB, ck, top, ciP, cjP, li);
        PEER_HEAD(4, va, vb, true, s2_round(ck, top, li == 0), s2_round(ck, top, li == 1), s2_round(ck, top, li == 2), s2_round(ck, top, li == 3))
        PEER_HEAD(5, vb, va, true, s2_round(ck, top, li == 4), s2_round(ck, top, li == 5), s2_round(ck, top, li == 6), s2_round(ck, top, li == 7))
        PEER_HEAD(6, va, vb, true, s2_round(ck, top, li == 8), s2_round(ck, top, li == 9), s2_round(ck, top, li == 10), s2_round(ck, top, li == 11))
        v4u xr_cur0, xr_cur1; { int lo_ = lane; asm volatile("" : "+v"(lo_)); const v4u* xp_ = (const v4u*)(XB + (size_t)tkn * 1024 + lo_ * 16); xr_cur0 = xp_[0]; xr_cur1 = xp_[1]; }
        { int lp_ = lane; asm volatile("" : "+v"(lp_)); load_pre(pre, S, XB, tn2, lp_); }
        PEER_HEAD(7, vb, va, false, s2_round(ck, top, li == 12), s2_round(ck, top, li == 13), s2_round(ck, top, li == 14), s2_round(ck, top, li == 15))
        finalize(top, MA, MB, cij, rs1n, sx, SU, SV, lane, nxt);
        load_t_head(tq, nxt.eidP0, 0, rsUV, lo);
        { f32x4 xf[4]; pg8::unpack8(xr_cur0, xf[0], xf[1]); pg8::unpack8(xr_cur1, xf[2], xf[3]);
          f32x4 y[4]; float ss = 0.f;
#pragma unroll
          for (int w = 0; w < 4; ++w)
#pragma unroll
              for (int e = 0; e < 4; ++e) { y[w][e] = xf[w][e] + acc[4 * w + e]; ss += y[w][e] * y[w][e]; }
          int lo_ = lane; asm volatile("" : "+v"(lo_));
          bf16* xb = XB + (size_t)tkn * 1024 + lo_ * 16;
          *(v4u*)xb = pg8::pack8(y[0], y[1]); *(v4u*)(xb + 8) = pg8::pack8(y[2], y[3]);
          { v4u o8; o8.x = pg8::pkf8(y[0][0], y[0][1], y[0][2], y[0][3]); o8.y = pg8::pkf8(y[1][0], y[1][1], y[1][2], y[1][3]); o8.z = pg8::pkf8(y[2][0], y[2][1], y[2][2], y[2][3]); o8.w = pg8::pkf8(y[3][0], y[3][1], y[3][2], y[3][3]);
            *(v4u*)((unsigned char*)XB + X8D + (size_t)tkn * 1024 + lo_ * 16) = o8; }
          ss = wave_sum(ss, lane);
          if (lane == 0) rs2[tkn] = 1.0f / sqrtf(ss * (1.0f / 1024.0f) + EPS); }
        cur = nxt; xq_cur = xq_nxt; sumx_cur = sumx_nxt;
    }
}
#undef PEER_HEAD
#undef PEER_ROW
#undef PEER_ROWV
}

__global__ void __launch_bounds__(NWAVES * 64, 2) mk_fwd(Args args) {
    extern __shared__ __attribute__((aligned(16))) unsigned char lds[];
    LAS unsigned char* L = (LAS unsigned char*)lds;
    volatile LAS unsigned* MISC = (volatile LAS unsigned*)(L + MISC_OFF);
    const int G = gridDim.x, bx = blockIdx.x;
    const int wave_s = __builtin_amdgcn_readfirstlane((int)threadIdx.x >> 6);
    const int NGW = G * NWAVES, NGT = G * NWAVES * 64;
#define FRESH_IDS() int tid = wave_s * 64 + lane_id_opaque(); asm volatile("" : "+v"(tid)); const int lane = tid & 63, wave = __builtin_amdgcn_readfirstlane(tid >> 6); \
    const int gw = bx * NWAVES + wave, gtid = bx * (NWAVES * 64) + tid; (void)lane; (void)gw; (void)gtid
    typedef const unsigned char __attribute__((address_space(4))) karg_t;
#define FRESH_ARGS() karg_t* kp_ = (karg_t*)__builtin_amdgcn_kernarg_segment_ptr(); asm volatile("" : "+s"(kp_)); \
    unsigned char* ws = *(unsigned char* const __attribute__((address_space(4)))*)(kp_ + 224); float* out = *(float* const __attribute__((address_space(4)))*)(kp_ + 216); (void)out; (void)ws
#define IN(k) (*(const float* const __attribute__((address_space(4)))*)(kp_ + 8 * (k)))
#define WSP(T_, off) ((T_*)(ws + (off)))
    { FRESH_IDS(); for (int u = tid; u < (LDS_BYTES - LDSCTL_OFF) / 4; u += NWAVES * 64) ((LAS unsigned*)(L + LDSCTL_OFF))[u] = 0u; }
    __syncthreads();
    XcdBarrier bar;
    { FRESH_ARGS(); bar = xcd_barrier_post((unsigned*)(ws + WS_CTL) + CW_BAR, MISC + 8, wave_s); }
#define GRID_BAR() xcd_barrier(bar, wave_s)

    {
        FRESH_IDS(); FRESH_ARGS();
        bf16* WinT = WSP(bf16, WS_WIN); bf16* WgluT = WSP(bf16, WS_WGLU); bf16* WpsT = WSP(bf16, WS_WPS); bf16* WpaT = WSP(bf16, WS_WPA);
        bf16* WoutT = WSP(bf16, WS_WOUT); bf16* WsT = WSP(bf16, WS_WS); bf16* WgateT = WSP(bf16, WS_WGATE); bf16* WppT = WSP(bf16, WS_WPP);
        float* rope = WSP(float, WS_ROPE); unsigned char* s5p = ws + WS_S5P; bf16* XN = WSP(bf16, WS_XN); bf16* PB = WSP(bf16, WS_PB);
        const float* x = IN(I_X);
        for (int it = bx; it < 256; it += G) p0_ws_item(IN(I_WQ), IN(I_GFFN), IN(I_KEY1), IN(I_KEY2), WsT, L + RING_OFF, it, tid);
        {
            LAS float* scr = (LAS float*)(L + RING_OFF + wave * 16384);
            constexpr int I_1 = (1024 / 64) * (4096 / 32), I_2 = (512 / 64) * (512 / 32), I_3 = (512 / 64) * (1024 / 32), I_4 = I_3, I_5 = (1024 / 64) * (1024 / 32), I_6 = I_5, I_7 = (256 / 64) * (1024 / 32);
            constexpr int NIT = I_1 + I_2 + I_3 + I_4 + I_5 + I_6 + I_7;
            for (int it = gw; it < NIT; it += NGW) {
                int r = it;
                if (r < I_1) { p0_transpose_item<true>(IN(I_WIN), IN(I_GMIX), 1024, 4096, WinT, scr, r, lane); continue; } r -= I_1;
                if (r < I_2) { p0_transpose_item<true>(IN(I_WGLU), nullptr, 512, 512, WgluT, scr, r, lane); continue; } r -= I_2;
                if (r < I_3) { p0_transpose_item<true>(IN(I_WPS), nullptr, 512, 1024, WpsT, scr, r, lane); continue; } r -= I_3;
                if (r < I_4) { p0_transpose_item<true>(IN(I_WPA), nullptr, 512, 1024, WpaT, scr, r, lane); continue; } r -= I_4;
                if (r < I_5) { p0_transpose_item<true>(IN(I_WOUT), nullptr, 1024, 1024, WoutT, scr, r, lane); continue; } r -= I_5;
                if (r < I_6) { p0_transpose_item<true>(IN(I_WGATE), IN(I_GPLE), 1024, 1024, WgateT, scr, r, lane); continue; } r -= I_6;
                p0_transpose_item(IN(I_WPP), nullptr, 256, 1024, WppT, scr, r, lane);
            }
        }
        {
            const float* pu = IN(I_PU); const float* pv = IN(I_PV); const float* gf = IN(I_GFFN);
            unsigned char* UQ = WSP(unsigned char, WS_UT); unsigned char* VQ = WSP(unsigned char, WS_VT); float* SU = WSP(float, WS_SU); float* SV = WSP(float, WS_SV);
            f32x4 gf4[4];
#pragma unroll
            for (int j = 0; j < 4; ++j) gf4[j] = *(const f32x4*)(gf + 16 * lane + 4 * j);
            for (int r0 = gw * 4; r0 < NEXP; r0 += NGW * 4) { peer::Row4 rw[4];
#pragma unroll
                for (int i = 0; i < 4; ++i) peer::load_row16(rw[i], pu + (size_t)(r0 + i) * 1024, lane);
#pragma unroll
                for (int i = 0; i < 4; ++i) peer::quant_row4(rw[i], gf4, true, UQ + (size_t)(r0 + i) * 1024, SU + r0 + i, lane); }
            for (int r0 = gw * 4; r0 < NEXP; r0 += NGW * 4) { peer::Row4 rw[4];
#pragma unroll
                for (int i = 0; i < 4; ++i) peer::load_row16(rw[i], pv + (size_t)(r0 + i) * 1024, lane);
#pragma unroll
                for (int i = 0; i < 4; ++i) peer::quant_row4(rw[i], gf4, false, UQ + (size_t)(r0 + i) * 1024 + 8, SV + r0 + i, lane, true); }
        }
        for (int m0 = gw * 4; m0 < T; m0 += NGW * 4) {
            f32x4 v[4][4];
#pragma unroll
            for (int i = 0; i < 4; ++i) { const f32x4* xr = (const f32x4*)(x + (size_t)(m0 + i) * D) + lane;
#pragma unroll
                for (int j = 0; j < 4; ++j) v[i][j] = xr[64 * j]; }
#pragma unroll
            for (int i = 0; i < 4; ++i) { float s = 0.f;
#pragma unroll
                for (int j = 0; j < 4; ++j) s += (v[i][j].x * v[i][j].x + v[i][j].y * v[i][j].y) + (v[i][j].z * v[i][j].z + v[i][j].w * v[i][j].w);
                const float rs = 1.0f / sqrtf(wave_sum(s, lane) * (1.f / D) + EPS);
                unsigned* o8 = (unsigned*)((unsigned char*)XN + (size_t)(m0 + i) * D) + lane;
#pragma unroll
                for (int j = 0; j < 4; ++j) o8[64 * j] = pg8::pkf8(v[i][j].x * rs, v[i][j].y * rs, v[i][j].z * rs, v[i][j].w * rs); }
        }
        {
            const float* pp = IN(I_P);
            constexpr int NI = T * D_PLE / 8;
            for (int i8 = gtid; i8 < NI; i8 += 4 * NGT) { f32x4 a[4], b[4];
#pragma unroll
                for (int j = 0; j < 4; ++j) { const int ij = i8 + j * NGT; const size_t o = (size_t)(ij < NI ? ij : NI - 1) * 8; a[j] = *(const f32x4*)(pp + o); b[j] = *(const f32x4*)(pp + o + 4); }
#pragma unroll
                for (int j = 0; j < 4; ++j) { const int ij = i8 + j * NGT; if (ij >= NI) break; const size_t o = (size_t)ij * 8; *(v4u*)(PB + o) = pg8::pack8(a[j], b[j]); } }
        }
        {
            const int* pos = (const int*)IN(I_POS);
            for (int i = gtid; i < T * 8; i += NGT) { const int t = i >> 3, k = i & 7;
                const double invf = k == 0 ? 1.0 : k == 1 ? 0.19392274474868576 : k == 2 ? 0.03760603093086393 : k == 3 ? 0.007292664737217109 : k == 4 ? 0.001414213562373095
                                  : k == 5 ? 0.0002742481756762073 : k == 6 ? 5.318295896944988e-05 : 1.031338537721246e-05;
                float c, s; cs_reduced((double)pos[t] * invf, c, s);
                rope[(size_t)t * 16 + 2 * k] = c; rope[(size_t)t * 16 + 2 * k + 1] = s; }
        }
        if (gtid < NG * NS) {
            const int g = gtid >> 6;
            const float dt = expf(IN(I_LOGDT)[g]); const float are = IN(I_ARE)[gtid], aim = IN(I_AIM)[gtid];
            const double zr = (double)dt * (double)are, th = (double)dt * (double)aim;
            float c, s; cs_reduced(th, c, s); const float mag = expf((float)zr);
            const float abr = mag * c, abi = mag * s;
            float cL, sL; cs_reduced(64.0 * th, cL, sL); const float magL = expf((float)(64.0 * zr));
            ((float*)(s5p + S5_ABR))[gtid] = abr; ((float*)(s5p + S5_ABI))[gtid] = abi;
            ((float*)(s5p + S5_ALR))[gtid] = magL * cL; ((float*)(s5p + S5_ALI))[gtid] = magL * sL;
            const float den = are * are + aim * aim, nr = abr - 1.0f, ni = abi;
            const float fre = (nr * are + ni * aim) / den, fim = (ni * are - nr * aim) / den;
            const float* br = IN(I_BRE) + (size_t)gtid * 16; const float* bi = IN(I_BIM) + (size_t)gtid * 16;
            float* obr = (float*)(s5p + S5_BRE) + (size_t)gtid * 16; float* obi = (float*)(s5p + S5_BIM) + (size_t)gtid * 16;
#pragma unroll
            for (int cc = 0; cc < 16; ++cc) { obr[cc] = fre * br[cc] - fim * bi[cc]; obi[cc] = fre * bi[cc] + fim * br[cc]; }
        }
        for (int i = gtid; i < NG * NS * 64; i += NGT) { const int t = i & 63, gn = i >> 6, g = gn >> 6;
            const float dt = expf(IN(I_LOGDT)[g]); const float are = IN(I_ARE)[gn], aim = IN(I_AIM)[gn];
            const double zr = (double)dt * (double)are, th = (double)dt * (double)aim;
            float c1, s1; cs_reduced(th, c1, s1); const float mag1 = expf((float)zr); const float abr = mag1 * c1, abi = mag1 * s1;
            const float den = are * are + aim * aim, nr = abr - 1.0f, ni = abi;
            const float fre = (nr * are + ni * aim) / den, fim = (ni * are - nr * aim) / den;
            float cp, sp; cs_reduced((double)(63 - t) * th, cp, sp); const float magp = expf((float)((double)(63 - t) * zr)); const float pr = magp * cp, pi = magp * sp;
            const float qr = pr * fre - pi * fim, qi = pr * fim + pi * fre;
            const f32x4* br = (const f32x4*)(IN(I_BRE) + (size_t)gn * 16); const f32x4* bi = (const f32x4*)(IN(I_BIM) + (size_t)gn * 16);
            bf16* wre = WSP(bf16, WS_S5W) + ((size_t)g * 128 + (gn & 63)) * 1024 + 16 * t; bf16* wim = wre + (size_t)64 * 1024;
#pragma unroll
            for (int h8 = 0; h8 < 2; ++h8) { const f32x4 r0 = br[2 * h8], r1 = br[2 * h8 + 1], i0 = bi[2 * h8], i1 = bi[2 * h8 + 1];
                *(v4u*)(wre + 8 * h8) = pg8::pack8(qr * r0 - qi * i0, qr * r1 - qi * i1); *(v4u*)(wim + 8 * h8) = pg8::pack8(qr * i0 + qi * r0, qr * i1 + qi * r1); } }
        for (int i = gtid; i < NG * 16 * 128; i += NGT) { const int gc = i >> 7, n = i & 127;
            const float v = n < 64 ? IN(I_CRE)[(size_t)gc * 64 + n] : -IN(I_CIM)[(size_t)gc * 64 + n - 64];
            ((bf16*)(s5p + S5_CM))[i] = (bf16)(pkbf(v, 0.f) & 0xffffu); }
    }
    GRID_BAR();

    {
        FRESH_ARGS();
        bf16* XN = WSP(bf16, WS_XN); bf16* WinT = WSP(bf16, WS_WIN); bf16* PB = WSP(bf16, WS_PB); bf16* WppT = WSP(bf16, WS_WPP); bf16* EB = WSP(bf16, WS_E);
        bf16* Ub = WSP(bf16, WS_U); bf16* Qb = WSP(bf16, WS_Q); bf16* Kb = WSP(bf16, WS_K); bf16* Vb = WSP(bf16, WS_V); bf16* SGA = WSP(bf16, WS_SGA); bf16* SGB = WSP(bf16, WS_SGB);
        float* kmean = WSP(float, CTL_KMEAN); float* rope = WSP(float, WS_ROPE);
        { pg8::Gemm g{XN, WinT, T, D_IN, D}; pg8::StaticOrder S; S.init(T, D_IN, G, bx);
          pg8::EpiWin E{Ub, Qb, Kb, Vb, SGA, SGB, kmean, rope, 0.18033688011112042f};
          pg8::gemm_phase<pg8::EpiWin, pg8::StaticOrder, true, true, true, D>(L + RING_OFF, g, S, E, wave_s); }
        { pg8::Gemm g{PB, WppT, T, D, D_PLE}; pg8::StaticOrder S; S.init(T, D, G, bx);
          pg8::EpiPlain E{EB, D};
          pg8::gemm_phase<pg8::EpiPlain, pg8::StaticOrder, true, true, false, D_PLE>(L + RING_OFF, g, S, E, wave_s); }
    }
    GRID_BAR();

    {
        { FRESH_IDS(); FRESH_ARGS();
          const bf16* Qb = WSP(bf16, WS_Q); const float* kmean = WSP(float, CTL_KMEAN);
          unsigned short* SUB = WSP(unsigned short, WS_MSUB); unsigned* CNT = WSP(unsigned, WS_MCNT); float* LSE = WSP(float, WS_MLSE);
          for (int u = bx; u < 512; u += G) moba::select_pair(u, 1023 - u, (const moba::bf16*)Qb, kmean, SUB, CNT, LSE, (char*)lds + RING_OFF, tid); }
        FRESH_IDS(); FRESH_ARGS();
        __syncthreads();
        s5::pass1_gemm(L + RING_OFF, WSP(bf16, WS_S5W), WSP(bf16, WS_U), WSP(float, WS_HLOC), G, bx, tid, wave);
    }
    GRID_BAR();

    {
        FRESH_IDS(); FRESH_ARGS();
        moba::sparse_phase((const moba::bf16*)WSP(bf16, WS_Q), (const moba::bf16*)WSP(bf16, WS_K), (const moba::bf16*)WSP(bf16, WS_V), WSP(unsigned short, WS_MSUB), WSP(unsigned, WS_MCNT),
                           (moba::bf16*)out, WSP(float, WS_MLSE), (char*)lds + RING_OFF, G, bx, tid, wave_s);
    }
    GRID_BAR();

    {
        { FRESH_ARGS();
          moba::own_phase((const moba::bf16*)WSP(bf16, WS_Q), (const moba::bf16*)WSP(bf16, WS_K), (const moba::bf16*)WSP(bf16, WS_V), (const moba::bf16*)out, WSP(float, WS_MLSE), (moba::bf16*)WSP(bf16, WS_PB),
                          (char*)lds + RING_OFF, G, bx, wave_s); }
        FRESH_IDS(); FRESH_ARGS();
        s5::run<2>(L + RING_OFF + wave * 16384, ws + WS_S5P, WSP(bf16, WS_U), WSP(float, WS_HLOC), IN(I_DSK), WSP(bf16, WS_YP), gw, NGW, lane); }
    GRID_BAR();

    {
        FRESH_ARGS(); bf16* YP = WSP(bf16, WS_YP); bf16* YS = WSP(bf16, WS_V); bf16* WgluT = WSP(bf16, WS_WGLU);
        pg8::Gemm g{WSP(bf16, WS_MSUB), WgluT, T, D_SSM, D_SSM}; pg8::StaticOrder S; S.init(T, D_SSM, G, bx);
        pg8::EpiGlu E{YP, YS};
        pg8::gemm_phase<pg8::EpiGlu, pg8::StaticOrder, true, true, true, D_SSM>(L + RING_OFF, g, S, E, wave_s);
    }
    GRID_BAR();

    {
        FRESH_ARGS(); bf16* YS = WSP(bf16, WS_V); bf16* Qb = WSP(bf16, WS_PB); unsigned char* M8 = WSP(unsigned char, WS_U); bf16* WpsT = WSP(bf16, WS_WPS); bf16* WpaT = WSP(bf16, WS_WPA); bf16* SGA = WSP(bf16, WS_SGA); bf16* SGB = WSP(bf16, WS_SGB);
        { pg8::Gemm g{YS, WpsT, T, D, D_SSM}; pg8::StaticOrder S; S.init(T, D, G, bx);
          pg8::EpiMerge<0> E{SGA, nullptr, nullptr};
          pg8::gemm_phase<pg8::EpiMerge<0>, pg8::StaticOrder, true, true, true, D_SSM>(L + RING_OFF, g, S, E, wave_s); }
        { pg8::Gemm g{Qb, WpaT, T, D, D_ATT}; pg8::StaticOrder S; S.init(T, D, G, bx);
          pg8::EpiMerge<1> E{SGA, SGB, M8};
          pg8::gemm_phase<pg8::EpiMerge<1>, pg8::StaticOrder, true, true, true, D_ATT>(L + RING_OFF, g, S, E, wave_s); }
    }
    GRID_BAR();

    {
        FRESH_ARGS(); bf16* SGA = WSP(bf16, WS_U); bf16* WoutT = WSP(bf16, WS_WOUT); bf16* XN = WSP(bf16, WS_XN); float* ss1 = WSP(float, CTL_SS1); const float* x = IN(I_X);
        pg8::Gemm g{SGA, WoutT, T, D, D}; pg8::StaticOrder S; S.init(T, D, G, bx);
        pg8::EpiResid E{x, XN, ss1};
        pg8::gemm_phase<pg8::EpiResid, pg8::StaticOrder, true, true, true, D>(L + RING_OFF, g, S, E, wave_s);
    }
    GRID_BAR();

    {
        FRESH_ARGS(); bf16* XN = WSP(bf16, WS_XN); bf16* WsT = WSP(bf16, WS_WS); float* SC = WSP(float, WS_SC); float* ss1 = WSP(float, CTL_SS1);
        pg8::Gemm g{XN, WsT, T, PH * PQD, D}; pg8::StaticOrder S; S.init(T, PH * PQD, G, bx);
        pg8::EpiScores E{(pg8::bf16_t*)SC, ss1};
        pg8::gemm_phase<pg8::EpiScores, pg8::StaticOrder, true, true, false, D>(L + RING_OFF, g, S, E, wave_s);
    }
    GRID_BAR();

    {
        FRESH_IDS(); FRESH_ARGS();
        float* SC = WSP(float, WS_SC); bf16* XN = WSP(bf16, WS_XN); float* ss1 = WSP(float, CTL_SS1); float* rs2 = WSP(float, WS_RS2);
        const unsigned char* UQ = WSP(unsigned char, WS_UT); const unsigned char* VQ = WSP(unsigned char, WS_VT); const float* SU = WSP(float, WS_SU); const float* SV = WSP(float, WS_SV);
        peer::run_wave<(long)WS_X8 - (long)WS_XN>(SC, XN, UQ, VQ, SU, SV, ss1, rs2, gw, NGW, T, lane);
    }
    GRID_BAR();

    {
        FRESH_ARGS(); bf16* XN = WSP(bf16, WS_XN); bf16* WgateT = WSP(bf16, WS_WGATE); bf16* EB = WSP(bf16, WS_E); float* rs2 = WSP(float, WS_RS2); float* ss3 = WSP(float, CTL_SS3);
        pg8::Gemm g{WSP(bf16, WS_X8), WgateT, T, D, D}; pg8::StaticOrder S; S.init(T, D, G, bx);
        pg8::EpiPle E{XN, EB, rs2, ss3};
        pg8::gemm_phase<pg8::EpiPle, pg8::StaticOrder, true, true, true, D>(L + RING_OFF, g, S, E, wave_s);
    }
    GRID_BAR();

    {
        FRESH_IDS(); FRESH_ARGS();
        const bool bad = xb_ld(&bar.bar[XB_TMO]) != 0u;
        const float* gfin = IN(I_GFIN); float* ss3 = WSP(float, CTL_SS3);
        const f32x4* gp = (const f32x4*)gfin + lane;
        f32x4 g4[4];
#pragma unroll
        for (int j = 0; j < 4; ++j) g4[j] = gp[64 * j];
        const bf16* X3B = WSP(bf16, WS_E);
        for (int m0 = gw * 4; m0 < T; m0 += NGW * 4) {
            v2u v[4][4]; float rs[4];
#pragma unroll
            for (int i = 0; i < 4; ++i) { const v2u* xr = (const v2u*)(X3B + (size_t)(m0 + i) * D) + lane; rs[i] = ss3[m0 + i];
#pragma unroll
                for (int j = 0; j < 4; ++j) v[i][j] = xr[64 * j]; }
#pragma unroll
            for (int i = 0; i < 4; ++i) { const float r_ = 1.0f / sqrtf(rs[i] * (1.f / D) + EPS); f32x4* xo = (f32x4*)(out + (size_t)(m0 + i) * D) + lane;
#pragma unroll
                for (int j = 0; j < 4; ++j) { f32x4 r = (f32x4){bflo(v[i][j].x), bfhi(v[i][j].x), bflo(v[i][j].y), bfhi(v[i][j].y)} * r_ * g4[j]; if (bad) r = (f32x4){__builtin_nanf(""), 0.f, 0.f, 0.f}; xo[64 * j] = r; } }
        }
    }
}

extern "C" void kernel_launch(void* const* d_in, const int* in_sizes, int n_in, void* d_out, int out_size, void* d_ws, size_t ws_size, hipStream_t stream) {
    static int grid = 0;
    if (grid == 0) {
        if (n_in != 27 || in_sizes[0] != T * D || out_size != T * D || ws_size < WS_END) {
            fprintf(stderr, "kernel_launch: built for 27 inputs, x/out of %d floats, >= %zu bytes of workspace; got n_in %d in0 %d out %d ws %zu\n", T * D, (size_t)WS_END, n_in, n_in > 0 ? in_sizes[0] : -1, out_size, ws_size);
            grid = -1; return; }
        int dev = 0, cus = 0, per_cu = 0;
        if (hipGetDevice(&dev) != hipSuccess || hipDeviceGetAttribute(&cus, hipDeviceAttributeMultiprocessorCount, dev) != hipSuccess) { grid = -1; return; }
        if (hipFuncSetAttribute((const void*)mk_fwd, hipFuncAttributeMaxDynamicSharedMemorySize, LDS_BYTES) != hipSuccess) { fprintf(stderr, "kernel_launch: hipFuncSetAttribute failed\n"); grid = -1; return; }
        if (hipOccupancyMaxActiveBlocksPerMultiprocessor(&per_cu, (const void*)mk_fwd, NWAVES * 64, LDS_BYTES) != hipSuccess || per_cu < 1) { fprintf(stderr, "kernel_launch: occupancy query says %d\n", per_cu); per_cu = 1; }
        (void)hipGetLastError();
        grid = cus;
        if (grid % 32 != 0 || grid > 256) grid = (grid / 32) * 32 > 256 ? 256 : (grid / 32) * 32;
        fprintf(stderr, "kernel_launch: cus %d per_cu %d grid %d ws %zu\n", cus, per_cu, grid, ws_size);
    }
    if (grid <= 0) return;
    if (hipMemsetAsync((char*)d_ws + WS_CTL, 0, CTL_ZERO_BYTES, stream) != hipSuccess) { fprintf(stderr, "kernel_launch: memset failed\n"); return; }
    Args a{};
    for (int i = 0; i < 27; ++i) a.in[i] = (const float*)d_in[i];
    a.out = (float*)d_out; a.ws = (unsigned char*)d_ws;
    void* kargs[] = {&a};
    const hipError_t e = hipLaunchCooperativeKernel((const void*)mk_fwd, dim3(grid), dim3(NWAVES * 64), kargs, LDS_BYTES, stream);
    if (e != hipSuccess) fprintf(stderr, "kernel_launch: cooperative launch failed: %s (grid %d)\n", hipGetErrorString(e), grid);
}
```

```cpp
#include <hip/hip_runtime.h>
#include <hip/hip_bf16.h>
#include <cstdio>
#include <cstdint>
#include <cmath>
namespace pg8 {
#define PG8_LAS __attribute__((address_space(3)))
typedef unsigned short bf16_t;
typedef short bf16x8 __attribute__((ext_vector_type(8)));
typedef float f32x4 __attribute__((ext_vector_type(4)));
typedef unsigned u32x4 __attribute__((ext_vector_type(4)));
constexpr int BM = 256, BK = 64, HALF = 128, HTB = HALF * BK * 2  , STAGE_BYTES = 8 * HTB, NXCD = 8, WGM = 8;

__host__ __device__ __forceinline__ int lds_byte(int r, int c) { const int st = (r >> 4) * 2 + (c >> 5), rr = r & 15, cc = c & 31, ob = rr * 64 + cc * 2; return st * 1024 + (ob ^ (((ob >> 9) & 1) << 5)); }
__host__ __device__ __forceinline__ void stage_rc(int b, int& R, int& C) { const int st = b / 1024, sb = b % 1024, swz = sb ^ (((sb >> 9) & 1) << 5); R = (st >> 1) * 16 + swz / 64; C = (st & 1) * 32 + (swz % 64) / 2; }
__host__ __device__ __forceinline__ int perm32(int rho) { const int n = rho >> 4, i = rho & 15; return 8 * (i >> 2) + 4 * n + (i & 3); }

struct Unit { int pm, pn; };
struct Gemm { const bf16_t* A; const bf16_t* Bt; int M, N, K; };

struct StaticOrder {
    int nM, nN, nwg, G, c;
    __host__ __device__ void init(int M, int N, int G_, int c_) { nM = M / BM; nN = N / BM; nwg = nM * nN; G = G_; c = c_; }
    __host__ __device__ bool next(int i, Unit& u) const {
        const long L = (long)i * G + c; if (L >= nwg) return false;
        int wgid = (int)L; { const int q = nwg / NXCD, r = nwg % NXCD, xcd = wgid % NXCD, off = wgid / NXCD; wgid = (xcd < r ? xcd * (q + 1) : r * (q + 1) + (xcd - r) * q) + off; }
        const int nig = WGM * nN, gid = wgid / nig, fm = gid * WGM, gsz = (nM - fm) < WGM ? (nM - fm) : WGM;
        u.pm = fm + ((wgid % nig) % gsz); u.pn = (wgid % nig) / gsz; return true;
    }
    __device__ __forceinline__ void a_ready(const Unit&) const {}
    __device__ __forceinline__ void done(const Unit&) const {}
};

__device__ __forceinline__ unsigned cvt_pk_bf16(float lo, float hi) { unsigned r; asm volatile("v_cvt_pk_bf16_f32 %0, %1, %2" : "=v"(r) : "v"(lo), "v"(hi)); return r; }
typedef float f32x2 __attribute__((ext_vector_type(2)));
typedef unsigned u32x2 __attribute__((ext_vector_type(2)));
typedef __bf16 bf16x2_t __attribute__((ext_vector_type(2)));
__device__ __forceinline__ unsigned pkbf(float lo, float hi) { f32x2 v = {lo, hi}; bf16x2_t b = __builtin_convertvector(v, bf16x2_t); return __builtin_bit_cast(unsigned, b); }
__device__ __forceinline__ float bflo(unsigned w) { return __uint_as_float(w << 16); }
__device__ __forceinline__ float bfhi(unsigned w) { return __uint_as_float(w & 0xffff0000u); }
__device__ __forceinline__ unsigned pkf8(float a, float b, float c, float d) {
    a = __builtin_amdgcn_fmed3f(a, -448.f, 448.f); b = __builtin_amdgcn_fmed3f(b, -448.f, 448.f); c = __builtin_amdgcn_fmed3f(c, -448.f, 448.f); d = __builtin_amdgcn_fmed3f(d, -448.f, 448.f);
    int w = __builtin_amdgcn_cvt_pk_fp8_f32(a, b, 0, false); w = __builtin_amdgcn_cvt_pk_fp8_f32(c, d, w, true); return (unsigned)w; }
__device__ __forceinline__ f32x4 unpk8(unsigned w) { const f32x2 lo = __builtin_amdgcn_cvt_pk_f32_fp8((int)w, false), hi = __builtin_amdgcn_cvt_pk_f32_fp8((int)w, true); return (f32x4){lo[0], lo[1], hi[0], hi[1]}; }
__device__ __forceinline__ float sigmoidf_(float x) { return __builtin_amdgcn_rcpf(1.0f + __expf(-x)); }
__device__ __forceinline__ float gelu_tanh(float x) { const float t = 1.5957691216057308f * (x + 0.044715f * x * x * x); return x * __builtin_amdgcn_rcpf(1.0f + __expf(-t)); }
__device__ __forceinline__ u32x4 pack8(const f32x4 a, const f32x4 b) { u32x4 w; w.x = pkbf(a[0], a[1]); w.y = pkbf(a[2], a[3]); w.z = pkbf(b[0], b[1]); w.w = pkbf(b[2], b[3]); return w; }
__device__ __forceinline__ void unpack8(const u32x4 w, f32x4& a, f32x4& b) { a = (f32x4){bflo(w.x), bfhi(w.x), bflo(w.y), bfhi(w.y)}; b = (f32x4){bflo(w.z), bfhi(w.z), bflo(w.w), bfhi(w.w)}; }

template <int M> __device__ __forceinline__ float shx(float v, int lane) {
    const int iv = __builtin_bit_cast(int, v); int r;
    if (M == 1) r = __builtin_amdgcn_mov_dpp(iv, 0xB1, 0xf, 0xf, true);
    else if (M == 2) r = __builtin_amdgcn_mov_dpp(iv, 0x4E, 0xf, 0xf, true);
    else if (M == 4) r = __builtin_amdgcn_ds_swizzle(iv, 0x101F);
    else if (M == 8) r = __builtin_amdgcn_ds_swizzle(iv, 0x201F);
    else if (M == 16) r = __builtin_amdgcn_ds_swizzle(iv, 0x401F);
    else r = __builtin_amdgcn_ds_bpermute((lane ^ M) << 2, iv);
    return __builtin_bit_cast(float, r);
}
__device__ __forceinline__ float bperm(float v, int srclane) { return __builtin_bit_cast(float, __builtin_amdgcn_ds_bpermute(srclane << 2, __builtin_bit_cast(int, v))); }
__device__ __forceinline__ int bpermi(int v, int srclane) { return __builtin_amdgcn_ds_bpermute(srclane << 2, v); }
__device__ __forceinline__ int lane_id_opaque() { unsigned m = ~0u; asm volatile("" : "+s"(m)); return (int)__builtin_amdgcn_mbcnt_hi(m, __builtin_amdgcn_mbcnt_lo(m, 0u)); }

#define EPI_IDS() int frq_ = lane_id_opaque(); fr = frq_ & 15; fq = frq_ >> 4; (void)frq_;     \
        const int row0 = u.pm * BM + wr * 64 + fr, col0 = u.pn * BM + wc * 64 + 16 * fq; (void)row0; (void)col0
constexpr int CBJ = 8;
__device__ __forceinline__ void store_pair(bf16_t* rowp, long offA, long offB, const u32x4 p0, const u32x4 p1, bool up) {
    u32x4 recv, dA, dB;
#pragma unroll
    for (int k = 0; k < 4; ++k) { const unsigned send = up ? p0[k] : p1[k]; recv[k] = (unsigned)__builtin_amdgcn_update_dpp(0, (int)send, 0x128, 0xf, 0xf, true); dA[k] = up ? recv[k] : p0[k]; dB[k] = up ? p1[k] : recv[k]; }
    *(u32x4*)(rowp + offA) = dA; *(u32x4*)(rowp + offB) = dB;
}
#define EPI_PAIR_OFFS(pitch) const bool up_ = (fr & 8) != 0; const long offA_ = up_ ? (long)8 - 8 * (long)(pitch) : 0, offB_ = up_ ? 8 : 8 * (long)(pitch)

struct EpiPlain {
    static constexpr bool PERM = true, PERM2 = true, AFTER_DRAIN = false;
    bf16_t* O; int ldc;
    __device__ __forceinline__ void operator()(const f32x4 (&acc)[2][2][4][2], const Unit& u, int wr, int wc, int fr, int fq) const {
        EPI_IDS(); EPI_PAIR_OFFS(ldc);
#pragma unroll
        for (int ai = 0; ai < 2; ++ai)
#pragma unroll
            for (int m = 0; m < 4; ++m) { bf16_t* rowp = O + (size_t)(row0 + ai * HALF + m * 16) * ldc + col0;
                store_pair(rowp, offA_, offB_, pack8(acc[ai][0][m][0], acc[ai][0][m][1]), pack8(acc[ai][1][m][0], acc[ai][1][m][1]), up_); }
    }
};

struct EpiWin {
    static constexpr bool PERM = true, PERM2 = true, AFTER_DRAIN = false;
    bf16_t *U, *Q, *K, *V; unsigned char *SGA, *SGB; float* kmean; const float* rope;
    float qscale;
    __device__ __forceinline__ void operator()(const f32x4 (&acc)[2][2][4][2], const Unit& u, int wr, int wc, int fr, int fq) const {
        EPI_IDS();
        const int pn = u.pn;
        if (pn < 2) {
            const int g = (pn * 256 + wc * 64) / 16 + fq;
#pragma unroll
            for (int ai = 0; ai < 2; ++ai)
#pragma unroll
                for (int m = 0; m < 4; ++m) { const int row = row0 + ai * HALF + m * 16, b = row >> 13, t = row & 8191; bf16_t* up = U + ((size_t)(b * 32 + g) * 8192 + t) * 16;
#pragma unroll
                    for (int bj = 0; bj < 2; ++bj) *(u32x4*)(up + 8 * bj) = pack8(acc[ai][bj][m][0], acc[ai][bj][m][1]); }
        } else if (pn < 6) {
            const bool isq = pn < 4; bf16_t* dst = isq ? Q : K; const int cb = (pn - (isq ? 2 : 4)) * 256 + wc * 64 + 16 * fq;
            const float sc = isq ? qscale : 1.0f;
            float cs[2][8];
#pragma unroll
            for (int bj = 0; bj < 2; ++bj)
#pragma unroll
                for (int i = 0; i < 8; ++i) cs[bj][i] = 0.f;
#pragma unroll
            for (int ai = 0; ai < 2; ++ai)
#pragma unroll
                for (int m = 0; m < 4; ++m) { const int row = row0 + ai * HALF + m * 16;
                    f32x4 v[2][2];
#pragma unroll
                    for (int bj = 0; bj < 2; ++bj) { v[bj][0] = acc[ai][bj][m][0]; v[bj][1] = acc[ai][bj][m][1]; }
                    { const f32x4* cp = (const f32x4*)(rope + (size_t)row * 16);
                      const f32x4 c01 = cp[0], c23 = cp[1], c45 = cp[2], c67 = cp[3];
                      const float co[8] = {c01[0], c01[2], c23[0], c23[2], c45[0], c45[2], c67[0], c67[2]};
                      const float si[8] = {c01[1], c01[3], c23[1], c23[3], c45[1], c45[3], c67[1], c67[3]};
#pragma unroll
                      for (int n = 0; n < 2; ++n)
#pragma unroll
                          for (int e = 0; e < 4; ++e) { const float a = v[0][n][e], b = v[1][n][e];
                              const float ra = a * co[4 * n + e] - b * si[4 * n + e], rb = b * co[4 * n + e] + a * si[4 * n + e];
                              v[0][n][e] = (fq == 0) ? ra : a; v[1][n][e] = (fq == 0) ? rb : b; } }
#pragma unroll
                    for (int bj = 0; bj < 2; ++bj) {
                        if (!isq) {
#pragma unroll
                            for (int n = 0; n < 2; ++n)
#pragma unroll
                                for (int e = 0; e < 4; ++e) cs[bj][4 * n + e] += v[bj][n][e]; } }
                    { EPI_PAIR_OFFS(512); store_pair(dst + (size_t)row * 512 + cb, offA_, offB_, pack8(v[0][0] * sc, v[0][1] * sc), pack8(v[1][0] * sc, v[1][1] * sc), up_); }
                }
            if (!isq) {
#pragma unroll
                for (int bj = 0; bj < 2; ++bj)
#pragma unroll
                    for (int i = 0; i < 8; ++i) { float s = cs[bj][i]; s += shx<1>(s, frq_); s += shx<2>(s, frq_); s += shx<4>(s, frq_); s += shx<8>(s, frq_);
                        if (fr == 0) atomicAdd(kmean + (size_t)u.pm * 512 + cb + bj * CBJ + i, s); }
            }
        } else if (pn < 8) {
            const int cb = (pn - 6) * 256 + wc * 64 + 16 * fq;
#pragma unroll
            for (int ai = 0; ai < 2; ++ai)
#pragma unroll
                for (int m = 0; m < 4; ++m) { const int row = row0 + ai * HALF + m * 16; EPI_PAIR_OFFS(512);
                    store_pair(V + (size_t)row * 512 + cb, offA_, offB_, pack8(acc[ai][0][m][0], acc[ai][0][m][1]), pack8(acc[ai][1][m][0], acc[ai][1][m][1]), up_); }
        } else {
            unsigned char* dst = pn < 12 ? SGA : SGB; const int cb = (pn - (pn < 12 ? 8 : 12)) * 256 + wc * 64 + 16 * fq;
#pragma unroll
            for (int ai = 0; ai < 2; ++ai)
#pragma unroll
                for (int m = 0; m < 4; ++m) { const int row = row0 + ai * HALF + m * 16; u32x4 o8;
#pragma unroll
                    for (int bj = 0; bj < 2; ++bj) { f32x4 a = acc[ai][bj][m][0], b = acc[ai][bj][m][1];
#pragma unroll
                        for (int e = 0; e < 4; ++e) { a[e] = sigmoidf_(a[e]); b[e] = sigmoidf_(b[e]); }
                        o8[2 * bj] = pkf8(a[0], a[1], a[2], a[3]); o8[2 * bj + 1] = pkf8(b[0], b[1], b[2], b[3]); }
                    *(u32x4*)(dst + (size_t)row * 1024 + cb) = o8; }
        }
    }
};

struct EpiGlu {
    static constexpr bool PERM = true, PERM2 = true, AFTER_DRAIN = false;
    const bf16_t* YP; bf16_t* YS;
    __device__ __forceinline__ void operator()(const f32x4 (&acc)[2][2][4][2], const Unit& u, int wr, int wc, int fr, int fq) const {
        EPI_IDS();
#pragma unroll
        for (int ai = 0; ai < 2; ++ai)
#pragma unroll
            for (int m = 0; m < 4; ++m) { const size_t off = (size_t)(row0 + ai * HALF + m * 16) * 512 + col0; u32x4 o8;
#pragma unroll
                for (int bj = 0; bj < 2; ++bj) { const u32x4 w = *(const u32x4*)(YP + off + bj * CBJ); f32x4 ya, yb; unpack8(w, ya, yb);
                    f32x4 a = acc[ai][bj][m][0], b = acc[ai][bj][m][1];
#pragma unroll
                    for (int e = 0; e < 4; ++e) { a[e] = ya[e] * sigmoidf_(a[e]); b[e] = yb[e] * sigmoidf_(b[e]); }
                    o8[2 * bj] = pkf8(a[0], a[1], a[2], a[3]); o8[2 * bj + 1] = pkf8(b[0], b[1], b[2], b[3]); }
                *(u32x4*)((unsigned char*)YS + off) = o8; }
    }
};

template <int MODE> struct EpiMerge {
    static constexpr bool PERM = true, PERM2 = true, AFTER_DRAIN = false;
    const unsigned char* G8; bf16_t* T1; unsigned char* M8;
    __device__ __forceinline__ void operator()(const f32x4 (&acc)[2][2][4][2], const Unit& u, int wr, int wc, int fr, int fq) const {
        EPI_IDS();
#pragma unroll
        for (int ai = 0; ai < 2; ++ai)
#pragma unroll
            for (int m = 0; m < 4; ++m) { const size_t off = (size_t)(row0 + ai * HALF + m * 16) * 1024 + col0; u32x4 o8, pk[2]; EPI_PAIR_OFFS(1024);
                const u32x4 g8 = *(const u32x4*)(G8 + off);
#pragma unroll
                for (int bj = 0; bj < 2; ++bj) { const f32x4 ga = unpk8(g8[2 * bj]), gb = unpk8(g8[2 * bj + 1]);
                    f32x4 a = acc[ai][bj][m][0], b = acc[ai][bj][m][1];
                    if (MODE == 0) { a = ga * a; b = gb * b; pk[bj] = pack8(a, b); }
                    else { const u32x4 w = *(const u32x4*)(T1 + off + bj * CBJ); f32x4 ta, tb; unpack8(w, ta, tb); a = ta + ga * a; b = tb + gb * b;
                        o8[2 * bj] = pkf8(a[0], a[1], a[2], a[3]); o8[2 * bj + 1] = pkf8(b[0], b[1], b[2], b[3]); } }
                if (MODE == 1) *(u32x4*)(M8 + off) = o8; else store_pair(T1 + off, offA_, offB_, pk[0], pk[1], up_); }
    }
};

struct EpiResid {
    static constexpr bool PERM = true, PERM2 = true, AFTER_DRAIN = false;
    const float* X; bf16_t* X1B; float* sumsq;
    __device__ __forceinline__ void operator()(const f32x4 (&acc)[2][2][4][2], const Unit& u, int wr, int wc, int fr, int fq) const {
        EPI_IDS();
#pragma unroll
        for (int ai = 0; ai < 2; ++ai)
#pragma unroll
            for (int m = 0; m < 4; ++m) { const int row = row0 + ai * HALF + m * 16; const size_t off = (size_t)row * 1024 + col0; float ss = 0.f; u32x4 pk[2]; EPI_PAIR_OFFS(1024);
#pragma unroll
                for (int bj = 0; bj < 2; ++bj) { const f32x4 xa = *(const f32x4*)(X + off + bj * CBJ), xb = *(const f32x4*)(X + off + bj * CBJ + 4);
                    const f32x4 a = xa + acc[ai][bj][m][0], b = xb + acc[ai][bj][m][1];
                    pk[bj] = pack8(a, b);
                    ss += (a[0] * a[0] + a[1] * a[1]) + (a[2] * a[2] + a[3] * a[3]) + (b[0] * b[0] + b[1] * b[1]) + (b[2] * b[2] + b[3] * b[3]); }
                store_pair(X1B + off, offA_, offB_, pk[0], pk[1], up_);
                ss += shx<16>(ss, frq_); ss += shx<32>(ss, frq_);
                if (fq == 0) atomicAdd(sumsq + row, ss); }
    }
};

struct EpiScores {
    static constexpr bool PERM = true, PERM2 = true, AFTER_DRAIN = false;
    bf16_t* S; const float* sumsq;
    __device__ __forceinline__ void operator()(const f32x4 (&acc)[2][2][4][2], const Unit& u, int wr, int wc, int fr, int fq) const {
        EPI_IDS(); EPI_PAIR_OFFS(2048);
#pragma unroll
        for (int ai = 0; ai < 2; ++ai)
#pragma unroll
            for (int m = 0; m < 4; ++m) { const int row = row0 + ai * HALF + m * 16; const size_t off = (size_t)row * 2048 + col0;
                const float rs = 1.0f / sqrtf(sumsq[row] * (1.0f / 1024.0f) + 1e-6f);
                store_pair(S + off, offA_, offB_, pack8(acc[ai][0][m][0] * rs, acc[ai][0][m][1] * rs), pack8(acc[ai][1][m][0] * rs, acc[ai][1][m][1] * rs), up_); }
    }
};

struct EpiPle {
    static constexpr bool PERM = true, PERM2 = true, AFTER_DRAIN = false;
    const bf16_t* X2B; bf16_t* E; const float* rs2; float* sumsq;
    __device__ __forceinline__ void operator()(const f32x4 (&acc)[2][2][4][2], const Unit& u, int wr, int wc, int fr, int fq) const {
        EPI_IDS();
#pragma unroll
        for (int ai = 0; ai < 2; ++ai)
#pragma unroll
            for (int m = 0; m < 4; ++m) { const int row = row0 + ai * HALF + m * 16; const size_t off = (size_t)row * 1024 + col0; float ss = 0.f; const float rs = rs2[row]; u32x4 pk[2]; EPI_PAIR_OFFS(1024);
#pragma unroll
                for (int bj = 0; bj < 2; ++bj) { const u32x4 wx = *(const u32x4*)(X2B + off + bj * CBJ); f32x4 xa, xb; unpack8(wx, xa, xb);
                    const u32x4 w = *(const u32x4*)(E + off + bj * CBJ); f32x4 ea, eb; unpack8(w, ea, eb);
                    f32x4 a = acc[ai][bj][m][0], b = acc[ai][bj][m][1];
#pragma unroll
                    for (int e = 0; e < 4; ++e) { a[e] = xa[e] + sigmoidf_(rs * a[e]) * ea[e]; b[e] = xb[e] + sigmoidf_(rs * b[e]) * eb[e]; }
                    pk[bj] = pack8(a, b);
                    ss += (a[0] * a[0] + a[1] * a[1]) + (a[2] * a[2] + a[3] * a[3]) + (b[0] * b[0] + b[1] * b[1]) + (b[2] * b[2] + b[3] * b[3]); }
                store_pair(E + off, offA_, offB_, pk[0], pk[1], up_);
                ss += shx<16>(ss, frq_); ss += shx<32>(ss, frq_);
                if (fq == 0) atomicAdd(sumsq + row, ss); }
    }
};
#undef EPI_IDS
#undef EPI_PAIR_OFFS
typedef int v4i_t __attribute__((ext_vector_type(4)));
constexpr int W8_SHIFT = 6;
template <class Epi, class Sched, bool ALIGN_EPI = false, bool SP2 = false, bool FP8 = false, int KC = 0>
__device__ __forceinline__ void gemm_phase(PG8_LAS unsigned char* lds, const Gemm g, const Sched& S, const Epi& E, const int wave_s) {
    int tid_o = wave_s * 64 + lane_id_opaque(); asm volatile("" : "+v"(tid_o)); const int tid = tid_o, wid = __builtin_amdgcn_readfirstlane(tid >> 6), lane = tid & 63, wr = wid >> 2, wc = wid & 3, fr = lane & 15, fq = lane >> 4;
    const int K = KC ? KC : g.K, nt = FP8 ? K / 128 : K / BK;
    unsigned voffA[2], voffB[2]; int aoff, boff;
#define PG8_LANE_SETUP() do { int t_ = wave_s * 64 + lane_id_opaque(); asm volatile("" : "+v"(t_)); const int l_ = t_ & 63, fr_ = l_ & 15, fq_ = l_ >> 4; \
        _Pragma("unroll") for (int i = 0; i < 2; ++i) { int R, C; stage_rc(t_ * 16 + i * 8192, R, C); const int Rb = Epi::PERM2 ? (64 * (R >> 5) + 16 * ((R >> 2) & 3) + 4 * ((R >> 4) & 1) + (R & 3)) : Epi::PERM ? ((R & ~31) + perm32(R & 31)) : R;     \
            voffA[i] = FP8 ? (unsigned)(R * K + 2 * C) : (unsigned)(R * K + C) * 2u; voffB[i] = FP8 ? (unsigned)(Rb * K + 2 * C) : (unsigned)(Rb * K + C) * 2u; } \
        aoff = lds_byte(wr * 64 + fr_, fq_ * 8); boff = lds_byte(wc * 32 + fr_, fq_ * 8); } while (0)
    PG8_LANE_SETUP();
#if 0
    for (int i = 0; i < 2; ++i) { int R, C; stage_rc(tid * 16 + i * 8192, R, C); const int Rb = Epi::PERM ? ((R & ~31) + perm32(R & 31)) : R;
        voffA[i] = FP8 ? (unsigned)(R * K + 2 * C) : (unsigned)(R * K + C) * 2u; voffB[i] = FP8 ? (unsigned)(Rb * K + 2 * C) : (unsigned)(Rb * K + C) * 2u; }
#endif
    const size_t kstep = (size_t)(BK * 2);
    const size_t hstep = (size_t)HALF * K * (FP8 ? 1 : 2); const size_t hstepB = Epi::PERM2 ? (size_t)8 * K * (FP8 ? 1 : 2) : hstep;
    const size_t tstep = 2 * hstep;
    const unsigned ldsw = (unsigned)wid * 1024u;
#define PG8_SA(b, h) (((b) * 2 + (h)) * HTB)
#define PG8_SB(b, h) ((4 + (b) * 2 + (h)) * HTB)
#define PG8_STAGE(bufoff, gbase, voff) do { const char* gb_ = (const char*)(gbase); asm volatile("" : "+s"(gb_)); _Pragma("unroll") for (int _i = 0; _i < 2; ++_i) \
        __builtin_amdgcn_global_load_lds((const unsigned*)(gb_ + (voff)[_i]), (PG8_LAS unsigned*)(lds + (bufoff) + ldsw + _i * 8192), 16, 0, 0); } while (0)
#define PG8_LDA(dst, b, h) do { _Pragma("unroll") for (int m = 0; m < 4; ++m) _Pragma("unroll") for (int k = 0; k < 2; ++k) dst[m][k] = *(const PG8_LAS bf16x8*)(lds + PG8_SA(b, h) + aoff + m * 2048 + k * 1024); } while (0)
#define PG8_LDB(dst, b, h) do { _Pragma("unroll") for (int n = 0; n < 2; ++n) _Pragma("unroll") for (int k = 0; k < 2; ++k) dst[n][k] = *(const PG8_LAS bf16x8*)(lds + PG8_SB(b, h) + boff + n * 2048 + k * 1024); } while (0)
#define PG8_CAT8(x0, x1) __builtin_shufflevector(__builtin_bit_cast(v4i_t, x0), __builtin_bit_cast(v4i_t, x1), 0, 1, 2, 3, 4, 5, 6, 7)
#define PG8_MMA(ai, bj, At, Bt) do { __builtin_amdgcn_s_setprio(1); _Pragma("unroll") for (int m = 0; m < 4; ++m) _Pragma("unroll") for (int n = 0; n < 2; ++n) { \
        if constexpr (FP8) acc[ai][bj][m][n] = __builtin_amdgcn_mfma_scale_f32_16x16x128_f8f6f4(PG8_CAT8(Bt[n][0], Bt[n][1]), PG8_CAT8(At[m][0], At[m][1]), acc[ai][bj][m][n], 0, 0, 0, 0, 0, 0); \
        else { _Pragma("unroll") for (int k = 0; k < 2; ++k) acc[ai][bj][m][n] = __builtin_amdgcn_mfma_f32_16x16x32_bf16(Bt[n][k], At[m][k], acc[ai][bj][m][n], 0, 0, 0); } } __builtin_amdgcn_s_setprio(0); } while (0)
#define PG8_WAIT_V(n) asm volatile("s_waitcnt vmcnt(" #n ")" ::: "memory")
#define PG8_WAIT_L(n) asm volatile("s_waitcnt lgkmcnt(" #n ")" ::: "memory")
#define PG8_BAR __builtin_amdgcn_s_barrier()
#define PG8_SCHED __builtin_amdgcn_sched_barrier(0)
    Unit cur, nxt; int ui = 0;
    if (!S.next(0, cur)) return;
    f32x4 acc[2][2][4][2];
#pragma unroll
    for (int a = 0; a < 2; ++a)
#pragma unroll
        for (int b = 0; b < 2; ++b)
#pragma unroll
            for (int m = 0; m < 4; ++m)
#pragma unroll
                for (int n = 0; n < 2; ++n) acc[a][b][m][n] = (f32x4){0.f, 0.f, 0.f, 0.f};
    bf16x8 At[4][2], B0[2][2], B1[2][2];
    const char* cA = (const char*)g.A + (size_t)cur.pm * tstep; const char* cB = (const char*)g.Bt + (size_t)cur.pn * tstep;
    S.a_ready(cur);
    if constexpr (SP2) {
        PG8_STAGE(PG8_SB(0, 0), cB, voffB); PG8_STAGE(PG8_SB(0, 1), cB + hstepB, voffB); PG8_STAGE(PG8_SA(0, 0), cA, voffA); PG8_STAGE(PG8_SA(0, 1), cA + hstep, voffA);
        if (wr == 1) PG8_BAR;
        PG8_WAIT_V(2); PG8_BAR;
        PG8_STAGE(PG8_SB(1, 0), cB + kstep, voffB); PG8_STAGE(PG8_SA(1, 0), cA + kstep, voffA); PG8_STAGE(PG8_SB(1, 1), cB + hstepB + kstep, voffB);
        PG8_WAIT_V(6); PG8_BAR;
    } else {
        PG8_STAGE(PG8_SB(0, 0), cB, voffB); PG8_STAGE(PG8_SA(0, 0), cA, voffA); PG8_STAGE(PG8_SB(0, 1), cB + hstepB, voffB); PG8_STAGE(PG8_SA(0, 1), cA + hstep, voffA);
        if (wr == 1) PG8_BAR;
        PG8_WAIT_V(4); PG8_BAR;
        PG8_STAGE(PG8_SB(1, 0), cB + kstep, voffB); PG8_STAGE(PG8_SA(1, 0), cA + kstep, voffA); PG8_STAGE(PG8_SB(1, 1), cB + hstepB + kstep, voffB);
        PG8_WAIT_V(6); PG8_BAR;
    }
    for (;;) {
        const bool has_next = S.next(ui + 1, nxt);
        const char* nA = has_next ? (const char*)g.A + (size_t)nxt.pm * tstep : cA; const char* nB = has_next ? (const char*)g.Bt + (size_t)nxt.pn * tstep : cB;
#pragma nounroll
        for (int t = 0; t < nt; t += 2) {
            const bool last = (t == nt - 2);
            const char* a1 = cA + (size_t)(t + 1) * kstep;
            const char* a2 = last ? nA : cA + (size_t)(t + 2) * kstep; const char* b2 = last ? nB : cB + (size_t)(t + 2) * kstep;
            const char* a3 = a2 + kstep; const char* b3 = b2 + kstep;
            if (last && has_next) S.a_ready(nxt);
            if constexpr (SP2) {
            PG8_LDB(B0, 0, 0); PG8_LDB(B1, 0, 1); PG8_SCHED; PG8_LDA(At, 0, 0); PG8_STAGE(PG8_SA(1, 1), a1 + hstep, voffA);
            PG8_WAIT_V(8); PG8_WAIT_L(0); PG8_BAR; PG8_MMA(0, 0, At, B0); PG8_MMA(0, 1, At, B1); PG8_BAR; PG8_SCHED;
            PG8_LDA(At, 0, 1); PG8_STAGE(PG8_SB(0, 0), b2, voffB); PG8_STAGE(PG8_SB(0, 1), b2 + hstepB, voffB); PG8_STAGE(PG8_SA(0, 0), a2, voffA);
            PG8_WAIT_V(8); PG8_WAIT_L(0); PG8_BAR; PG8_MMA(1, 0, At, B0); PG8_MMA(1, 1, At, B1); PG8_BAR; PG8_SCHED;
            PG8_LDB(B0, 1, 0); PG8_LDB(B1, 1, 1); PG8_SCHED; PG8_LDA(At, 1, 0); PG8_STAGE(PG8_SA(0, 1), a2 + hstep, voffA);
            PG8_WAIT_V(8); PG8_WAIT_L(0); PG8_BAR; PG8_MMA(0, 0, At, B0); PG8_MMA(0, 1, At, B1); PG8_BAR; PG8_SCHED;
            PG8_LDA(At, 1, 1); PG8_STAGE(PG8_SB(1, 0), b3, voffB); PG8_STAGE(PG8_SB(1, 1), b3 + hstepB, voffB); PG8_STAGE(PG8_SA(1, 0), a3, voffA);
            PG8_WAIT_V(8); PG8_WAIT_L(0); PG8_BAR; PG8_MMA(1, 0, At, B0); PG8_MMA(1, 1, At, B1); PG8_BAR; PG8_SCHED;
            } else {
            PG8_LDB(B0, 0, 0); PG8_SCHED; PG8_LDA(At, 0, 0); PG8_STAGE(PG8_SA(1, 1), a1 + hstep, voffA);
            PG8_WAIT_L(8); PG8_BAR; PG8_WAIT_L(0); PG8_MMA(0, 0, At, B0); PG8_BAR; PG8_SCHED;
            PG8_LDB(B1, 0, 1); PG8_STAGE(PG8_SB(0, 0), b2, voffB);
            PG8_BAR; PG8_WAIT_L(0); PG8_MMA(0, 1, At, B1); PG8_BAR;
            PG8_LDA(At, 0, 1); PG8_STAGE(PG8_SA(0, 0), a2, voffA);
            PG8_BAR; PG8_WAIT_L(0); PG8_MMA(1, 0, At, B0); PG8_BAR; PG8_SCHED;
            PG8_STAGE(PG8_SB(0, 1), b2 + hstepB, voffB);
            PG8_WAIT_V(6); PG8_BAR; PG8_MMA(1, 1, At, B1); PG8_BAR;
            PG8_LDB(B0, 1, 0); PG8_SCHED; PG8_LDA(At, 1, 0); PG8_STAGE(PG8_SA(0, 1), a2 + hstep, voffA);
            PG8_WAIT_L(8); PG8_BAR; PG8_WAIT_L(0); PG8_MMA(0, 0, At, B0); PG8_BAR; PG8_SCHED;
            PG8_LDB(B1, 1, 1); PG8_STAGE(PG8_SB(1, 0), b3, voffB);
            PG8_BAR; PG8_WAIT_L(0); PG8_MMA(0, 1, At, B1); PG8_BAR;
            PG8_LDA(At, 1, 1); PG8_STAGE(PG8_SA(1, 0), a3, voffA);
            PG8_BAR; PG8_WAIT_L(0); PG8_MMA(1, 0, At, B0); PG8_BAR; PG8_SCHED;
            PG8_STAGE(PG8_SB(1, 1), b3 + hstepB, voffB);
            PG8_WAIT_V(6); PG8_BAR; PG8_MMA(1, 1, At, B1); PG8_BAR;
            }
        }
        if constexpr (ALIGN_EPI) { if (wr == 0) PG8_BAR; }
        if constexpr (FP8) {
#pragma unroll
            for (int a = 0; a < 2; ++a)
#pragma unroll
                for (int b = 0; b < 2; ++b)
#pragma unroll
                    for (int m = 0; m < 4; ++m)
#pragma unroll
                        for (int n = 0; n < 2; ++n) acc[a][b][m][n] *= (1.0f / (float)(1 << W8_SHIFT)); }
        if constexpr (!Epi::AFTER_DRAIN) { E(acc, cur, wr, wc, fr, fq); S.done(cur); }
        if (!has_next) break;
#pragma unroll
        for (int a = 0; a < 2; ++a)
#pragma unroll
            for (int b = 0; b < 2; ++b)
#pragma unroll
                for (int m = 0; m < 4; ++m)
#pragma unroll
                    for (int n = 0; n < 2; ++n) acc[a][b][m][n] = (f32x4){0.f, 0.f, 0.f, 0.f};
        cur = nxt; cA = nA; cB = nB; ++ui;
        PG8_LANE_SETUP();
        if constexpr (ALIGN_EPI) { if (wr == 1) PG8_BAR; }
    }
    PG8_WAIT_V(0);
    if constexpr (!ALIGN_EPI) { if (wr == 0) PG8_BAR; }
    PG8_BAR;
    if constexpr (Epi::AFTER_DRAIN) { E.fused(acc, cur, wr, wc, fr, fq, lds, wid, lane); S.done(cur); }
#undef PG8_SA
#undef PG8_SB
#undef PG8_STAGE
#undef PG8_LDA
#undef PG8_LDB
#undef PG8_LANE_SETUP
#undef PG8_MMA
#undef PG8_CAT8
#undef PG8_WAIT_V
#undef PG8_WAIT_L
#undef PG8_BAR
#undef PG8_SCHED
}
}

#include <hip/hip_bf16.h>
namespace moba {
using bf16=__hip_bfloat16;
using bf16x8=__attribute__((ext_vector_type(8)))short;
using s16x4=__attribute__((ext_vector_type(4)))short;
using f32x16=__attribute__((ext_vector_type(16)))float;
using u32x4=__attribute__((ext_vector_type(4)))unsigned;
using f32x4_m=__attribute__((ext_vector_type(4)))float;
constexpr int BATCH=4,NHEAD=8,SEQ=8192,D=64,DM=NHEAD*D;
constexpr int NW=8,QBLK=32,QB=QBLK*NW,KVBLK=64,NQB=SEQ/QB;
constexpr int ATTN_PITCH=DM, ATTN_UNIT_ROWS=QB;
__device__ __forceinline__ int crow(int r,int hi){return (r&3)+8*(r>>2)+4*hi;}
#define SBAR() __builtin_amdgcn_sched_barrier(0)
__device__ __forceinline__ void cmask(f32x16&p0,f32x16&p1,int jb,int qrel,int hi){
  const float NEG=-INFINITY; int kb=64*jb+4*hi;
  #pragma unroll
  for(int r=0;r<16;++r){int kv=kb+(r&3)+8*(r>>2); if(kv>qrel)p0[r]=NEG; if(kv+32>qrel)p1[r]=NEG;}
}

constexpr int NSLOT=3, SLOTB=8192;
constexpr int LDS_K=0, LDS_V=NSLOT*SLOTB, LDS_WS=2*NSLOT*SLOTB, LDS_OST=LDS_WS+NW*64*4, LDS_BYTES=LDS_OST+NW*4096;
constexpr float C2=0.125f*1.4426950408889634f;
__device__ __forceinline__ void glds16(const void*gsrc,unsigned lds_dst){unsigned keep;
  asm volatile("s_mov_b32 %0, m0\n\ts_mov_b32 m0, %2\n\ts_nop 0\n\tglobal_load_lds_dwordx4 %1, off\n\ts_mov_b32 m0, %0":"=&s"(keep):"v"(gsrc),"s"(lds_dst):"memory");}
__device__ __forceinline__ float max3f(float a,float b,float c){float r;asm("v_max3_f32 %0, %1, %2, %3":"=v"(r):"v"(a),"v"(b),"v"(c));return r;}
__device__ __forceinline__ float max2f(float a,float b){float r;asm("v_max_f32_e32 %0, %1, %2":"=v"(r):"v"(a),"v"(b));return r;}
__device__ __forceinline__ float fadd_s(float a,float b){float r;asm("v_add_f32_e32 %0, %1, %2":"=v"(r):"v"(a),"v"(b));return r;}
__device__ __forceinline__ float fsub_s(float a,float b){float r;asm("v_sub_f32_e32 %0, %1, %2":"=v"(r):"v"(a),"v"(b));return r;}
typedef float f32x2_t __attribute__((ext_vector_type(2))); typedef __bf16 bf16x2_t __attribute__((ext_vector_type(2)));
__device__ __forceinline__ unsigned cvtpk_s(float lo,float hi){f32x2_t v={lo,hi};bf16x2_t b=__builtin_convertvector(v,bf16x2_t);return __builtin_bit_cast(unsigned,b);}
#define WAIT_BAR(N) asm volatile("s_waitcnt vmcnt(" #N ") lgkmcnt(0)\n\ts_barrier":::"memory")

__device__ __forceinline__ void qkt(f32x16&p0,f32x16&p1,const char*Kslot,const bf16x8*qr,const f32x16&negm,int r32,int hi){
  const char*kb=Kslot+hi*1024+r32*16;
  #pragma unroll
  for(int d0=0;d0<4;++d0){
    const bf16x8 b0=*reinterpret_cast<const bf16x8*>(kb+d0*2048);
    const bf16x8 b1=*reinterpret_cast<const bf16x8*>(kb+d0*2048+512);
    if(d0==0){p0=__builtin_amdgcn_mfma_f32_32x32x16_bf16(b0,qr[0],negm,0,0,0);p1=__builtin_amdgcn_mfma_f32_32x32x16_bf16(b1,qr[0],negm,0,0,0);}
    else{p0=__builtin_amdgcn_mfma_f32_32x32x16_bf16(b0,qr[d0],p0,0,0,0);p1=__builtin_amdgcn_mfma_f32_32x32x16_bf16(b1,qr[d0],p1,0,0,0);}}
}
typedef __attribute__((address_space(3))) const char* lds_cptr;
typedef short v4i16_t __attribute__((ext_vector_type(4)));
__device__ __forceinline__ void kload8(bf16x8*kf,lds_cptr kp){
  kf[0]=*(const __attribute__((address_space(3))) bf16x8*)(kp);      kf[1]=*(const __attribute__((address_space(3))) bf16x8*)(kp+512);
  kf[2]=*(const __attribute__((address_space(3))) bf16x8*)(kp+2048); kf[3]=*(const __attribute__((address_space(3))) bf16x8*)(kp+2560);
  kf[4]=*(const __attribute__((address_space(3))) bf16x8*)(kp+4096); kf[5]=*(const __attribute__((address_space(3))) bf16x8*)(kp+4608);
  kf[6]=*(const __attribute__((address_space(3))) bf16x8*)(kp+6144); kf[7]=*(const __attribute__((address_space(3))) bf16x8*)(kp+6656);
}
__device__ __forceinline__ void kload2(bf16x8*kf,lds_cptr kp,int j){ kf[2*j]=*(const __attribute__((address_space(3))) bf16x8*)(kp+j*2048); kf[2*j+1]=*(const __attribute__((address_space(3))) bf16x8*)(kp+j*2048+512); }
__device__ __forceinline__ s16x4 vtr(lds_cptr p){ return __builtin_bit_cast(s16x4,__builtin_amdgcn_ds_read_tr16_b64_v4i16((__attribute__((address_space(3))) v4i16_t*)p)); }
__device__ __forceinline__ float rowmax(const f32x16&p0,const f32x16&p1){
  float a=max3f(p0[0],p0[1],p1[0]),b=max3f(p0[2],p0[3],p1[1]);a=max3f(a,p1[2],p1[3]);
  #pragma unroll
  for(int r=4;r<16;r+=4){a=max3f(a,p0[r],p0[r+1]);b=max3f(b,p0[r+2],p0[r+3]);a=max3f(a,p1[r],p1[r+1]);b=max3f(b,p1[r+2],p1[r+3]);}
  const float m=max2f(a,b);
  auto rr=__builtin_amdgcn_permlane32_swap(__float_as_uint(m),__float_as_uint(m),false,false);
  return max2f(__uint_as_float(rr[0]),__uint_as_float(rr[1]));
}
__device__ __forceinline__ void pv(f32x16*o,int vb,bf16x8 pa0,bf16x8 pa1,bf16x8 pa2,bf16x8 pa3){
  #pragma unroll
  for(int d0=0;d0<2;++d0){s16x4 lo[4],hi[4];
    #pragma unroll
    for(int ks=0;ks<4;++ks){
      asm volatile("ds_read_b64_tr_b16 %0,%1 offset:%c2":"=&v"(lo[ks]):"v"(vb),"i"(d0*4096+ks*1024):"memory");
      asm volatile("ds_read_b64_tr_b16 %0,%1 offset:%c2":"=&v"(hi[ks]):"v"(vb),"i"(d0*4096+ks*1024+512):"memory");}
    asm volatile("s_waitcnt lgkmcnt(0)":::"memory");SBAR();
    #define PK(k) (bf16x8){lo[k][0],lo[k][1],lo[k][2],lo[k][3],hi[k][0],hi[k][1],hi[k][2],hi[k][3]}
    o[d0]=__builtin_amdgcn_mfma_f32_32x32x16_bf16(pa0,PK(0),o[d0],0,0,0);
    o[d0]=__builtin_amdgcn_mfma_f32_32x32x16_bf16(pa1,PK(1),o[d0],0,0,0);
    o[d0]=__builtin_amdgcn_mfma_f32_32x32x16_bf16(pa2,PK(2),o[d0],0,0,0);
    o[d0]=__builtin_amdgcn_mfma_f32_32x32x16_bf16(pa3,PK(3),o[d0],0,0,0);
    #undef PK
  }
}

#ifndef ATTN_STORE16
#define ATTN_STORE16(p,v) (*(u32x4*)(p)=(v))
#endif
constexpr int QIDX_OFF=86016;
template<int THRL,bool CAUSAL> __device__ __forceinline__ void attn_unit(int b,int h,int kvb,int qoff,const bf16*Q,const bf16*K,const bf16*V,bf16*PART,float*LSE,bf16*O,char*shm,const int wave_s){
  int tid_o=wave_s*64+pg8::lane_id_opaque(); asm volatile("":"+v"(tid_o)); const int tid=tid_o,lane=tid&63,r32=lane&31,hi=lane>>5; const int wid=__builtin_amdgcn_readfirstlane(tid>>6);
  const long rowbase=(long)b*SEQ; const int bh=b*NHEAD+h;
  const __attribute__((address_space(3))) int*qlist=(const __attribute__((address_space(3))) int*)((lds_cptr)shm+qoff);
  const int qent=CAUSAL?((kvb*QB+wid*QBLK+r32)|(3<<16)):qlist[wid*QBLK+r32]; const int qrow=qent<0?kvb*QB:(qent&0xffff);
  const bf16*Qw=Q+(rowbase+qrow)*DM+h*D;
  const bf16*Kh=K+(rowbase+(long)kvb*QB)*DM+h*D,*Vh=V+(rowbase+(long)kvb*QB)*DM+h*D;
  const unsigned lds0=(unsigned)(uintptr_t)shm;
  float*wsf=(float*)(shm+LDS_WS)+wid*64;
  const bf16*ksrc=Kh+(long)lane*DM+wid*8;
  const bf16*vsrc=Vh+(long)(16*(wid&3)+(lane>>2))*DM+(wid>>2)*32+(lane&3)*8;
  const unsigned kdst=lds0+LDS_K+wid*1024, vdst=lds0+LDS_V+wid*1024;
  #define DMA_K(t,slot) glds16(ksrc+(long)(t)*KVBLK*DM,(unsigned)__builtin_amdgcn_readfirstlane(kdst+(slot)))
  #define DMA_V(t,slot) glds16(vsrc+(long)(t)*KVBLK*DM,(unsigned)__builtin_amdgcn_readfirstlane(vdst+(slot)))
  const int vb0=(int)(lds0+LDS_V)+((lane>>4)&1)*32+(lane&3)*8+(4*hi+((lane&15)>>2))*64;
  const char*Kbase=shm+LDS_K; bf16x8 kf[8];
  const lds_cptr shm3=(lds_cptr)shm; const lds_cptr kp0=shm3+LDS_K+hi*1024+r32*16; const lds_cptr vp0=shm3+LDS_V+((lane>>4)&1)*32+(lane&3)*8+(4*hi+((lane&15)>>2))*64;
  constexpr int NT=4;
  DMA_K(0,0);DMA_V(0,0);DMA_K(1,SLOTB);
  bf16x8 qr[4];
  #pragma unroll
  for(int d0=0;d0<4;++d0)qr[d0]=*reinterpret_cast<const bf16x8*>(&Qw[d0*16+hi*8]);
  float mhat=0.f,l_reg=0.f;f32x16 o[2];o[0]=f32x16{};o[1]=f32x16{};f32x16 negm=f32x16{};asm volatile("":"+v"(negm));
  const int qrel=wid*QBLK+r32;
  #define CMASK(P0,P1,t) do{ if(CAUSAL){int jb_=(t)-(NT-4); if(jb_>=0)cmask(P0,P1,jb_,qrel,hi);} }while(0)
  bool resc=false;
  #define START(P0,P1) do{ const float rm=rowmax(P0,P1); resc=false; \
    { const float dl=__builtin_fmaxf(rm,0.f); mhat=fadd_s(mhat,dl); \
      _Pragma("unroll") for(int r=0;r<16;++r){P0[r]=fsub_s(P0[r],dl);P1[r]=fsub_s(P1[r],dl);} \
      _Pragma("unroll") for(int r=0;r<16;++r)negm[r]=-mhat; asm volatile("":"+v"(negm)); } \
    _Pragma("unroll") for(int r=0;r<16;++r)P0[r]=__builtin_amdgcn_exp2f(P0[r]); }while(0)
  #define RESC() do{ if(resc){ asm volatile("s_waitcnt lgkmcnt(0)":::"memory"); \
      _Pragma("unroll") for(int d_=0;d_<2;++d_) _Pragma("unroll") for(int r=0;r<16;++r)o[d_][r]*=wsf[crow(r,hi)]; } }while(0)
  f32x16 pA0,pA1,pB0,pB1;
  int sl_prev=0,sl_cur=0,sl_next=SLOTB;
  #define ROT() do{sl_prev=sl_cur;sl_cur=sl_next;sl_next=(sl_next==(NSLOT-1)*SLOTB)?0:sl_next+SLOTB;}while(0)
  DMA_K(2,2*SLOTB);
  WAIT_BAR(3);
  qkt(pA0,pA1,Kbase,qr,negm,r32,hi);asm volatile("s_nop 15\n\ts_nop 7":"+v"(pA0),"+v"(pA1));CMASK(pA0,pA1,0);
  START(pA0,pA1);
  _Pragma("unroll") for(int r=0;r<16;++r)pA1[r]=__builtin_amdgcn_exp2f(pA1[r]);
  WAIT_BAR(0);
  DMA_K(3,0);DMA_V(1,SLOTB);
  ROT();
  kload8(kf,kp0+sl_cur);
  WAIT_BAR(2);
  s16x4 vlo[8],vhi[8]; u32x4 pw0,pw1,pw2,pw3;
  #define PKW(P,B) cvtpk_s(P[B],P[B+1])
  #define PAF(k) __builtin_bit_cast(bf16x8,pw##k)
  #define VFR(i) (bf16x8){vlo[i][0],vlo[i][1],vlo[i][2],vlo[i][3],vhi[i][0],vhi[i][1],vhi[i][2],vhi[i][3]}
  #define PIN(x) asm volatile("":"+v"(x))
  #define MX3(a,b,c) __builtin_fmaxf(__builtin_fmaxf((a),(b)),(c))
  #define GAPA(MF,A0,A1,A2,A3,W0,W1,PW) do{ MF; sacc+=A0; sacc+=A1; sacc+=A2; sacc+=A3; PIN(sacc); W0; W1; PIN(PW); SBAR(); }while(0)
  #define EX(v) __builtin_amdgcn_exp2f(v)
  #define GAPB(MF,X,B) do{ MF; X[B]=EX(X[B]); X[B+1]=EX(X[B+1]); X[B+2]=EX(X[B+2]); X[B+3]=EX(X[B+3]); PIN(X); SBAR(); }while(0)
  #define VRD(i) do{ vlo[i]=vtr(vp_+(((i)>>2)*4096+((i)&3)*1024)); vhi[i]=vtr(vp_+(((i)>>2)*4096+((i)&3)*1024+512)); }while(0)
  #define KRD(G,j) do{ if(G){ kload2(kf,kp0+sl_next,j); SBAR(); } }while(0)
  #define STEP(C0,C1,P0,P1,t,GK,GV,GL) do{ SBAR(); \
    const lds_cptr vp_=vp0+sl_prev; \
    VRD(0); SBAR(); float sacc=(P0[0]+P0[1]); \
    GAPA(C0=__builtin_amdgcn_mfma_f32_32x32x16_bf16(kf[0],qr[0],negm,0,0,0), P0[2],P0[3],P0[4],P0[5],     pw0[0]=PKW(P0,0), pw0[1]=PKW(P0,2), pw0); \
    VRD(4); SBAR(); GAPA(C1=__builtin_amdgcn_mfma_f32_32x32x16_bf16(kf[1],qr[0],negm,0,0,0), P0[6],P0[7],P0[8],P0[9],     pw0[2]=PKW(P0,4), pw0[3]=PKW(P0,6), pw0); \
    VRD(1); SBAR(); GAPA(C0=__builtin_amdgcn_mfma_f32_32x32x16_bf16(kf[2],qr[1],C0,0,0,0),   P0[10],P0[11],P0[12],P0[13], pw1[0]=PKW(P0,8), pw1[1]=PKW(P0,10), pw1); \
    VRD(5); SBAR(); GAPA(C1=__builtin_amdgcn_mfma_f32_32x32x16_bf16(kf[3],qr[1],C1,0,0,0),   P0[14],P0[15],P1[0],P1[1],   pw1[2]=PKW(P0,12),pw1[3]=PKW(P0,14), pw1); \
    VRD(2); SBAR(); GAPA(C0=__builtin_amdgcn_mfma_f32_32x32x16_bf16(kf[4],qr[2],C0,0,0,0),   P1[2],P1[3],P1[4],P1[5],     pw2[0]=PKW(P1,0), pw2[1]=PKW(P1,2), pw2); \
    VRD(6); SBAR(); GAPA(C1=__builtin_amdgcn_mfma_f32_32x32x16_bf16(kf[5],qr[2],C1,0,0,0),   P1[6],P1[7],P1[8],P1[9],     pw2[2]=PKW(P1,4), pw2[3]=PKW(P1,6), pw2); \
    VRD(3); SBAR(); GAPA(C0=__builtin_amdgcn_mfma_f32_32x32x16_bf16(kf[6],qr[3],C0,0,0,0),   P1[10],P1[11],P1[12],P1[13], pw3[0]=PKW(P1,8), pw3[1]=PKW(P1,10), pw3); \
    VRD(7); SBAR(); GAPA(C1=__builtin_amdgcn_mfma_f32_32x32x16_bf16(kf[7],qr[3],C1,0,0,0),   P1[14],P1[15],0.f,0.f,       pw3[2]=PKW(P1,12),pw3[3]=PKW(P1,14), pw3); \
    l_reg+=sacc; \
    if(GK){DMA_K((t)+3,sl_cur);} if(GV){DMA_V((t)+1,sl_next);} \
    CMASK(C0,C1,t); \
    { float a=MX3(C0[0],C0[1],C1[0]),b=MX3(C0[2],C0[3],C1[1]); a=MX3(a,C1[2],C1[3]); \
      _Pragma("unroll") for(int r=4;r<16;r+=4){a=MX3(a,C0[r],C0[r+1]);b=MX3(b,C0[r+2],C0[r+3]);a=MX3(a,C1[r],C1[r+1]);b=MX3(b,C1[r+2],C1[r+3]);} \
      float rm=__builtin_fmaxf(a,b); { auto rr=__builtin_amdgcn_permlane32_swap(__float_as_uint(rm),__float_as_uint(rm),false,false); rm=__builtin_fmaxf(__uint_as_float(rr[0]),__uint_as_float(rr[1])); } \
      resc=false; \
      if(__builtin_expect(__any(rm>(float)THRL),0)){ const float dl=__builtin_fmaxf(rm,0.f); mhat+=dl; \
        _Pragma("unroll") for(int r=0;r<16;++r){C0[r]-=dl;C1[r]-=dl;} \
        _Pragma("unroll") for(int r=0;r<16;++r)negm[r]=-mhat; asm volatile("":"+v"(negm)); \
        const float f=__builtin_amdgcn_exp2f(-dl); l_reg*=f; if(hi==0)wsf[r32]=f; resc=true; } } \
    SBAR(); \
    GAPB(o[0]=__builtin_amdgcn_mfma_f32_32x32x16_bf16(PAF(0),VFR(0),o[0],0,0,0), C0,0); \
    GAPB(o[1]=__builtin_amdgcn_mfma_f32_32x32x16_bf16(PAF(0),VFR(4),o[1],0,0,0), C0,4); \
    KRD(GL,0); GAPB(o[0]=__builtin_amdgcn_mfma_f32_32x32x16_bf16(PAF(1),VFR(1),o[0],0,0,0), C0,8); \
    KRD(GL,1); GAPB(o[1]=__builtin_amdgcn_mfma_f32_32x32x16_bf16(PAF(1),VFR(5),o[1],0,0,0), C0,12); \
    KRD(GL,2); GAPB(o[0]=__builtin_amdgcn_mfma_f32_32x32x16_bf16(PAF(2),VFR(2),o[0],0,0,0), C1,0); \
    KRD(GL,3); GAPB(o[1]=__builtin_amdgcn_mfma_f32_32x32x16_bf16(PAF(2),VFR(6),o[1],0,0,0), C1,4); \
    GAPB(o[0]=__builtin_amdgcn_mfma_f32_32x32x16_bf16(PAF(3),VFR(3),o[0],0,0,0), C1,8); \
    GAPB(o[1]=__builtin_amdgcn_mfma_f32_32x32x16_bf16(PAF(3),VFR(7),o[1],0,0,0), C1,12); \
    }while(0)
  int t=1;
  #undef CMASK
  #define CMASK(P0,P1,t) do{}while(0)
  for(;t+5<NT;t+=2){
    STEP(pB0,pB1,pA0,pA1,t,true,true,true);     WAIT_BAR(2); RESC(); ROT();
    STEP(pA0,pA1,pB0,pB1,t+1,true,true,true);   WAIT_BAR(2); RESC(); ROT();
  }
  #undef CMASK
  #define CMASK(P0,P1,t) do{ if(CAUSAL){int jb_=(t)-(NT-4); if(jb_>=0)cmask(P0,P1,jb_,qrel,hi);} }while(0)
  #define ENDW(tt) do{ if((tt)+3<NT){WAIT_BAR(2);} else if((tt)+2<NT){WAIT_BAR(1);} else {WAIT_BAR(0);} }while(0)
  for(;t+1<NT;t+=2){
    STEP(pB0,pB1,pA0,pA1,t,(t+3<NT),(t+1<NT),(t+1<NT));       ENDW(t);   RESC(); ROT();
    STEP(pA0,pA1,pB0,pB1,t+1,(t+4<NT),(t+2<NT),(t+2<NT));     ENDW(t+1); RESC(); ROT();
  }
  STEP(pB0,pB1,pA0,pA1,NT-1,false,false,false); RESC();
  { float sacc=pB0[0]+pB0[1]; _Pragma("unroll") for(int r=2;r<16;++r)sacc+=pB0[r]; _Pragma("unroll") for(int r=0;r<16;++r)sacc+=pB1[r]; l_reg+=sacc;
    pw0=(u32x4){PKW(pB0,0),PKW(pB0,2),PKW(pB0,4),PKW(pB0,6)};pw1=(u32x4){PKW(pB0,8),PKW(pB0,10),PKW(pB0,12),PKW(pB0,14)};pw2=(u32x4){PKW(pB1,0),PKW(pB1,2),PKW(pB1,4),PKW(pB1,6)};pw3=(u32x4){PKW(pB1,8),PKW(pB1,10),PKW(pB1,12),PKW(pB1,14)};
    SBAR(); pv(o,vb0+sl_cur,PAF(0),PAF(1),PAF(2),PAF(3)); }
  #undef PKW
  #undef PAF
  #undef VFR
  #undef PIN
  #undef MX3
  #undef GAPA
  #undef GAPB
  #undef EX
  #undef VRD
  #undef KRD
  #undef STEP
  #undef ENDW
  f32x4_m pls[4]; pg8::u32x2 ppv[4][3];
  if(CAUSAL){
    _Pragma("unroll") for(int i=0;i<4;++i){ const size_t rid=(size_t)bh*SEQ+kvb*QB+wid*QBLK+i*8+(lane>>3); pls[i]=*(const f32x4_m*)(LSE+rid*4);
      _Pragma("unroll") for(int s_=0;s_<3;++s_) ppv[i][s_]=*(const pg8::u32x2*)((const unsigned char*)PART+(rid*4+s_)*64+(lane&7)*8); } }
  {auto rr=__builtin_amdgcn_permlane32_swap(__float_as_uint(l_reg),__float_as_uint(l_reg),false,false);l_reg=__uint_as_float(rr[0])+__uint_as_float(rr[1]);}
  if(hi==0)wsf[32+r32]=l_reg;asm volatile("s_waitcnt lgkmcnt(0)":::"memory");
  float rli[16];
  #pragma unroll
  for(int r=0;r<16;++r)rli[r]=__builtin_amdgcn_rcpf(wsf[32+crow(r,hi)]);
  if(CAUSAL){ if(hi==0) wsf[r32]=mhat+__builtin_amdgcn_logf(l_reg); }
  else if(hi==0&&qent>=0) LSE[((size_t)bh*SEQ+qrow)*4+(qent>>16)]=mhat+__builtin_amdgcn_logf(l_reg);
  { bf16*stg=(bf16*)(shm+LDS_OST)+wid*2048;
    #pragma unroll
    for(int r=0;r<16;++r){const int orow=crow(r,hi);
      #pragma unroll
      for(int d0=0;d0<2;++d0)stg[orow*64+d0*32+r32]=__float2bfloat16(o[d0][r]*rli[r]);}
    asm volatile("s_waitcnt lgkmcnt(0)":::"memory");
    #pragma unroll
    for(int i=0;i<4;++i){const int row=i*8+(lane>>3),ch=lane&7; const u32x4 v=*(const u32x4*)(stg+row*64+ch*8); if(CAUSAL){ const int qr_=kvb*QB+wid*QBLK+row; const float lown=wsf[row]; const f32x4_m ls=pls[i];
        const float L=__builtin_fmaxf(__builtin_fmaxf(lown,ls[0]),__builtin_fmaxf(ls[1],ls[2]));
        const float wo=__builtin_amdgcn_exp2f(lown-L),w0=__builtin_amdgcn_exp2f(ls[0]-L),w1=__builtin_amdgcn_exp2f(ls[1]-L),w2=__builtin_amdgcn_exp2f(ls[2]-L); const float inv=__builtin_amdgcn_rcpf(wo+w0+w1+w2);
        float ac[8]; { const float ww=wo*inv; ac[0]=ww*__uint_as_float(v.x<<16); ac[1]=ww*__uint_as_float(v.x&0xffff0000u); ac[2]=ww*__uint_as_float(v.y<<16); ac[3]=ww*__uint_as_float(v.y&0xffff0000u);
          ac[4]=ww*__uint_as_float(v.z<<16); ac[5]=ww*__uint_as_float(v.z&0xffff0000u); ac[6]=ww*__uint_as_float(v.w<<16); ac[7]=ww*__uint_as_float(v.w&0xffff0000u); }
        _Pragma("unroll") for(int s_=0;s_<3;++s_){ const float ws_=(s_==0?w0:s_==1?w1:w2)*inv; const bool on_=ws_>0.f; pg8::u32x2 pv_=ppv[i][s_]; pv_.x=on_?pv_.x:0u; pv_.y=on_?pv_.y:0u;
          const pg8::f32x4 pa_=pg8::unpk8(pv_.x), pb_=pg8::unpk8(pv_.y);
          ac[0]+=ws_*pa_[0]; ac[1]+=ws_*pa_[1]; ac[2]+=ws_*pa_[2]; ac[3]+=ws_*pa_[3]; ac[4]+=ws_*pb_[0]; ac[5]+=ws_*pb_[1]; ac[6]+=ws_*pb_[2]; ac[7]+=ws_*pb_[3]; }
        pg8::u32x2 ov; ov.x=pg8::pkf8(ac[0],ac[1],ac[2],ac[3]); ov.y=pg8::pkf8(ac[4],ac[5],ac[6],ac[7]);
        *(pg8::u32x2*)((unsigned char*)O+(rowbase+qr_)*DM+h*D+ch*8)=ov; }
      else {const int qe=qlist[wid*QBLK+row]; if(qe>=0){ pg8::u32x2 o8_; o8_.x=pg8::pkf8(__uint_as_float(v.x<<16),__uint_as_float(v.x&0xffff0000u),__uint_as_float(v.y<<16),__uint_as_float(v.y&0xffff0000u)); o8_.y=pg8::pkf8(__uint_as_float(v.z<<16),__uint_as_float(v.z&0xffff0000u),__uint_as_float(v.w<<16),__uint_as_float(v.w&0xffff0000u)); *(pg8::u32x2*)((unsigned char*)PART+(((size_t)bh*SEQ+(qe&0xffff))*4+(qe>>16))*64+ch*8)=o8_; } }} }
  asm volatile("s_waitcnt lgkmcnt(0)\n\ts_barrier":::"memory");
  #undef DMA_K
  #undef DMA_V
  #undef CMASK
  #undef START
  #undef RESC
  #undef ROT
}
constexpr int ATTN_LDS_BYTES=LDS_BYTES;

typedef __attribute__((address_space(3))) float lds_f; typedef __attribute__((address_space(3))) unsigned lds_u; typedef __attribute__((address_space(3))) int lds_i; typedef __attribute__((address_space(3))) unsigned short lds_h;
typedef __attribute__((ext_vector_type(4))) float f4_t;
constexpr int SEL_KM = 0, SEL_GT = 8192, SEL_SUB = SEL_GT + 256 * 33 * 4, SEL_CNT = SEL_SUB + 32 * 256 * 2, SEL_END = SEL_CNT + 128;
constexpr int UP_OFF = 88064, QP_OFF = UP_OFF + 1040 * 4, UI_OFF = QP_OFF + 8 * 36 * 4, QL_OFF = 94208, QL_MAX = 32;
static_assert(UI_OFF + 128 <= QL_OFF && QL_OFF + QL_MAX * 1024 <= 131072 && QIDX_OFF + 1024 <= UP_OFF, "moba LDS map");

constexpr int SEL_HALF = 59392;
static_assert(SEL_END <= SEL_HALF && 2 * SEL_HALF <= 131072, "selection LDS map");
__device__ __forceinline__ void select_pair(int uA, int uB, const bf16* Q, const float* kmean, unsigned short* SUB, unsigned* CNT, float* LSE, char* shm, int tid) {
    const int half = tid >> 8, lt = tid & 255, u = half ? uB : uA;
    const int bh = u >> 5, qb = u & 31, b = bh / NHEAD, h = bh % NHEAD;
    const lds_cptr base = (lds_cptr)shm + half * SEL_HALF;
    lds_h* sub = (lds_h*)(base + SEL_SUB); lds_u* cnt = (lds_u*)(base + SEL_CNT);
    const long rowbase = (long)b * SEQ; const int q0 = qb * QB;
    if (lt < 32) cnt[lt] = 0u;
    const int lane = lt & 63, wq = lt >> 6, r32 = lane & 31, hi = lane >> 5;
    bf16x8 af[4];
#pragma unroll
    for (int kk = 0; kk < 4; ++kk) { const float* kp = kmean + ((size_t)(b * 32 + r32)) * 512 + h * 64 + 16 * kk + 8 * hi; const f4_t k0 = *(const f4_t*)kp, k1 = *(const f4_t*)(kp + 4);
        const pg8::u32x4 w = pg8::pack8(__builtin_bit_cast(pg8::f32x4, k0), __builtin_bit_cast(pg8::f32x4, k1)); af[kk] = __builtin_bit_cast(bf16x8, w); }
    __syncthreads();
#pragma unroll
    for (int c = 0; c < 2; ++c) {
        const int ql = 64 * wq + 32 * c + r32;
        const bf16* qp = Q + (rowbase + q0 + ql) * DM + h * D + 8 * hi;
        f32x16 g = f32x16{};
#pragma unroll
        for (int kk = 0; kk < 4; ++kk) { const bf16x8 bq = *reinterpret_cast<const bf16x8*>(qp + 16 * kk); g = __builtin_amdgcn_mfma_f32_32x32x16_bf16(af[kk], bq, g, 0, 0, 0); }
        float v0 = -INFINITY, v1 = -INFINITY, v2 = -INFINITY; int i0 = -1, i1 = -1, i2 = -1;
#pragma unroll
        for (int r = 0; r < 16; ++r) { const int j = (r & 3) + 8 * (r >> 2) + 4 * hi; const float x = j < qb ? g[r] : -INFINITY;
            const bool c0 = x > v0, c1 = x > v1, c2 = x > v2;
            v2 = c1 ? v1 : (c2 ? x : v2); i2 = c1 ? i1 : (c2 ? j : i2);
            v1 = c0 ? v0 : (c1 ? x : v1); i1 = c0 ? i0 : (c1 ? j : i1);
            v0 = c0 ? x : v0; i0 = c0 ? j : i0; }
        { float pv[3]; int pi[3];
          pv[0] = pg8::shx<32>(v0, lane); pv[1] = pg8::shx<32>(v1, lane); pv[2] = pg8::shx<32>(v2, lane);
          pi[0] = __builtin_amdgcn_ds_bpermute((lane ^ 32) << 2, i0); pi[1] = __builtin_amdgcn_ds_bpermute((lane ^ 32) << 2, i1); pi[2] = __builtin_amdgcn_ds_bpermute((lane ^ 32) << 2, i2);
#pragma unroll
          for (int t = 0; t < 3; ++t) { const float x = pv[t]; const int j = pi[t];
              const bool c0 = x > v0 || (x == v0 && j >= 0 && j < i0), c1 = x > v1 || (x == v1 && j >= 0 && j < i1), c2 = x > v2 || (x == v2 && j >= 0 && j < i2);
              v2 = c1 ? v1 : (c2 ? x : v2); i2 = c1 ? i1 : (c2 ? j : i2);
              v1 = c0 ? v0 : (c1 ? x : v1); i1 = c0 ? i0 : (c1 ? j : i1);
              v0 = c0 ? x : v0; i0 = c0 ? j : i0; } }
        if (hi == 0) {
            if (i0 >= 0) { const unsigned p = __hip_atomic_fetch_add(cnt + i0, 1u, __ATOMIC_RELAXED, __HIP_MEMORY_SCOPE_WORKGROUP); sub[i0 * 256 + p] = (unsigned short)(ql | (0 << 8)); }
            if (i1 >= 0) { const unsigned p = __hip_atomic_fetch_add(cnt + i1, 1u, __ATOMIC_RELAXED, __HIP_MEMORY_SCOPE_WORKGROUP); sub[i1 * 256 + p] = (unsigned short)(ql | (1 << 8)); }
            if (i2 >= 0) { const unsigned p = __hip_atomic_fetch_add(cnt + i2, 1u, __ATOMIC_RELAXED, __HIP_MEMORY_SCOPE_WORKGROUP); sub[i2 * 256 + p] = (unsigned short)(ql | (2 << 8)); }
            float* ls = LSE + ((size_t)bh * SEQ + q0 + ql) * 4; *(f4_t*)ls = (f4_t){-INFINITY, -INFINITY, -INFINITY, -INFINITY}; }
    }
    __syncthreads();
    if (lt < 32) CNT[((size_t)bh * 32 + lt) * 32 + qb] = cnt[lt];
    for (int idx = lt; idx < 32 * 256; idx += 256) { const int j = idx >> 8, i = idx & 255; if ((unsigned)i < cnt[j]) SUB[(((size_t)bh * 32 + j) * 32 + qb) * 256 + i] = sub[idx]; }
    __syncthreads();
}

__device__ __forceinline__ void sparse_phase(const bf16* Q, const bf16* K, const bf16* V, const unsigned short* SUB, const unsigned* CNT, bf16* PART, float* LSE, char* shm, int G, int bx, int tid, int wave_s) {
    lds_i* UP = (lds_i*)((lds_cptr)shm + UP_OFF); lds_i* QP = (lds_i*)((lds_cptr)shm + QP_OFF); lds_i* QI = (lds_i*)((lds_cptr)shm + QIDX_OFF);
    for (int it = tid; it < 1024; it += 512) { const unsigned* c = CNT + (size_t)it * 32; unsigned len = 0u;
#pragma unroll 8
        for (int qb = 0; qb < 32; ++qb) len += c[qb];
        UP[it + 1] = (int)((len + 255u) >> 8); }
    if (tid == 0) UP[0] = 0;
    __syncthreads();
    for (int off = 1; off < 1024; off <<= 1) {
        int a0 = 0, a1 = 0; const int i0 = tid + 1, i1 = tid + 513;
        if (i0 > off) a0 = UP[i0 - off]; if (i1 > off) a1 = UP[i1 - off];
        __syncthreads();
        UP[i0] += a0; UP[i1] += a1;
        __syncthreads();
    }
    const int U = UP[1024];
    lds_i* UI = (lds_i*)((lds_cptr)shm + UI_OFF);
    const int lane = tid & 63, wv = __builtin_amdgcn_readfirstlane(tid >> 6);
    int nloc = bx < U ? (U - bx + G - 1) / G : 0; if (nloc > QL_MAX) nloc = QL_MAX;
    for (int k = wv; k < nloc; k += 8) {
        const int u = bx + k * G;
        int lo_ = 0, hi_ = 1024;
        while (hi_ - lo_ > 1) { const int mid = (lo_ + hi_) >> 1; if (UP[mid] <= u) lo_ = mid; else hi_ = mid; }
        const int item = lo_, t = u - UP[item];
        lds_i* QPw = QP + wv * 36;
        { const int qb = lane & 31; int x = (int)CNT[(size_t)item * 32 + qb];
#pragma unroll
          for (int o = 1; o < 32; o <<= 1) { const int y = __builtin_amdgcn_ds_bpermute(((lane & 32) + ((qb - o) & 31)) << 2, x); if (qb >= o) x += y; }
          if (lane < 32) { QPw[qb + 1] = x; if (qb == 0) QPw[0] = 0; } }
        asm volatile("s_waitcnt lgkmcnt(0)" ::: "memory");
        const int len = QPw[32];
        lds_i* ql = (lds_i*)((lds_cptr)shm + QL_OFF) + k * 256;
#pragma unroll
        for (int i = 0; i < 4; ++i) { const int sidx = lane + 64 * i, g = 256 * t + sidx; int ent = -1;
            if (g < len) { int a_ = 0, bnd = 32; while (bnd - a_ > 1) { const int mid = (a_ + bnd) >> 1; if (QPw[mid] <= g) a_ = mid; else bnd = mid; }
                const unsigned e = SUB[((size_t)item * 32 + a_) * 256 + (g - QPw[a_])]; ent = (a_ * 256 + (int)(e & 255u)) | ((int)(e >> 8) << 16); }
            ql[sidx] = ent; }
        if (lane == 0) UI[k] = item;
    }
    __syncthreads();
    for (int k = 0; k < nloc; ++k) { const int item = UI[k], bh = item >> 5, j = item & 31;
        attn_unit<8, false>(bh / NHEAD, bh % NHEAD, j, QL_OFF + k * 1024, Q, K, V, PART, LSE, nullptr, shm, wave_s); }
    for (int u = bx + QL_MAX * G; u < U; u += G) {
        int lo_ = 0, hi_ = 1024; while (hi_ - lo_ > 1) { const int mid = (lo_ + hi_) >> 1; if (UP[mid] <= u) lo_ = mid; else hi_ = mid; }
        const int item = lo_, t = u - UP[item], bh = item >> 5, j = item & 31;
        if (tid < 64) { const int qb = tid & 31; int x = (int)CNT[(size_t)item * 32 + qb];
#pragma unroll
            for (int o = 1; o < 32; o <<= 1) { const int y = __builtin_amdgcn_ds_bpermute(((tid & 32) + ((qb - o) & 31)) << 2, x); if (qb >= o) x += y; }
            if (tid < 32) { QP[qb + 1] = x; if (qb == 0) QP[0] = 0; } }
        __syncthreads();
        if (tid < 256) { const int g = 256 * t + tid; int ent = -1;
            if (g < QP[32]) { int a_ = 0, bnd = 32; while (bnd - a_ > 1) { const int mid = (a_ + bnd) >> 1; if (QP[mid] <= g) a_ = mid; else bnd = mid; }
                const unsigned e = SUB[((size_t)item * 32 + a_) * 256 + (g - QP[a_])]; ent = (a_ * 256 + (int)(e & 255u)) | ((int)(e >> 8) << 16); }
            QI[tid] = ent; }
        __syncthreads();
        attn_unit<8, false>(bh / NHEAD, bh % NHEAD, j, QIDX_OFF, Q, K, V, PART, LSE, nullptr, shm, wave_s);
    }
}

__device__ __forceinline__ void own_phase(const bf16* Q, const bf16* K, const bf16* V, const bf16* PART, const float* LSE, bf16* O, char* shm, int G, int bx, int wave_s) {
    for (int u = bx; u < BATCH * NHEAD * NQB; u += G) { const int bh = u >> 5, qb = u & 31;
        attn_unit<8, true>(bh / NHEAD, bh % NHEAD, qb, 0, Q, K, V, (bf16*)PART, (float*)LSE, O, shm, wave_s); }
}
#undef SBAR
#undef WAIT_BAR
}

constexpr int NWAVES = 8;
constexpr int NB = 4, SEQ = 8192, T = NB * SEQ, D = 1024;
constexpr int D_SSM = 512, NG = 32, NS = 64;
constexpr int D_ATT = 512;
constexpr int D_IN = 4096;
constexpr int PH = 8, PQD = 256, NEXP = 16384;
constexpr int D_PLE = 256;
constexpr float EPS = 1e-6f;

constexpr size_t MiB = 1u << 20, KiB = 1u << 10;
constexpr size_t WS_CTL = 0, CTL_ZERO_BYTES = 1 * MiB;
constexpr int CW_BAR = 4096;
constexpr size_t CTL_KMEAN = 64 * KiB;
constexpr size_t CTL_SS1 = 320 * KiB;
constexpr size_t CTL_SS3 = 448 * KiB;
constexpr size_t WS_WIN = 1 * MiB;
constexpr size_t WS_WGLU = 9 * MiB;
constexpr size_t WS_WPS = 9 * MiB + 512 * KiB;
constexpr size_t WS_WPA = 10 * MiB + 512 * KiB;
constexpr size_t WS_WOUT = 11 * MiB + 512 * KiB;
constexpr size_t WS_WS = 13 * MiB + 512 * KiB;
constexpr size_t WS_WGATE = 17 * MiB + 512 * KiB;
constexpr size_t WS_WPP = 19 * MiB + 512 * KiB;
constexpr size_t WS_ROPE = 20 * MiB;
constexpr size_t WS_S5P = 22 * MiB;
constexpr size_t WS_RS2 = 23 * MiB;
constexpr size_t WS_UT = 24 * MiB;
constexpr size_t WS_S5W = 40 * MiB;
constexpr size_t WS_VT = 40 * MiB;
constexpr size_t WS_SU = 48 * MiB, WS_SV = 48 * MiB + 64 * KiB;
constexpr size_t WS_X8 = 56 * MiB;
constexpr size_t WS_XN = 88 * MiB;
constexpr size_t WS_MSUB = 88 * MiB, WS_MCNT = 104 * MiB, WS_MLSE = 105 * MiB;
constexpr size_t WS_YP = 112 * MiB;
constexpr size_t WS_PB = 152 * MiB;
constexpr size_t WS_E = 168 * MiB;
constexpr size_t WS_U = 232 * MiB;
constexpr size_t WS_Q = 264 * MiB;
constexpr size_t WS_K = 296 * MiB;
constexpr size_t WS_V = 328 * MiB;
constexpr size_t WS_SGA = 360 * MiB;
constexpr size_t WS_SGB = 424 * MiB;
constexpr size_t WS_SC = 232 * MiB;
constexpr size_t WS_HLOC = 488 * MiB;
constexpr size_t WS_END = 496 * MiB;
constexpr size_t S5_ABR = 0, S5_ABI = 8 * KiB, S5_ALR = 16 * KiB, S5_ALI = 24 * KiB;
constexpr size_t S5_BRE = 32 * KiB, S5_BIM = 160 * KiB;
constexpr size_t S5_CM = 288 * KiB;

constexpr int RING_OFF = 0, RING_BYTES = 131072;
constexpr int LDSCTL_OFF = RING_BYTES, MISC_OFF = LDSCTL_OFF + 320;
constexpr int LDS_BYTES = 147456;

#define GAS __attribute__((address_space(1)))
#define LAS __attribute__((address_space(3)))
typedef unsigned short bf16;
typedef unsigned v4u __attribute__((ext_vector_type(4)));
typedef unsigned v2u __attribute__((ext_vector_type(2)));
typedef float f32x4 __attribute__((ext_vector_type(4)));
typedef float f32x2 __attribute__((ext_vector_type(2)));
typedef short bf16x8 __attribute__((ext_vector_type(8)));
using pg8::shx; using pg8::bperm; using pg8::bpermi; using pg8::lane_id_opaque;
using pg8::pkbf; using pg8::bflo; using pg8::bfhi; using pg8::gelu_tanh; using pg8::sigmoidf_;
#define LDS_WAIT() asm volatile("s_waitcnt lgkmcnt(0)" ::: "memory")

#define XB_TMO      128
#define XB_XCNT(j)  (256  + 64 * (j))
#define XB_XSUB(j)  (1280 + 64 * (j))
#define XB_XGEN(j)  (2304 + 64 * (j))
#define XB_TOP      3328
#define XB_TOPGEN   3392
#define XCD_BAR_WORDS 3456
#define XB_SPIN_CAP (1u << 22)
__device__ __forceinline__ unsigned xb_ld(unsigned* p)              { return __hip_atomic_load(p, __ATOMIC_RELAXED, __HIP_MEMORY_SCOPE_AGENT); }
__device__ __forceinline__ unsigned xb_add(unsigned* p, unsigned v) { return __hip_atomic_fetch_add(p, v, __ATOMIC_RELAXED, __HIP_MEMORY_SCOPE_AGENT); }
__device__ __forceinline__ unsigned xb_xcc_id() { return (unsigned)__builtin_amdgcn_s_getreg((3 << 11) | 20) & 0xFu; }
#define XB_SPIN(cond, bar) do { unsigned _sp = 0; while (cond) { __builtin_amdgcn_s_sleep(1); \
    if ((++_sp & 255u) == 0u) { if (xb_ld(&(bar)[XB_TMO])) break; if (_sp > XB_SPIN_CAP) { atomicAdd(&(bar)[XB_TMO], 1u); break; } } } } while (0)
struct XcdBarrier { unsigned* bar; unsigned x; volatile LAS unsigned* st; };
__device__ __forceinline__ bool is_thread0(int wave_s) { return wave_s == 0 && lane_id_opaque() == 0; }
__device__ __forceinline__ XcdBarrier xcd_barrier_post(unsigned* bar, volatile LAS unsigned* st, int wave_s) {
    XcdBarrier b; b.bar = bar; b.x = xb_xcc_id(); b.st = st;
    if (is_thread0(wave_s)) (void)xb_add(&bar[XB_XCNT(b.x)], 1u);
    return b;
}
__device__ __forceinline__ void xcd_barrier_complete(unsigned* bar, unsigned x, unsigned& nloc, unsigned& nx) {
    const unsigned G = gridDim.x * gridDim.y * gridDim.z;
    unsigned sum, cnt, mine, sp = 0u;
    for (;;) {
        sum = 0u; cnt = 0u; mine = 0u;
#pragma unroll
        for (unsigned j = 0; j < 16; ++j) { const unsigned c = xb_ld(&bar[XB_XCNT(j)]); sum += c; cnt += (c > 0u) ? 1u : 0u; mine = (j == x) ? c : mine; }
        if (sum == G) break;
        __builtin_amdgcn_s_sleep(1);
        if ((++sp & 255u) == 0u) { if (xb_ld(&bar[XB_TMO])) break; if (sp > XB_SPIN_CAP) { atomicAdd(&bar[XB_TMO], 1u); break; } }
    }
    nloc = mine > 0u ? mine : 1u; nx = cnt > 0u ? cnt : 1u;
}
__device__ __forceinline__ void xcd_barrier(const XcdBarrier& b, int wave_s) {
    asm volatile("s_waitcnt vmcnt(0)" ::: "memory");
    __syncthreads();
    if (is_thread0(wave_s)) {
        unsigned* bar = b.bar;
        __builtin_amdgcn_s_waitcnt(0);
        unsigned nloc = b.st[0], nx = b.st[1];
        if (nloc == 0u) { xcd_barrier_complete(bar, b.x, nloc, nx); b.st[0] = nloc; b.st[1] = nx; }
        const unsigned old = xb_add(&bar[XB_XSUB(b.x)], 1u);
        const unsigned gen = old / nloc;
        if (old + 1u == (gen + 1u) * nloc) {
            __builtin_amdgcn_fence(__ATOMIC_RELEASE, "agent");
            asm volatile("s_waitcnt vmcnt(0)" ::: "memory");
            const unsigned og = xb_add(&bar[XB_TOP], 1u);
            const unsigned tg = og / nx;
            if (og + 1u == (tg + 1u) * nx) xb_add(&bar[XB_TOPGEN], 1u);
            else XB_SPIN(xb_ld(&bar[XB_TOPGEN]) == tg, bar);
            __builtin_amdgcn_fence(__ATOMIC_ACQUIRE, "agent");
            xb_add(&bar[XB_XGEN(b.x)], 1u);
            asm volatile("s_waitcnt vmcnt(0)" ::: "memory");
        } else {
            XB_SPIN(xb_ld(&bar[XB_XGEN(b.x)]) == gen, bar);
            __builtin_amdgcn_fence(__ATOMIC_ACQUIRE, "agent");
            asm volatile("s_waitcnt vmcnt(0)" ::: "memory");
        }
    }
    __syncthreads();
}

struct Args { const float* in[27]; float* out; unsigned char* ws; };
enum { I_X = 0, I_P, I_POS, I_GMIX, I_WIN, I_LOGDT, I_ARE, I_AIM, I_BRE, I_BIM, I_CRE, I_CIM, I_DSK, I_WGLU, I_WPS, I_WPA, I_WOUT, I_GFFN, I_WQ, I_KEY1, I_KEY2, I_PU, I_PV, I_GPLE, I_WGATE, I_WPP, I_GFIN };

__device__ __forceinline__ float wave_sum(float v, int lane) {
    v += shx<1>(v, lane); v += shx<2>(v, lane); v += shx<4>(v, lane); v += shx<8>(v, lane); v += shx<16>(v, lane); v += shx<32>(v, lane);
    return v;
}

template <bool F8 = false>
__device__ __forceinline__ void p0_transpose_item(const float* W, const float* ks, int K, int N, bf16* WT, LAS float* scr, int item, int lane) {
    const int nblk = N / 32, kb = item / nblk, nb = item % nblk, k0 = 64 * kb, n0 = 32 * nb;
    { f32x4 w4[8]; float sc[8];
#pragma unroll
      for (int i = 0; i < 8; ++i) { const int kk = 8 * i + (lane >> 3); w4[i] = *(const f32x4*)(W + (size_t)(k0 + kk) * N + n0 + 4 * (lane & 7)); sc[i] = ks ? ks[k0 + kk] : 1.0f; }
#pragma unroll
      for (int i = 0; i < 8; ++i) { const int kk = 8 * i + (lane >> 3); LAS float* d = scr + kk * 33 + 4 * (lane & 7); d[0] = w4[i][0] * sc[i]; d[1] = w4[i][1] * sc[i]; d[2] = w4[i][2] * sc[i]; d[3] = w4[i][3] * sc[i]; } }
    LDS_WAIT(); asm volatile("" ::: "memory");
    const int c = lane & 7;
#pragma unroll
    for (int j = 0; j < 4; ++j) { const int n = (lane >> 3) + 8 * j; const LAS float* s = scr + (8 * c) * 33 + n;
        if (F8) { constexpr float sc8 = (float)(1 << pg8::W8_SHIFT); v2u o; o.x = pg8::pkf8(s[0 * 33] * sc8, s[1 * 33] * sc8, s[2 * 33] * sc8, s[3 * 33] * sc8); o.y = pg8::pkf8(s[4 * 33] * sc8, s[5 * 33] * sc8, s[6 * 33] * sc8, s[7 * 33] * sc8);
            *(v2u*)((unsigned char*)WT + (size_t)(n0 + n) * K + k0 + 8 * c) = o; }
        else { v4u o; o.x = pkbf(s[0 * 33], s[1 * 33]); o.y = pkbf(s[2 * 33], s[3 * 33]); o.z = pkbf(s[4 * 33], s[5 * 33]); o.w = pkbf(s[6 * 33], s[7 * 33]);
            *(v4u*)(WT + (size_t)(n0 + n) * K + k0 + 8 * c) = o; } }
    LDS_WAIT(); asm volatile("" ::: "memory");
}

__device__ __forceinline__ void cs_reduced(double ang, float& c, float& s) {
    const double r = ang * 0.15915494309189535; double fr = r - floor(r); if (fr > 0.5) fr -= 1.0;
    const float y = (float)(fr * 6.283185307179586);
    c = cosf(y); s = sinf(y);
}

__device__ __forceinline__ void p0_ws_item(const float* Wq, const float* gffn, const float* key1, const float* key2, bf16* WsT, LAS unsigned char* lds, int item, int tid) {
    constexpr int P = 132;
    LAS float* wq = (LAS float*)lds;
    LAS float* ky = (LAS float*)(lds + 64 * P * 4);
    const int hh = item >> 4, kb = item & 15, h = hh >> 1, half = hh & 1, k0 = 64 * kb;
    const float* keys = (half ? key2 : key1) + (size_t)h * 128 * 128;
#pragma unroll
    for (int i = 0; i < 4; ++i) { const int idx = tid + 512 * i, kk = idx >> 5, d4 = idx & 31;
        f32x4 v = *(const f32x4*)(Wq + (size_t)(k0 + kk) * 2048 + h * 256 + half * 128 + 4 * d4); v = v * gffn[k0 + kk];
        *(LAS f32x4*)(wq + kk * P + 4 * d4) = v; }
#pragma unroll
    for (int i = 0; i < 8; ++i) { const int idx = tid + 512 * i, n = idx >> 5, d4 = idx & 31;
        *(LAS f32x4*)(ky + n * P + 4 * d4) = *(const f32x4*)(keys + (size_t)n * 128 + 4 * d4); }
    __syncthreads();
    const int kq = tid & 15, nq = tid >> 4;
    float acc[4][4];
#pragma unroll
    for (int a = 0; a < 4; ++a)
#pragma unroll
        for (int b = 0; b < 4; ++b) acc[a][b] = 0.f;
    for (int d4 = 0; d4 < 32; ++d4) {
        f32x4 wv[4], kv[4];
#pragma unroll
        for (int a = 0; a < 4; ++a) { wv[a] = *(const LAS f32x4*)(wq + (4 * kq + a) * P + 4 * d4); kv[a] = *(const LAS f32x4*)(ky + (4 * nq + a) * P + 4 * d4); }
#pragma unroll
        for (int a = 0; a < 4; ++a)
#pragma unroll
            for (int b = 0; b < 4; ++b)
                acc[a][b] += (kv[a][0] * wv[b][0] + kv[a][1] * wv[b][1]) + (kv[a][2] * wv[b][2] + kv[a][3] * wv[b][3]);
    }
#pragma unroll
    for (int a = 0; a < 4; ++a) { v2u o; o.x = pkbf(acc[a][0], acc[a][1]); o.y = pkbf(acc[a][2], acc[a][3]);
        *(v2u*)(WsT + (size_t)(h * 256 + half * 128 + 4 * nq + a) * 1024 + k0 + 4 * kq) = o; }
    __syncthreads();
}

namespace s5 {
constexpr long YP8_DELTA = (long)WS_MSUB - (long)WS_YP;
constexpr int L = 64, NCH = SEQ / L, HP = 136, XP = 132;
constexpr int X_BYTES = 16 * XP * 4, WAVE_LDS = X_BYTES + 16 * HP * 2;
constexpr int ITEMS_PER_BG = 8, CH_STRIDE = NCH / ITEMS_PER_BG;

template <int PASS> struct Loads { v4u uf[4]; v2u uw[4]; float hlr[16], hli[16]; };
constexpr size_t HPLANE = (size_t)NB * NG * NCH * 64;

template <int PASS>
__device__ __forceinline__ void issue(Loads<PASS>& ld, const bf16* Ub, const float* Hb, int ch, int q, int nl, int lane) {
#pragma unroll
    for (int blk = 0; blk < 4; ++blk) { ld.uf[blk] = *(const v4u*)(Ub + (blk * 16 + nl) * 16 + 8 * (q & 1));
        if (PASS == 2) ld.uw[blk] = *(const v2u*)(Ub + (blk * 16 + nl) * 16 + 4 * q); }
    if (PASS == 2) {
#pragma unroll
        for (int j = 0; j < 16; ++j) { const int c = ch - 16 + j; const float* hp = Hb + (size_t)(c < 0 ? 0 : c) * 64 + lane; ld.hlr[j] = hp[0]; ld.hli[j] = hp[HPLANE]; }
    }
}

template <int PASS>
__device__ __forceinline__ void run(LAS unsigned char* ldsw, const unsigned char* s5p, const bf16* U, float* Hloc, const float* dskip, bf16* YP, int gw, int ngw, int lane) {
    const int q = lane >> 4, nl = lane & 15;
    LAS float* Xt = (LAS float*)ldsw;
    LAS bf16* Ht = (LAS bf16*)(ldsw + X_BYTES);
    for (int wv = gw; wv < NB * NG * CH_STRIDE; wv += ngw) {
        const int g = wv & 31, b = (wv >> 5) & 3, ch0 = wv >> 7;
        bf16x8 af[8];
#pragma unroll
        for (int j = 0; j < 8; ++j) {
            const float* src = (const float*)(s5p + (j < 4 ? S5_BRE : S5_BIM)) + (size_t)(g * 64 + 16 * (j & 3) + nl) * 16 + 8 * (q & 1);
            const f32x4 a = *(const f32x4*)src, bb = *(const f32x4*)(src + 4);
            v4u w = pg8::pack8(a, bb); if (q >= 2) w = (v4u){0u, 0u, 0u, 0u};
            af[j] = __builtin_bit_cast(bf16x8, w);
        }
        const float ar = ((const float*)(s5p + S5_ABR))[g * 64 + lane], ai = ((const float*)(s5p + S5_ABI))[g * 64 + lane];
        const float aLr = ((const float*)(s5p + S5_ALR))[g * 64 + lane], aLi = ((const float*)(s5p + S5_ALI))[g * 64 + lane];
        bf16x8 cf[4]; float dsk[4];
        if (PASS == 2) {
#pragma unroll
            for (int kk = 0; kk < 4; ++kk) cf[kk] = *(const bf16x8*)((const bf16*)(s5p + S5_CM) + (size_t)(g * 16 + nl) * 128 + 32 * kk + 8 * q);
#pragma unroll
            for (int r = 0; r < 4; ++r) dsk[r] = dskip[g * 16 + 4 * q + r];
        }
        const bf16* Ubg = U + (size_t)(b * 32 + g) * SEQ * 16;
        float* Hbg = Hloc + (size_t)(b * 32 + g) * NCH * 64;
        float cr = 0.f, ci = 0.f;
        Loads<PASS> cur, nxt;
        issue<PASS>(cur, Ubg + (size_t)ch0 * L * 16, Hbg, ch0, q, nl, lane);
#pragma unroll 1
        for (int i = 0; i < ITEMS_PER_BG; ++i) {
            const int ch = ch0 + CH_STRIDE * i;
            if (i + 1 < ITEMS_PER_BG) issue<PASS>(nxt, Ubg + (size_t)(ch + CH_STRIDE) * L * 16, Hbg, ch + CH_STRIDE, q, nl, lane);
            float hr = 0.f, hi = 0.f;
            if (PASS == 2) {
#pragma unroll
                for (int j = 0; j < 16; ++j) { const bool ok = (ch - 16 + j) >= 0; const float lr = ok ? cur.hlr[j] : 0.f, li = ok ? cur.hli[j] : 0.f;
                    const float ncr = fmaf(aLr, cr, fmaf(-aLi, ci, lr)), nci = fmaf(aLr, ci, fmaf(aLi, cr, li)); cr = ok ? ncr : cr; ci = ok ? nci : ci; }
                hr = cr; hi = ci;
            }
#pragma unroll
            for (int blk = 0; blk < L / 16; ++blk) {
                v4u uw4 = cur.uf[blk]; if (q >= 2) uw4 = (v4u){0u, 0u, 0u, 0u};
                const bf16x8 uf = __builtin_bit_cast(bf16x8, uw4);
#pragma unroll
                for (int j = 0; j < 8; ++j) { const f32x4 d = __builtin_amdgcn_mfma_f32_16x16x32_bf16(af[j], uf, (f32x4){0.f, 0.f, 0.f, 0.f}, 0, 0, 0);
                    *(LAS f32x4*)(Xt + nl * XP + 16 * j + 4 * q) = d; }
#pragma unroll
                for (int tt = 0; tt < 16; ++tt) {
                    const float xr = Xt[tt * XP + lane], xi = Xt[tt * XP + 64 + lane];
                    const float nhr = fmaf(ar, hr, fmaf(-ai, hi, xr)), nhi = fmaf(ar, hi, fmaf(ai, hr, xi));
                    hr = nhr; hi = nhi;
                    if (PASS == 2) { const unsigned pw = pkbf(hr, hi); Ht[tt * HP + lane] = (bf16)(pw & 0xffffu); Ht[tt * HP + 64 + lane] = (bf16)(pw >> 16); }
                }
                if (PASS == 2) {
                    f32x4 acc = {0.f, 0.f, 0.f, 0.f};
#pragma unroll
                    for (int kk = 0; kk < 4; ++kk) { const bf16x8 hf = *(const LAS bf16x8*)(Ht + nl * HP + 32 * kk + 8 * q);
                        acc = __builtin_amdgcn_mfma_f32_16x16x32_bf16(cf[kk], hf, acc, 0, 0, 0); }
                    const int tl = blk * 16 + nl;
                    const v2u uw = cur.uw[blk];
                    const float y0 = gelu_tanh(acc[0] + dsk[0] * bflo(uw.x)), y1 = gelu_tanh(acc[1] + dsk[1] * bfhi(uw.x));
                    const float y2 = gelu_tanh(acc[2] + dsk[2] * bflo(uw.y)), y3 = gelu_tanh(acc[3] + dsk[3] * bfhi(uw.y));
                    v2u o; o.x = pkbf(y0, y1); o.y = pkbf(y2, y3);
                    *(v2u*)(YP + ((size_t)b * SEQ + (size_t)ch * L + tl) * 512 + g * 16 + 4 * q) = o;
                    *(unsigned*)((unsigned char*)YP + YP8_DELTA + ((size_t)b * SEQ + (size_t)ch * L + tl) * 512 + g * 16 + 4 * q) = pg8::pkf8(y0, y1, y2, y3);
                }
            }
            if (PASS == 1) { Hbg[(size_t)ch * 64 + lane] = hr; Hbg[HPLANE + (size_t)ch * 64 + lane] = hi; }
            cur = nxt;
        }
    }
}


__device__ __forceinline__ void pass1_gemm(LAS unsigned char* lds, const bf16* W, const bf16* U, float* Hloc, int G, int bx, int tid, int wave) {
    constexpr int PITCH = 528, A_OFF = 0, B_OFF = 128 * PITCH;
    const int lane = tid & 63, fr = lane & 15, fq = lane >> 4;
    for (int task = bx; task < NG * 8; task += G) {
        const int g = task >> 3, c8 = task & 7, b = c8 >> 1, ch0 = 64 * (c8 & 1);
        const bf16* Wg = W + (size_t)g * 128 * 1024;
        const bf16* Ub = U + ((size_t)(b * 32 + g) * SEQ + (size_t)ch0 * L) * 16;
        f32x4 acc[4];
#pragma unroll
        for (int nt = 0; nt < 4; ++nt) acc[nt] = (f32x4){0.f, 0.f, 0.f, 0.f};
#pragma unroll 1
        for (int slab = 0; slab < 4; ++slab) {
            v4u ta[8], tb[4];
#pragma unroll
            for (int i = 0; i < 8; ++i) { const int p = tid + 512 * i; ta[i] = *(const v4u*)((const unsigned char*)Wg + (size_t)(p >> 5) * 2048 + slab * 512 + 16 * (p & 31)); }
#pragma unroll
            for (int i = 0; i < 4; ++i) { const int p = tid + 512 * i; tb[i] = *(const v4u*)((const unsigned char*)Ub + (size_t)(p >> 5) * 2048 + slab * 512 + 16 * (p & 31)); }
            __syncthreads();
#pragma unroll
            for (int i = 0; i < 8; ++i) { const int p = tid + 512 * i; *(LAS v4u*)(lds + A_OFF + (p >> 5) * PITCH + 16 * (p & 31)) = ta[i]; }
#pragma unroll
            for (int i = 0; i < 4; ++i) { const int p = tid + 512 * i; *(LAS v4u*)(lds + B_OFF + (p >> 5) * PITCH + 16 * (p & 31)) = tb[i]; }
            __syncthreads();
#pragma unroll
            for (int kk = 0; kk < 8; ++kk) { const bf16x8 wf = *(const LAS bf16x8*)(lds + A_OFF + (16 * wave + fr) * PITCH + 64 * kk + 16 * fq);
#pragma unroll
                for (int nt = 0; nt < 4; ++nt) { const bf16x8 uf = *(const LAS bf16x8*)(lds + B_OFF + (16 * nt + fr) * PITCH + 64 * kk + 16 * fq); acc[nt] = __builtin_amdgcn_mfma_f32_16x16x32_bf16(wf, uf, acc[nt], 0, 0, 0); } }
        }
        const int np = 16 * wave + 4 * fq;
        float* Hp = Hloc + (size_t)(np >> 6) * HPLANE + ((size_t)(b * 32 + g) * NCH + ch0 + fr) * 64 + (np & 63);
#pragma unroll
        for (int nt = 0; nt < 4; ++nt) *(f32x4*)(Hp + (size_t)(16 * nt) * 64) = acc[nt];
        __syncthreads();
    }
}
}

namespace peer {
template <int M> __device__ __forceinline__ int shxi(int v, int lane) { return __builtin_bit_cast(int, shx<M>(__builtin_bit_cast(float, v), lane)); }
__device__ __forceinline__ float hmax32(float m, int lane) { m = fmaxf(m, shx<1>(m, lane)); m = fmaxf(m, shx<2>(m, lane)); m = fmaxf(m, shx<4>(m, lane)); m = fmaxf(m, shx<8>(m, lane)); m = fmaxf(m, shx<16>(m, lane)); return m; }
__device__ __forceinline__ unsigned f2o(float f) { const unsigned b = __float_as_uint(f); return b ^ ((unsigned)((int)b >> 31) | 0x80000000u); }
__device__ __forceinline__ float o2f(unsigned k) { return __uint_as_float(k ^ ((~(unsigned)((int)k >> 31)) | 0x80000000u)); }
template <int CTRL> __device__ __forceinline__ unsigned dppmax(unsigned x) { const unsigned y = (unsigned)__builtin_amdgcn_update_dpp(0, (int)x, CTRL, 0xf, 0xf, true); return x > y ? x : y; }
__device__ __forceinline__ unsigned rowmax16(unsigned x) { x = dppmax<0xB1>(x); x = dppmax<0x4E>(x); x = dppmax<0x141>(x); x = dppmax<0x140>(x); return x; }
__device__ __forceinline__ unsigned wrlane(unsigned v, unsigned val, int sel) { unsigned keep;
    asm("s_mov_b32 %1, m0\n\ts_mov_b32 m0, %3\n\ts_nop 0\n\tv_writelane_b32 %0, %2, m0\n\ts_mov_b32 m0, %1" : "+v"(v), "=&s"(keep) : "s"(val), "s"(sel)); return v; }
__device__ __forceinline__ void cex(unsigned& a, unsigned& b) { const unsigned hi = a > b ? a : b, lo = a > b ? b : a; a = hi; b = lo; }
__device__ __forceinline__ unsigned qpack4(const f32x4 v, float inv, int ob) { const int a = (int)rintf(v[0] * inv) + ob, b = (int)rintf(v[1] * inv) + ob, c = (int)rintf(v[2] * inv) + ob, d = (int)rintf(v[3] * inv) + ob;
    return ((unsigned)a & 0xffu) | (((unsigned)b & 0xffu) << 8) | (((unsigned)c & 0xffu) << 16) | (((unsigned)d & 0xffu) << 24); }
__device__ __forceinline__ float sel8(const float (&a)[8], int h) { float r = a[0];
#pragma unroll
    for (int q = 1; q < 8; ++q) r = (h == q) ? a[q] : r;
    return r; }
__device__ __forceinline__ unsigned sel8u(const unsigned (&a)[8], int h) { unsigned r = a[0];
#pragma unroll
    for (int q = 1; q < 8; ++q) r = (h == q) ? a[q] : r;
    return r; }

struct Pre { v2u sc[8]; v4u xr[2]; };
__device__ __forceinline__ void load_pre(Pre& p, const float* S, const bf16* XB, int tkn, int lane) {
    const v2u* Sp = (const v2u*)((const bf16*)S + (size_t)tkn * 2048) + lane;
#pragma unroll
    for (int h = 0; h < 8; ++h) p.sc[h] = Sp[64 * h];
    const v4u* xp = (const v4u*)(XB + (size_t)tkn * 1024 + lane * 16);
    p.xr[0] = xp[0]; p.xr[1] = xp[1];
}

struct Row4 { f32x4 v[4]; };
__device__ __forceinline__ void load_row(Row4& r, const float* src, int lane) {
#pragma unroll
    for (int j = 0; j < 4; ++j) r.v[j] = *(const f32x4*)(src + 256 * j + 4 * lane); }
__device__ __forceinline__ void load_row16(Row4& r, const float* src, int lane) {
#pragma unroll
    for (int j = 0; j < 4; ++j) r.v[j] = *(const f32x4*)(src + 16 * lane + 4 * j); }
__device__ __forceinline__ void quant_row(const Row4& r, const f32x4 (&gf)[4], bool use_gf, unsigned char* dst, float* scale_out, bool offset_binary, int lane) {
    f32x4 v[4]; float m = 0.f;
#pragma unroll
    for (int j = 0; j < 4; ++j) { v[j] = r.v[j]; if (use_gf) v[j] = v[j] * gf[j];
        m = fmaxf(fmaxf(m, fmaxf(fabsf(v[j][0]), fabsf(v[j][1]))), fmaxf(fabsf(v[j][2]), fabsf(v[j][3]))); }
    m = hmax32(m, lane); m = fmaxf(m, shx<32>(m, lane));
    const float inv = m > 0.f ? 127.0f / m : 0.f; const int ob = offset_binary ? 128 : 0;
#pragma unroll
    for (int j = 0; j < 4; ++j) *(unsigned*)(dst + 256 * j + 4 * lane) = qpack4(v[j], inv, ob);
    if (lane == 0) *scale_out = m * (1.0f / 127.0f);
}
__device__ __forceinline__ void quant_row4(Row4 r, const f32x4 (&gf)[4], bool use_gf, unsigned char* dst, float* scale_out, int lane, bool signed_hi = false) {
    if (use_gf) {
#pragma unroll
        for (int j = 0; j < 4; ++j) r.v[j] = r.v[j] * gf[j]; }
    float ssq = 0.f;
#pragma unroll
    for (int j = 0; j < 4; ++j) ssq += (r.v[j][0] * r.v[j][0] + r.v[j][1] * r.v[j][1]) + (r.v[j][2] * r.v[j][2] + r.v[j][3] * r.v[j][3]);
    ssq = wave_sum(ssq, lane);
    const float step = 0.3352f * sqrtf(ssq * (1.0f / 1024.0f)), inv = step > 0.f ? 1.0f / step : 0.f;
    v2u o;
#pragma unroll
    for (int g = 0; g < 2; ++g) { unsigned w = 0u;
#pragma unroll
        for (int j = 0; j < 4; ++j) { const int a = (int)floorf(r.v[2 * g][j] * inv) + 8, b = (int)floorf(r.v[2 * g + 1][j] * inv) + 8;
            const unsigned lo4 = (unsigned)(a < 0 ? 0 : a > 15 ? 15 : a); unsigned hi4 = (unsigned)(b < 0 ? 0 : b > 15 ? 15 : b); if (signed_hi) hi4 = (hi4 - 8u) & 15u; w |= (lo4 | (hi4 << 4)) << (8 * j); }
        if (g == 0) o.x = w; else o.y = w; }
    *(v2u*)(dst + 16 * lane) = o;
    if (lane == 0) *scale_out = step;
}
}

namespace peer {
struct TK { unsigned eidP0, eidP1; float cAP0, cAP1, cBP0, cBP1; };

__device__ __forceinline__ void sort8(unsigned (&v)[8]) {
    cex(v[0], v[1]); cex(v[2], v[3]); cex(v[4], v[5]); cex(v[6], v[7]); cex(v[0], v[2]); cex(v[1], v[3]); cex(v[4], v[6]); cex(v[5], v[7]);
    cex(v[1], v[2]); cex(v[5], v[6]); cex(v[0], v[4]); cex(v[3], v[7]); cex(v[1], v[5]); cex(v[2], v[6]); cex(v[1], v[4]); cex(v[3], v[6]); cex(v[2], v[4]); cex(v[3], v[5]); cex(v[3], v[4]);
}
__device__ __forceinline__ float rowsum16(float x) {
#define PEER_RS(CTRL) x += __builtin_bit_cast(float, __builtin_amdgcn_update_dpp(0, __builtin_bit_cast(int, x), CTRL, 0xf, 0xf, true))
    PEER_RS(0xB1); PEER_RS(0x4E); PEER_RS(0x141); PEER_RS(0x140);
#undef PEER_RS
    return x; }
__device__ __forceinline__ void prep_keys(const Pre& pre, unsigned (&kk)[4][8], int hl) {
#pragma unroll
    for (int p = 0; p < 4; ++p) { const v2u wa = pre.sc[2 * p], wb = pre.sc[2 * p + 1];
        const f32x4 sa = {pg8::bflo(wa.x), pg8::bfhi(wa.x), pg8::bflo(wa.y), pg8::bfhi(wa.y)}, sb = {pg8::bflo(wb.x), pg8::bfhi(wb.x), pg8::bflo(wb.y), pg8::bfhi(wb.y)};
#pragma unroll
        for (int e = 0; e < 4; ++e) { const unsigned ka = (f2o(sa[e]) & ~127u) | (unsigned)(4 * hl + e), kb = (f2o(sb[e]) & ~127u) | (unsigned)(4 * hl + e);
            const auto r = __builtin_amdgcn_permlane16_swap(ka, kb, false, false);
            kk[p][e] = (unsigned)r[0]; kk[p][4 + e] = (unsigned)r[1]; }
        sort8(kk[p]); }
}
__device__ __forceinline__ void quant_x(const Pre& pre, v4u& xq, float& sx, int& sumx, int lane) {
    f32x4 xf[4]; pg8::unpack8(pre.xr[0], xf[0], xf[1]); pg8::unpack8(pre.xr[1], xf[2], xf[3]);
    float m = 0.f;
#pragma unroll
    for (int e = 0; e < 4; ++e) m = fmaxf(fmaxf(m, fabsf(xf[0][e])), fmaxf(fmaxf(fabsf(xf[1][e]), fabsf(xf[2][e])), fabsf(xf[3][e])));
    unsigned am = rowmax16(__float_as_uint(m)); am = dppmax<0x142>(am); am = dppmax<0x143>(am);
    m = __uint_as_float((unsigned)__builtin_amdgcn_readlane((int)am, 63));
    sx = m * (1.0f / 127.0f); const float inv = m > 0.f ? 127.0f / m : 0.f;
    xq.x = qpack4(xf[0], inv, 0); xq.y = qpack4(xf[1], inv, 0); xq.z = qpack4(xf[2], inv, 0); xq.w = qpack4(xf[3], inv, 0);
    int t = __builtin_amdgcn_sdot4((int)xq.x, 0x01010101, 0, false); t = __builtin_amdgcn_sdot4((int)xq.y, 0x01010101, t, false); t = __builtin_amdgcn_sdot4((int)xq.z, 0x01010101, t, false); t = __builtin_amdgcn_sdot4((int)xq.w, 0x01010101, t, false);
    t += shxi<1>(t, lane); t += shxi<2>(t, lane); t += shxi<4>(t, lane); t += shxi<8>(t, lane); t += shxi<16>(t, lane); t += shxi<32>(t, lane); sumx = t;
}
__device__ __forceinline__ void s1_round(unsigned (&kk)[4][8], unsigned (&mine)[4], bool sel) {
    unsigned x[4];
#pragma unroll
    for (int p = 0; p < 4; ++p) x[p] = rowmax16(kk[p][0]);
#pragma unroll
    for (int p = 0; p < 4; ++p) { const bool win = kk[p][0] == x[p];
#pragma unroll
        for (int j = 0; j < 7; ++j) kk[p][j] = win ? kk[p][j + 1] : kk[p][j];
        kk[p][7] = win ? 0u : kk[p][7];
        mine[p] = sel ? x[p] : mine[p]; }
}
__device__ __forceinline__ void s2_setup(const unsigned (&mine)[4], unsigned (&MA)[2], unsigned (&MB)[2], unsigned (&ck)[2][4], unsigned (&top)[2], unsigned ciP, unsigned cjP, int li) {
#pragma unroll
    for (int q = 0; q < 2; ++q) { const auto r = __builtin_amdgcn_permlane32_swap(mine[2 * q], mine[2 * q + 1], false, false);
        MA[q] = (unsigned)r[0]; MB[q] = (unsigned)r[1];
#pragma unroll
        for (int k = 0; k < 4; ++k) { const int la = (int)((ciP >> (8 * k)) & 255u), lb = (int)((cjP >> (8 * k)) & 255u);
            const float av = o2f((unsigned)bpermi((int)MA[q], la)), bv = o2f((unsigned)bpermi((int)MB[q], lb));
            const int c = li + 16 * k;
            ck[q][k] = (c < 50) ? ((f2o(av + bv) & ~63u) | (unsigned)c) : 0u; }
        cex(ck[q][0], ck[q][1]); cex(ck[q][2], ck[q][3]); cex(ck[q][0], ck[q][2]); cex(ck[q][1], ck[q][3]); cex(ck[q][1], ck[q][2]);
        top[q] = 0u; }
}
__device__ __forceinline__ void s2_round(unsigned (&ck)[2][4], unsigned (&top)[2], bool sel) {
    unsigned x[2];
#pragma unroll
    for (int q = 0; q < 2; ++q) x[q] = rowmax16(ck[q][0]);
#pragma unroll
    for (int q = 0; q < 2; ++q) { const bool win = ck[q][0] == x[q];
        ck[q][0] = win ? ck[q][1] : ck[q][0]; ck[q][1] = win ? ck[q][2] : ck[q][1]; ck[q][2] = win ? ck[q][3] : ck[q][2]; ck[q][3] = win ? 0u : ck[q][3];
        top[q] = sel ? x[q] : top[q]; }
}
__device__ __forceinline__ void finalize(const unsigned (&top)[2], const unsigned (&MA)[2], const unsigned (&MB)[2], int cij, float rs1, float sx, const float* SU, const float* SV, int lane, TK& o) {
    const int rb = lane & 48;
    unsigned ex_id[2]; float gate[2], su[2], sv[2];
#pragma unroll
    for (int q = 0; q < 2; ++q) { const int c = (int)(top[q] & 63u); const int t = bpermi(cij, c); const int ci = t & 255, cj = t >> 8;
        const unsigned e1 = (unsigned)bpermi((int)MA[q], rb + ci) & 127u, e2 = (unsigned)bpermi((int)MB[q], rb + cj) & 127u; ex_id[q] = e1 * 128u + e2; }
#pragma unroll
    for (int q = 0; q < 2; ++q) { su[q] = SU[ex_id[q]]; sv[q] = SV[ex_id[q]]; }
#pragma unroll
    for (int q = 0; q < 2; ++q) { const float topf = o2f(top[q]), mx = o2f(rowmax16(top[q]));
        const float ex = __expf(topf - mx); const float sm = rowsum16(ex);
        gate[q] = ex * __builtin_amdgcn_rcpf(fmaxf(sm, 1e-30f)); }
    o.eidP0 = ex_id[0]; o.eidP1 = ex_id[1];
    o.cAP0 = 0.5f * rs1 * sx * su[0]; o.cAP1 = 0.5f * rs1 * sx * su[1];
    o.cBP0 = gate[0] * sv[0]; o.cBP1 = gate[1] * sv[1];
}
#define PEER_ROWUV(id) __builtin_amdgcn_raw_buffer_load_b128(rsUV, lo, (int)((id) * 1024u), 0)
__device__ __forceinline__ void load_t_head(v4u (&tq)[16], unsigned esrc, int l0, __amdgpu_buffer_rsrc_t rsUV, int lo) {
#pragma unroll
    for (int e = 0; e < 16; ++e) { const unsigned id = (unsigned)__builtin_amdgcn_readlane((int)esrc, l0 + e); tq[e] = PEER_ROWUV(id); }
}
struct GH { int p[16]; int cq; float cscale; int accI[16]; int sumcq; };
template <bool NEXTU>
__device__ __forceinline__ void gh_a(GH& g, int h, const TK& t, const v4u xq, v4u (&tq)[16], v2u (&vq)[16], __amdgpu_buffer_rsrc_t rsUV, int lo) {
#pragma unroll
    for (int e = 0; e < 16; ++e) { int d = __builtin_amdgcn_sdot4((int)(tq[e].x & 0x0f0f0f0fu), (int)xq.x, 0, false); d = __builtin_amdgcn_sdot4((int)((tq[e].x >> 4) & 0x0f0f0f0fu), (int)xq.y, d, false);
        d = __builtin_amdgcn_sdot4((int)(tq[e].y & 0x0f0f0f0fu), (int)xq.z, d, false); g.p[e] = __builtin_amdgcn_sdot4((int)((tq[e].y >> 4) & 0x0f0f0f0fu), (int)xq.w, d, false);
        vq[e].x = tq[e].z; vq[e].y = tq[e].w; }
    if (NEXTU) { const unsigned en = (h + 1 < 4) ? t.eidP0 : t.eidP1; load_t_head(tq, en, ((h + 1) & 3) * 16, rsUV, lo); }
}
__device__ __forceinline__ void gh_b(GH& g, int h, const TK& t, int lane, int sumx) {
    const float cAh = (h < 4) ? t.cAP0 : t.cAP1, cBh = (h < 4) ? t.cBP0 : t.cBP1; const int l0 = (h & 3) * 16;
    int q8[8], r4[4], s2[2], s1;
#pragma unroll
    for (int e = 0; e < 8; ++e) { const auto r = __builtin_amdgcn_permlane32_swap(g.p[e], g.p[e + 8], false, false); q8[e] = (int)r[0] + (int)r[1]; }
#pragma unroll
    for (int e = 0; e < 4; ++e) { const auto r = __builtin_amdgcn_permlane16_swap(q8[e], q8[e + 4], false, false); r4[e] = (int)r[0] + (int)r[1]; }
    { const bool up = (lane & 8) != 0;
#pragma unroll
      for (int e = 0; e < 2; ++e) { const int send = up ? r4[e] : r4[e + 2], keep = up ? r4[e + 2] : r4[e]; s2[e] = keep + __builtin_amdgcn_update_dpp(0, send, 0x128, 0xf, 0xf, true); } }
    { const bool up = (lane & 4) != 0; const int send = up ? s2[0] : s2[1], keep = up ? s2[1] : s2[0];
      int recv = __builtin_amdgcn_update_dpp(send, send, 0x104, 0xf, 0x5, false); recv = __builtin_amdgcn_update_dpp(recv, send, 0x114, 0xf, 0xa, false);
      s1 = keep + recv; }
    s1 += __builtin_amdgcn_update_dpp(0, s1, 0x4E, 0xf, 0xf, true); s1 += __builtin_amdgcn_update_dpp(0, s1, 0xB1, 0xf, 0xf, true);
    const int eb = lane >> 2;
    const float cf = bperm(cBh, l0 + eb) * gelu_tanh((float)(2 * s1 - 15 * sumx) * bperm(cAh, l0 + eb));
    unsigned am = rowmax16(__float_as_uint(cf) & 0x7fffffffu); am = dppmax<0x142>(am); am = dppmax<0x143>(am);
    const float amax = __uint_as_float((unsigned)__builtin_amdgcn_readlane((int)am, 63));
    const float cinv = amax > 0.f ? 127.0f / amax : 0.f; g.cscale = amax * (1.0f / 127.0f);
    g.cq = (int)rintf(cf * cinv);
#pragma unroll
    for (int i = 0; i < 16; ++i) g.accI[i] = 0;
    g.sumcq = 0;
}
template <int GQ0>
__device__ __forceinline__ void gh_c(GH& g, const v2u (&vq)[16]) {
#pragma unroll
    for (int gq = GQ0; gq < GQ0 + 2; ++gq) {
        const int q0 = __builtin_amdgcn_readlane(g.cq, 16 * gq), q1 = __builtin_amdgcn_readlane(g.cq, 16 * gq + 4), q2 = __builtin_amdgcn_readlane(g.cq, 16 * gq + 8), q3 = __builtin_amdgcn_readlane(g.cq, 16 * gq + 12);
        g.sumcq += (q0 + q1) + (q2 + q3);
        const int cw = (int)(((unsigned)q0 & 0xffu) | (((unsigned)q1 & 0xffu) << 8) | (((unsigned)q2 & 0xffu) << 16) | (((unsigned)q3 & 0xffu) << 24));
#pragma unroll
        for (int wg = 0; wg < 2; ++wg) {
            const unsigned r0 = wg ? vq[4 * gq].y : vq[4 * gq].x, r1 = wg ? vq[4 * gq + 1].y : vq[4 * gq + 1].x, r2 = wg ? vq[4 * gq + 2].y : vq[4 * gq + 2].x, r3 = wg ? vq[4 * gq + 3].y : vq[4 * gq + 3].x;
            const unsigned t0 = __builtin_amdgcn_perm(r1, r0, 0x05010400u), t1 = __builtin_amdgcn_perm(r1, r0, 0x07030602u);
            const unsigned t2 = __builtin_amdgcn_perm(r3, r2, 0x05010400u), t3 = __builtin_amdgcn_perm(r3, r2, 0x07030602u);
            unsigned o[4]; o[0] = __builtin_amdgcn_perm(t2, t0, 0x05040100u); o[1] = __builtin_amdgcn_perm(t2, t0, 0x07060302u);
            o[2] = __builtin_amdgcn_perm(t3, t1, 0x05040100u); o[3] = __builtin_amdgcn_perm(t3, t1, 0x07060302u);
#pragma unroll
            for (int j = 0; j < 4; ++j) {
                g.accI[8 * wg + j] = __builtin_amdgcn_sdot4((int)(o[j] & 0x0f0f0f0fu), cw, g.accI[8 * wg + j], false);
                g.accI[8 * wg + 4 + j] = __builtin_amdgcn_sdot4((int)o[j], cw, g.accI[8 * wg + 4 + j], false);
            }
        }
    }
}
__device__ __forceinline__ void gh_d(const GH& g, float (&acc)[16]) {
    const int offI = 15 * g.sumcq, offH = 8 * g.sumcq;
#pragma unroll
    for (int wg = 0; wg < 2; ++wg)
#pragma unroll
        for (int j = 0; j < 4; ++j) { const int Ls = g.accI[8 * wg + j], Fs = g.accI[8 * wg + 4 + j];
            acc[8 * wg + j] = fmaf((float)(2 * Ls - offI), 0.5f * g.cscale, acc[8 * wg + j]);
            acc[8 * wg + 4 + j] = fmaf((float)(Fs - Ls + offH), 0.0625f * g.cscale, acc[8 * wg + 4 + j]); }
}

template <long X8D>
__device__ __forceinline__ void run_wave(const float* S, bf16* XB, const unsigned char* UQ, const unsigned char* VQ, const float* SU, const float* SV, const float* ss1, float* rs2, int gw, int ngw, int ntok, int lane_in) {
    int lane = lane_in; asm volatile("" : "+v"(lane));
    const int hl = lane & 31, li = lane & 15;
    auto slot_ij = [](int l, int& ci, int& cj) { if (l < 16) { ci = 0; cj = l; } else if (l < 24) { ci = 1; cj = l - 16; } else if (l < 29) { ci = 2; cj = l - 24; } else if (l < 33) { ci = 3; cj = l - 29; }
      else if (l < 36) { ci = 4; cj = l - 33; } else if (l < 42) { ci = 5 + ((l - 36) >> 1); cj = (l - 36) & 1; } else if (l < 50) { ci = 8 + (l - 42); cj = 0; } else { ci = 0; cj = 0; } };
    int cij; unsigned ciP = 0u, cjP = 0u;
    { int ci, cj; slot_ij(lane, ci, cj); cij = ci | (cj << 8);
#pragma unroll
      for (int k = 0; k < 4; ++k) { slot_ij(li + 16 * k, ci, cj); ciP |= (unsigned)((lane & 48) + ci) << (8 * k); cjP |= (unsigned)((lane & 48) + cj) << (8 * k); } }
    const __amdgpu_buffer_rsrc_t rsUV = __builtin_amdgcn_make_buffer_rsrc((void*)UQ, 0, NEXP * 1024, 0x00020000); (void)VQ;
    const int lo = lane * 16;
    if (gw >= ntok) return;
    Pre pre; unsigned kk[4][8], mine[4], MA[2], MB[2], ck[2][4], top[2];
    int sumx_cur = 0, sumx_nxt = 0;
    TK cur, nxt; v4u xq_cur, xq_nxt; float sx;
    load_pre(pre, S, XB, gw, lane);
    prep_keys(pre, kk, hl); quant_x(pre, xq_cur, sx, sumx_cur, lane);
#pragma unroll
    for (int p = 0; p < 4; ++p) mine[p] = 0u;
#pragma unroll 1
    for (int it = 0; it < 16; ++it) s1_round(kk, mine, li == it);
    s2_setup(mine, MA, MB, ck, top, ciP, cjP, li);
#pragma unroll 1
    for (int it = 0; it < 16; ++it) s2_round(ck, top, li == it);
    finalize(top, MA, MB, cij, 1.0f / sqrtf(ss1[gw] * (1.0f / 1024.0f) + EPS), sx, SU, SV, lane, cur);
    { const int t1 = (gw + ngw < ntok) ? gw + ngw : gw; load_pre(pre, S, XB, t1, lane); }
    v4u tq[16]; v2u vq[16];
    load_t_head(tq, cur.eidP0, 0, rsUV, lo);
#define PEER_HEAD(H, VCUR, VNEXT, NEXTU, R0, R1, R2, R3) { GH g; \
        gh_a<NEXTU>(g, H, cur, xq_cur, tq, vq, rsUV, lo); R0; \
        gh_b(g, H, cur, lane, sumx_cur);                          R1; \
        gh_c<0>(g, vq);                                           R2; \
        gh_c<2>(g, vq); gh_d(g, acc);                             R3; }
#pragma unroll 1
    for (int tkn = gw; tkn < ntok; tkn += ngw) {
        asm volatile("" : "+v"(lane)); const int hl = lane & 31, li = lane & 15, lo = lane * 16; (void)hl; (void)li; (void)lo;
        const int tn1 = (tkn + ngw < ntok) ? tkn + ngw : tkn, tn2 = (tn1 + ngw < ntok) ? tn1 + ngw : tn1;
        prep_keys(pre, kk, hl); quant_x(pre, xq_nxt, sx, sumx_nxt, lane);
        const float rs1n = 1.0f / sqrtf(ss1[tn1] * (1.0f / 1024.0f) + EPS);
#pragma unroll
        for (int p = 0; p < 4; ++p) mine[p] = 0u;
        float acc[16];
#pragma unroll
        for (int i = 0; i < 16; ++i) acc[i] = 0.f;
#pragma unroll 1
        for (int hh = 0; hh < 2; ++hh) {
            PEER_HEAD(2 * hh, va, vb, true, s1_round(kk, mine, li == 8 * hh + 0), s1_round(kk, mine, li == 8 * hh + 1), s1_round(kk, mine, li == 8 * hh + 2), s1_round(kk, mine, li == 8 * hh + 3))
            PEER_HEAD(2 * hh + 1, vb, va, true, s1_round(kk, mine, li == 8 * hh + 4), s1_round(kk, mine, li == 8 * hh + 5), s1_round(kk, mine, li == 8 * hh + 6), s1_round(kk, mine, li == 8 * hh + 7))
        }
        s2_setup(mine, MA, MB, ck, top, ciP, cjP, li);
        PEER_HEAD(4, va, vb, true, s2_round(ck, top, li == 0), s2_round(ck, top, li == 1), s2_round(ck, top, li == 2), s2_round(ck, top, li == 3))
        PEER_HEAD(5, vb, va, true, s2_round(ck, top, li == 4), s2_round(ck, top, li == 5), s2_round(ck, top, li == 6), s2_round(ck, top, li == 7))
        PEER_HEAD(6, va, vb, true, s2_round(ck, top, li == 8), s2_round(ck, top, li == 9), s2_round(ck, top, li == 10), s2_round(ck, top, li == 11))
        v4u xr_cur0, xr_cur1; { int lo_ = lane; asm volatile("" : "+v"(lo_)); const v4u* xp_ = (const v4u*)(XB + (size_t)tkn * 1024 + lo_ * 16); xr_cur0 = xp_[0]; xr_cur1 = xp_[1]; }
        { int lp_ = lane; asm volatile("" : "+v"(lp_)); load_pre(pre, S, XB, tn2, lp_); }
        PEER_HEAD(7, vb, va, false, s2_round(ck, top, li == 12), s2_round(ck, top, li == 13), s2_round(ck, top, li == 14), s2_round(ck, top, li == 15))
        finalize(top, MA, MB, cij, rs1n, sx, SU, SV, lane, nxt);
        load_t_head(tq, nxt.eidP0, 0, rsUV, lo);
        { f32x4 xf[4]; pg8::unpack8(xr_cur0, xf[0], xf[1]); pg8::unpack8(xr_cur1, xf[2], xf[3]);
          f32x4 y[4]; float ss = 0.f;
#pragma unroll
          for (int w = 0; w < 4; ++w)
#pragma unroll
              for (int e = 0; e < 4; ++e) { y[w][e] = xf[w][e] + acc[4 * w + e]; ss += y[w][e] * y[w][e]; }
          int lo_ = lane; asm volatile("" : "+v"(lo_));
          bf16* xb = XB + (size_t)tkn * 1024 + lo_ * 16;
          *(v4u*)xb = pg8::pack8(y[0], y[1]); *(v4u*)(xb + 8) = pg8::pack8(y[2], y[3]);
          { v4u o8; o8.x = pg8::pkf8(y[0][0], y[0][1], y[0][2], y[0][3]); o8.y = pg8::pkf8(y[1][0], y[1][1], y[1][2], y[1][3]); o8.z = pg8::pkf8(y[2][0], y[2][1], y[2][2], y[2][3]); o8.w = pg8::pkf8(y[3][0], y[3][1], y[3][2], y[3][3]);
            *(v4u*)((unsigned char*)XB + X8D + (size_t)tkn * 1024 + lo_ * 16) = o8; }
          ss = wave_sum(ss, lane);
          if (lane == 0) rs2[tkn] = 1.0f / sqrtf(ss * (1.0f / 1024.0f) + EPS); }
        cur = nxt; xq_cur = xq_nxt; sumx_cur = sumx_nxt;
    }
}
#undef PEER_HEAD
#undef PEER_ROW
#undef PEER_ROWV
}

__global__ void __launch_bounds__(NWAVES * 64, 2) mk_fwd(Args args) {
    extern __shared__ __attribute__((aligned(16))) unsigned char lds[];
    LAS unsigned char* L = (LAS unsigned char*)lds;
    volatile LAS unsigned* MISC = (volatile LAS unsigned*)(L + MISC_OFF);
    const int G = gridDim.x, bx = blockIdx.x;
    const int wave_s = __builtin_amdgcn_readfirstlane((int)threadIdx.x >> 6);
    const int NGW = G * NWAVES, NGT = G * NWAVES * 64;
#define FRESH_IDS() int tid = wave_s * 64 + lane_id_opaque(); asm volatile("" : "+v"(tid)); const int lane = tid & 63, wave = __builtin_amdgcn_readfirstlane(tid >> 6); \
    const int gw = bx * NWAVES + wave, gtid = bx * (NWAVES * 64) + tid; (void)lane; (void)gw; (void)gtid
    typedef const unsigned char __attribute__((address_space(4))) karg_t;
#define FRESH_ARGS() karg_t* kp_ = (karg_t*)__builtin_amdgcn_kernarg_segment_ptr(); asm volatile("" : "+s"(kp_)); \
    unsigned char* ws = *(unsigned char* const __attribute__((address_space(4)))*)(kp_ + 224); float* out = *(float* const __attribute__((address_space(4)))*)(kp_ + 216); (void)out; (void)ws
#define IN(k) (*(const float* const __attribute__((address_space(4)))*)(kp_ + 8 * (k)))
#define WSP(T_, off) ((T_*)(ws + (off)))
    { FRESH_IDS(); for (int u = tid; u < (LDS_BYTES - LDSCTL_OFF) / 4; u += NWAVES * 64) ((LAS unsigned*)(L + LDSCTL_OFF))[u] = 0u; }
    __syncthreads();
    XcdBarrier bar;
    { FRESH_ARGS(); bar = xcd_barrier_post((unsigned*)(ws + WS_CTL) + CW_BAR, MISC + 8, wave_s); }
#define GRID_BAR() xcd_barrier(bar, wave_s)

    {
        FRESH_IDS(); FRESH_ARGS();
        bf16* WinT = WSP(bf16, WS_WIN); bf16* WgluT = WSP(bf16, WS_WGLU); bf16* WpsT = WSP(bf16, WS_WPS); bf16* WpaT = WSP(bf16, WS_WPA);
        bf16* WoutT = WSP(bf16, WS_WOUT); bf16* WsT = WSP(bf16, WS_WS); bf16* WgateT = WSP(bf16, WS_WGATE); bf16* WppT = WSP(bf16, WS_WPP);
        float* rope = WSP(float, WS_ROPE); unsigned char* s5p = ws + WS_S5P; bf16* XN = WSP(bf16, WS_XN); bf16* PB = WSP(bf16, WS_PB);
        const float* x = IN(I_X);
        for (int it = bx; it < 256; it += G) p0_ws_item(IN(I_WQ), IN(I_GFFN), IN(I_KEY1), IN(I_KEY2), WsT, L + RING_OFF, it, tid);
        {
            LAS float* scr = (LAS float*)(L + RING_OFF + wave * 16384);
            constexpr int I_1 = (1024 / 64) * (4096 / 32), I_2 = (512 / 64) * (512 / 32), I_3 = (512 / 64) * (1024 / 32), I_4 = I_3, I_5 = (1024 / 64) * (1024 / 32), I_6 = I_5, I_7 = (256 / 64) * (1024 / 32);
            constexpr int NIT = I_1 + I_2 + I_3 + I_4 + I_5 + I_6 + I_7;
            for (int it = gw; it < NIT; it += NGW) {
                int r = it;
                if (r < I_1) { p0_transpose_item<true>(IN(I_WIN), IN(I_GMIX), 1024, 4096, WinT, scr, r, lane); continue; } r -= I_1;
                if (r < I_2) { p0_transpose_item<true>(IN(I_WGLU), nullptr, 512, 512, WgluT, scr, r, lane); continue; } r -= I_2;
                if (r < I_3) { p0_transpose_item<true>(IN(I_WPS), nullptr, 512, 1024, WpsT, scr, r, lane); continue; } r -= I_3;
                if (r < I_4) { p0_transpose_item<true>(IN(I_WPA), nullptr, 512, 1024, WpaT, scr, r, lane); continue; } r -= I_4;
                if (r < I_5) { p0_transpose_item<true>(IN(I_WOUT), nullptr, 1024, 1024, WoutT, scr, r, lane); continue; } r -= I_5;
                if (r < I_6) { p0_transpose_item<true>(IN(I_WGATE), IN(I_GPLE), 1024, 1024, WgateT, scr, r, lane); continue; } r -= I_6;
                p0_transpose_item(IN(I_WPP), nullptr, 256, 1024, WppT, scr, r, lane);
            }
        }
        {
            const float* pu = IN(I_PU); const float* pv = IN(I_PV); const float* gf = IN(I_GFFN);
            unsigned char* UQ = WSP(unsigned char, WS_UT); unsigned char* VQ = WSP(unsigned char, WS_VT); float* SU = WSP(float, WS_SU); float* SV = WSP(float, WS_SV);
            f32x4 gf4[4];
#pragma unroll
            for (int j = 0; j < 4; ++j) gf4[j] = *(const f32x4*)(gf + 16 * lane + 4 * j);
            for (int r0 = gw * 4; r0 < NEXP; r0 += NGW * 4) { peer::Row4 rw[4];
#pragma unroll
                for (int i = 0; i < 4; ++i) peer::load_row16(rw[i], pu + (size_t)(r0 + i) * 1024, lane);
#pragma unroll
                for (int i = 0; i < 4; ++i) peer::quant_row4(rw[i], gf4, true, UQ + (size_t)(r0 + i) * 1024, SU + r0 + i, lane); }
            for (int r0 = gw * 4; r0 < NEXP; r0 += NGW * 4) { peer::Row4 rw[4];
#pragma unroll
                for (int i = 0; i < 4; ++i) peer::load_row16(rw[i], pv + (size_t)(r0 + i) * 1024, lane);
#pragma unroll
                for (int i = 0; i < 4; ++i) peer::quant_row4(rw[i], gf4, false, UQ + (size_t)(r0 + i) * 1024 + 8, SV + r0 + i, lane, true); }
        }
        for (int m0 = gw * 4; m0 < T; m0 += NGW * 4) {
            f32x4 v[4][4];
#pragma unroll
            for (int i = 0; i < 4; ++i) { const f32x4* xr = (const f32x4*)(x + (size_t)(m0 + i) * D) + lane;
#pragma unroll
                for (int j = 0; j < 4; ++j) v[i][j] = xr[64 * j]; }
#pragma unroll
            for (int i = 0; i < 4; ++i) { float s = 0.f;
#pragma unroll
                for (int j = 0; j < 4; ++j) s += (v[i][j].x * v[i][j].x + v[i][j].y * v[i][j].y) + (v[i][j].z * v[i][j].z + v[i][j].w * v[i][j].w);
                const float rs = 1.0f / sqrtf(wave_sum(s, lane) * (1.f / D) + EPS);
                unsigned* o8 = (unsigned*)((unsigned char*)XN + (size_t)(m0 + i) * D) + lane;
#pragma unroll
                for (int j = 0; j < 4; ++j) o8[64 * j] = pg8::pkf8(v[i][j].x * rs, v[i][j].y * rs, v[i][j].z * rs, v[i][j].w * rs); }
        }
        {
            const float* pp = IN(I_P);
            constexpr int NI = T * D_PLE / 8;
            for (int i8 = gtid; i8 < NI; i8 += 4 * NGT) { f32x4 a[4], b[4];
#pragma unroll
                for (int j = 0; j < 4; ++j) { const int ij = i8 + j * NGT; const size_t o = (size_t)(ij < NI ? ij : NI - 1) * 8; a[j] = *(const f32x4*)(pp + o); b[j] = *(const f32x4*)(pp + o + 4); }
#pragma unroll
                for (int j = 0; j < 4; ++j) { const int ij = i8 + j * NGT; if (ij >= NI) break; const size_t o = (size_t)ij * 8; *(v4u*)(PB + o) = pg8::pack8(a[j], b[j]); } }
        }
        {
            const int* pos = (const int*)IN(I_POS);
            for (int i = gtid; i < T * 8; i += NGT) { const int t = i >> 3, k = i & 7;
                const double invf = k == 0 ? 1.0 : k == 1 ? 0.19392274474868576 : k == 2 ? 0.03760603093086393 : k == 3 ? 0.007292664737217109 : k == 4 ? 0.001414213562373095
                                  : k == 5 ? 0.0002742481756762073 : k == 6 ? 5.318295896944988e-05 : 1.031338537721246e-05;
                float c, s; cs_reduced((double)pos[t] * invf, c, s);
                rope[(size_t)t * 16 + 2 * k] = c; rope[(size_t)t * 16 + 2 * k + 1] = s; }
        }
        if (gtid < NG * NS) {
            const int g = gtid >> 6;
            const float dt = expf(IN(I_LOGDT)[g]); const float are = IN(I_ARE)[gtid], aim = IN(I_AIM)[gtid];
            const double zr = (double)dt * (double)are, th = (double)dt * (double)aim;
            float c, s; cs_reduced(th, c, s); const float mag = expf((float)zr);
            const float abr = mag * c, abi = mag * s;
            float cL, sL; cs_reduced(64.0 * th, cL, sL); const float magL = expf((float)(64.0 * zr));
            ((float*)(s5p + S5_ABR))[gtid] = abr; ((float*)(s5p + S5_ABI))[gtid] = abi;
            ((float*)(s5p + S5_ALR))[gtid] = magL * cL; ((float*)(s5p + S5_ALI))[gtid] = magL * sL;
            const float den = are * are + aim * aim, nr = abr - 1.0f, ni = abi;
            const float fre = (nr * are + ni * aim) / den, fim = (ni * are - nr * aim) / den;
            const float* br = IN(I_BRE) + (size_t)gtid * 16; const float* bi = IN(I_BIM) + (size_t)gtid * 16;
            float* obr = (float*)(s5p + S5_BRE) + (size_t)gtid * 16; float* obi = (float*)(s5p + S5_BIM) + (size_t)gtid * 16;
#pragma unroll
            for (int cc = 0; cc < 16; ++cc) { obr[cc] = fre * br[cc] - fim * bi[cc]; obi[cc] = fre * bi[cc] + fim * br[cc]; }
        }
        for (int i = gtid; i < NG * NS * 64; i += NGT) { const int t = i & 63, gn = i >> 6, g = gn >> 6;
            const float dt = expf(IN(I_LOGDT)[g]); const float are = IN(I_ARE)[gn], aim = IN(I_AIM)[gn];
            const double zr = (double)dt * (double)are, th = (double)dt * (double)aim;
            float c1, s1; cs_reduced(th, c1, s1); const float mag1 = expf((float)zr); const float abr = mag1 * c1, abi = mag1 * s1;
            const float den = are * are + aim * aim, nr = abr - 1.0f, ni = abi;
            const float fre = (nr * are + ni * aim) / den, fim = (ni * are - nr * aim) / den;
            float cp, sp; cs_reduced((double)(63 - t) * th, cp, sp); const float magp = expf((float)((double)(63 - t) * zr)); const float pr = magp * cp, pi = magp * sp;
            const float qr = pr * fre - pi * fim, qi = pr * fim + pi * fre;
            const f32x4* br = (const f32x4*)(IN(I_BRE) + (size_t)gn * 16); const f32x4* bi = (const f32x4*)(IN(I_BIM) + (size_t)gn * 16);
            bf16* wre = WSP(bf16, WS_S5W) + ((size_t)g * 128 + (gn & 63)) * 1024 + 16 * t; bf16* wim = wre + (size_t)64 * 1024;
#pragma unroll
            for (int h8 = 0; h8 < 2; ++h8) { const f32x4 r0 = br[2 * h8], r1 = br[2 * h8 + 1], i0 = bi[2 * h8], i1 = bi[2 * h8 + 1];
                *(v4u*)(wre + 8 * h8) = pg8::pack8(qr * r0 - qi * i0, qr * r1 - qi * i1); *(v4u*)(wim + 8 * h8) = pg8::pack8(qr * i0 + qi * r0, qr * i1 + qi * r1); } }
        for (int i = gtid; i < NG * 16 * 128; i += NGT) { const int gc = i >> 7, n = i & 127;
            const float v = n < 64 ? IN(I_CRE)[(size_t)gc * 64 + n] : -IN(I_CIM)[(size_t)gc * 64 + n - 64];
            ((bf16*)(s5p + S5_CM))[i] = (bf16)(pkbf(v, 0.f) & 0xffffu); }
    }
    GRID_BAR();

    {
        FRESH_ARGS();
        bf16* XN = WSP(bf16, WS_XN); bf16* WinT = WSP(bf16, WS_WIN); bf16* PB = WSP(bf16, WS_PB); bf16* WppT = WSP(bf16, WS_WPP); bf16* EB = WSP(bf16, WS_E);
        bf16* Ub = WSP(bf16, WS_U); bf16* Qb = WSP(bf16, WS_Q); bf16* Kb = WSP(bf16, WS_K); bf16* Vb = WSP(bf16, WS_V); unsigned char* SGA = WSP(unsigned char, WS_SGA); unsigned char* SGB = WSP(unsigned char, WS_SGB);
        float* kmean = WSP(float, CTL_KMEAN); float* rope = WSP(float, WS_ROPE);
        { pg8::Gemm g{XN, WinT, T, D_IN, D}; pg8::StaticOrder S; S.init(T, D_IN, G, bx);
          pg8::EpiWin E{Ub, Qb, Kb, Vb, SGA, SGB, kmean, rope, 0.18033688011112042f};
          pg8::gemm_phase<pg8::EpiWin, pg8::StaticOrder, true, true, true, D>(L + RING_OFF, g, S, E, wave_s); }
        { pg8::Gemm g{PB, WppT, T, D, D_PLE}; pg8::StaticOrder S; S.init(T, D, G, bx);
          pg8::EpiPlain E{EB, D};
          pg8::gemm_phase<pg8::EpiPlain, pg8::StaticOrder, true, true, false, D_PLE>(L + RING_OFF, g, S, E, wave_s); }
    }
    GRID_BAR();

    {
        { FRESH_IDS(); FRESH_ARGS();
          const bf16* Qb = WSP(bf16, WS_Q); const float* kmean = WSP(float, CTL_KMEAN);
          unsigned short* SUB = WSP(unsigned short, WS_MSUB); unsigned* CNT = WSP(unsigned, WS_MCNT); float* LSE = WSP(float, WS_MLSE);
          for (int u = bx; u < 512; u += G) moba::select_pair(u, 1023 - u, (const moba::bf16*)Qb, kmean, SUB, CNT, LSE, (char*)lds + RING_OFF, tid); }
        FRESH_IDS(); FRESH_ARGS();
        __syncthreads();
        s5::pass1_gemm(L + RING_OFF, WSP(bf16, WS_S5W), WSP(bf16, WS_U), WSP(float, WS_HLOC), G, bx, tid, wave);
    }
    GRID_BAR();

    {
        FRESH_IDS(); FRESH_ARGS();
        moba::sparse_phase((const moba::bf16*)WSP(bf16, WS_Q), (const moba::bf16*)WSP(bf16, WS_K), (const moba::bf16*)WSP(bf16, WS_V), WSP(unsigned short, WS_MSUB), WSP(unsigned, WS_MCNT),
                           (moba::bf16*)out, WSP(float, WS_MLSE), (char*)lds + RING_OFF, G, bx, tid, wave_s);
    }
    GRID_BAR();

    {
        { FRESH_ARGS();
          moba::own_phase((const moba::bf16*)WSP(bf16, WS_Q), (const moba::bf16*)WSP(bf16, WS_K), (const moba::bf16*)WSP(bf16, WS_V), (const moba::bf16*)out, WSP(float, WS_MLSE), (moba::bf16*)WSP(bf16, WS_PB),
                          (char*)lds + RING_OFF, G, bx, wave_s); }
        FRESH_IDS(); FRESH_ARGS();
        s5::run<2>(L + RING_OFF + wave * 16384, ws + WS_S5P, WSP(bf16, WS_U), WSP(float, WS_HLOC), IN(I_DSK), WSP(bf16, WS_YP), gw, NGW, lane); }
    GRID_BAR();

    {
        FRESH_ARGS(); bf16* YP = WSP(bf16, WS_YP); bf16* YS = WSP(bf16, WS_V); bf16* WgluT = WSP(bf16, WS_WGLU);
        pg8::Gemm g{WSP(bf16, WS_MSUB), WgluT, T, D_SSM, D_SSM}; pg8::StaticOrder S; S.init(T, D_SSM, G, bx);
        pg8::EpiGlu E{YP, YS};
        pg8::gemm_phase<pg8::EpiGlu, pg8::StaticOrder, true, true, true, D_SSM>(L + RING_OFF, g, S, E, wave_s);
    }
    GRID_BAR();

    {
        FRESH_ARGS(); bf16* YS = WSP(bf16, WS_V); bf16* Qb = WSP(bf16, WS_PB); unsigned char* M8 = WSP(unsigned char, WS_U); bf16* WpsT = WSP(bf16, WS_WPS); bf16* WpaT = WSP(bf16, WS_WPA); const unsigned char* SGA = WSP(unsigned char, WS_SGA); const unsigned char* SGB = WSP(unsigned char, WS_SGB); bf16* T1 = WSP(bf16, WS_Q);
        { pg8::Gemm g{YS, WpsT, T, D, D_SSM}; pg8::StaticOrder S; S.init(T, D, G, bx);
          pg8::EpiMerge<0> E{SGA, T1, nullptr};
          pg8::gemm_phase<pg8::EpiMerge<0>, pg8::StaticOrder, true, true, true, D_SSM>(L + RING_OFF, g, S, E, wave_s); }
        { pg8::Gemm g{Qb, WpaT, T, D, D_ATT}; pg8::StaticOrder S; S.init(T, D, G, bx);
          pg8::EpiMerge<1> E{SGB, T1, M8};
          pg8::gemm_phase<pg8::EpiMerge<1>, pg8::StaticOrder, true, true, true, D_ATT>(L + RING_OFF, g, S, E, wave_s); }
    }
    GRID_BAR();

    {
        FRESH_ARGS(); bf16* SGA = WSP(bf16, WS_U); bf16* WoutT = WSP(bf16, WS_WOUT); bf16* XN = WSP(bf16, WS_XN); float* ss1 = WSP(float, CTL_SS1); const float* x = IN(I_X);
        pg8::Gemm g{SGA, WoutT, T, D, D}; pg8::StaticOrder S; S.init(T, D, G, bx);
        pg8::EpiResid E{x, XN, ss1};
        pg8::gemm_phase<pg8::EpiResid, pg8::StaticOrder, true, true, true, D>(L + RING_OFF, g, S, E, wave_s);
    }
    GRID_BAR();

    {
        FRESH_ARGS(); bf16* XN = WSP(bf16, WS_XN); bf16* WsT = WSP(bf16, WS_WS); float* SC = WSP(float, WS_SC); float* ss1 = WSP(float, CTL_SS1);
        pg8::Gemm g{XN, WsT, T, PH * PQD, D}; pg8::StaticOrder S; S.init(T, PH * PQD, G, bx);
        pg8::EpiScores E{(pg8::bf16_t*)SC, ss1};
        pg8::gemm_phase<pg8::EpiScores, pg8::StaticOrder, true, true, false, D>(L + RING_OFF, g, S, E, wave_s);
    }
    GRID_BAR();

    {
        FRESH_IDS(); FRESH_ARGS();
        float* SC = WSP(float, WS_SC); bf16* XN = WSP(bf16, WS_XN); float* ss1 = WSP(float, CTL_SS1); float* rs2 = WSP(float, WS_RS2);
        const unsigned char* UQ = WSP(unsigned char, WS_UT); const unsigned char* VQ = WSP(unsigned char, WS_VT); const float* SU = WSP(float, WS_SU); const float* SV = WSP(float, WS_SV);
        peer::run_wave<(long)WS_X8 - (long)WS_XN>(SC, XN, UQ, VQ, SU, SV, ss1, rs2, gw, NGW, T, lane);
    }
    GRID_BAR();

    {
        FRESH_ARGS(); bf16* XN = WSP(bf16, WS_XN); bf16* WgateT = WSP(bf16, WS_WGATE); bf16* EB = WSP(bf16, WS_E); float* rs2 = WSP(float, WS_RS2); float* ss3 = WSP(float, CTL_SS3);
        pg8::Gemm g{WSP(bf16, WS_X8), WgateT, T, D, D}; pg8::StaticOrder S; S.init(T, D, G, bx);
        pg8::EpiPle E{XN, EB, rs2, ss3};
        pg8::gemm_phase<pg8::EpiPle, pg8::StaticOrder, true, true, true, D>(L + RING_OFF, g, S, E, wave_s);
    }
    GRID_BAR();

    {
        FRESH_IDS(); FRESH_ARGS();
        const bool bad = xb_ld(&bar.bar[XB_TMO]) != 0u;
        const float* gfin = IN(I_GFIN); float* ss3 = WSP(float, CTL_SS3);
        const f32x4* gp = (const f32x4*)gfin + lane;
        f32x4 g4[4];
#pragma unroll
        for (int j = 0; j < 4; ++j) g4[j] = gp[64 * j];
        const bf16* X3B = WSP(bf16, WS_E);
        for (int m0 = gw * 4; m0 < T; m0 += NGW * 4) {
            v2u v[4][4]; float rs[4];
#pragma unroll
            for (int i = 0; i < 4; ++i) { const v2u* xr = (const v2u*)(X3B + (size_t)(m0 + i) * D) + lane; rs[i] = ss3[m0 + i];
#pragma unroll
                for (int j = 0; j < 4; ++j) v[i][j] = xr[64 * j]; }
#pragma unroll
            for (int i = 0; i < 4; ++i) { const float r_ = 1.0f / sqrtf(rs[i] * (1.f / D) + EPS); f32x4* xo = (f32x4*)(out + (size_t)(m0 + i) * D) + lane;
#pragma unroll
                for (int j = 0; j < 4; ++j) { f32x4 r = (f32x4){bflo(v[i][j].x), bfhi(v[i][j].x), bflo(v[i][j].y), bfhi(v[i][j].y)} * r_ * g4[j]; if (bad) r = (f32x4){__builtin_nanf(""), 0.f, 0.f, 0.f}; xo[64 * j] = r; } }
        }
    }
}

extern "C" void kernel_launch(void* const* d_in, const int* in_sizes, int n_in, void* d_out, int out_size, void* d_ws, size_t ws_size, hipStream_t stream) {
    static int grid = 0;
    if (grid == 0) {
        if (n_in != 27 || in_sizes[0] != T * D || out_size != T * D || ws_size < WS_END) {
            fprintf(stderr, "kernel_launch: built for 27 inputs, x/out of %d floats, >= %zu bytes of workspace; got n_in %d in0 %d out %d ws %zu\n", T * D, (size_t)WS_END, n_in, n_in > 0 ? in_sizes[0] : -1, out_size, ws_size);
            grid = -1; return; }
        int dev = 0, cus = 0, per_cu = 0;
        if (hipGetDevice(&dev) != hipSuccess || hipDeviceGetAttribute(&cus, hipDeviceAttributeMultiprocessorCount, dev) != hipSuccess) { grid = -1; return; }
        if (hipFuncSetAttribute((const void*)mk_fwd, hipFuncAttributeMaxDynamicSharedMemorySize, LDS_BYTES) != hipSuccess) { fprintf(stderr, "kernel_launch: hipFuncSetAttribute failed\n"); grid = -1; return; }
        if (hipOccupancyMaxActiveBlocksPerMultiprocessor(&per_cu, (const void*)mk_fwd, NWAVES * 64, LDS_BYTES) != hipSuccess || per_cu < 1) { fprintf(stderr, "kernel_launch: occupancy query says %d\n", per_cu); per_cu = 1; }
        (void)hipGetLastError();
        grid = cus;
        if (grid % 32 != 0 || grid > 256) grid = (grid / 32) * 32 > 256 ? 256 : (grid / 32) * 32;
        fprintf(stderr, "kernel_launch: cus %d per_cu %d grid %d ws %zu\n", cus, per_cu, grid, ws_size);
    }
    if (grid <= 0) return;
    if (hipMemsetAsync((char*)d_ws + WS_CTL, 0, CTL_ZERO_BYTES, stream) != hipSuccess) { fprintf(stderr, "kernel_launch: memset failed\n"); return; }
    Args a{};
    for (int i = 0; i < 27; ++i) a.in[i] = (const float*)d_in[i];
    a.out = (float*)d_out; a.ws = (unsigned char*)d_ws;
    void* kargs[] = {&a};
    const hipError_t e = hipLaunchCooperativeKernel((const void*)mk_fwd, dim3(grid), dim3(NWAVES * 64), kargs, LDS_BYTES, stream);
    if (e != hipSuccess) fprintf(stderr, "kernel_launch: cooperative launch failed: %s (grid %d)\n", hipGetErrorString(e), grid);
}
```

```cpp
#include <hip/hip_runtime.h>
#include <hip/hip_bf16.h>
#include <cstdio>
#include <cstdint>
#include <cmath>
namespace pg8 {
#define PG8_LAS __attribute__((address_space(3)))
typedef unsigned short bf16_t;
typedef short bf16x8 __attribute__((ext_vector_type(8)));
typedef float f32x4 __attribute__((ext_vector_type(4)));
typedef unsigned u32x4 __attribute__((ext_vector_type(4)));
constexpr int BM = 256, BK = 64, HALF = 128, HTB = HALF * BK * 2  , STAGE_BYTES = 8 * HTB, NXCD = 8, WGM = 8;

__host__ __device__ __forceinline__ int lds_byte(int r, int c) { const int st = (r >> 4) * 2 + (c >> 5), rr = r & 15, cc = c & 31, ob = rr * 64 + cc * 2; return st * 1024 + (ob ^ (((ob >> 9) & 1) << 5)); }
__host__ __device__ __forceinline__ void stage_rc(int b, int& R, int& C) { const int st = b / 1024, sb = b % 1024, swz = sb ^ (((sb >> 9) & 1) << 5); R = (st >> 1) * 16 + swz / 64; C = (st & 1) * 32 + (swz % 64) / 2; }
__host__ __device__ __forceinline__ int perm32(int rho) { const int n = rho >> 4, i = rho & 15; return 8 * (i >> 2) + 4 * n + (i & 3); }

struct Unit { int pm, pn; };
struct Gemm { const bf16_t* A; const bf16_t* Bt; int M, N, K; };

struct StaticOrder {
    int nM, nN, nwg, G, c;
    __host__ __device__ void init(int M, int N, int G_, int c_) { nM = M / BM; nN = N / BM; nwg = nM * nN; G = G_; c = c_; }
    __host__ __device__ bool next(int i, Unit& u) const {
        const long L = (long)i * G + c; if (L >= nwg) return false;
        int wgid = (int)L; { const int q = nwg / NXCD, r = nwg % NXCD, xcd = wgid % NXCD, off = wgid / NXCD; wgid = (xcd < r ? xcd * (q + 1) : r * (q + 1) + (xcd - r) * q) + off; }
        const int nig = WGM * nN, gid = wgid / nig, fm = gid * WGM, gsz = (nM - fm) < WGM ? (nM - fm) : WGM;
        u.pm = fm + ((wgid % nig) % gsz); u.pn = (wgid % nig) / gsz; return true;
    }
    __device__ __forceinline__ void a_ready(const Unit&) const {}
    __device__ __forceinline__ void done(const Unit&) const {}
};

__device__ __forceinline__ unsigned cvt_pk_bf16(float lo, float hi) { unsigned r; asm volatile("v_cvt_pk_bf16_f32 %0, %1, %2" : "=v"(r) : "v"(lo), "v"(hi)); return r; }
typedef float f32x2 __attribute__((ext_vector_type(2)));
typedef unsigned u32x2 __attribute__((ext_vector_type(2)));
typedef __bf16 bf16x2_t __attribute__((ext_vector_type(2)));
__device__ __forceinline__ unsigned pkbf(float lo, float hi) { f32x2 v = {lo, hi}; bf16x2_t b = __builtin_convertvector(v, bf16x2_t); return __builtin_bit_cast(unsigned, b); }
__device__ __forceinline__ float bflo(unsigned w) { return __uint_as_float(w << 16); }
__device__ __forceinline__ float bfhi(unsigned w) { return __uint_as_float(w & 0xffff0000u); }
__device__ __forceinline__ unsigned pkf8(float a, float b, float c, float d) {
    a = __builtin_amdgcn_fmed3f(a, -448.f, 448.f); b = __builtin_amdgcn_fmed3f(b, -448.f, 448.f); c = __builtin_amdgcn_fmed3f(c, -448.f, 448.f); d = __builtin_amdgcn_fmed3f(d, -448.f, 448.f);
    int w = __builtin_amdgcn_cvt_pk_fp8_f32(a, b, 0, false); w = __builtin_amdgcn_cvt_pk_fp8_f32(c, d, w, true); return (unsigned)w; }
__device__ __forceinline__ f32x4 unpk8(unsigned w) { const f32x2 lo = __builtin_amdgcn_cvt_pk_f32_fp8((int)w, false), hi = __builtin_amdgcn_cvt_pk_f32_fp8((int)w, true); return (f32x4){lo[0], lo[1], hi[0], hi[1]}; }
__device__ __forceinline__ float sigmoidf_(float x) { return __builtin_amdgcn_rcpf(1.0f + __expf(-x)); }
__device__ __forceinline__ float gelu_tanh(float x) { const float t = 1.5957691216057308f * (x + 0.044715f * x * x * x); return x * __builtin_amdgcn_rcpf(1.0f + __expf(-t)); }
__device__ __forceinline__ u32x4 pack8(const f32x4 a, const f32x4 b) { u32x4 w; w.x = pkbf(a[0], a[1]); w.y = pkbf(a[2], a[3]); w.z = pkbf(b[0], b[1]); w.w = pkbf(b[2], b[3]); return w; }
__device__ __forceinline__ void unpack8(const u32x4 w, f32x4& a, f32x4& b) { a = (f32x4){bflo(w.x), bfhi(w.x), bflo(w.y), bfhi(w.y)}; b = (f32x4){bflo(w.z), bfhi(w.z), bflo(w.w), bfhi(w.w)}; }

template <int M> __device__ __forceinline__ float shx(float v, int lane) {
    const int iv = __builtin_bit_cast(int, v); int r;
    if (M == 1) r = __builtin_amdgcn_mov_dpp(iv, 0xB1, 0xf, 0xf, true);
    else if (M == 2) r = __builtin_amdgcn_mov_dpp(iv, 0x4E, 0xf, 0xf, true);
    else if (M == 4) r = __builtin_amdgcn_ds_swizzle(iv, 0x101F);
    else if (M == 8) r = __builtin_amdgcn_ds_swizzle(iv, 0x201F);
    else if (M == 16) r = __builtin_amdgcn_ds_swizzle(iv, 0x401F);
    else r = __builtin_amdgcn_ds_bpermute((lane ^ M) << 2, iv);
    return __builtin_bit_cast(float, r);
}
__device__ __forceinline__ float bperm(float v, int srclane) { return __builtin_bit_cast(float, __builtin_amdgcn_ds_bpermute(srclane << 2, __builtin_bit_cast(int, v))); }
__device__ __forceinline__ int bpermi(int v, int srclane) { return __builtin_amdgcn_ds_bpermute(srclane << 2, v); }
__device__ __forceinline__ int lane_id_opaque() { unsigned m = ~0u; asm volatile("" : "+s"(m)); return (int)__builtin_amdgcn_mbcnt_hi(m, __builtin_amdgcn_mbcnt_lo(m, 0u)); }

#define EPI_IDS() int frq_ = lane_id_opaque(); fr = frq_ & 15; fq = frq_ >> 4; (void)frq_;     \
        const int row0 = u.pm * BM + wr * 64 + fr, col0 = u.pn * BM + wc * 64 + 16 * fq; (void)row0; (void)col0
constexpr int CBJ = 8;
__device__ __forceinline__ void store_pair(bf16_t* rowp, long offA, long offB, const u32x4 p0, const u32x4 p1, bool up) {
    u32x4 recv, dA, dB;
#pragma unroll
    for (int k = 0; k < 4; ++k) { const unsigned send = up ? p0[k] : p1[k]; recv[k] = (unsigned)__builtin_amdgcn_update_dpp(0, (int)send, 0x128, 0xf, 0xf, true); dA[k] = up ? recv[k] : p0[k]; dB[k] = up ? p1[k] : recv[k]; }
    *(u32x4*)(rowp + offA) = dA; *(u32x4*)(rowp + offB) = dB;
}
#define EPI_PAIR_OFFS(pitch) const bool up_ = (fr & 8) != 0; const long offA_ = up_ ? (long)8 - 8 * (long)(pitch) : 0, offB_ = up_ ? 8 : 8 * (long)(pitch)

struct RangeOrder {
    StaticOrder b; int i0, i1;
    __device__ __forceinline__ bool next(int i, Unit& u) const { return (i + i0 < i1) && b.next(i + i0, u); }
    __device__ __forceinline__ void a_ready(const Unit&) const {}
    __device__ __forceinline__ void done(const Unit&) const {}
};

struct EpiPlain {
    static constexpr bool PERM = true, PERM2 = true, AFTER_DRAIN = false;
    bf16_t* O; int ldc;
    __device__ __forceinline__ void operator()(const f32x4 (&acc)[2][2][4][2], const Unit& u, int wr, int wc, int fr, int fq) const {
        EPI_IDS(); EPI_PAIR_OFFS(ldc);
#pragma unroll
        for (int ai = 0; ai < 2; ++ai)
#pragma unroll
            for (int m = 0; m < 4; ++m) { bf16_t* rowp = O + (size_t)(row0 + ai * HALF + m * 16) * ldc + col0;
                store_pair(rowp, offA_, offB_, pack8(acc[ai][0][m][0], acc[ai][0][m][1]), pack8(acc[ai][1][m][0], acc[ai][1][m][1]), up_); }
    }
};

struct EpiWin {
    static constexpr bool PERM = true, PERM2 = true, AFTER_DRAIN = false;
    bf16_t *U, *Q, *K, *V; unsigned char *SGA, *SGB; float* kmean; const float* rope;
    float qscale;
    __device__ __forceinline__ void operator()(const f32x4 (&acc)[2][2][4][2], const Unit& u, int wr, int wc, int fr, int fq) const {
        EPI_IDS();
        const int pn = u.pn;
        if (pn < 2) {
            const int g = (pn * 256 + wc * 64) / 16 + fq;
#pragma unroll
            for (int ai = 0; ai < 2; ++ai)
#pragma unroll
                for (int m = 0; m < 4; ++m) { const int row = row0 + ai * HALF + m * 16, b = row >> 13, t = row & 8191; bf16_t* up = U + ((size_t)(b * 32 + g) * 8192 + t) * 16;
#pragma unroll
                    for (int bj = 0; bj < 2; ++bj) *(u32x4*)(up + 8 * bj) = pack8(acc[ai][bj][m][0], acc[ai][bj][m][1]); }
        } else if (pn < 6) {
            const bool isq = pn < 4; bf16_t* dst = isq ? Q : K; const int cb = (pn - (isq ? 2 : 4)) * 256 + wc * 64 + 16 * fq;
            const float sc = isq ? qscale : 1.0f;
            float cs[2][8];
#pragma unroll
            for (int bj = 0; bj < 2; ++bj)
#pragma unroll
                for (int i = 0; i < 8; ++i) cs[bj][i] = 0.f;
#pragma unroll
            for (int ai = 0; ai < 2; ++ai)
#pragma unroll
                for (int m = 0; m < 4; ++m) { const int row = row0 + ai * HALF + m * 16;
                    f32x4 v[2][2];
#pragma unroll
                    for (int bj = 0; bj < 2; ++bj) { v[bj][0] = acc[ai][bj][m][0]; v[bj][1] = acc[ai][bj][m][1]; }
                    { const f32x4* cp = (const f32x4*)(rope + (size_t)row * 16);
                      const f32x4 c01 = cp[0], c23 = cp[1], c45 = cp[2], c67 = cp[3];
                      const float co[8] = {c01[0], c01[2], c23[0], c23[2], c45[0], c45[2], c67[0], c67[2]};
                      const float si[8] = {c01[1], c01[3], c23[1], c23[3], c45[1], c45[3], c67[1], c67[3]};
#pragma unroll
                      for (int n = 0; n < 2; ++n)
#pragma unroll
                          for (int e = 0; e < 4; ++e) { const float a = v[0][n][e], b = v[1][n][e];
                              const float ra = a * co[4 * n + e] - b * si[4 * n + e], rb = b * co[4 * n + e] + a * si[4 * n + e];
                              v[0][n][e] = (fq == 0) ? ra : a; v[1][n][e] = (fq == 0) ? rb : b; } }
#pragma unroll
                    for (int bj = 0; bj < 2; ++bj) {
                        if (!isq) {
#pragma unroll
                            for (int n = 0; n < 2; ++n)
#pragma unroll
                                for (int e = 0; e < 4; ++e) cs[bj][4 * n + e] += v[bj][n][e]; } }
                    { EPI_PAIR_OFFS(512); store_pair(dst + (size_t)row * 512 + cb, offA_, offB_, pack8(v[0][0] * sc, v[0][1] * sc), pack8(v[1][0] * sc, v[1][1] * sc), up_); }
                }
            if (!isq) {
#pragma unroll
                for (int bj = 0; bj < 2; ++bj)
#pragma unroll
                    for (int i = 0; i < 8; ++i) { float s = cs[bj][i]; s += shx<1>(s, frq_); s += shx<2>(s, frq_); s += shx<4>(s, frq_); s += shx<8>(s, frq_);
                        if (fr == 0) atomicAdd(kmean + (size_t)u.pm * 512 + cb + bj * CBJ + i, s); }
            }
        } else if (pn < 8) {
            const int cb = (pn - 6) * 256 + wc * 64 + 16 * fq;
#pragma unroll
            for (int ai = 0; ai < 2; ++ai)
#pragma unroll
                for (int m = 0; m < 4; ++m) { const int row = row0 + ai * HALF + m * 16; EPI_PAIR_OFFS(512);
                    store_pair(V + (size_t)row * 512 + cb, offA_, offB_, pack8(acc[ai][0][m][0], acc[ai][0][m][1]), pack8(acc[ai][1][m][0], acc[ai][1][m][1]), up_); }
        } else {
            unsigned char* dst = pn < 12 ? SGA : SGB; const int cb = (pn - (pn < 12 ? 8 : 12)) * 256 + wc * 64 + 16 * fq;
#pragma unroll
            for (int ai = 0; ai < 2; ++ai)
#pragma unroll
                for (int m = 0; m < 4; ++m) { const int row = row0 + ai * HALF + m * 16; u32x4 o8;
#pragma unroll
                    for (int bj = 0; bj < 2; ++bj) { f32x4 a = acc[ai][bj][m][0], b = acc[ai][bj][m][1];
#pragma unroll
                        for (int e = 0; e < 4; ++e) { a[e] = sigmoidf_(a[e]); b[e] = sigmoidf_(b[e]); }
                        o8[2 * bj] = pkf8(a[0], a[1], a[2], a[3]); o8[2 * bj + 1] = pkf8(b[0], b[1], b[2], b[3]); }
                    *(u32x4*)(dst + (size_t)row * 1024 + cb) = o8; }
        }
    }
};

struct EpiGlu {
    static constexpr bool PERM = true, PERM2 = true, AFTER_DRAIN = false;
    const bf16_t* YP; bf16_t* YS;
    __device__ __forceinline__ void operator()(const f32x4 (&acc)[2][2][4][2], const Unit& u, int wr, int wc, int fr, int fq) const {
        EPI_IDS();
#pragma unroll
        for (int ai = 0; ai < 2; ++ai)
#pragma unroll
            for (int m = 0; m < 4; ++m) { const size_t off = (size_t)(row0 + ai * HALF + m * 16) * 512 + col0; u32x4 o8;
#pragma unroll
                for (int bj = 0; bj < 2; ++bj) { const u32x4 w = *(const u32x4*)(YP + off + bj * CBJ); f32x4 ya, yb; unpack8(w, ya, yb);
                    f32x4 a = acc[ai][bj][m][0], b = acc[ai][bj][m][1];
#pragma unroll
                    for (int e = 0; e < 4; ++e) { a[e] = ya[e] * sigmoidf_(a[e]); b[e] = yb[e] * sigmoidf_(b[e]); }
                    o8[2 * bj] = pkf8(a[0], a[1], a[2], a[3]); o8[2 * bj + 1] = pkf8(b[0], b[1], b[2], b[3]); }
                *(u32x4*)((unsigned char*)YS + off) = o8; }
    }
};

template <int MODE> struct EpiMerge {
    static constexpr bool PERM = true, PERM2 = true, AFTER_DRAIN = false;
    const unsigned char* G8; bf16_t* T1; unsigned char* M8;
    __device__ __forceinline__ void operator()(const f32x4 (&acc)[2][2][4][2], const Unit& u, int wr, int wc, int fr, int fq) const {
        EPI_IDS();
#pragma unroll
        for (int ai = 0; ai < 2; ++ai)
#pragma unroll
            for (int m = 0; m < 4; ++m) { const size_t off = (size_t)(row0 + ai * HALF + m * 16) * 1024 + col0; u32x4 o8, pk[2]; EPI_PAIR_OFFS(1024);
                const u32x4 g8 = *(const u32x4*)(G8 + off);
#pragma unroll
                for (int bj = 0; bj < 2; ++bj) { const f32x4 ga = unpk8(g8[2 * bj]), gb = unpk8(g8[2 * bj + 1]);
                    f32x4 a = acc[ai][bj][m][0], b = acc[ai][bj][m][1];
                    if (MODE == 0) { a = ga * a; b = gb * b; pk[bj] = pack8(a, b); }
                    else { const u32x4 w = *(const u32x4*)(T1 + off + bj * CBJ); f32x4 ta, tb; unpack8(w, ta, tb); a = ta + ga * a; b = tb + gb * b;
                        o8[2 * bj] = pkf8(a[0], a[1], a[2], a[3]); o8[2 * bj + 1] = pkf8(b[0], b[1], b[2], b[3]); } }
                if (MODE == 1) *(u32x4*)(M8 + off) = o8; else store_pair(T1 + off, offA_, offB_, pk[0], pk[1], up_); }
    }
};

struct EpiResid {
    static constexpr bool PERM = true, PERM2 = true, AFTER_DRAIN = false;
    const float* X; bf16_t* X1B; float* sumsq;
    __device__ __forceinline__ void operator()(const f32x4 (&acc)[2][2][4][2], const Unit& u, int wr, int wc, int fr, int fq) const {
        EPI_IDS();
#pragma unroll
        for (int ai = 0; ai < 2; ++ai)
#pragma unroll
            for (int m = 0; m < 4; ++m) { const int row = row0 + ai * HALF + m * 16; const size_t off = (size_t)row * 1024 + col0; float ss = 0.f; u32x4 pk[2]; EPI_PAIR_OFFS(1024);
#pragma unroll
                for (int bj = 0; bj < 2; ++bj) { const f32x4 xa = *(const f32x4*)(X + off + bj * CBJ), xb = *(const f32x4*)(X + off + bj * CBJ + 4);
                    const f32x4 a = xa + acc[ai][bj][m][0], b = xb + acc[ai][bj][m][1];
                    pk[bj] = pack8(a, b);
                    ss += (a[0] * a[0] + a[1] * a[1]) + (a[2] * a[2] + a[3] * a[3]) + (b[0] * b[0] + b[1] * b[1]) + (b[2] * b[2] + b[3] * b[3]); }
                store_pair(X1B + off, offA_, offB_, pk[0], pk[1], up_);
                ss += shx<16>(ss, frq_); ss += shx<32>(ss, frq_);
                if (fq == 0) atomicAdd(sumsq + row, ss); }
    }
};

struct EpiScores {
    static constexpr bool PERM = true, PERM2 = true, AFTER_DRAIN = false;
    bf16_t* S; const float* sumsq;
    __device__ __forceinline__ void operator()(const f32x4 (&acc)[2][2][4][2], const Unit& u, int wr, int wc, int fr, int fq) const {
        EPI_IDS(); EPI_PAIR_OFFS(2048);
#pragma unroll
        for (int ai = 0; ai < 2; ++ai)
#pragma unroll
            for (int m = 0; m < 4; ++m) { const int row = row0 + ai * HALF + m * 16; const size_t off = (size_t)row * 2048 + col0;
                const float rs = 1.0f / sqrtf(sumsq[row] * (1.0f / 1024.0f) + 1e-6f);
                store_pair(S + off, offA_, offB_, pack8(acc[ai][0][m][0] * rs, acc[ai][0][m][1] * rs), pack8(acc[ai][1][m][0] * rs, acc[ai][1][m][1] * rs), up_); }
    }
};

struct EpiPle {
    static constexpr bool PERM = true, PERM2 = true, AFTER_DRAIN = false;
    const bf16_t* X2B; bf16_t* E; const float* rs2; float* sumsq;
    __device__ __forceinline__ void operator()(const f32x4 (&acc)[2][2][4][2], const Unit& u, int wr, int wc, int fr, int fq) const {
        EPI_IDS();
#pragma unroll
        for (int ai = 0; ai < 2; ++ai)
#pragma unroll
            for (int m = 0; m < 4; ++m) { const int row = row0 + ai * HALF + m * 16; const size_t off = (size_t)row * 1024 + col0; float ss = 0.f; const float rs = rs2[row]; u32x4 pk[2]; EPI_PAIR_OFFS(1024);
#pragma unroll
                for (int bj = 0; bj < 2; ++bj) { const u32x4 wx = *(const u32x4*)(X2B + off + bj * CBJ); f32x4 xa, xb; unpack8(wx, xa, xb);
                    const u32x4 w = *(const u32x4*)(E + off + bj * CBJ); f32x4 ea, eb; unpack8(w, ea, eb);
                    f32x4 a = acc[ai][bj][m][0], b = acc[ai][bj][m][1];
#pragma unroll
                    for (int e = 0; e < 4; ++e) { a[e] = xa[e] + sigmoidf_(rs * a[e]) * ea[e]; b[e] = xb[e] + sigmoidf_(rs * b[e]) * eb[e]; }
                    pk[bj] = pack8(a, b);
                    ss += (a[0] * a[0] + a[1] * a[1]) + (a[2] * a[2] + a[3] * a[3]) + (b[0] * b[0] + b[1] * b[1]) + (b[2] * b[2] + b[3] * b[3]); }
                store_pair(E + off, offA_, offB_, pk[0], pk[1], up_);
                ss += shx<16>(ss, frq_); ss += shx<32>(ss, frq_);
                if (fq == 0) atomicAdd(sumsq + row, ss); }
    }
};
#undef EPI_IDS
#undef EPI_PAIR_OFFS
typedef int v4i_t __attribute__((ext_vector_type(4)));
constexpr int W8_SHIFT = 6;
template <class Epi, class Sched, bool ALIGN_EPI = false, bool SP2 = false, bool FP8 = false, int KC = 0>
__device__ __forceinline__ void gemm_phase(PG8_LAS unsigned char* lds, const Gemm g, const Sched& S, const Epi& E, const int wave_s) {
    int tid_o = wave_s * 64 + lane_id_opaque(); asm volatile("" : "+v"(tid_o)); const int tid = tid_o, wid = __builtin_amdgcn_readfirstlane(tid >> 6), lane = tid & 63, wr = wid >> 2, wc = wid & 3, fr = lane & 15, fq = lane >> 4;
    const int K = KC ? KC : g.K, nt = FP8 ? K / 128 : K / BK;
    unsigned voffA[2], voffB[2]; int aoff, boff;
#define PG8_LANE_SETUP() do { int t_ = wave_s * 64 + lane_id_opaque(); asm volatile("" : "+v"(t_)); const int l_ = t_ & 63, fr_ = l_ & 15, fq_ = l_ >> 4; \
        _Pragma("unroll") for (int i = 0; i < 2; ++i) { int R, C; stage_rc(t_ * 16 + i * 8192, R, C); const int Rb = Epi::PERM2 ? (64 * (R >> 5) + 16 * ((R >> 2) & 3) + 4 * ((R >> 4) & 1) + (R & 3)) : Epi::PERM ? ((R & ~31) + perm32(R & 31)) : R;     \
            voffA[i] = FP8 ? (unsigned)(R * K + 2 * C) : (unsigned)(R * K + C) * 2u; voffB[i] = FP8 ? (unsigned)(Rb * K + 2 * C) : (unsigned)(Rb * K + C) * 2u; } \
        aoff = lds_byte(wr * 64 + fr_, fq_ * 8); boff = lds_byte(wc * 32 + fr_, fq_ * 8); } while (0)
    PG8_LANE_SETUP();
#if 0
    for (int i = 0; i < 2; ++i) { int R, C; stage_rc(tid * 16 + i * 8192, R, C); const int Rb = Epi::PERM ? ((R & ~31) + perm32(R & 31)) : R;
        voffA[i] = FP8 ? (unsigned)(R * K + 2 * C) : (unsigned)(R * K + C) * 2u; voffB[i] = FP8 ? (unsigned)(Rb * K + 2 * C) : (unsigned)(Rb * K + C) * 2u; }
#endif
    const size_t kstep = (size_t)(BK * 2);
    const size_t hstep = (size_t)HALF * K * (FP8 ? 1 : 2); const size_t hstepB = Epi::PERM2 ? (size_t)8 * K * (FP8 ? 1 : 2) : hstep;
    const size_t tstep = 2 * hstep;
    const unsigned ldsw = (unsigned)wid * 1024u;
#define PG8_SA(b, h) (((b) * 2 + (h)) * HTB)
#define PG8_SB(b, h) ((4 + (b) * 2 + (h)) * HTB)
#define PG8_STAGE(bufoff, gbase, voff) do { const char* gb_ = (const char*)(gbase); asm volatile("" : "+s"(gb_)); _Pragma("unroll") for (int _i = 0; _i < 2; ++_i) \
        __builtin_amdgcn_global_load_lds((const unsigned*)(gb_ + (voff)[_i]), (PG8_LAS unsigned*)(lds + (bufoff) + ldsw + _i * 8192), 16, 0, 0); } while (0)
#define PG8_LDA(dst, b, h) do { _Pragma("unroll") for (int m = 0; m < 4; ++m) _Pragma("unroll") for (int k = 0; k < 2; ++k) dst[m][k] = *(const PG8_LAS bf16x8*)(lds + PG8_SA(b, h) + aoff + m * 2048 + k * 1024); } while (0)
#define PG8_LDB(dst, b, h) do { _Pragma("unroll") for (int n = 0; n < 2; ++n) _Pragma("unroll") for (int k = 0; k < 2; ++k) dst[n][k] = *(const PG8_LAS bf16x8*)(lds + PG8_SB(b, h) + boff + n * 2048 + k * 1024); } while (0)
#define PG8_CAT8(x0, x1) __builtin_shufflevector(__builtin_bit_cast(v4i_t, x0), __builtin_bit_cast(v4i_t, x1), 0, 1, 2, 3, 4, 5, 6, 7)
#define PG8_MMA(ai, bj, At, Bt) do { __builtin_amdgcn_s_setprio(1); _Pragma("unroll") for (int m = 0; m < 4; ++m) _Pragma("unroll") for (int n = 0; n < 2; ++n) { \
        if constexpr (FP8) acc[ai][bj][m][n] = __builtin_amdgcn_mfma_scale_f32_16x16x128_f8f6f4(PG8_CAT8(Bt[n][0], Bt[n][1]), PG8_CAT8(At[m][0], At[m][1]), acc[ai][bj][m][n], 0, 0, 0, 0, 0, 0); \
        else { _Pragma("unroll") for (int k = 0; k < 2; ++k) acc[ai][bj][m][n] = __builtin_amdgcn_mfma_f32_16x16x32_bf16(Bt[n][k], At[m][k], acc[ai][bj][m][n], 0, 0, 0); } } __builtin_amdgcn_s_setprio(0); } while (0)
#define PG8_WAIT_V(n) asm volatile("s_waitcnt vmcnt(" #n ")" ::: "memory")
#define PG8_WAIT_L(n) asm volatile("s_waitcnt lgkmcnt(" #n ")" ::: "memory")
#define PG8_BAR __builtin_amdgcn_s_barrier()
#define PG8_SCHED __builtin_amdgcn_sched_barrier(0)
    Unit cur, nxt; int ui = 0;
    if (!S.next(0, cur)) return;
    f32x4 acc[2][2][4][2];
#pragma unroll
    for (int a = 0; a < 2; ++a)
#pragma unroll
        for (int b = 0; b < 2; ++b)
#pragma unroll
            for (int m = 0; m < 4; ++m)
#pragma unroll
                for (int n = 0; n < 2; ++n) acc[a][b][m][n] = (f32x4){0.f, 0.f, 0.f, 0.f};
    bf16x8 At[4][2], B0[2][2], B1[2][2];
    const char* cA = (const char*)g.A + (size_t)cur.pm * tstep; const char* cB = (const char*)g.Bt + (size_t)cur.pn * tstep;
    S.a_ready(cur);
    if constexpr (SP2) {
        PG8_STAGE(PG8_SB(0, 0), cB, voffB); PG8_STAGE(PG8_SB(0, 1), cB + hstepB, voffB); PG8_STAGE(PG8_SA(0, 0), cA, voffA); PG8_STAGE(PG8_SA(0, 1), cA + hstep, voffA);
        if (wr == 1) PG8_BAR;
        PG8_WAIT_V(2); PG8_BAR;
        PG8_STAGE(PG8_SB(1, 0), cB + kstep, voffB); PG8_STAGE(PG8_SA(1, 0), cA + kstep, voffA); PG8_STAGE(PG8_SB(1, 1), cB + hstepB + kstep, voffB);
        PG8_WAIT_V(6); PG8_BAR;
    } else {
        PG8_STAGE(PG8_SB(0, 0), cB, voffB); PG8_STAGE(PG8_SA(0, 0), cA, voffA); PG8_STAGE(PG8_SB(0, 1), cB + hstepB, voffB); PG8_STAGE(PG8_SA(0, 1), cA + hstep, voffA);
        if (wr == 1) PG8_BAR;
        PG8_WAIT_V(4); PG8_BAR;
        PG8_STAGE(PG8_SB(1, 0), cB + kstep, voffB); PG8_STAGE(PG8_SA(1, 0), cA + kstep, voffA); PG8_STAGE(PG8_SB(1, 1), cB + hstepB + kstep, voffB);
        PG8_WAIT_V(6); PG8_BAR;
    }
    for (;;) {
        const bool has_next = S.next(ui + 1, nxt);
        const char* nA = has_next ? (const char*)g.A + (size_t)nxt.pm * tstep : cA; const char* nB = has_next ? (const char*)g.Bt + (size_t)nxt.pn * tstep : cB;
#pragma nounroll
        for (int t = 0; t < nt; t += 2) {
            const bool last = (t == nt - 2);
            const char* a1 = cA + (size_t)(t + 1) * kstep;
            const char* a2 = last ? nA : cA + (size_t)(t + 2) * kstep; const char* b2 = last ? nB : cB + (size_t)(t + 2) * kstep;
            const char* a3 = a2 + kstep; const char* b3 = b2 + kstep;
            if (last && has_next) S.a_ready(nxt);
            if constexpr (SP2) {
            PG8_LDB(B0, 0, 0); PG8_LDB(B1, 0, 1); PG8_SCHED; PG8_LDA(At, 0, 0); PG8_STAGE(PG8_SA(1, 1), a1 + hstep, voffA);
            PG8_WAIT_V(8); PG8_WAIT_L(0); PG8_BAR; PG8_MMA(0, 0, At, B0); PG8_MMA(0, 1, At, B1); PG8_BAR; PG8_SCHED;
            PG8_LDA(At, 0, 1); PG8_STAGE(PG8_SB(0, 0), b2, voffB); PG8_STAGE(PG8_SB(0, 1), b2 + hstepB, voffB); PG8_STAGE(PG8_SA(0, 0), a2, voffA);
            PG8_WAIT_V(8); PG8_WAIT_L(0); PG8_BAR; PG8_MMA(1, 0, At, B0); PG8_MMA(1, 1, At, B1); PG8_BAR; PG8_SCHED;
            PG8_LDB(B0, 1, 0); PG8_LDB(B1, 1, 1); PG8_SCHED; PG8_LDA(At, 1, 0); PG8_STAGE(PG8_SA(0, 1), a2 + hstep, voffA);
            PG8_WAIT_V(8); PG8_WAIT_L(0); PG8_BAR; PG8_MMA(0, 0, At, B0); PG8_MMA(0, 1, At, B1); PG8_BAR; PG8_SCHED;
            PG8_LDA(At, 1, 1); PG8_STAGE(PG8_SB(1, 0), b3, voffB); PG8_STAGE(PG8_SB(1, 1), b3 + hstepB, voffB); PG8_STAGE(PG8_SA(1, 0), a3, voffA);
            PG8_WAIT_V(8); PG8_WAIT_L(0); PG8_BAR; PG8_MMA(1, 0, At, B0); PG8_MMA(1, 1, At, B1); PG8_BAR; PG8_SCHED;
            } else {
            PG8_LDB(B0, 0, 0); PG8_SCHED; PG8_LDA(At, 0, 0); PG8_STAGE(PG8_SA(1, 1), a1 + hstep, voffA);
            PG8_WAIT_L(8); PG8_BAR; PG8_WAIT_L(0); PG8_MMA(0, 0, At, B0); PG8_BAR; PG8_SCHED;
            PG8_LDB(B1, 0, 1); PG8_STAGE(PG8_SB(0, 0), b2, voffB);
            PG8_BAR; PG8_WAIT_L(0); PG8_MMA(0, 1, At, B1); PG8_BAR;
            PG8_LDA(At, 0, 1); PG8_STAGE(PG8_SA(0, 0), a2, voffA);
            PG8_BAR; PG8_WAIT_L(0); PG8_MMA(1, 0, At, B0); PG8_BAR; PG8_SCHED;
            PG8_STAGE(PG8_SB(0, 1), b2 + hstepB, voffB);
            PG8_WAIT_V(6); PG8_BAR; PG8_MMA(1, 1, At, B1); PG8_BAR;
            PG8_LDB(B0, 1, 0); PG8_SCHED; PG8_LDA(At, 1, 0); PG8_STAGE(PG8_SA(0, 1), a2 + hstep, voffA);
            PG8_WAIT_L(8); PG8_BAR; PG8_WAIT_L(0); PG8_MMA(0, 0, At, B0); PG8_BAR; PG8_SCHED;
            PG8_LDB(B1, 1, 1); PG8_STAGE(PG8_SB(1, 0), b3, voffB);
            PG8_BAR; PG8_WAIT_L(0); PG8_MMA(0, 1, At, B1); PG8_BAR;
            PG8_LDA(At, 1, 1); PG8_STAGE(PG8_SA(1, 0), a3, voffA);
            PG8_BAR; PG8_WAIT_L(0); PG8_MMA(1, 0, At, B0); PG8_BAR; PG8_SCHED;
            PG8_STAGE(PG8_SB(1, 1), b3 + hstepB, voffB);
            PG8_WAIT_V(6); PG8_BAR; PG8_MMA(1, 1, At, B1); PG8_BAR;
            }
        }
        if constexpr (ALIGN_EPI) { if (wr == 0) PG8_BAR; }
        if constexpr (FP8) {
#pragma unroll
            for (int a = 0; a < 2; ++a)
#pragma unroll
                for (int b = 0; b < 2; ++b)
#pragma unroll
                    for (int m = 0; m < 4; ++m)
#pragma unroll
                        for (int n = 0; n < 2; ++n) acc[a][b][m][n] *= (1.0f / (float)(1 << W8_SHIFT)); }
        if constexpr (!Epi::AFTER_DRAIN) { E(acc, cur, wr, wc, fr, fq); S.done(cur); }
        if (!has_next) break;
#pragma unroll
        for (int a = 0; a < 2; ++a)
#pragma unroll
            for (int b = 0; b < 2; ++b)
#pragma unroll
                for (int m = 0; m < 4; ++m)
#pragma unroll
                    for (int n = 0; n < 2; ++n) acc[a][b][m][n] = (f32x4){0.f, 0.f, 0.f, 0.f};
        cur = nxt; cA = nA; cB = nB; ++ui;
        PG8_LANE_SETUP();
        if constexpr (ALIGN_EPI) { if (wr == 1) PG8_BAR; }
    }
    PG8_WAIT_V(0);
    if constexpr (!ALIGN_EPI) { if (wr == 0) PG8_BAR; }
    PG8_BAR;
    if constexpr (Epi::AFTER_DRAIN) { E.fused(acc, cur, wr, wc, fr, fq, lds, wid, lane); S.done(cur); }
#undef PG8_SA
#undef PG8_SB
#undef PG8_STAGE
#undef PG8_LDA
#undef PG8_LDB
#undef PG8_LANE_SETUP
#undef PG8_MMA
#undef PG8_CAT8
#undef PG8_WAIT_V
#undef PG8_WAIT_L
#undef PG8_BAR
#undef PG8_SCHED
}
}

#include <hip/hip_bf16.h>
namespace moba {
using bf16=__hip_bfloat16;
using bf16x8=__attribute__((ext_vector_type(8)))short;
using s16x4=__attribute__((ext_vector_type(4)))short;
using f32x16=__attribute__((ext_vector_type(16)))float;
using u32x4=__attribute__((ext_vector_type(4)))unsigned;
using f32x4_m=__attribute__((ext_vector_type(4)))float;
constexpr int BATCH=4,NHEAD=8,SEQ=8192,D=64,DM=NHEAD*D;
constexpr int NW=8,QBLK=32,QB=QBLK*NW,KVBLK=64,NQB=SEQ/QB;
constexpr int ATTN_PITCH=DM, ATTN_UNIT_ROWS=QB;
__device__ __forceinline__ int crow(int r,int hi){return (r&3)+8*(r>>2)+4*hi;}
#define SBAR() __builtin_amdgcn_sched_barrier(0)
__device__ __forceinline__ void cmask(f32x16&p0,f32x16&p1,int jb,int qrel,int hi){
  const float NEG=-INFINITY; int kb=64*jb+4*hi;
  #pragma unroll
  for(int r=0;r<16;++r){int kv=kb+(r&3)+8*(r>>2); if(kv>qrel)p0[r]=NEG; if(kv+32>qrel)p1[r]=NEG;}
}

constexpr int NSLOT=3, SLOTB=8192;
constexpr int LDS_K=0, LDS_V=NSLOT*SLOTB, LDS_WS=2*NSLOT*SLOTB, LDS_OST=LDS_WS+NW*64*4, LDS_BYTES=LDS_OST+NW*4096;
constexpr float C2=0.125f*1.4426950408889634f;
__device__ __forceinline__ void glds16(const void*gsrc,unsigned lds_dst){unsigned keep;
  asm volatile("s_mov_b32 %0, m0\n\ts_mov_b32 m0, %2\n\ts_nop 0\n\tglobal_load_lds_dwordx4 %1, off\n\ts_mov_b32 m0, %0":"=&s"(keep):"v"(gsrc),"s"(lds_dst):"memory");}
__device__ __forceinline__ float max3f(float a,float b,float c){float r;asm("v_max3_f32 %0, %1, %2, %3":"=v"(r):"v"(a),"v"(b),"v"(c));return r;}
__device__ __forceinline__ float max2f(float a,float b){float r;asm("v_max_f32_e32 %0, %1, %2":"=v"(r):"v"(a),"v"(b));return r;}
__device__ __forceinline__ float fadd_s(float a,float b){float r;asm("v_add_f32_e32 %0, %1, %2":"=v"(r):"v"(a),"v"(b));return r;}
__device__ __forceinline__ float fsub_s(float a,float b){float r;asm("v_sub_f32_e32 %0, %1, %2":"=v"(r):"v"(a),"v"(b));return r;}
typedef float f32x2_t __attribute__((ext_vector_type(2))); typedef __bf16 bf16x2_t __attribute__((ext_vector_type(2)));
__device__ __forceinline__ unsigned cvtpk_s(float lo,float hi){f32x2_t v={lo,hi};bf16x2_t b=__builtin_convertvector(v,bf16x2_t);return __builtin_bit_cast(unsigned,b);}
#define WAIT_BAR(N) asm volatile("s_waitcnt vmcnt(" #N ") lgkmcnt(0)\n\ts_barrier":::"memory")

__device__ __forceinline__ void qkt(f32x16&p0,f32x16&p1,const char*Kslot,const bf16x8*qr,const f32x16&negm,int r32,int hi){
  const char*kb=Kslot+hi*1024+r32*16;
  #pragma unroll
  for(int d0=0;d0<4;++d0){
    const bf16x8 b0=*reinterpret_cast<const bf16x8*>(kb+d0*2048);
    const bf16x8 b1=*reinterpret_cast<const bf16x8*>(kb+d0*2048+512);
    if(d0==0){p0=__builtin_amdgcn_mfma_f32_32x32x16_bf16(b0,qr[0],negm,0,0,0);p1=__builtin_amdgcn_mfma_f32_32x32x16_bf16(b1,qr[0],negm,0,0,0);}
    else{p0=__builtin_amdgcn_mfma_f32_32x32x16_bf16(b0,qr[d0],p0,0,0,0);p1=__builtin_amdgcn_mfma_f32_32x32x16_bf16(b1,qr[d0],p1,0,0,0);}}
}
typedef __attribute__((address_space(3))) const char* lds_cptr;
typedef short v4i16_t __attribute__((ext_vector_type(4)));
__device__ __forceinline__ void kload8(bf16x8*kf,lds_cptr kp){
  kf[0]=*(const __attribute__((address_space(3))) bf16x8*)(kp);      kf[1]=*(const __attribute__((address_space(3))) bf16x8*)(kp+512);
  kf[2]=*(const __attribute__((address_space(3))) bf16x8*)(kp+2048); kf[3]=*(const __attribute__((address_space(3))) bf16x8*)(kp+2560);
  kf[4]=*(const __attribute__((address_space(3))) bf16x8*)(kp+4096); kf[5]=*(const __attribute__((address_space(3))) bf16x8*)(kp+4608);
  kf[6]=*(const __attribute__((address_space(3))) bf16x8*)(kp+6144); kf[7]=*(const __attribute__((address_space(3))) bf16x8*)(kp+6656);
}
__device__ __forceinline__ void kload2(bf16x8*kf,lds_cptr kp,int j){ kf[2*j]=*(const __attribute__((address_space(3))) bf16x8*)(kp+j*2048); kf[2*j+1]=*(const __attribute__((address_space(3))) bf16x8*)(kp+j*2048+512); }
__device__ __forceinline__ s16x4 vtr(lds_cptr p){ return __builtin_bit_cast(s16x4,__builtin_amdgcn_ds_read_tr16_b64_v4i16((__attribute__((address_space(3))) v4i16_t*)p)); }
__device__ __forceinline__ float rowmax(const f32x16&p0,const f32x16&p1){
  float a=max3f(p0[0],p0[1],p1[0]),b=max3f(p0[2],p0[3],p1[1]);a=max3f(a,p1[2],p1[3]);
  #pragma unroll
  for(int r=4;r<16;r+=4){a=max3f(a,p0[r],p0[r+1]);b=max3f(b,p0[r+2],p0[r+3]);a=max3f(a,p1[r],p1[r+1]);b=max3f(b,p1[r+2],p1[r+3]);}
  const float m=max2f(a,b);
  auto rr=__builtin_amdgcn_permlane32_swap(__float_as_uint(m),__float_as_uint(m),false,false);
  return max2f(__uint_as_float(rr[0]),__uint_as_float(rr[1]));
}
__device__ __forceinline__ void pv(f32x16*o,int vb,bf16x8 pa0,bf16x8 pa1,bf16x8 pa2,bf16x8 pa3){
  #pragma unroll
  for(int d0=0;d0<2;++d0){s16x4 lo[4],hi[4];
    #pragma unroll
    for(int ks=0;ks<4;++ks){
      asm volatile("ds_read_b64_tr_b16 %0,%1 offset:%c2":"=&v"(lo[ks]):"v"(vb),"i"(d0*4096+ks*1024):"memory");
      asm volatile("ds_read_b64_tr_b16 %0,%1 offset:%c2":"=&v"(hi[ks]):"v"(vb),"i"(d0*4096+ks*1024+512):"memory");}
    asm volatile("s_waitcnt lgkmcnt(0)":::"memory");SBAR();
    #define PK(k) (bf16x8){lo[k][0],lo[k][1],lo[k][2],lo[k][3],hi[k][0],hi[k][1],hi[k][2],hi[k][3]}
    o[d0]=__builtin_amdgcn_mfma_f32_32x32x16_bf16(pa0,PK(0),o[d0],0,0,0);
    o[d0]=__builtin_amdgcn_mfma_f32_32x32x16_bf16(pa1,PK(1),o[d0],0,0,0);
    o[d0]=__builtin_amdgcn_mfma_f32_32x32x16_bf16(pa2,PK(2),o[d0],0,0,0);
    o[d0]=__builtin_amdgcn_mfma_f32_32x32x16_bf16(pa3,PK(3),o[d0],0,0,0);
    #undef PK
  }
}

#ifndef ATTN_STORE16
#define ATTN_STORE16(p,v) (*(u32x4*)(p)=(v))
#endif
constexpr int QIDX_OFF=86016;
template<int THRL,bool CAUSAL> __device__ __forceinline__ void attn_unit(int b,int h,int kvb,int qoff,const bf16*Q,const bf16*K,const bf16*V,bf16*PART,float*LSE,bf16*O,char*shm,const int wave_s){
  int tid_o=wave_s*64+pg8::lane_id_opaque(); asm volatile("":"+v"(tid_o)); const int tid=tid_o,lane=tid&63,r32=lane&31,hi=lane>>5; const int wid=__builtin_amdgcn_readfirstlane(tid>>6);
  const long rowbase=(long)b*SEQ; const int bh=b*NHEAD+h;
  const __attribute__((address_space(3))) int*qlist=(const __attribute__((address_space(3))) int*)((lds_cptr)shm+qoff);
  const int qent=CAUSAL?((kvb*QB+wid*QBLK+r32)|(3<<16)):qlist[wid*QBLK+r32]; const int qrow=qent<0?kvb*QB:(qent&0xffff);
  const bf16*Qw=Q+(rowbase+qrow)*DM+h*D;
  const bf16*Kh=K+(rowbase+(long)kvb*QB)*DM+h*D,*Vh=V+(rowbase+(long)kvb*QB)*DM+h*D;
  const unsigned lds0=(unsigned)(uintptr_t)shm;
  float*wsf=(float*)(shm+LDS_WS)+wid*64;
  const bf16*ksrc=Kh+(long)lane*DM+wid*8;
  const bf16*vsrc=Vh+(long)(16*(wid&3)+(lane>>2))*DM+(wid>>2)*32+(lane&3)*8;
  const unsigned kdst=lds0+LDS_K+wid*1024, vdst=lds0+LDS_V+wid*1024;
  #define DMA_K(t,slot) glds16(ksrc+(long)(t)*KVBLK*DM,(unsigned)__builtin_amdgcn_readfirstlane(kdst+(slot)))
  #define DMA_V(t,slot) glds16(vsrc+(long)(t)*KVBLK*DM,(unsigned)__builtin_amdgcn_readfirstlane(vdst+(slot)))
  const int vb0=(int)(lds0+LDS_V)+((lane>>4)&1)*32+(lane&3)*8+(4*hi+((lane&15)>>2))*64;
  const char*Kbase=shm+LDS_K; bf16x8 kf[8];
  const lds_cptr shm3=(lds_cptr)shm; const lds_cptr kp0=shm3+LDS_K+hi*1024+r32*16; const lds_cptr vp0=shm3+LDS_V+((lane>>4)&1)*32+(lane&3)*8+(4*hi+((lane&15)>>2))*64;
  constexpr int NT=4;
  DMA_K(0,0);DMA_V(0,0);DMA_K(1,SLOTB);
  bf16x8 qr[4];
  #pragma unroll
  for(int d0=0;d0<4;++d0)qr[d0]=*reinterpret_cast<const bf16x8*>(&Qw[d0*16+hi*8]);
  float mhat=0.f,l_reg=0.f;f32x16 o[2];o[0]=f32x16{};o[1]=f32x16{};f32x16 negm=f32x16{};asm volatile("":"+v"(negm));
  const int qrel=wid*QBLK+r32;
  #define CMASK(P0,P1,t) do{ if(CAUSAL){int jb_=(t)-(NT-4); if(jb_>=0)cmask(P0,P1,jb_,qrel,hi);} }while(0)
  bool resc=false;
  #define START(P0,P1) do{ const float rm=rowmax(P0,P1); resc=false; \
    { const float dl=__builtin_fmaxf(rm,0.f); mhat=fadd_s(mhat,dl); \
      _Pragma("unroll") for(int r=0;r<16;++r){P0[r]=fsub_s(P0[r],dl);P1[r]=fsub_s(P1[r],dl);} \
      _Pragma("unroll") for(int r=0;r<16;++r)negm[r]=-mhat; asm volatile("":"+v"(negm)); } \
    _Pragma("unroll") for(int r=0;r<16;++r)P0[r]=__builtin_amdgcn_exp2f(P0[r]); }while(0)
  #define RESC() do{ if(resc){ asm volatile("s_waitcnt lgkmcnt(0)":::"memory"); \
      _Pragma("unroll") for(int d_=0;d_<2;++d_) _Pragma("unroll") for(int r=0;r<16;++r)o[d_][r]*=wsf[crow(r,hi)]; } }while(0)
  f32x16 pA0,pA1,pB0,pB1;
  int sl_prev=0,sl_cur=0,sl_next=SLOTB;
  #define ROT() do{sl_prev=sl_cur;sl_cur=sl_next;sl_next=(sl_next==(NSLOT-1)*SLOTB)?0:sl_next+SLOTB;}while(0)
  DMA_K(2,2*SLOTB);
  WAIT_BAR(3);
  qkt(pA0,pA1,Kbase,qr,negm,r32,hi);asm volatile("s_nop 15\n\ts_nop 7":"+v"(pA0),"+v"(pA1));CMASK(pA0,pA1,0);
  START(pA0,pA1);
  _Pragma("unroll") for(int r=0;r<16;++r)pA1[r]=__builtin_amdgcn_exp2f(pA1[r]);
  WAIT_BAR(0);
  DMA_K(3,0);DMA_V(1,SLOTB);
  ROT();
  kload8(kf,kp0+sl_cur);
  WAIT_BAR(2);
  s16x4 vlo[8],vhi[8]; u32x4 pw0,pw1,pw2,pw3;
  #define PKW(P,B) cvtpk_s(P[B],P[B+1])
  #define PAF(k) __builtin_bit_cast(bf16x8,pw##k)
  #define VFR(i) (bf16x8){vlo[i][0],vlo[i][1],vlo[i][2],vlo[i][3],vhi[i][0],vhi[i][1],vhi[i][2],vhi[i][3]}
  #define PIN(x) asm volatile("":"+v"(x))
  #define MX3(a,b,c) __builtin_fmaxf(__builtin_fmaxf((a),(b)),(c))
  #define GAPA(MF,A0,A1,A2,A3,W0,W1,PW) do{ MF; sacc+=A0; sacc+=A1; sacc+=A2; sacc+=A3; PIN(sacc); W0; W1; PIN(PW); SBAR(); }while(0)
  #define EX(v) __builtin_amdgcn_exp2f(v)
  #define GAPB(MF,X,B) do{ MF; X[B]=EX(X[B]); X[B+1]=EX(X[B+1]); X[B+2]=EX(X[B+2]); X[B+3]=EX(X[B+3]); PIN(X); SBAR(); }while(0)
  #define VRD(i) do{ vlo[i]=vtr(vp_+(((i)>>2)*4096+((i)&3)*1024)); vhi[i]=vtr(vp_+(((i)>>2)*4096+((i)&3)*1024+512)); }while(0)
  #define KRD(G,j) do{ if(G){ kload2(kf,kp0+sl_next,j); SBAR(); } }while(0)
  #define STEP(C0,C1,P0,P1,t,GK,GV,GL) do{ SBAR(); \
    const lds_cptr vp_=vp0+sl_prev; \
    VRD(0); SBAR(); float sacc=(P0[0]+P0[1]); \
    GAPA(C0=__builtin_amdgcn_mfma_f32_32x32x16_bf16(kf[0],qr[0],negm,0,0,0), P0[2],P0[3],P0[4],P0[5],     pw0[0]=PKW(P0,0), pw0[1]=PKW(P0,2), pw0); \
    VRD(4); SBAR(); GAPA(C1=__builtin_amdgcn_mfma_f32_32x32x16_bf16(kf[1],qr[0],negm,0,0,0), P0[6],P0[7],P0[8],P0[9],     pw0[2]=PKW(P0,4), pw0[3]=PKW(P0,6), pw0); \
    VRD(1); SBAR(); GAPA(C0=__builtin_amdgcn_mfma_f32_32x32x16_bf16(kf[2],qr[1],C0,0,0,0),   P0[10],P0[11],P0[12],P0[13], pw1[0]=PKW(P0,8), pw1[1]=PKW(P0,10), pw1); \
    VRD(5); SBAR(); GAPA(C1=__builtin_amdgcn_mfma_f32_32x32x16_bf16(kf[3],qr[1],C1,0,0,0),   P0[14],P0[15],P1[0],P1[1],   pw1[2]=PKW(P0,12),pw1[3]=PKW(P0,14), pw1); \
    VRD(2); SBAR(); GAPA(C0=__builtin_amdgcn_mfma_f32_32x32x16_bf16(kf[4],qr[2],C0,0,0,0),   P1[2],P1[3],P1[4],P1[5],     pw2[0]=PKW(P1,0), pw2[1]=PKW(P1,2), pw2); \
    VRD(6); SBAR(); GAPA(C1=__builtin_amdgcn_mfma_f32_32x32x16_bf16(kf[5],qr[2],C1,0,0,0),   P1[6],P1[7],P1[8],P1[9],     pw2[2]=PKW(P1,4), pw2[3]=PKW(P1,6), pw2); \
    VRD(3); SBAR(); GAPA(C0=__builtin_amdgcn_mfma_f32_32x32x16_bf16(kf[6],qr[3],C0,0,0,0),   P1[10],P1[11],P1[12],P1[13], pw3[0]=PKW(P1,8), pw3[1]=PKW(P1,10), pw3); \
    VRD(7); SBAR(); GAPA(C1=__builtin_amdgcn_mfma_f32_32x32x16_bf16(kf[7],qr[3],C1,0,0,0),   P1[14],P1[15],0.f,0.f,       pw3[2]=PKW(P1,12),pw3[3]=PKW(P1,14), pw3); \
    l_reg+=sacc; \
    if(GK){DMA_K((t)+3,sl_cur);} if(GV){DMA_V((t)+1,sl_next);} \
    CMASK(C0,C1,t); \
    { float a=MX3(C0[0],C0[1],C1[0]),b=MX3(C0[2],C0[3],C1[1]); a=MX3(a,C1[2],C1[3]); \
      _Pragma("unroll") for(int r=4;r<16;r+=4){a=MX3(a,C0[r],C0[r+1]);b=MX3(b,C0[r+2],C0[r+3]);a=MX3(a,C1[r],C1[r+1]);b=MX3(b,C1[r+2],C1[r+3]);} \
      float rm=__builtin_fmaxf(a,b); { auto rr=__builtin_amdgcn_permlane32_swap(__float_as_uint(rm),__float_as_uint(rm),false,false); rm=__builtin_fmaxf(__uint_as_float(rr[0]),__uint_as_float(rr[1])); } \
      resc=false; \
      if(__builtin_expect(__any(rm>(float)THRL),0)){ const float dl=__builtin_fmaxf(rm,0.f); mhat+=dl; \
        _Pragma("unroll") for(int r=0;r<16;++r){C0[r]-=dl;C1[r]-=dl;} \
        _Pragma("unroll") for(int r=0;r<16;++r)negm[r]=-mhat; asm volatile("":"+v"(negm)); \
        const float f=__builtin_amdgcn_exp2f(-dl); l_reg*=f; if(hi==0)wsf[r32]=f; resc=true; } } \
    SBAR(); \
    GAPB(o[0]=__builtin_amdgcn_mfma_f32_32x32x16_bf16(PAF(0),VFR(0),o[0],0,0,0), C0,0); \
    GAPB(o[1]=__builtin_amdgcn_mfma_f32_32x32x16_bf16(PAF(0),VFR(4),o[1],0,0,0), C0,4); \
    KRD(GL,0); GAPB(o[0]=__builtin_amdgcn_mfma_f32_32x32x16_bf16(PAF(1),VFR(1),o[0],0,0,0), C0,8); \
    KRD(GL,1); GAPB(o[1]=__builtin_amdgcn_mfma_f32_32x32x16_bf16(PAF(1),VFR(5),o[1],0,0,0), C0,12); \
    KRD(GL,2); GAPB(o[0]=__builtin_amdgcn_mfma_f32_32x32x16_bf16(PAF(2),VFR(2),o[0],0,0,0), C1,0); \
    KRD(GL,3); GAPB(o[1]=__builtin_amdgcn_mfma_f32_32x32x16_bf16(PAF(2),VFR(6),o[1],0,0,0), C1,4); \
    GAPB(o[0]=__builtin_amdgcn_mfma_f32_32x32x16_bf16(PAF(3),VFR(3),o[0],0,0,0), C1,8); \
    GAPB(o[1]=__builtin_amdgcn_mfma_f32_32x32x16_bf16(PAF(3),VFR(7),o[1],0,0,0), C1,12); \
    }while(0)
  int t=1;
  #undef CMASK
  #define CMASK(P0,P1,t) do{}while(0)
  for(;t+5<NT;t+=2){
    STEP(pB0,pB1,pA0,pA1,t,true,true,true);     WAIT_BAR(2); RESC(); ROT();
    STEP(pA0,pA1,pB0,pB1,t+1,true,true,true);   WAIT_BAR(2); RESC(); ROT();
  }
  #undef CMASK
  #define CMASK(P0,P1,t) do{ if(CAUSAL){int jb_=(t)-(NT-4); if(jb_>=0)cmask(P0,P1,jb_,qrel,hi);} }while(0)
  #define ENDW(tt) do{ if((tt)+3<NT){WAIT_BAR(2);} else if((tt)+2<NT){WAIT_BAR(1);} else {WAIT_BAR(0);} }while(0)
  for(;t+1<NT;t+=2){
    STEP(pB0,pB1,pA0,pA1,t,(t+3<NT),(t+1<NT),(t+1<NT));       ENDW(t);   RESC(); ROT();
    STEP(pA0,pA1,pB0,pB1,t+1,(t+4<NT),(t+2<NT),(t+2<NT));     ENDW(t+1); RESC(); ROT();
  }
  STEP(pB0,pB1,pA0,pA1,NT-1,false,false,false); RESC();
  { float sacc=pB0[0]+pB0[1]; _Pragma("unroll") for(int r=2;r<16;++r)sacc+=pB0[r]; _Pragma("unroll") for(int r=0;r<16;++r)sacc+=pB1[r]; l_reg+=sacc;
    pw0=(u32x4){PKW(pB0,0),PKW(pB0,2),PKW(pB0,4),PKW(pB0,6)};pw1=(u32x4){PKW(pB0,8),PKW(pB0,10),PKW(pB0,12),PKW(pB0,14)};pw2=(u32x4){PKW(pB1,0),PKW(pB1,2),PKW(pB1,4),PKW(pB1,6)};pw3=(u32x4){PKW(pB1,8),PKW(pB1,10),PKW(pB1,12),PKW(pB1,14)};
    SBAR(); pv(o,vb0+sl_cur,PAF(0),PAF(1),PAF(2),PAF(3)); }
  #undef PKW
  #undef PAF
  #undef VFR
  #undef PIN
  #undef MX3
  #undef GAPA
  #undef GAPB
  #undef EX
  #undef VRD
  #undef KRD
  #undef STEP
  #undef ENDW
  f32x4_m pls[4]; pg8::u32x2 ppv[4][3];
  if(CAUSAL){
    _Pragma("unroll") for(int i=0;i<4;++i){ const size_t rid=(size_t)bh*SEQ+kvb*QB+wid*QBLK+i*8+(lane>>3); pls[i]=*(const f32x4_m*)(LSE+rid*4);
      _Pragma("unroll") for(int s_=0;s_<3;++s_) ppv[i][s_]=*(const pg8::u32x2*)((const unsigned char*)PART+(rid*4+s_)*64+(lane&7)*8); } }
  {auto rr=__builtin_amdgcn_permlane32_swap(__float_as_uint(l_reg),__float_as_uint(l_reg),false,false);l_reg=__uint_as_float(rr[0])+__uint_as_float(rr[1]);}
  if(hi==0)wsf[32+r32]=l_reg;asm volatile("s_waitcnt lgkmcnt(0)":::"memory");
  float rli[16];
  #pragma unroll
  for(int r=0;r<16;++r)rli[r]=__builtin_amdgcn_rcpf(wsf[32+crow(r,hi)]);
  if(CAUSAL){ if(hi==0) wsf[r32]=mhat+__builtin_amdgcn_logf(l_reg); }
  else if(hi==0&&qent>=0) LSE[((size_t)bh*SEQ+qrow)*4+(qent>>16)]=mhat+__builtin_amdgcn_logf(l_reg);
  { bf16*stg=(bf16*)(shm+LDS_OST)+wid*2048;
    #pragma unroll
    for(int r=0;r<16;++r){const int orow=crow(r,hi);
      #pragma unroll
      for(int d0=0;d0<2;++d0)stg[orow*64+d0*32+r32]=__float2bfloat16(o[d0][r]*rli[r]);}
    asm volatile("s_waitcnt lgkmcnt(0)":::"memory");
    #pragma unroll
    for(int i=0;i<4;++i){const int row=i*8+(lane>>3),ch=lane&7; const u32x4 v=*(const u32x4*)(stg+row*64+ch*8); if(CAUSAL){ const int qr_=kvb*QB+wid*QBLK+row; const float lown=wsf[row]; const f32x4_m ls=pls[i];
        const float L=__builtin_fmaxf(__builtin_fmaxf(lown,ls[0]),__builtin_fmaxf(ls[1],ls[2]));
        const float wo=__builtin_amdgcn_exp2f(lown-L),w0=__builtin_amdgcn_exp2f(ls[0]-L),w1=__builtin_amdgcn_exp2f(ls[1]-L),w2=__builtin_amdgcn_exp2f(ls[2]-L); const float inv=__builtin_amdgcn_rcpf(wo+w0+w1+w2);
        float ac[8]; { const float ww=wo*inv; ac[0]=ww*__uint_as_float(v.x<<16); ac[1]=ww*__uint_as_float(v.x&0xffff0000u); ac[2]=ww*__uint_as_float(v.y<<16); ac[3]=ww*__uint_as_float(v.y&0xffff0000u);
          ac[4]=ww*__uint_as_float(v.z<<16); ac[5]=ww*__uint_as_float(v.z&0xffff0000u); ac[6]=ww*__uint_as_float(v.w<<16); ac[7]=ww*__uint_as_float(v.w&0xffff0000u); }
        _Pragma("unroll") for(int s_=0;s_<3;++s_){ const float ws_=(s_==0?w0:s_==1?w1:w2)*inv; const bool on_=ws_>0.f; pg8::u32x2 pv_=ppv[i][s_]; pv_.x=on_?pv_.x:0u; pv_.y=on_?pv_.y:0u;
          const pg8::f32x4 pa_=pg8::unpk8(pv_.x), pb_=pg8::unpk8(pv_.y);
          ac[0]+=ws_*pa_[0]; ac[1]+=ws_*pa_[1]; ac[2]+=ws_*pa_[2]; ac[3]+=ws_*pa_[3]; ac[4]+=ws_*pb_[0]; ac[5]+=ws_*pb_[1]; ac[6]+=ws_*pb_[2]; ac[7]+=ws_*pb_[3]; }
        pg8::u32x2 ov; ov.x=pg8::pkf8(ac[0],ac[1],ac[2],ac[3]); ov.y=pg8::pkf8(ac[4],ac[5],ac[6],ac[7]);
        *(pg8::u32x2*)((unsigned char*)O+(rowbase+qr_)*DM+h*D+ch*8)=ov; }
      else {const int qe=qlist[wid*QBLK+row]; if(qe>=0){ pg8::u32x2 o8_; o8_.x=pg8::pkf8(__uint_as_float(v.x<<16),__uint_as_float(v.x&0xffff0000u),__uint_as_float(v.y<<16),__uint_as_float(v.y&0xffff0000u)); o8_.y=pg8::pkf8(__uint_as_float(v.z<<16),__uint_as_float(v.z&0xffff0000u),__uint_as_float(v.w<<16),__uint_as_float(v.w&0xffff0000u)); *(pg8::u32x2*)((unsigned char*)PART+(((size_t)bh*SEQ+(qe&0xffff))*4+(qe>>16))*64+ch*8)=o8_; } }} }
  asm volatile("s_waitcnt lgkmcnt(0)\n\ts_barrier":::"memory");
  #undef DMA_K
  #undef DMA_V
  #undef CMASK
  #undef START
  #undef RESC
  #undef ROT
}
constexpr int ATTN_LDS_BYTES=LDS_BYTES;

typedef __attribute__((address_space(3))) float lds_f; typedef __attribute__((address_space(3))) unsigned lds_u; typedef __attribute__((address_space(3))) int lds_i; typedef __attribute__((address_space(3))) unsigned short lds_h;
typedef __attribute__((ext_vector_type(4))) float f4_t;
constexpr int SEL_KM = 0, SEL_GT = 8192, SEL_SUB = SEL_GT + 256 * 33 * 4, SEL_CNT = SEL_SUB + 32 * 256 * 2, SEL_END = SEL_CNT + 128;
constexpr int UP_OFF = 88064, QP_OFF = UP_OFF + 1040 * 4, UI_OFF = QP_OFF + 8 * 36 * 4, QL_OFF = 94208, QL_MAX = 32;
static_assert(UI_OFF + 128 <= QL_OFF && QL_OFF + QL_MAX * 1024 <= 131072 && QIDX_OFF + 1024 <= UP_OFF, "moba LDS map");

constexpr int SEL_HALF = 59392;
static_assert(SEL_END <= SEL_HALF && 2 * SEL_HALF <= 131072, "selection LDS map");
__device__ __forceinline__ void select_pair(int uA, int uB, const bf16* Q, const float* kmean, unsigned short* SUB, unsigned* CNT, float* LSE, char* shm, int tid) {
    const int half = tid >> 8, lt = tid & 255, u = half ? uB : uA;
    const int bh = u >> 5, qb = u & 31, b = bh / NHEAD, h = bh % NHEAD;
    const lds_cptr base = (lds_cptr)shm + half * SEL_HALF;
    lds_h* sub = (lds_h*)(base + SEL_SUB); lds_u* cnt = (lds_u*)(base + SEL_CNT);
    const long rowbase = (long)b * SEQ; const int q0 = qb * QB;
    if (lt < 32) cnt[lt] = 0u;
    const int lane = lt & 63, wq = lt >> 6, r32 = lane & 31, hi = lane >> 5;
    bf16x8 af[4];
#pragma unroll
    for (int kk = 0; kk < 4; ++kk) { const float* kp = kmean + ((size_t)(b * 32 + r32)) * 512 + h * 64 + 16 * kk + 8 * hi; const f4_t k0 = *(const f4_t*)kp, k1 = *(const f4_t*)(kp + 4);
        const pg8::u32x4 w = pg8::pack8(__builtin_bit_cast(pg8::f32x4, k0), __builtin_bit_cast(pg8::f32x4, k1)); af[kk] = __builtin_bit_cast(bf16x8, w); }
    __syncthreads();
#pragma unroll
    for (int c = 0; c < 2; ++c) {
        const int ql = 64 * wq + 32 * c + r32;
        const bf16* qp = Q + (rowbase + q0 + ql) * DM + h * D + 8 * hi;
        f32x16 g = f32x16{};
#pragma unroll
        for (int kk = 0; kk < 4; ++kk) { const bf16x8 bq = *reinterpret_cast<const bf16x8*>(qp + 16 * kk); g = __builtin_amdgcn_mfma_f32_32x32x16_bf16(af[kk], bq, g, 0, 0, 0); }
        float v0 = -INFINITY, v1 = -INFINITY, v2 = -INFINITY; int i0 = -1, i1 = -1, i2 = -1;
#pragma unroll
        for (int r = 0; r < 16; ++r) { const int j = (r & 3) + 8 * (r >> 2) + 4 * hi; const float x = j < qb ? g[r] : -INFINITY;
            const bool c0 = x > v0, c1 = x > v1, c2 = x > v2;
            v2 = c1 ? v1 : (c2 ? x : v2); i2 = c1 ? i1 : (c2 ? j : i2);
            v1 = c0 ? v0 : (c1 ? x : v1); i1 = c0 ? i0 : (c1 ? j : i1);
            v0 = c0 ? x : v0; i0 = c0 ? j : i0; }
        { float pv[3]; int pi[3];
          pv[0] = pg8::shx<32>(v0, lane); pv[1] = pg8::shx<32>(v1, lane); pv[2] = pg8::shx<32>(v2, lane);
          pi[0] = __builtin_amdgcn_ds_bpermute((lane ^ 32) << 2, i0); pi[1] = __builtin_amdgcn_ds_bpermute((lane ^ 32) << 2, i1); pi[2] = __builtin_amdgcn_ds_bpermute((lane ^ 32) << 2, i2);
#pragma unroll
          for (int t = 0; t < 3; ++t) { const float x = pv[t]; const int j = pi[t];
              const bool c0 = x > v0 || (x == v0 && j >= 0 && j < i0), c1 = x > v1 || (x == v1 && j >= 0 && j < i1), c2 = x > v2 || (x == v2 && j >= 0 && j < i2);
              v2 = c1 ? v1 : (c2 ? x : v2); i2 = c1 ? i1 : (c2 ? j : i2);
              v1 = c0 ? v0 : (c1 ? x : v1); i1 = c0 ? i0 : (c1 ? j : i1);
              v0 = c0 ? x : v0; i0 = c0 ? j : i0; } }
        if (hi == 0) {
            if (i0 >= 0) { const unsigned p = __hip_atomic_fetch_add(cnt + i0, 1u, __ATOMIC_RELAXED, __HIP_MEMORY_SCOPE_WORKGROUP); sub[i0 * 256 + p] = (unsigned short)(ql | (0 << 8)); }
            if (i1 >= 0) { const unsigned p = __hip_atomic_fetch_add(cnt + i1, 1u, __ATOMIC_RELAXED, __HIP_MEMORY_SCOPE_WORKGROUP); sub[i1 * 256 + p] = (unsigned short)(ql | (1 << 8)); }
            if (i2 >= 0) { const unsigned p = __hip_atomic_fetch_add(cnt + i2, 1u, __ATOMIC_RELAXED, __HIP_MEMORY_SCOPE_WORKGROUP); sub[i2 * 256 + p] = (unsigned short)(ql | (2 << 8)); }
            float* ls = LSE + ((size_t)bh * SEQ + q0 + ql) * 4; *(f4_t*)ls = (f4_t){-INFINITY, -INFINITY, -INFINITY, -INFINITY}; }
    }
    __syncthreads();
    if (lt < 32) CNT[((size_t)bh * 32 + lt) * 32 + qb] = cnt[lt];
    for (int idx = lt; idx < 32 * 256; idx += 256) { const int j = idx >> 8, i = idx & 255; if ((unsigned)i < cnt[j]) SUB[(((size_t)bh * 32 + j) * 32 + qb) * 256 + i] = sub[idx]; }
    __syncthreads();
}

__device__ __forceinline__ void sparse_phase(const bf16* Q, const bf16* K, const bf16* V, const unsigned short* SUB, const unsigned* CNT, bf16* PART, float* LSE, char* shm, int G, int bx, int tid, int wave_s) {
    lds_i* UP = (lds_i*)((lds_cptr)shm + UP_OFF); lds_i* QP = (lds_i*)((lds_cptr)shm + QP_OFF); lds_i* QI = (lds_i*)((lds_cptr)shm + QIDX_OFF);
    for (int it = tid; it < 1024; it += 512) { const unsigned* c = CNT + (size_t)it * 32; unsigned len = 0u;
#pragma unroll 8
        for (int qb = 0; qb < 32; ++qb) len += c[qb];
        UP[it + 1] = (int)((len + 255u) >> 8); }
    if (tid == 0) UP[0] = 0;
    __syncthreads();
    for (int off = 1; off < 1024; off <<= 1) {
        int a0 = 0, a1 = 0; const int i0 = tid + 1, i1 = tid + 513;
        if (i0 > off) a0 = UP[i0 - off]; if (i1 > off) a1 = UP[i1 - off];
        __syncthreads();
        UP[i0] += a0; UP[i1] += a1;
        __syncthreads();
    }
    const int U = UP[1024];
    lds_i* UI = (lds_i*)((lds_cptr)shm + UI_OFF);
    const int lane = tid & 63, wv = __builtin_amdgcn_readfirstlane(tid >> 6);
    int nloc = bx < U ? (U - bx + G - 1) / G : 0; if (nloc > QL_MAX) nloc = QL_MAX;
    for (int k = wv; k < nloc; k += 8) {
        const int u = bx + k * G;
        int lo_ = 0, hi_ = 1024;
        while (hi_ - lo_ > 1) { const int mid = (lo_ + hi_) >> 1; if (UP[mid] <= u) lo_ = mid; else hi_ = mid; }
        const int item = lo_, t = u - UP[item];
        lds_i* QPw = QP + wv * 36;
        { const int qb = lane & 31; int x = (int)CNT[(size_t)item * 32 + qb];
#pragma unroll
          for (int o = 1; o < 32; o <<= 1) { const int y = __builtin_amdgcn_ds_bpermute(((lane & 32) + ((qb - o) & 31)) << 2, x); if (qb >= o) x += y; }
          if (lane < 32) { QPw[qb + 1] = x; if (qb == 0) QPw[0] = 0; } }
        asm volatile("s_waitcnt lgkmcnt(0)" ::: "memory");
        const int len = QPw[32];
        lds_i* ql = (lds_i*)((lds_cptr)shm + QL_OFF) + k * 256;
#pragma unroll
        for (int i = 0; i < 4; ++i) { const int sidx = lane + 64 * i, g = 256 * t + sidx; int ent = -1;
            if (g < len) { int a_ = 0, bnd = 32; while (bnd - a_ > 1) { const int mid = (a_ + bnd) >> 1; if (QPw[mid] <= g) a_ = mid; else bnd = mid; }
                const unsigned e = SUB[((size_t)item * 32 + a_) * 256 + (g - QPw[a_])]; ent = (a_ * 256 + (int)(e & 255u)) | ((int)(e >> 8) << 16); }
            ql[sidx] = ent; }
        if (lane == 0) UI[k] = item;
    }
    __syncthreads();
    for (int k = 0; k < nloc; ++k) { const int item = UI[k], bh = item >> 5, j = item & 31;
        attn_unit<8, false>(bh / NHEAD, bh % NHEAD, j, QL_OFF + k * 1024, Q, K, V, PART, LSE, nullptr, shm, wave_s); }
    for (int u = bx + QL_MAX * G; u < U; u += G) {
        int lo_ = 0, hi_ = 1024; while (hi_ - lo_ > 1) { const int mid = (lo_ + hi_) >> 1; if (UP[mid] <= u) lo_ = mid; else hi_ = mid; }
        const int item = lo_, t = u - UP[item], bh = item >> 5, j = item & 31;
        if (tid < 64) { const int qb = tid & 31; int x = (int)CNT[(size_t)item * 32 + qb];
#pragma unroll
            for (int o = 1; o < 32; o <<= 1) { const int y = __builtin_amdgcn_ds_bpermute(((tid & 32) + ((qb - o) & 31)) << 2, x); if (qb >= o) x += y; }
            if (tid < 32) { QP[qb + 1] = x; if (qb == 0) QP[0] = 0; } }
        __syncthreads();
        if (tid < 256) { const int g = 256 * t + tid; int ent = -1;
            if (g < QP[32]) { int a_ = 0, bnd = 32; while (bnd - a_ > 1) { const int mid = (a_ + bnd) >> 1; if (QP[mid] <= g) a_ = mid; else bnd = mid; }
                const unsigned e = SUB[((size_t)item * 32 + a_) * 256 + (g - QP[a_])]; ent = (a_ * 256 + (int)(e & 255u)) | ((int)(e >> 8) << 16); }
            QI[tid] = ent; }
        __syncthreads();
        attn_unit<8, false>(bh / NHEAD, bh % NHEAD, j, QIDX_OFF, Q, K, V, PART, LSE, nullptr, shm, wave_s);
    }
}

__device__ __forceinline__ void own_phase(const bf16* Q, const bf16* K, const bf16* V, const bf16* PART, const float* LSE, bf16* O, char* shm, int G, int bx, int wave_s) {
    for (int u = bx; u < BATCH * NHEAD * NQB; u += G) { const int bh = u >> 5, qb = u & 31;
        attn_unit<8, true>(bh / NHEAD, bh % NHEAD, qb, 0, Q, K, V, (bf16*)PART, (float*)LSE, O, shm, wave_s); }
}
#undef SBAR
#undef WAIT_BAR
}

constexpr int NWAVES = 8;
constexpr int NB = 4, SEQ = 8192, T = NB * SEQ, D = 1024;
constexpr int D_SSM = 512, NG = 32, NS = 64;
constexpr int D_ATT = 512;
constexpr int D_IN = 4096;
constexpr int PH = 8, PQD = 256, NEXP = 16384;
constexpr int D_PLE = 256;
constexpr float EPS = 1e-6f;

constexpr size_t MiB = 1u << 20, KiB = 1u << 10;
constexpr size_t WS_CTL = 0, CTL_ZERO_BYTES = 1 * MiB;
constexpr int CW_BAR = 4096;
constexpr size_t CTL_KMEAN = 64 * KiB;
constexpr size_t CTL_SS1 = 320 * KiB;
constexpr size_t CTL_SS3 = 448 * KiB;
constexpr size_t WS_WIN = 1 * MiB;
constexpr size_t WS_WGLU = 9 * MiB;
constexpr size_t WS_WPS = 9 * MiB + 512 * KiB;
constexpr size_t WS_WPA = 10 * MiB + 512 * KiB;
constexpr size_t WS_WOUT = 11 * MiB + 512 * KiB;
constexpr size_t WS_WS = 13 * MiB + 512 * KiB;
constexpr size_t WS_WGATE = 17 * MiB + 512 * KiB;
constexpr size_t WS_WPP = 19 * MiB + 512 * KiB;
constexpr size_t WS_ROPE = 20 * MiB;
constexpr size_t WS_S5P = 22 * MiB;
constexpr size_t WS_RS2 = 23 * MiB;
constexpr size_t WS_UT = 24 * MiB;
constexpr size_t WS_S5W = 40 * MiB;
constexpr size_t WS_VT = 40 * MiB;
constexpr size_t WS_SU = 48 * MiB, WS_SV = 48 * MiB + 64 * KiB;
constexpr size_t WS_X8 = 56 * MiB;
constexpr size_t WS_XN = 88 * MiB;
constexpr size_t WS_MSUB = 88 * MiB, WS_MCNT = 104 * MiB, WS_MLSE = 105 * MiB;
constexpr size_t WS_YP = 112 * MiB;
constexpr size_t WS_PB = 152 * MiB;
constexpr size_t WS_E = 168 * MiB;
constexpr size_t WS_U = 232 * MiB;
constexpr size_t WS_Q = 264 * MiB;
constexpr size_t WS_K = 296 * MiB;
constexpr size_t WS_V = 328 * MiB;
constexpr size_t WS_SGA = 360 * MiB;
constexpr size_t WS_SGB = 424 * MiB;
constexpr size_t WS_SC = 232 * MiB;
constexpr size_t WS_HLOC = 488 * MiB;
constexpr size_t WS_END = 496 * MiB;
constexpr size_t S5_ABR = 0, S5_ABI = 8 * KiB, S5_ALR = 16 * KiB, S5_ALI = 24 * KiB;
constexpr size_t S5_BRE = 32 * KiB, S5_BIM = 160 * KiB;
constexpr size_t S5_CM = 288 * KiB;

constexpr int RING_OFF = 0, RING_BYTES = 131072;
constexpr int LDSCTL_OFF = RING_BYTES, MISC_OFF = LDSCTL_OFF + 320;
constexpr int LDS_BYTES = 147456;

#define GAS __attribute__((address_space(1)))
#define LAS __attribute__((address_space(3)))
typedef unsigned short bf16;
typedef unsigned v4u __attribute__((ext_vector_type(4)));
typedef unsigned v2u __attribute__((ext_vector_type(2)));
typedef float f32x4 __attribute__((ext_vector_type(4)));
typedef float f32x2 __attribute__((ext_vector_type(2)));
typedef short bf16x8 __attribute__((ext_vector_type(8)));
using pg8::shx; using pg8::bperm; using pg8::bpermi; using pg8::lane_id_opaque;
using pg8::pkbf; using pg8::bflo; using pg8::bfhi; using pg8::gelu_tanh; using pg8::sigmoidf_;
#define LDS_WAIT() asm volatile("s_waitcnt lgkmcnt(0)" ::: "memory")

#define XB_TMO      128
#define XB_XCNT(j)  (256  + 64 * (j))
#define XB_XSUB(j)  (1280 + 64 * (j))
#define XB_XGEN(j)  (2304 + 64 * (j))
#define XB_TOP      3328
#define XB_TOPGEN   3392
#define XCD_BAR_WORDS 3456
#define XB_SPIN_CAP (1u << 22)
__device__ __forceinline__ unsigned xb_ld(unsigned* p)              { return __hip_atomic_load(p, __ATOMIC_RELAXED, __HIP_MEMORY_SCOPE_AGENT); }
__device__ __forceinline__ unsigned xb_add(unsigned* p, unsigned v) { return __hip_atomic_fetch_add(p, v, __ATOMIC_RELAXED, __HIP_MEMORY_SCOPE_AGENT); }
__device__ __forceinline__ unsigned xb_xcc_id() { return (unsigned)__builtin_amdgcn_s_getreg((3 << 11) | 20) & 0xFu; }
#define XB_SPIN(cond, bar) do { unsigned _sp = 0; while (cond) { __builtin_amdgcn_s_sleep(1); \
    if ((++_sp & 255u) == 0u) { if (xb_ld(&(bar)[XB_TMO])) break; if (_sp > XB_SPIN_CAP) { atomicAdd(&(bar)[XB_TMO], 1u); break; } } } } while (0)
struct XcdBarrier { unsigned* bar; unsigned x; volatile LAS unsigned* st; };
__device__ __forceinline__ bool is_thread0(int wave_s) { return wave_s == 0 && lane_id_opaque() == 0; }
__device__ __forceinline__ XcdBarrier xcd_barrier_post(unsigned* bar, volatile LAS unsigned* st, int wave_s) {
    XcdBarrier b; b.bar = bar; b.x = xb_xcc_id(); b.st = st;
    if (is_thread0(wave_s)) (void)xb_add(&bar[XB_XCNT(b.x)], 1u);
    return b;
}
__device__ __forceinline__ void xcd_barrier_complete(unsigned* bar, unsigned x, unsigned& nloc, unsigned& nx) {
    const unsigned G = gridDim.x * gridDim.y * gridDim.z;
    unsigned sum, cnt, mine, sp = 0u;
    for (;;) {
        sum = 0u; cnt = 0u; mine = 0u;
#pragma unroll
        for (unsigned j = 0; j < 16; ++j) { const unsigned c = xb_ld(&bar[XB_XCNT(j)]); sum += c; cnt += (c > 0u) ? 1u : 0u; mine = (j == x) ? c : mine; }
        if (sum == G) break;
        __builtin_amdgcn_s_sleep(1);
        if ((++sp & 255u) == 0u) { if (xb_ld(&bar[XB_TMO])) break; if (sp > XB_SPIN_CAP) { atomicAdd(&bar[XB_TMO], 1u); break; } }
    }
    nloc = mine > 0u ? mine : 1u; nx = cnt > 0u ? cnt : 1u;
}
__device__ __forceinline__ void xcd_barrier(const XcdBarrier& b, int wave_s) {
    asm volatile("s_waitcnt vmcnt(0)" ::: "memory");
    __syncthreads();
    if (is_thread0(wave_s)) {
        unsigned* bar = b.bar;
        __builtin_amdgcn_s_waitcnt(0);
        unsigned nloc = b.st[0], nx = b.st[1];
        if (nloc == 0u) { xcd_barrier_complete(bar, b.x, nloc, nx); b.st[0] = nloc; b.st[1] = nx; }
        const unsigned old = xb_add(&bar[XB_XSUB(b.x)], 1u);
        const unsigned gen = old / nloc;
        if (old + 1u == (gen + 1u) * nloc) {
            __builtin_amdgcn_fence(__ATOMIC_RELEASE, "agent");
            asm volatile("s_waitcnt vmcnt(0)" ::: "memory");
            const unsigned og = xb_add(&bar[XB_TOP], 1u);
            const unsigned tg = og / nx;
            if (og + 1u == (tg + 1u) * nx) xb_add(&bar[XB_TOPGEN], 1u);
            else XB_SPIN(xb_ld(&bar[XB_TOPGEN]) == tg, bar);
            __builtin_amdgcn_fence(__ATOMIC_ACQUIRE, "agent");
            xb_add(&bar[XB_XGEN(b.x)], 1u);
            asm volatile("s_waitcnt vmcnt(0)" ::: "memory");
        } else {
            XB_SPIN(xb_ld(&bar[XB_XGEN(b.x)]) == gen, bar);
            __builtin_amdgcn_fence(__ATOMIC_ACQUIRE, "agent");
            asm volatile("s_waitcnt vmcnt(0)" ::: "memory");
        }
    }
    __syncthreads();
}

struct Args { const float* in[27]; float* out; unsigned char* ws; };
enum { I_X = 0, I_P, I_POS, I_GMIX, I_WIN, I_LOGDT, I_ARE, I_AIM, I_BRE, I_BIM, I_CRE, I_CIM, I_DSK, I_WGLU, I_WPS, I_WPA, I_WOUT, I_GFFN, I_WQ, I_KEY1, I_KEY2, I_PU, I_PV, I_GPLE, I_WGATE, I_WPP, I_GFIN };

__device__ __forceinline__ float wave_sum(float v, int lane) {
    v += shx<1>(v, lane); v += shx<2>(v, lane); v += shx<4>(v, lane); v += shx<8>(v, lane); v += shx<16>(v, lane); v += shx<32>(v, lane);
    return v;
}

template <bool F8 = false>
__device__ __forceinline__ void p0_transpose_item(const float* W, const float* ks, int K, int N, bf16* WT, LAS float* scr, int item, int lane) {
    const int nblk = N / 32, kb = item / nblk, nb = item % nblk, k0 = 64 * kb, n0 = 32 * nb;
    { f32x4 w4[8]; float sc[8];
#pragma unroll
      for (int i = 0; i < 8; ++i) { const int kk = 8 * i + (lane >> 3); w4[i] = *(const f32x4*)(W + (size_t)(k0 + kk) * N + n0 + 4 * (lane & 7)); sc[i] = ks ? ks[k0 + kk] : 1.0f; }
#pragma unroll
      for (int i = 0; i < 8; ++i) { const int kk = 8 * i + (lane >> 3); LAS float* d = scr + kk * 33 + 4 * (lane & 7); d[0] = w4[i][0] * sc[i]; d[1] = w4[i][1] * sc[i]; d[2] = w4[i][2] * sc[i]; d[3] = w4[i][3] * sc[i]; } }
    LDS_WAIT(); asm volatile("" ::: "memory");
    const int c = lane & 7;
#pragma unroll
    for (int j = 0; j < 4; ++j) { const int n = (lane >> 3) + 8 * j; const LAS float* s = scr + (8 * c) * 33 + n;
        if (F8) { constexpr float sc8 = (float)(1 << pg8::W8_SHIFT); v2u o; o.x = pg8::pkf8(s[0 * 33] * sc8, s[1 * 33] * sc8, s[2 * 33] * sc8, s[3 * 33] * sc8); o.y = pg8::pkf8(s[4 * 33] * sc8, s[5 * 33] * sc8, s[6 * 33] * sc8, s[7 * 33] * sc8);
            *(v2u*)((unsigned char*)WT + (size_t)(n0 + n) * K + k0 + 8 * c) = o; }
        else { v4u o; o.x = pkbf(s[0 * 33], s[1 * 33]); o.y = pkbf(s[2 * 33], s[3 * 33]); o.z = pkbf(s[4 * 33], s[5 * 33]); o.w = pkbf(s[6 * 33], s[7 * 33]);
            *(v4u*)(WT + (size_t)(n0 + n) * K + k0 + 8 * c) = o; } }
    LDS_WAIT(); asm volatile("" ::: "memory");
}

__device__ __forceinline__ void cs_reduced(double ang, float& c, float& s) {
    const double r = ang * 0.15915494309189535; double fr = r - floor(r); if (fr > 0.5) fr -= 1.0;
    const float y = (float)(fr * 6.283185307179586);
    c = cosf(y); s = sinf(y);
}

__device__ __forceinline__ void p0_ws_item(const float* Wq, const float* gffn, const float* key1, const float* key2, bf16* WsT, LAS unsigned char* lds, int item, int tid) {
    constexpr int P = 132;
    LAS float* wq = (LAS float*)lds;
    LAS float* ky = (LAS float*)(lds + 64 * P * 4);
    const int hh = item >> 4, kb = item & 15, h = hh >> 1, half = hh & 1, k0 = 64 * kb;
    const float* keys = (half ? key2 : key1) + (size_t)h * 128 * 128;
#pragma unroll
    for (int i = 0; i < 4; ++i) { const int idx = tid + 512 * i, kk = idx >> 5, d4 = idx & 31;
        f32x4 v = *(const f32x4*)(Wq + (size_t)(k0 + kk) * 2048 + h * 256 + half * 128 + 4 * d4); v = v * gffn[k0 + kk];
        *(LAS f32x4*)(wq + kk * P + 4 * d4) = v; }
#pragma unroll
    for (int i = 0; i < 8; ++i) { const int idx = tid + 512 * i, n = idx >> 5, d4 = idx & 31;
        *(LAS f32x4*)(ky + n * P + 4 * d4) = *(const f32x4*)(keys + (size_t)n * 128 + 4 * d4); }
    __syncthreads();
    const int kq = tid & 15, nq = tid >> 4;
    float acc[4][4];
#pragma unroll
    for (int a = 0; a < 4; ++a)
#pragma unroll
        for (int b = 0; b < 4; ++b) acc[a][b] = 0.f;
    for (int d4 = 0; d4 < 32; ++d4) {
        f32x4 wv[4], kv[4];
#pragma unroll
        for (int a = 0; a < 4; ++a) { wv[a] = *(const LAS f32x4*)(wq + (4 * kq + a) * P + 4 * d4); kv[a] = *(const LAS f32x4*)(ky + (4 * nq + a) * P + 4 * d4); }
#pragma unroll
        for (int a = 0; a < 4; ++a)
#pragma unroll
            for (int b = 0; b < 4; ++b)
                acc[a][b] += (kv[a][0] * wv[b][0] + kv[a][1] * wv[b][1]) + (kv[a][2] * wv[b][2] + kv[a][3] * wv[b][3]);
    }
#pragma unroll
    for (int a = 0; a < 4; ++a) { v2u o; o.x = pkbf(acc[a][0], acc[a][1]); o.y = pkbf(acc[a][2], acc[a][3]);
        *(v2u*)(WsT + (size_t)(h * 256 + half * 128 + 4 * nq + a) * 1024 + k0 + 4 * kq) = o; }
    __syncthreads();
}

namespace s5 {
constexpr long YP8_DELTA = (long)WS_MSUB - (long)WS_YP;
constexpr int L = 64, NCH = SEQ / L, HP = 136, XP = 132;
constexpr int X_BYTES = 16 * XP * 4, WAVE_LDS = X_BYTES + 16 * HP * 2;
constexpr int ITEMS_PER_BG = 8, CH_STRIDE = NCH / ITEMS_PER_BG;

template <int PASS> struct Loads { v4u uf[4]; v2u uw[4]; float hlr[16], hli[16]; };
constexpr size_t HPLANE = (size_t)NB * NG * NCH * 64;

template <int PASS>
__device__ __forceinline__ void issue(Loads<PASS>& ld, const bf16* Ub, const float* Hb, int ch, int q, int nl, int lane) {
#pragma unroll
    for (int blk = 0; blk < 4; ++blk) { ld.uf[blk] = *(const v4u*)(Ub + (blk * 16 + nl) * 16 + 8 * (q & 1));
        if (PASS == 2) ld.uw[blk] = *(const v2u*)(Ub + (blk * 16 + nl) * 16 + 4 * q); }
    if (PASS == 2) {
#pragma unroll
        for (int j = 0; j < 16; ++j) { const int c = ch - 16 + j; const float* hp = Hb + (size_t)(c < 0 ? 0 : c) * 64 + lane; ld.hlr[j] = hp[0]; ld.hli[j] = hp[HPLANE]; }
    }
}

template <int PASS>
__device__ __forceinline__ void run(LAS unsigned char* ldsw, const unsigned char* s5p, const bf16* U, float* Hloc, const float* dskip, bf16* YP, int gw, int ngw, int lane) {
    const int q = lane >> 4, nl = lane & 15;
    LAS float* Xt = (LAS float*)ldsw;
    LAS bf16* Ht = (LAS bf16*)(ldsw + X_BYTES);
    for (int wv = gw; wv < NB * NG * CH_STRIDE; wv += ngw) {
        const int g = wv & 31, b = (wv >> 5) & 3, ch0 = wv >> 7;
        bf16x8 af[8];
#pragma unroll
        for (int j = 0; j < 8; ++j) {
            const float* src = (const float*)(s5p + (j < 4 ? S5_BRE : S5_BIM)) + (size_t)(g * 64 + 16 * (j & 3) + nl) * 16 + 8 * (q & 1);
            const f32x4 a = *(const f32x4*)src, bb = *(const f32x4*)(src + 4);
            v4u w = pg8::pack8(a, bb); if (q >= 2) w = (v4u){0u, 0u, 0u, 0u};
            af[j] = __builtin_bit_cast(bf16x8, w);
        }
        const float ar = ((const float*)(s5p + S5_ABR))[g * 64 + lane], ai = ((const float*)(s5p + S5_ABI))[g * 64 + lane];
        const float aLr = ((const float*)(s5p + S5_ALR))[g * 64 + lane], aLi = ((const float*)(s5p + S5_ALI))[g * 64 + lane];
        bf16x8 cf[4]; float dsk[4];
        if (PASS == 2) {
#pragma unroll
            for (int kk = 0; kk < 4; ++kk) cf[kk] = *(const bf16x8*)((const bf16*)(s5p + S5_CM) + (size_t)(g * 16 + nl) * 128 + 32 * kk + 8 * q);
#pragma unroll
            for (int r = 0; r < 4; ++r) dsk[r] = dskip[g * 16 + 4 * q + r];
        }
        const bf16* Ubg = U + (size_t)(b * 32 + g) * SEQ * 16;
        float* Hbg = Hloc + (size_t)(b * 32 + g) * NCH * 64;
        float cr = 0.f, ci = 0.f;
        Loads<PASS> cur, nxt;
        issue<PASS>(cur, Ubg + (size_t)ch0 * L * 16, Hbg, ch0, q, nl, lane);
#pragma unroll 1
        for (int i = 0; i < ITEMS_PER_BG; ++i) {
            const int ch = ch0 + CH_STRIDE * i;
            if (i + 1 < ITEMS_PER_BG) issue<PASS>(nxt, Ubg + (size_t)(ch + CH_STRIDE) * L * 16, Hbg, ch + CH_STRIDE, q, nl, lane);
            float hr = 0.f, hi = 0.f;
            if (PASS == 2) {
#pragma unroll
                for (int j = 0; j < 16; ++j) { const bool ok = (ch - 16 + j) >= 0; const float lr = ok ? cur.hlr[j] : 0.f, li = ok ? cur.hli[j] : 0.f;
                    const float ncr = fmaf(aLr, cr, fmaf(-aLi, ci, lr)), nci = fmaf(aLr, ci, fmaf(aLi, cr, li)); cr = ok ? ncr : cr; ci = ok ? nci : ci; }
                hr = cr; hi = ci;
            }
#pragma unroll
            for (int blk = 0; blk < L / 16; ++blk) {
                v4u uw4 = cur.uf[blk]; if (q >= 2) uw4 = (v4u){0u, 0u, 0u, 0u};
                const bf16x8 uf = __builtin_bit_cast(bf16x8, uw4);
#pragma unroll
                for (int j = 0; j < 8; ++j) { const f32x4 d = __builtin_amdgcn_mfma_f32_16x16x32_bf16(af[j], uf, (f32x4){0.f, 0.f, 0.f, 0.f}, 0, 0, 0);
                    *(LAS f32x4*)(Xt + nl * XP + 16 * j + 4 * q) = d; }
#pragma unroll
                for (int tt = 0; tt < 16; ++tt) {
                    const float xr = Xt[tt * XP + lane], xi = Xt[tt * XP + 64 + lane];
                    const float nhr = fmaf(ar, hr, fmaf(-ai, hi, xr)), nhi = fmaf(ar, hi, fmaf(ai, hr, xi));
                    hr = nhr; hi = nhi;
                    if (PASS == 2) { const unsigned pw = pkbf(hr, hi); Ht[tt * HP + lane] = (bf16)(pw & 0xffffu); Ht[tt * HP + 64 + lane] = (bf16)(pw >> 16); }
                }
                if (PASS == 2) {
                    f32x4 acc = {0.f, 0.f, 0.f, 0.f};
#pragma unroll
                    for (int kk = 0; kk < 4; ++kk) { const bf16x8 hf = *(const LAS bf16x8*)(Ht + nl * HP + 32 * kk + 8 * q);
                        acc = __builtin_amdgcn_mfma_f32_16x16x32_bf16(cf[kk], hf, acc, 0, 0, 0); }
                    const int tl = blk * 16 + nl;
                    const v2u uw = cur.uw[blk];
                    const float y0 = gelu_tanh(acc[0] + dsk[0] * bflo(uw.x)), y1 = gelu_tanh(acc[1] + dsk[1] * bfhi(uw.x));
                    const float y2 = gelu_tanh(acc[2] + dsk[2] * bflo(uw.y)), y3 = gelu_tanh(acc[3] + dsk[3] * bfhi(uw.y));
                    v2u o; o.x = pkbf(y0, y1); o.y = pkbf(y2, y3);
                    *(v2u*)(YP + ((size_t)b * SEQ + (size_t)ch * L + tl) * 512 + g * 16 + 4 * q) = o;
                    *(unsigned*)((unsigned char*)YP + YP8_DELTA + ((size_t)b * SEQ + (size_t)ch * L + tl) * 512 + g * 16 + 4 * q) = pg8::pkf8(y0, y1, y2, y3);
                }
            }
            if (PASS == 1) { Hbg[(size_t)ch * 64 + lane] = hr; Hbg[HPLANE + (size_t)ch * 64 + lane] = hi; }
            cur = nxt;
        }
    }
}


__device__ __forceinline__ void pass1_gemm(LAS unsigned char* lds, const bf16* W, const bf16* U, float* Hloc, int G, int bx, int tid, int wave) {
    constexpr int PITCH = 528, A_OFF = 0, B_OFF = 128 * PITCH;
    const int lane = tid & 63, fr = lane & 15, fq = lane >> 4;
    for (int task = bx; task < NG * 8; task += G) {
        const int g = task >> 3, c8 = task & 7, b = c8 >> 1, ch0 = 64 * (c8 & 1);
        const bf16* Wg = W + (size_t)g * 128 * 1024;
        const bf16* Ub = U + ((size_t)(b * 32 + g) * SEQ + (size_t)ch0 * L) * 16;
        f32x4 acc[4];
#pragma unroll
        for (int nt = 0; nt < 4; ++nt) acc[nt] = (f32x4){0.f, 0.f, 0.f, 0.f};
#pragma unroll 1
        for (int slab = 0; slab < 4; ++slab) {
            v4u ta[8], tb[4];
#pragma unroll
            for (int i = 0; i < 8; ++i) { const int p = tid + 512 * i; ta[i] = *(const v4u*)((const unsigned char*)Wg + (size_t)(p >> 5) * 2048 + slab * 512 + 16 * (p & 31)); }
#pragma unroll
            for (int i = 0; i < 4; ++i) { const int p = tid + 512 * i; tb[i] = *(const v4u*)((const unsigned char*)Ub + (size_t)(p >> 5) * 2048 + slab * 512 + 16 * (p & 31)); }
            __syncthreads();
#pragma unroll
            for (int i = 0; i < 8; ++i) { const int p = tid + 512 * i; *(LAS v4u*)(lds + A_OFF + (p >> 5) * PITCH + 16 * (p & 31)) = ta[i]; }
#pragma unroll
            for (int i = 0; i < 4; ++i) { const int p = tid + 512 * i; *(LAS v4u*)(lds + B_OFF + (p >> 5) * PITCH + 16 * (p & 31)) = tb[i]; }
            __syncthreads();
#pragma unroll
            for (int kk = 0; kk < 8; ++kk) { const bf16x8 wf = *(const LAS bf16x8*)(lds + A_OFF + (16 * wave + fr) * PITCH + 64 * kk + 16 * fq);
#pragma unroll
                for (int nt = 0; nt < 4; ++nt) { const bf16x8 uf = *(const LAS bf16x8*)(lds + B_OFF + (16 * nt + fr) * PITCH + 64 * kk + 16 * fq); acc[nt] = __builtin_amdgcn_mfma_f32_16x16x32_bf16(wf, uf, acc[nt], 0, 0, 0); } }
        }
        const int np = 16 * wave + 4 * fq;
        float* Hp = Hloc + (size_t)(np >> 6) * HPLANE + ((size_t)(b * 32 + g) * NCH + ch0 + fr) * 64 + (np & 63);
#pragma unroll
        for (int nt = 0; nt < 4; ++nt) *(f32x4*)(Hp + (size_t)(16 * nt) * 64) = acc[nt];
        __syncthreads();
    }
}
}

namespace peer {
template <int M> __device__ __forceinline__ int shxi(int v, int lane) { return __builtin_bit_cast(int, shx<M>(__builtin_bit_cast(float, v), lane)); }
__device__ __forceinline__ float hmax32(float m, int lane) { m = fmaxf(m, shx<1>(m, lane)); m = fmaxf(m, shx<2>(m, lane)); m = fmaxf(m, shx<4>(m, lane)); m = fmaxf(m, shx<8>(m, lane)); m = fmaxf(m, shx<16>(m, lane)); return m; }
__device__ __forceinline__ unsigned f2o(float f) { const unsigned b = __float_as_uint(f); return b ^ ((unsigned)((int)b >> 31) | 0x80000000u); }
__device__ __forceinline__ float o2f(unsigned k) { return __uint_as_float(k ^ ((~(unsigned)((int)k >> 31)) | 0x80000000u)); }
template <int CTRL> __device__ __forceinline__ unsigned dppmax(unsigned x) { const unsigned y = (unsigned)__builtin_amdgcn_update_dpp(0, (int)x, CTRL, 0xf, 0xf, true); return x > y ? x : y; }
__device__ __forceinline__ unsigned rowmax16(unsigned x) { x = dppmax<0xB1>(x); x = dppmax<0x4E>(x); x = dppmax<0x141>(x); x = dppmax<0x140>(x); return x; }
__device__ __forceinline__ unsigned wrlane(unsigned v, unsigned val, int sel) { unsigned keep;
    asm("s_mov_b32 %1, m0\n\ts_mov_b32 m0, %3\n\ts_nop 0\n\tv_writelane_b32 %0, %2, m0\n\ts_mov_b32 m0, %1" : "+v"(v), "=&s"(keep) : "s"(val), "s"(sel)); return v; }
__device__ __forceinline__ void cex(unsigned& a, unsigned& b) { const unsigned hi = a > b ? a : b, lo = a > b ? b : a; a = hi; b = lo; }
__device__ __forceinline__ unsigned qpack4(const f32x4 v, float inv, int ob) { const int a = (int)rintf(v[0] * inv) + ob, b = (int)rintf(v[1] * inv) + ob, c = (int)rintf(v[2] * inv) + ob, d = (int)rintf(v[3] * inv) + ob;
    return ((unsigned)a & 0xffu) | (((unsigned)b & 0xffu) << 8) | (((unsigned)c & 0xffu) << 16) | (((unsigned)d & 0xffu) << 24); }
__device__ __forceinline__ float sel8(const float (&a)[8], int h) { float r = a[0];
#pragma unroll
    for (int q = 1; q < 8; ++q) r = (h == q) ? a[q] : r;
    return r; }
__device__ __forceinline__ unsigned sel8u(const unsigned (&a)[8], int h) { unsigned r = a[0];
#pragma unroll
    for (int q = 1; q < 8; ++q) r = (h == q) ? a[q] : r;
    return r; }

struct Pre { v2u sc[8]; v4u xr[2]; };
__device__ __forceinline__ void load_pre(Pre& p, const float* S, const bf16* XB, int tkn, int lane) {
    const v2u* Sp = (const v2u*)((const bf16*)S + (size_t)tkn * 2048) + lane;
#pragma unroll
    for (int h = 0; h < 8; ++h) p.sc[h] = Sp[64 * h];
    const v4u* xp = (const v4u*)(XB + (size_t)tkn * 1024 + lane * 16);
    p.xr[0] = xp[0]; p.xr[1] = xp[1];
}

struct Row4 { f32x4 v[4]; };
__device__ __forceinline__ void load_row(Row4& r, const float* src, int lane) {
#pragma unroll
    for (int j = 0; j < 4; ++j) r.v[j] = *(const f32x4*)(src + 256 * j + 4 * lane); }
__device__ __forceinline__ void load_row16(Row4& r, const float* src, int lane) {
#pragma unroll
    for (int j = 0; j < 4; ++j) r.v[j] = *(const f32x4*)(src + 16 * lane + 4 * j); }
__device__ __forceinline__ void quant_row(const Row4& r, const f32x4 (&gf)[4], bool use_gf, unsigned char* dst, float* scale_out, bool offset_binary, int lane) {
    f32x4 v[4]; float m = 0.f;
#pragma unroll
    for (int j = 0; j < 4; ++j) { v[j] = r.v[j]; if (use_gf) v[j] = v[j] * gf[j];
        m = fmaxf(fmaxf(m, fmaxf(fabsf(v[j][0]), fabsf(v[j][1]))), fmaxf(fabsf(v[j][2]), fabsf(v[j][3]))); }
    m = hmax32(m, lane); m = fmaxf(m, shx<32>(m, lane));
    const float inv = m > 0.f ? 127.0f / m : 0.f; const int ob = offset_binary ? 128 : 0;
#pragma unroll
    for (int j = 0; j < 4; ++j) *(unsigned*)(dst + 256 * j + 4 * lane) = qpack4(v[j], inv, ob);
    if (lane == 0) *scale_out = m * (1.0f / 127.0f);
}
__device__ __forceinline__ void quant_row4(Row4 r, const f32x4 (&gf)[4], bool use_gf, unsigned char* dst, float* scale_out, int lane, bool signed_hi = false) {
    if (use_gf) {
#pragma unroll
        for (int j = 0; j < 4; ++j) r.v[j] = r.v[j] * gf[j]; }
    float ssq = 0.f;
#pragma unroll
    for (int j = 0; j < 4; ++j) ssq += (r.v[j][0] * r.v[j][0] + r.v[j][1] * r.v[j][1]) + (r.v[j][2] * r.v[j][2] + r.v[j][3] * r.v[j][3]);
    ssq = wave_sum(ssq, lane);
    const float step = 0.3352f * sqrtf(ssq * (1.0f / 1024.0f)), inv = step > 0.f ? 1.0f / step : 0.f;
    v2u o;
#pragma unroll
    for (int g = 0; g < 2; ++g) { unsigned w = 0u;
#pragma unroll
        for (int j = 0; j < 4; ++j) { const int a = (int)floorf(r.v[2 * g][j] * inv) + 8, b = (int)floorf(r.v[2 * g + 1][j] * inv) + 8;
            const unsigned lo4 = (unsigned)(a < 0 ? 0 : a > 15 ? 15 : a); unsigned hi4 = (unsigned)(b < 0 ? 0 : b > 15 ? 15 : b); if (signed_hi) hi4 = (hi4 - 8u) & 15u; w |= (lo4 | (hi4 << 4)) << (8 * j); }
        if (g == 0) o.x = w; else o.y = w; }
    *(v2u*)(dst + 16 * lane) = o;
    if (lane == 0) *scale_out = step;
}
}

namespace peer {
struct TK { unsigned eidP0, eidP1; float cAP0, cAP1, cBP0, cBP1; };

__device__ __forceinline__ void sort8(unsigned (&v)[8]) {
    cex(v[0], v[1]); cex(v[2], v[3]); cex(v[4], v[5]); cex(v[6], v[7]); cex(v[0], v[2]); cex(v[1], v[3]); cex(v[4], v[6]); cex(v[5], v[7]);
    cex(v[1], v[2]); cex(v[5], v[6]); cex(v[0], v[4]); cex(v[3], v[7]); cex(v[1], v[5]); cex(v[2], v[6]); cex(v[1], v[4]); cex(v[3], v[6]); cex(v[2], v[4]); cex(v[3], v[5]); cex(v[3], v[4]);
}
__device__ __forceinline__ float rowsum16(float x) {
#define PEER_RS(CTRL) x += __builtin_bit_cast(float, __builtin_amdgcn_update_dpp(0, __builtin_bit_cast(int, x), CTRL, 0xf, 0xf, true))
    PEER_RS(0xB1); PEER_RS(0x4E); PEER_RS(0x141); PEER_RS(0x140);
#undef PEER_RS
    return x; }
__device__ __forceinline__ void prep_keys(const Pre& pre, unsigned (&kk)[4][8], int hl) {
#pragma unroll
    for (int p = 0; p < 4; ++p) { const v2u wa = pre.sc[2 * p], wb = pre.sc[2 * p + 1];
        const f32x4 sa = {pg8::bflo(wa.x), pg8::bfhi(wa.x), pg8::bflo(wa.y), pg8::bfhi(wa.y)}, sb = {pg8::bflo(wb.x), pg8::bfhi(wb.x), pg8::bflo(wb.y), pg8::bfhi(wb.y)};
#pragma unroll
        for (int e = 0; e < 4; ++e) { const unsigned ka = (f2o(sa[e]) & ~127u) | (unsigned)(4 * hl + e), kb = (f2o(sb[e]) & ~127u) | (unsigned)(4 * hl + e);
            const auto r = __builtin_amdgcn_permlane16_swap(ka, kb, false, false);
            kk[p][e] = (unsigned)r[0]; kk[p][4 + e] = (unsigned)r[1]; }
        sort8(kk[p]); }
}
__device__ __forceinline__ void quant_x(const Pre& pre, v4u& xq, float& sx, int& sumx, int lane) {
    f32x4 xf[4]; pg8::unpack8(pre.xr[0], xf[0], xf[1]); pg8::unpack8(pre.xr[1], xf[2], xf[3]);
    float m = 0.f;
#pragma unroll
    for (int e = 0; e < 4; ++e) m = fmaxf(fmaxf(m, fabsf(xf[0][e])), fmaxf(fmaxf(fabsf(xf[1][e]), fabsf(xf[2][e])), fabsf(xf[3][e])));
    unsigned am = rowmax16(__float_as_uint(m)); am = dppmax<0x142>(am); am = dppmax<0x143>(am);
    m = __uint_as_float((unsigned)__builtin_amdgcn_readlane((int)am, 63));
    sx = m * (1.0f / 127.0f); const float inv = m > 0.f ? 127.0f / m : 0.f;
    xq.x = qpack4(xf[0], inv, 0); xq.y = qpack4(xf[1], inv, 0); xq.z = qpack4(xf[2], inv, 0); xq.w = qpack4(xf[3], inv, 0);
    int t = __builtin_amdgcn_sdot4((int)xq.x, 0x01010101, 0, false); t = __builtin_amdgcn_sdot4((int)xq.y, 0x01010101, t, false); t = __builtin_amdgcn_sdot4((int)xq.z, 0x01010101, t, false); t = __builtin_amdgcn_sdot4((int)xq.w, 0x01010101, t, false);
    t += shxi<1>(t, lane); t += shxi<2>(t, lane); t += shxi<4>(t, lane); t += shxi<8>(t, lane); t += shxi<16>(t, lane); t += shxi<32>(t, lane); sumx = t;
}
__device__ __forceinline__ void s1_round(unsigned (&kk)[4][8], unsigned (&mine)[4], bool sel) {
    unsigned x[4];
#pragma unroll
    for (int p = 0; p < 4; ++p) x[p] = rowmax16(kk[p][0]);
#pragma unroll
    for (int p = 0; p < 4; ++p) { const bool win = kk[p][0] == x[p];
#pragma unroll
        for (int j = 0; j < 7; ++j) kk[p][j] = win ? kk[p][j + 1] : kk[p][j];
        kk[p][7] = win ? 0u : kk[p][7];
        mine[p] = sel ? x[p] : mine[p]; }
}
__device__ __forceinline__ void s2_setup(const unsigned (&mine)[4], unsigned (&MA)[2], unsigned (&MB)[2], unsigned (&ck)[2][4], unsigned (&top)[2], unsigned ciP, unsigned cjP, int li) {
#pragma unroll
    for (int q = 0; q < 2; ++q) { const auto r = __builtin_amdgcn_permlane32_swap(mine[2 * q], mine[2 * q + 1], false, false);
        MA[q] = (unsigned)r[0]; MB[q] = (unsigned)r[1];
#pragma unroll
        for (int k = 0; k < 4; ++k) { const int la = (int)((ciP >> (8 * k)) & 255u), lb = (int)((cjP >> (8 * k)) & 255u);
            const float av = o2f((unsigned)bpermi((int)MA[q], la)), bv = o2f((unsigned)bpermi((int)MB[q], lb));
            const int c = li + 16 * k;
            ck[q][k] = (c < 50) ? ((f2o(av + bv) & ~63u) | (unsigned)c) : 0u; }
        cex(ck[q][0], ck[q][1]); cex(ck[q][2], ck[q][3]); cex(ck[q][0], ck[q][2]); cex(ck[q][1], ck[q][3]); cex(ck[q][1], ck[q][2]);
        top[q] = 0u; }
}
__device__ __forceinline__ void s2_round(unsigned (&ck)[2][4], unsigned (&top)[2], bool sel) {
    unsigned x[2];
#pragma unroll
    for (int q = 0; q < 2; ++q) x[q] = rowmax16(ck[q][0]);
#pragma unroll
    for (int q = 0; q < 2; ++q) { const bool win = ck[q][0] == x[q];
        ck[q][0] = win ? ck[q][1] : ck[q][0]; ck[q][1] = win ? ck[q][2] : ck[q][1]; ck[q][2] = win ? ck[q][3] : ck[q][2]; ck[q][3] = win ? 0u : ck[q][3];
        top[q] = sel ? x[q] : top[q]; }
}
__device__ __forceinline__ void finalize(const unsigned (&top)[2], const unsigned (&MA)[2], const unsigned (&MB)[2], int cij, float rs1, float sx, const float* SU, const float* SV, int lane, TK& o) {
    const int rb = lane & 48;
    unsigned ex_id[2]; float gate[2], su[2], sv[2];
#pragma unroll
    for (int q = 0; q < 2; ++q) { const int c = (int)(top[q] & 63u); const int t = bpermi(cij, c); const int ci = t & 255, cj = t >> 8;
        const unsigned e1 = (unsigned)bpermi((int)MA[q], rb + ci) & 127u, e2 = (unsigned)bpermi((int)MB[q], rb + cj) & 127u; ex_id[q] = e1 * 128u + e2; }
#pragma unroll
    for (int q = 0; q < 2; ++q) { su[q] = SU[ex_id[q]]; sv[q] = SV[ex_id[q]]; }
#pragma unroll
    for (int q = 0; q < 2; ++q) { const float topf = o2f(top[q]), mx = o2f(rowmax16(top[q]));
        const float ex = __expf(topf - mx); const float sm = rowsum16(ex);
        gate[q] = ex * __builtin_amdgcn_rcpf(fmaxf(sm, 1e-30f)); }
    o.eidP0 = ex_id[0]; o.eidP1 = ex_id[1];
    o.cAP0 = 0.5f * rs1 * sx * su[0]; o.cAP1 = 0.5f * rs1 * sx * su[1];
    o.cBP0 = gate[0] * sv[0]; o.cBP1 = gate[1] * sv[1];
}
#define PEER_ROWUV(id) __builtin_amdgcn_raw_buffer_load_b128(rsUV, lo, (int)((id) * 1024u), 0)
__device__ __forceinline__ void load_t_head(v4u (&tq)[16], unsigned esrc, int l0, __amdgpu_buffer_rsrc_t rsUV, int lo) {
#pragma unroll
    for (int e = 0; e < 16; ++e) { const unsigned id = (unsigned)__builtin_amdgcn_readlane((int)esrc, l0 + e); tq[e] = PEER_ROWUV(id); }
}
struct GH { int p[16]; int cq; float cscale; int accI[16]; int sumcq; };
template <bool NEXTU>
__device__ __forceinline__ void gh_a(GH& g, int h, const TK& t, const v4u xq, v4u (&tq)[16], v2u (&vq)[16], __amdgpu_buffer_rsrc_t rsUV, int lo) {
#pragma unroll
    for (int e = 0; e < 16; ++e) { int d = __builtin_amdgcn_sdot4((int)(tq[e].x & 0x0f0f0f0fu), (int)xq.x, 0, false); d = __builtin_amdgcn_sdot4((int)((tq[e].x >> 4) & 0x0f0f0f0fu), (int)xq.y, d, false);
        d = __builtin_amdgcn_sdot4((int)(tq[e].y & 0x0f0f0f0fu), (int)xq.z, d, false); g.p[e] = __builtin_amdgcn_sdot4((int)((tq[e].y >> 4) & 0x0f0f0f0fu), (int)xq.w, d, false);
        vq[e].x = tq[e].z; vq[e].y = tq[e].w; }
    if (NEXTU) { const unsigned en = (h + 1 < 4) ? t.eidP0 : t.eidP1; load_t_head(tq, en, ((h + 1) & 3) * 16, rsUV, lo); }
}
__device__ __forceinline__ void gh_b(GH& g, int h, const TK& t, int lane, int sumx) {
    const float cAh = (h < 4) ? t.cAP0 : t.cAP1, cBh = (h < 4) ? t.cBP0 : t.cBP1; const int l0 = (h & 3) * 16;
    int q8[8], r4[4], s2[2], s1;
#pragma unroll
    for (int e = 0; e < 8; ++e) { const auto r = __builtin_amdgcn_permlane32_swap(g.p[e], g.p[e + 8], false, false); q8[e] = (int)r[0] + (int)r[1]; }
#pragma unroll
    for (int e = 0; e < 4; ++e) { const auto r = __builtin_amdgcn_permlane16_swap(q8[e], q8[e + 4], false, false); r4[e] = (int)r[0] + (int)r[1]; }
    { const bool up = (lane & 8) != 0;
#pragma unroll
      for (int e = 0; e < 2; ++e) { const int send = up ? r4[e] : r4[e + 2], keep = up ? r4[e + 2] : r4[e]; s2[e] = keep + __builtin_amdgcn_update_dpp(0, send, 0x128, 0xf, 0xf, true); } }
    { const bool up = (lane & 4) != 0; const int send = up ? s2[0] : s2[1], keep = up ? s2[1] : s2[0];
      int recv = __builtin_amdgcn_update_dpp(send, send, 0x104, 0xf, 0x5, false); recv = __builtin_amdgcn_update_dpp(recv, send, 0x114, 0xf, 0xa, false);
      s1 = keep + recv; }
    s1 += __builtin_amdgcn_update_dpp(0, s1, 0x4E, 0xf, 0xf, true); s1 += __builtin_amdgcn_update_dpp(0, s1, 0xB1, 0xf, 0xf, true);
    const int eb = lane >> 2;
    const float cf = bperm(cBh, l0 + eb) * gelu_tanh((float)(2 * s1 - 15 * sumx) * bperm(cAh, l0 + eb));
    unsigned am = rowmax16(__float_as_uint(cf) & 0x7fffffffu); am = dppmax<0x142>(am); am = dppmax<0x143>(am);
    const float amax = __uint_as_float((unsigned)__builtin_amdgcn_readlane((int)am, 63));
    const float cinv = amax > 0.f ? 127.0f / amax : 0.f; g.cscale = amax * (1.0f / 127.0f);
    g.cq = (int)rintf(cf * cinv);
#pragma unroll
    for (int i = 0; i < 16; ++i) g.accI[i] = 0;
    g.sumcq = 0;
}
template <int GQ0>
__device__ __forceinline__ void gh_c(GH& g, const v2u (&vq)[16]) {
#pragma unroll
    for (int gq = GQ0; gq < GQ0 + 2; ++gq) {
        const int q0 = __builtin_amdgcn_readlane(g.cq, 16 * gq), q1 = __builtin_amdgcn_readlane(g.cq, 16 * gq + 4), q2 = __builtin_amdgcn_readlane(g.cq, 16 * gq + 8), q3 = __builtin_amdgcn_readlane(g.cq, 16 * gq + 12);
        g.sumcq += (q0 + q1) + (q2 + q3);
        const int cw = (int)(((unsigned)q0 & 0xffu) | (((unsigned)q1 & 0xffu) << 8) | (((unsigned)q2 & 0xffu) << 16) | (((unsigned)q3 & 0xffu) << 24));
#pragma unroll
        for (int wg = 0; wg < 2; ++wg) {
            const unsigned r0 = wg ? vq[4 * gq].y : vq[4 * gq].x, r1 = wg ? vq[4 * gq + 1].y : vq[4 * gq + 1].x, r2 = wg ? vq[4 * gq + 2].y : vq[4 * gq + 2].x, r3 = wg ? vq[4 * gq + 3].y : vq[4 * gq + 3].x;
            const unsigned t0 = __builtin_amdgcn_perm(r1, r0, 0x05010400u), t1 = __builtin_amdgcn_perm(r1, r0, 0x07030602u);
            const unsigned t2 = __builtin_amdgcn_perm(r3, r2, 0x05010400u), t3 = __builtin_amdgcn_perm(r3, r2, 0x07030602u);
            unsigned o[4]; o[0] = __builtin_amdgcn_perm(t2, t0, 0x05040100u); o[1] = __builtin_amdgcn_perm(t2, t0, 0x07060302u);
            o[2] = __builtin_amdgcn_perm(t3, t1, 0x05040100u); o[3] = __builtin_amdgcn_perm(t3, t1, 0x07060302u);
#pragma unroll
            for (int j = 0; j < 4; ++j) {
                g.accI[8 * wg + j] = __builtin_amdgcn_sdot4((int)(o[j] & 0x0f0f0f0fu), cw, g.accI[8 * wg + j], false);
                g.accI[8 * wg + 4 + j] = __builtin_amdgcn_sdot4((int)o[j], cw, g.accI[8 * wg + 4 + j], false);
            }
        }
    }
}
__device__ __forceinline__ void gh_d(const GH& g, float (&acc)[16]) {
    const int offI = 15 * g.sumcq, offH = 8 * g.sumcq;
#pragma unroll
    for (int wg = 0; wg < 2; ++wg)
#pragma unroll
        for (int j = 0; j < 4; ++j) { const int Ls = g.accI[8 * wg + j], Fs = g.accI[8 * wg + 4 + j];
            acc[8 * wg + j] = fmaf((float)(2 * Ls - offI), 0.5f * g.cscale, acc[8 * wg + j]);
            acc[8 * wg + 4 + j] = fmaf((float)(Fs - Ls + offH), 0.0625f * g.cscale, acc[8 * wg + 4 + j]); }
}

template <long X8D>
__device__ __forceinline__ void run_wave(const float* S, bf16* XB, const unsigned char* UQ, const unsigned char* VQ, const float* SU, const float* SV, const float* ss1, float* rs2, int gw, int ngw, int ntok, int lane_in) {
    int lane = lane_in; asm volatile("" : "+v"(lane));
    const int hl = lane & 31, li = lane & 15;
    auto slot_ij = [](int l, int& ci, int& cj) { if (l < 16) { ci = 0; cj = l; } else if (l < 24) { ci = 1; cj = l - 16; } else if (l < 29) { ci = 2; cj = l - 24; } else if (l < 33) { ci = 3; cj = l - 29; }
      else if (l < 36) { ci = 4; cj = l - 33; } else if (l < 42) { ci = 5 + ((l - 36) >> 1); cj = (l - 36) & 1; } else if (l < 50) { ci = 8 + (l - 42); cj = 0; } else { ci = 0; cj = 0; } };
    int cij; unsigned ciP = 0u, cjP = 0u;
    { int ci, cj; slot_ij(lane, ci, cj); cij = ci | (cj << 8);
#pragma unroll
      for (int k = 0; k < 4; ++k) { slot_ij(li + 16 * k, ci, cj); ciP |= (unsigned)((lane & 48) + ci) << (8 * k); cjP |= (unsigned)((lane & 48) + cj) << (8 * k); } }
    const __amdgpu_buffer_rsrc_t rsUV = __builtin_amdgcn_make_buffer_rsrc((void*)UQ, 0, NEXP * 1024, 0x00020000); (void)VQ;
    const int lo = lane * 16;
    if (gw >= ntok) return;
    Pre pre; unsigned kk[4][8], mine[4], MA[2], MB[2], ck[2][4], top[2];
    int sumx_cur = 0, sumx_nxt = 0;
    TK cur, nxt; v4u xq_cur, xq_nxt; float sx;
    load_pre(pre, S, XB, gw, lane);
    prep_keys(pre, kk, hl); quant_x(pre, xq_cur, sx, sumx_cur, lane);
#pragma unroll
    for (int p = 0; p < 4; ++p) mine[p] = 0u;
#pragma unroll 1
    for (int it = 0; it < 16; ++it) s1_round(kk, mine, li == it);
    s2_setup(mine, MA, MB, ck, top, ciP, cjP, li);
#pragma unroll 1
    for (int it = 0; it < 16; ++it) s2_round(ck, top, li == it);
    finalize(top, MA, MB, cij, 1.0f / sqrtf(ss1[gw] * (1.0f / 1024.0f) + EPS), sx, SU, SV, lane, cur);
    { const int t1 = (gw + ngw < ntok) ? gw + ngw : gw; load_pre(pre, S, XB, t1, lane); }
    v4u tq[16]; v2u vq[16];
    load_t_head(tq, cur.eidP0, 0, rsUV, lo);
#define PEER_HEAD(H, VCUR, VNEXT, NEXTU, R0, R1, R2, R3) { GH g; \
        gh_a<NEXTU>(g, H, cur, xq_cur, tq, vq, rsUV, lo); R0; \
        gh_b(g, H, cur, lane, sumx_cur);                          R1; \
        gh_c<0>(g, vq);                                           R2; \
        gh_c<2>(g, vq); gh_d(g, acc);                             R3; }
#pragma unroll 1
    for (int tkn = gw; tkn < ntok; tkn += ngw) {
        asm volatile("" : "+v"(lane)); const int hl = lane & 31, li = lane & 15, lo = lane * 16; (void)hl; (void)li; (void)lo;
        const int tn1 = (tkn + ngw < ntok) ? tkn + ngw : tkn, tn2 = (tn1 + ngw < ntok) ? tn1 + ngw : tn1;
        prep_keys(pre, kk, hl); quant_x(pre, xq_nxt, sx, sumx_nxt, lane);
        const float rs1n = 1.0f / sqrtf(ss1[tn1] * (1.0f / 1024.0f) + EPS);
#pragma unroll
        for (int p = 0; p < 4; ++p) mine[p] = 0u;
        float acc[16];
#pragma unroll
        for (int i = 0; i < 16; ++i) acc[i] = 0.f;
#pragma unroll 1
        for (int hh = 0; hh < 2; ++hh) {
            PEER_HEAD(2 * hh, va, vb, true, s1_round(kk, mine, li == 8 * hh + 0), s1_round(kk, mine, li == 8 * hh + 1), s1_round(kk, mine, li == 8 * hh + 2), s1_round(kk, mine, li == 8 * hh + 3))
            PEER_HEAD(2 * hh + 1, vb, va, true, s1_round(kk, mine, li == 8 * hh + 4), s1_round(kk, mine, li == 8 * hh + 5), s1_round(kk, mine, li == 8 * hh + 6), s1_round(kk, mine, li == 8 * hh + 7))
        }
        s2_setup(mine, MA, MB, ck, top, ciP, cjP, li);
        PEER_HEAD(4, va, vb, true, s2_round(ck, top, li == 0), s2_round(ck, top, li == 1), s2_round(ck, top, li == 2), s2_round(ck, top, li == 3))
        PEER_HEAD(5, vb, va, true, s2_round(ck, top, li == 4), s2_round(ck, top, li == 5), s2_round(ck, top, li == 6), s2_round(ck, top, li == 7))
        PEER_HEAD(6, va, vb, true, s2_round(ck, top, li == 8), s2_round(ck, top, li == 9), s2_round(ck, top, li == 10), s2_round(ck, top, li == 11))
        v4u xr_cur0, xr_cur1; { int lo_ = lane; asm volatile("" : "+v"(lo_)); const v4u* xp_ = (const v4u*)(XB + (size_t)tkn * 1024 + lo_ * 16); xr_cur0 = xp_[0]; xr_cur1 = xp_[1]; }
        { int lp_ = lane; asm volatile("" : "+v"(lp_)); load_pre(pre, S, XB, tn2, lp_); }
        PEER_HEAD(7, vb, va, false, s2_round(ck, top, li == 12), s2_round(ck, top, li == 13), s2_round(ck, top, li == 14), s2_round(ck, top, li == 15))
        finalize(top, MA, MB, cij, rs1n, sx, SU, SV, lane, nxt);
        load_t_head(tq, nxt.eidP0, 0, rsUV, lo);
        { f32x4 xf[4]; pg8::unpack8(xr_cur0, xf[0], xf[1]); pg8::unpack8(xr_cur1, xf[2], xf[3]);
          f32x4 y[4]; float ss = 0.f;
#pragma unroll
          for (int w = 0; w < 4; ++w)
#pragma unroll
              for (int e = 0; e < 4; ++e) { y[w][e] = xf[w][e] + acc[4 * w + e]; ss += y[w][e] * y[w][e]; }
          int lo_ = lane; asm volatile("" : "+v"(lo_));
          bf16* xb = XB + (size_t)tkn * 1024 + lo_ * 16;
          *(v4u*)xb = pg8::pack8(y[0], y[1]); *(v4u*)(xb + 8) = pg8::pack8(y[2], y[3]);
          { v4u o8; o8.x = pg8::pkf8(y[0][0], y[0][1], y[0][2], y[0][3]); o8.y = pg8::pkf8(y[1][0], y[1][1], y[1][2], y[1][3]); o8.z = pg8::pkf8(y[2][0], y[2][1], y[2][2], y[2][3]); o8.w = pg8::pkf8(y[3][0], y[3][1], y[3][2], y[3][3]);
            *(v4u*)((unsigned char*)XB + X8D + (size_t)tkn * 1024 + lo_ * 16) = o8; }
          ss = wave_sum(ss, lane);
          if (lane == 0) rs2[tkn] = 1.0f / sqrtf(ss * (1.0f / 1024.0f) + EPS); }
        cur = nxt; xq_cur = xq_nxt; sumx_cur = sumx_nxt;
    }
}
#undef PEER_HEAD
#undef PEER_ROW
#undef PEER_ROWV
}

__global__ void __launch_bounds__(NWAVES * 64, 2) mk_fwd(Args args) {
    extern __shared__ __attribute__((aligned(16))) unsigned char lds[];
    LAS unsigned char* L = (LAS unsigned char*)lds;
    volatile LAS unsigned* MISC = (volatile LAS unsigned*)(L + MISC_OFF);
    const int G = gridDim.x, bx = blockIdx.x;
    const int wave_s = __builtin_amdgcn_readfirstlane((int)threadIdx.x >> 6);
    const int NGW = G * NWAVES, NGT = G * NWAVES * 64;
#define FRESH_IDS() int tid = wave_s * 64 + lane_id_opaque(); asm volatile("" : "+v"(tid)); const int lane = tid & 63, wave = __builtin_amdgcn_readfirstlane(tid >> 6); \
    const int gw = bx * NWAVES + wave, gtid = bx * (NWAVES * 64) + tid; (void)lane; (void)gw; (void)gtid
    typedef const unsigned char __attribute__((address_space(4))) karg_t;
#define FRESH_ARGS() karg_t* kp_ = (karg_t*)__builtin_amdgcn_kernarg_segment_ptr(); asm volatile("" : "+s"(kp_)); \
    unsigned char* ws = *(unsigned char* const __attribute__((address_space(4)))*)(kp_ + 224); float* out = *(float* const __attribute__((address_space(4)))*)(kp_ + 216); (void)out; (void)ws
#define IN(k) (*(const float* const __attribute__((address_space(4)))*)(kp_ + 8 * (k)))
#define WSP(T_, off) ((T_*)(ws + (off)))
    { FRESH_IDS(); for (int u = tid; u < (LDS_BYTES - LDSCTL_OFF) / 4; u += NWAVES * 64) ((LAS unsigned*)(L + LDSCTL_OFF))[u] = 0u; }
    __syncthreads();
    XcdBarrier bar;
    { FRESH_ARGS(); bar = xcd_barrier_post((unsigned*)(ws + WS_CTL) + CW_BAR, MISC + 8, wave_s); }
#define GRID_BAR() xcd_barrier(bar, wave_s)

    {
        FRESH_IDS(); FRESH_ARGS();
        bf16* WinT = WSP(bf16, WS_WIN); bf16* WgluT = WSP(bf16, WS_WGLU); bf16* WpsT = WSP(bf16, WS_WPS); bf16* WpaT = WSP(bf16, WS_WPA);
        bf16* WoutT = WSP(bf16, WS_WOUT); bf16* WsT = WSP(bf16, WS_WS); bf16* WgateT = WSP(bf16, WS_WGATE); bf16* WppT = WSP(bf16, WS_WPP);
        float* rope = WSP(float, WS_ROPE); unsigned char* s5p = ws + WS_S5P; bf16* XN = WSP(bf16, WS_XN); bf16* PB = WSP(bf16, WS_PB);
        const float* x = IN(I_X);
        for (int it = bx; it < 256; it += G) p0_ws_item(IN(I_WQ), IN(I_GFFN), IN(I_KEY1), IN(I_KEY2), WsT, L + RING_OFF, it, tid);
        {
            LAS float* scr = (LAS float*)(L + RING_OFF + wave * 16384);
            constexpr int I_1 = (1024 / 64) * (4096 / 32), I_2 = (512 / 64) * (512 / 32), I_3 = (512 / 64) * (1024 / 32), I_4 = I_3, I_5 = (1024 / 64) * (1024 / 32), I_6 = I_5, I_7 = (256 / 64) * (1024 / 32);
            constexpr int NIT = I_1 + I_2 + I_3 + I_4 + I_5 + I_6 + I_7;
            for (int it = gw; it < NIT; it += NGW) {
                int r = it;
                if (r < I_1) { p0_transpose_item<true>(IN(I_WIN), IN(I_GMIX), 1024, 4096, WinT, scr, r, lane); continue; } r -= I_1;
                if (r < I_2) { p0_transpose_item<true>(IN(I_WGLU), nullptr, 512, 512, WgluT, scr, r, lane); continue; } r -= I_2;
                if (r < I_3) { p0_transpose_item<true>(IN(I_WPS), nullptr, 512, 1024, WpsT, scr, r, lane); continue; } r -= I_3;
                if (r < I_4) { p0_transpose_item<true>(IN(I_WPA), nullptr, 512, 1024, WpaT, scr, r, lane); continue; } r -= I_4;
                if (r < I_5) { p0_transpose_item<true>(IN(I_WOUT), nullptr, 1024, 1024, WoutT, scr, r, lane); continue; } r -= I_5;
                if (r < I_6) { p0_transpose_item<true>(IN(I_WGATE), IN(I_GPLE), 1024, 1024, WgateT, scr, r, lane); continue; } r -= I_6;
                p0_transpose_item(IN(I_WPP), nullptr, 256, 1024, WppT, scr, r, lane);
            }
        }
        for (int m0 = gw * 4; m0 < T; m0 += NGW * 4) {
            f32x4 v[4][4];
#pragma unroll
            for (int i = 0; i < 4; ++i) { const f32x4* xr = (const f32x4*)(x + (size_t)(m0 + i) * D) + lane;
#pragma unroll
                for (int j = 0; j < 4; ++j) v[i][j] = xr[64 * j]; }
#pragma unroll
            for (int i = 0; i < 4; ++i) { float s = 0.f;
#pragma unroll
                for (int j = 0; j < 4; ++j) s += (v[i][j].x * v[i][j].x + v[i][j].y * v[i][j].y) + (v[i][j].z * v[i][j].z + v[i][j].w * v[i][j].w);
                const float rs = 1.0f / sqrtf(wave_sum(s, lane) * (1.f / D) + EPS);
                unsigned* o8 = (unsigned*)((unsigned char*)XN + (size_t)(m0 + i) * D) + lane;
#pragma unroll
                for (int j = 0; j < 4; ++j) o8[64 * j] = pg8::pkf8(v[i][j].x * rs, v[i][j].y * rs, v[i][j].z * rs, v[i][j].w * rs); }
        }
        {
            const float* pp = IN(I_P);
            constexpr int NI = T * D_PLE / 8;
            for (int i8 = gtid; i8 < NI; i8 += 4 * NGT) { f32x4 a[4], b[4];
#pragma unroll
                for (int j = 0; j < 4; ++j) { const int ij = i8 + j * NGT; const size_t o = (size_t)(ij < NI ? ij : NI - 1) * 8; a[j] = *(const f32x4*)(pp + o); b[j] = *(const f32x4*)(pp + o + 4); }
#pragma unroll
                for (int j = 0; j < 4; ++j) { const int ij = i8 + j * NGT; if (ij >= NI) break; const size_t o = (size_t)ij * 8; *(v4u*)(PB + o) = pg8::pack8(a[j], b[j]); } }
        }
        {
            const int* pos = (const int*)IN(I_POS);
            for (int i = gtid; i < T * 8; i += NGT) { const int t = i >> 3, k = i & 7;
                const double invf = k == 0 ? 1.0 : k == 1 ? 0.19392274474868576 : k == 2 ? 0.03760603093086393 : k == 3 ? 0.007292664737217109 : k == 4 ? 0.001414213562373095
                                  : k == 5 ? 0.0002742481756762073 : k == 6 ? 5.318295896944988e-05 : 1.031338537721246e-05;
                float c, s; cs_reduced((double)pos[t] * invf, c, s);
                rope[(size_t)t * 16 + 2 * k] = c; rope[(size_t)t * 16 + 2 * k + 1] = s; }
        }
        if (gtid < NG * NS) {
            const int g = gtid >> 6;
            const float dt = expf(IN(I_LOGDT)[g]); const float are = IN(I_ARE)[gtid], aim = IN(I_AIM)[gtid];
            const double zr = (double)dt * (double)are, th = (double)dt * (double)aim;
            float c, s; cs_reduced(th, c, s); const float mag = expf((float)zr);
            const float abr = mag * c, abi = mag * s;
            float cL, sL; cs_reduced(64.0 * th, cL, sL); const float magL = expf((float)(64.0 * zr));
            ((float*)(s5p + S5_ABR))[gtid] = abr; ((float*)(s5p + S5_ABI))[gtid] = abi;
            ((float*)(s5p + S5_ALR))[gtid] = magL * cL; ((float*)(s5p + S5_ALI))[gtid] = magL * sL;
            const float den = are * are + aim * aim, nr = abr - 1.0f, ni = abi;
            const float fre = (nr * are + ni * aim) / den, fim = (ni * are - nr * aim) / den;
            const float* br = IN(I_BRE) + (size_t)gtid * 16; const float* bi = IN(I_BIM) + (size_t)gtid * 16;
            float* obr = (float*)(s5p + S5_BRE) + (size_t)gtid * 16; float* obi = (float*)(s5p + S5_BIM) + (size_t)gtid * 16;
#pragma unroll
            for (int cc = 0; cc < 16; ++cc) { obr[cc] = fre * br[cc] - fim * bi[cc]; obi[cc] = fre * bi[cc] + fim * br[cc]; }
        }
        for (int i = gtid; i < NG * NS * 64; i += NGT) { const int t = i & 63, gn = i >> 6, g = gn >> 6;
            const float dt = expf(IN(I_LOGDT)[g]); const float are = IN(I_ARE)[gn], aim = IN(I_AIM)[gn];
            const double zr = (double)dt * (double)are, th = (double)dt * (double)aim;
            float c1, s1; cs_reduced(th, c1, s1); const float mag1 = expf((float)zr); const float abr = mag1 * c1, abi = mag1 * s1;
            const float den = are * are + aim * aim, nr = abr - 1.0f, ni = abi;
            const float fre = (nr * are + ni * aim) / den, fim = (ni * are - nr * aim) / den;
            float cp, sp; cs_reduced((double)(63 - t) * th, cp, sp); const float magp = expf((float)((double)(63 - t) * zr)); const float pr = magp * cp, pi = magp * sp;
            const float qr = pr * fre - pi * fim, qi = pr * fim + pi * fre;
            const f32x4* br = (const f32x4*)(IN(I_BRE) + (size_t)gn * 16); const f32x4* bi = (const f32x4*)(IN(I_BIM) + (size_t)gn * 16);
            bf16* wre = WSP(bf16, WS_S5W) + ((size_t)g * 128 + (gn & 63)) * 1024 + 16 * t; bf16* wim = wre + (size_t)64 * 1024;
#pragma unroll
            for (int h8 = 0; h8 < 2; ++h8) { const f32x4 r0 = br[2 * h8], r1 = br[2 * h8 + 1], i0 = bi[2 * h8], i1 = bi[2 * h8 + 1];
                *(v4u*)(wre + 8 * h8) = pg8::pack8(qr * r0 - qi * i0, qr * r1 - qi * i1); *(v4u*)(wim + 8 * h8) = pg8::pack8(qr * i0 + qi * r0, qr * i1 + qi * r1); } }
        for (int i = gtid; i < NG * 16 * 128; i += NGT) { const int gc = i >> 7, n = i & 127;
            const float v = n < 64 ? IN(I_CRE)[(size_t)gc * 64 + n] : -IN(I_CIM)[(size_t)gc * 64 + n - 64];
            ((bf16*)(s5p + S5_CM))[i] = (bf16)(pkbf(v, 0.f) & 0xffffu); }
    }
    GRID_BAR();

#define MK_PEER_TABLES() do { FRESH_IDS(); \
        { \
            const float* pu = IN(I_PU); const float* pv = IN(I_PV); const float* gf = IN(I_GFFN); \
            unsigned char* UQ = WSP(unsigned char, WS_UT); unsigned char* VQ = WSP(unsigned char, WS_VT); float* SU = WSP(float, WS_SU); float* SV = WSP(float, WS_SV); \
            f32x4 gf4[4]; \
        _Pragma("unroll") \
            for (int j = 0; j < 4; ++j) gf4[j] = *(const f32x4*)(gf + 16 * lane + 4 * j); \
            for (int r0 = gw * 4; r0 < NEXP; r0 += NGW * 4) { peer::Row4 rw[4]; \
        _Pragma("unroll") \
                for (int i = 0; i < 4; ++i) peer::load_row16(rw[i], pu + (size_t)(r0 + i) * 1024, lane); \
        _Pragma("unroll") \
                for (int i = 0; i < 4; ++i) peer::quant_row4(rw[i], gf4, true, UQ + (size_t)(r0 + i) * 1024, SU + r0 + i, lane); } \
            for (int r0 = gw * 4; r0 < NEXP; r0 += NGW * 4) { peer::Row4 rw[4]; \
        _Pragma("unroll") \
                for (int i = 0; i < 4; ++i) peer::load_row16(rw[i], pv + (size_t)(r0 + i) * 1024, lane); \
        _Pragma("unroll") \
                for (int i = 0; i < 4; ++i) peer::quant_row4(rw[i], gf4, false, UQ + (size_t)(r0 + i) * 1024 + 8, SV + r0 + i, lane, true); } \
        } \
    } while (0)
    {
        FRESH_ARGS();
        bf16* XN = WSP(bf16, WS_XN); bf16* WinT = WSP(bf16, WS_WIN); bf16* PB = WSP(bf16, WS_PB); bf16* WppT = WSP(bf16, WS_WPP); bf16* EB = WSP(bf16, WS_E);
        bf16* Ub = WSP(bf16, WS_U); bf16* Qb = WSP(bf16, WS_Q); bf16* Kb = WSP(bf16, WS_K); bf16* Vb = WSP(bf16, WS_V); unsigned char* SGA = WSP(unsigned char, WS_SGA); unsigned char* SGB = WSP(unsigned char, WS_SGB);
        float* kmean = WSP(float, CTL_KMEAN); float* rope = WSP(float, WS_ROPE);
        const int grp = (bx >> 3) & 3, nrounds = ((T / 256) * (D_IN / 256) + G - 1) / G, rhalf = (nrounds + 1) / 2;
        if (grp == 0) MK_PEER_TABLES();
        { pg8::Gemm g{XN, WinT, T, D_IN, D}; pg8::RangeOrder S; S.b.init(T, D_IN, G, bx); S.i0 = 0; S.i1 = rhalf;
          pg8::EpiWin E{Ub, Qb, Kb, Vb, SGA, SGB, kmean, rope, 0.18033688011112042f};
          pg8::gemm_phase<pg8::EpiWin, pg8::RangeOrder, true, true, true, D>(L + RING_OFF, g, S, E, wave_s); }
        if (grp == 1) MK_PEER_TABLES();
        { pg8::Gemm g{XN, WinT, T, D_IN, D}; pg8::RangeOrder S; S.b.init(T, D_IN, G, bx); S.i0 = rhalf; S.i1 = nrounds;
          pg8::EpiWin E{Ub, Qb, Kb, Vb, SGA, SGB, kmean, rope, 0.18033688011112042f};
          pg8::gemm_phase<pg8::EpiWin, pg8::RangeOrder, true, true, true, D>(L + RING_OFF, g, S, E, wave_s); }
        if (grp == 2) MK_PEER_TABLES();
        { pg8::Gemm g{PB, WppT, T, D, D_PLE}; pg8::StaticOrder S; S.init(T, D, G, bx);
          pg8::EpiPlain E{EB, D};
          pg8::gemm_phase<pg8::EpiPlain, pg8::StaticOrder, true, true, false, D_PLE>(L + RING_OFF, g, S, E, wave_s); }
        if (grp == 3) MK_PEER_TABLES();
    }
#undef MK_PEER_TABLES
    GRID_BAR();

    {
        { FRESH_IDS(); FRESH_ARGS();
          const bf16* Qb = WSP(bf16, WS_Q); const float* kmean = WSP(float, CTL_KMEAN);
          unsigned short* SUB = WSP(unsigned short, WS_MSUB); unsigned* CNT = WSP(unsigned, WS_MCNT); float* LSE = WSP(float, WS_MLSE);
          for (int u = bx; u < 512; u += G) moba::select_pair(u, 1023 - u, (const moba::bf16*)Qb, kmean, SUB, CNT, LSE, (char*)lds + RING_OFF, tid); }
        FRESH_IDS(); FRESH_ARGS();
        __syncthreads();
        s5::pass1_gemm(L + RING_OFF, WSP(bf16, WS_S5W), WSP(bf16, WS_U), WSP(float, WS_HLOC), G, bx, tid, wave);
    }
    GRID_BAR();

    {
        FRESH_IDS(); FRESH_ARGS();
        moba::sparse_phase((const moba::bf16*)WSP(bf16, WS_Q), (const moba::bf16*)WSP(bf16, WS_K), (const moba::bf16*)WSP(bf16, WS_V), WSP(unsigned short, WS_MSUB), WSP(unsigned, WS_MCNT),
                           (moba::bf16*)out, WSP(float, WS_MLSE), (char*)lds + RING_OFF, G, bx, tid, wave_s);
    }
    GRID_BAR();

    {
        { FRESH_ARGS();
          moba::own_phase((const moba::bf16*)WSP(bf16, WS_Q), (const moba::bf16*)WSP(bf16, WS_K), (const moba::bf16*)WSP(bf16, WS_V), (const moba::bf16*)out, WSP(float, WS_MLSE), (moba::bf16*)WSP(bf16, WS_PB),
                          (char*)lds + RING_OFF, G, bx, wave_s); }
        FRESH_IDS(); FRESH_ARGS();
        s5::run<2>(L + RING_OFF + wave * 16384, ws + WS_S5P, WSP(bf16, WS_U), WSP(float, WS_HLOC), IN(I_DSK), WSP(bf16, WS_YP), gw, NGW, lane); }
    GRID_BAR();

    {
        FRESH_ARGS(); bf16* YP = WSP(bf16, WS_YP); bf16* YS = WSP(bf16, WS_V); bf16* WgluT = WSP(bf16, WS_WGLU);
        pg8::Gemm g{WSP(bf16, WS_MSUB), WgluT, T, D_SSM, D_SSM}; pg8::StaticOrder S; S.init(T, D_SSM, G, bx);
        pg8::EpiGlu E{YP, YS};
        pg8::gemm_phase<pg8::EpiGlu, pg8::StaticOrder, true, true, true, D_SSM>(L + RING_OFF, g, S, E, wave_s);
    }
    GRID_BAR();

    {
        FRESH_ARGS(); bf16* YS = WSP(bf16, WS_V); bf16* Qb = WSP(bf16, WS_PB); unsigned char* M8 = WSP(unsigned char, WS_U); bf16* WpsT = WSP(bf16, WS_WPS); bf16* WpaT = WSP(bf16, WS_WPA); const unsigned char* SGA = WSP(unsigned char, WS_SGA); const unsigned char* SGB = WSP(unsigned char, WS_SGB); bf16* T1 = WSP(bf16, WS_Q);
        { pg8::Gemm g{YS, WpsT, T, D, D_SSM}; pg8::StaticOrder S; S.init(T, D, G, bx);
          pg8::EpiMerge<0> E{SGA, T1, nullptr};
          pg8::gemm_phase<pg8::EpiMerge<0>, pg8::StaticOrder, true, true, true, D_SSM>(L + RING_OFF, g, S, E, wave_s); }
        { pg8::Gemm g{Qb, WpaT, T, D, D_ATT}; pg8::StaticOrder S; S.init(T, D, G, bx);
          pg8::EpiMerge<1> E{SGB, T1, M8};
          pg8::gemm_phase<pg8::EpiMerge<1>, pg8::StaticOrder, true, true, true, D_ATT>(L + RING_OFF, g, S, E, wave_s); }
    }
    GRID_BAR();

    {
        FRESH_ARGS(); bf16* SGA = WSP(bf16, WS_U); bf16* WoutT = WSP(bf16, WS_WOUT); bf16* XN = WSP(bf16, WS_XN); float* ss1 = WSP(float, CTL_SS1); const float* x = IN(I_X);
        pg8::Gemm g{SGA, WoutT, T, D, D}; pg8::StaticOrder S; S.init(T, D, G, bx);
        pg8::EpiResid E{x, XN, ss1};
        pg8::gemm_phase<pg8::EpiResid, pg8::StaticOrder, true, true, true, D>(L + RING_OFF, g, S, E, wave_s);
    }
    GRID_BAR();

    {
        FRESH_ARGS(); bf16* XN = WSP(bf16, WS_XN); bf16* WsT = WSP(bf16, WS_WS); float* SC = WSP(float, WS_SC); float* ss1 = WSP(float, CTL_SS1);
        pg8::Gemm g{XN, WsT, T, PH * PQD, D}; pg8::StaticOrder S; S.init(T, PH * PQD, G, bx);
        pg8::EpiScores E{(pg8::bf16_t*)SC, ss1};
        pg8::gemm_phase<pg8::EpiScores, pg8::StaticOrder, true, true, false, D>(L + RING_OFF, g, S, E, wave_s);
    }
    GRID_BAR();

    {
        FRESH_IDS(); FRESH_ARGS();
        float* SC = WSP(float, WS_SC); bf16* XN = WSP(bf16, WS_XN); float* ss1 = WSP(float, CTL_SS1); float* rs2 = WSP(float, WS_RS2);
        const unsigned char* UQ = WSP(unsigned char, WS_UT); const unsigned char* VQ = WSP(unsigned char, WS_VT); const float* SU = WSP(float, WS_SU); const float* SV = WSP(float, WS_SV);
        peer::run_wave<(long)WS_X8 - (long)WS_XN>(SC, XN, UQ, VQ, SU, SV, ss1, rs2, gw, NGW, T, lane);
    }
    GRID_BAR();

    {
        FRESH_ARGS(); bf16* XN = WSP(bf16, WS_XN); bf16* WgateT = WSP(bf16, WS_WGATE); bf16* EB = WSP(bf16, WS_E); float* rs2 = WSP(float, WS_RS2); float* ss3 = WSP(float, CTL_SS3);
        pg8::Gemm g{WSP(bf16, WS_X8), WgateT, T, D, D}; pg8::StaticOrder S; S.init(T, D, G, bx);
        pg8::EpiPle E{XN, EB, rs2, ss3};
        pg8::gemm_phase<pg8::EpiPle, pg8::StaticOrder, true, true, true, D>(L + RING_OFF, g, S, E, wave_s);
    }
    GRID_BAR();

    {
        FRESH_IDS(); FRESH_ARGS();
        const bool bad = xb_ld(&bar.bar[XB_TMO]) != 0u;
        const float* gfin = IN(I_GFIN); float* ss3 = WSP(float, CTL_SS3);
        const f32x4* gp = (const f32x4*)gfin + lane;
        f32x4 g4[4];
#pragma unroll
        for (int j = 0; j < 4; ++j) g4[j] = gp[64 * j];
        const bf16* X3B = WSP(bf16, WS_E);
        for (int m0 = gw * 4; m0 < T; m0 += NGW * 4) {
            v2u v[4][4]; float rs[4];
#pragma unroll
            for (int i = 0; i < 4; ++i) { const v2u* xr = (const v2u*)(X3B + (size_t)(m0 + i) * D) + lane; rs[i] = ss3[m0 + i];
#pragma unroll
                for (int j = 0; j < 4; ++j) v[i][j] = xr[64 * j]; }
#pragma unroll
            for (int i = 0; i < 4; ++i) { const float r_ = 1.0f / sqrtf(rs[i] * (1.f / D) + EPS); f32x4* xo = (f32x4*)(out + (size_t)(m0 + i) * D) + lane;
#pragma unroll
                for (int j = 0; j < 4; ++j) { f32x4 r = (f32x4){bflo(v[i][j].x), bfhi(v[i][j].x), bflo(v[i][j].y), bfhi(v[i][j].y)} * r_ * g4[j]; if (bad) r = (f32x4){__builtin_nanf(""), 0.f, 0.f, 0.f}; xo[64 * j] = r; } }
        }
    }
}

extern "C" void kernel_launch(void* const* d_in, const int* in_sizes, int n_in, void* d_out, int out_size, void* d_ws, size_t ws_size, hipStream_t stream) {
    static int grid = 0;
    if (grid == 0) {
        if (n_in != 27 || in_sizes[0] != T * D || out_size != T * D || ws_size < WS_END) {
            fprintf(stderr, "kernel_launch: built for 27 inputs, x/out of %d floats, >= %zu bytes of workspace; got n_in %d in0 %d out %d ws %zu\n", T * D, (size_t)WS_END, n_in, n_in > 0 ? in_sizes[0] : -1, out_size, ws_size);
            grid = -1; return; }
        int dev = 0, cus = 0, per_cu = 0;
        if (hipGetDevice(&dev) != hipSuccess || hipDeviceGetAttribute(&cus, hipDeviceAttributeMultiprocessorCount, dev) != hipSuccess) { grid = -1; return; }
        if (hipFuncSetAttribute((const void*)mk_fwd, hipFuncAttributeMaxDynamicSharedMemorySize, LDS_BYTES) != hipSuccess) { fprintf(stderr, "kernel_launch: hipFuncSetAttribute failed\n"); grid = -1; return; }
        if (hipOccupancyMaxActiveBlocksPerMultiprocessor(&per_cu, (const void*)mk_fwd, NWAVES * 64, LDS_BYTES) != hipSuccess || per_cu < 1) { fprintf(stderr, "kernel_launch: occupancy query says %d\n", per_cu); per_cu = 1; }
        (void)hipGetLastError();
        grid = cus;
        if (grid % 32 != 0 || grid > 256) grid = (grid / 32) * 32 > 256 ? 256 : (grid / 32) * 32;
        fprintf(stderr, "kernel_launch: cus %d per_cu %d grid %d ws %zu\n", cus, per_cu, grid, ws_size);
    }
    if (grid <= 0) return;
    if (hipMemsetAsync((char*)d_ws + WS_CTL, 0, CTL_ZERO_BYTES, stream) != hipSuccess) { fprintf(stderr, "kernel_launch: memset failed\n"); return; }
    Args a{};
    for (int i = 0; i < 27; ++i) a.in[i] = (const float*)d_in[i];
    a.out = (float*)d_out; a.ws = (unsigned char*)d_ws;
    void* kargs[] = {&a};
    const hipError_t e = hipLaunchCooperativeKernel((const void*)mk_fwd, dim3(grid), dim3(NWAVES * 64), kargs, LDS_BYTES, stream);
    if (e != hipSuccess) fprintf(stderr, "kernel_launch: cooperative launch failed: %s (grid %d)\n", hipGetErrorString(e), grid);
}
```

```cpp
#include <hip/hip_runtime.h>
#include <hip/hip_bf16.h>
#include <cstdio>
#include <cstdint>
#include <cmath>
namespace pg8 {
#define PG8_LAS __attribute__((address_space(3)))
typedef unsigned short bf16_t;
typedef short bf16x8 __attribute__((ext_vector_type(8)));
typedef float f32x4 __attribute__((ext_vector_type(4)));
typedef unsigned u32x4 __attribute__((ext_vector_type(4)));
constexpr int BM = 256, BK = 64, HALF = 128, HTB = HALF * BK * 2  , STAGE_BYTES = 8 * HTB, NXCD = 8, WGM = 8;

__host__ __device__ __forceinline__ int lds_byte(int r, int c) { const int st = (r >> 4) * 2 + (c >> 5), rr = r & 15, cc = c & 31, ob = rr * 64 + cc * 2; return st * 1024 + (ob ^ (((ob >> 9) & 1) << 5)); }
__host__ __device__ __forceinline__ void stage_rc(int b, int& R, int& C) { const int st = b / 1024, sb = b % 1024, swz = sb ^ (((sb >> 9) & 1) << 5); R = (st >> 1) * 16 + swz / 64; C = (st & 1) * 32 + (swz % 64) / 2; }
__host__ __device__ __forceinline__ int perm32(int rho) { const int n = rho >> 4, i = rho & 15; return 8 * (i >> 2) + 4 * n + (i & 3); }

struct Unit { int pm, pn; };
struct Gemm { const bf16_t* A; const bf16_t* Bt; int M, N, K; };

struct StaticOrder {
    int nM, nN, nwg, G, c;
    __host__ __device__ void init(int M, int N, int G_, int c_) { nM = M / BM; nN = N / BM; nwg = nM * nN; G = G_; c = c_; }
    __host__ __device__ bool next(int i, Unit& u) const {
        const long L = (long)i * G + c; if (L >= nwg) return false;
        int wgid = (int)L; { const int q = nwg / NXCD, r = nwg % NXCD, xcd = wgid % NXCD, off = wgid / NXCD; wgid = (xcd < r ? xcd * (q + 1) : r * (q + 1) + (xcd - r) * q) + off; }
        const int nig = WGM * nN, gid = wgid / nig, fm = gid * WGM, gsz = (nM - fm) < WGM ? (nM - fm) : WGM;
        u.pm = fm + ((wgid % nig) % gsz); u.pn = (wgid % nig) / gsz; return true;
    }
    __device__ __forceinline__ void a_ready(const Unit&) const {}
    __device__ __forceinline__ void done(const Unit&) const {}
};

__device__ __forceinline__ unsigned cvt_pk_bf16(float lo, float hi) { unsigned r; asm volatile("v_cvt_pk_bf16_f32 %0, %1, %2" : "=v"(r) : "v"(lo), "v"(hi)); return r; }
typedef float f32x2 __attribute__((ext_vector_type(2)));
typedef unsigned u32x2 __attribute__((ext_vector_type(2)));
typedef __bf16 bf16x2_t __attribute__((ext_vector_type(2)));
__device__ __forceinline__ unsigned pkbf(float lo, float hi) { f32x2 v = {lo, hi}; bf16x2_t b = __builtin_convertvector(v, bf16x2_t); return __builtin_bit_cast(unsigned, b); }
__device__ __forceinline__ float bflo(unsigned w) { return __uint_as_float(w << 16); }
__device__ __forceinline__ float bfhi(unsigned w) { return __uint_as_float(w & 0xffff0000u); }
__device__ __forceinline__ unsigned pkf8(float a, float b, float c, float d) {
    a = __builtin_amdgcn_fmed3f(a, -448.f, 448.f); b = __builtin_amdgcn_fmed3f(b, -448.f, 448.f); c = __builtin_amdgcn_fmed3f(c, -448.f, 448.f); d = __builtin_amdgcn_fmed3f(d, -448.f, 448.f);
    int w = __builtin_amdgcn_cvt_pk_fp8_f32(a, b, 0, false); w = __builtin_amdgcn_cvt_pk_fp8_f32(c, d, w, true); return (unsigned)w; }
__device__ __forceinline__ f32x4 unpk8(unsigned w) { const f32x2 lo = __builtin_amdgcn_cvt_pk_f32_fp8((int)w, false), hi = __builtin_amdgcn_cvt_pk_f32_fp8((int)w, true); return (f32x4){lo[0], lo[1], hi[0], hi[1]}; }
__device__ __forceinline__ float sigmoidf_(float x) { return __builtin_amdgcn_rcpf(1.0f + __expf(-x)); }
__device__ __forceinline__ float gelu_tanh(float x) { const float t = 1.5957691216057308f * (x + 0.044715f * x * x * x); return x * __builtin_amdgcn_rcpf(1.0f + __expf(-t)); }
__device__ __forceinline__ u32x4 pack8(const f32x4 a, const f32x4 b) { u32x4 w; w.x = pkbf(a[0], a[1]); w.y = pkbf(a[2], a[3]); w.z = pkbf(b[0], b[1]); w.w = pkbf(b[2], b[3]); return w; }
__device__ __forceinline__ void unpack8(const u32x4 w, f32x4& a, f32x4& b) { a = (f32x4){bflo(w.x), bfhi(w.x), bflo(w.y), bfhi(w.y)}; b = (f32x4){bflo(w.z), bfhi(w.z), bflo(w.w), bfhi(w.w)}; }

template <int M> __device__ __forceinline__ float shx(float v, int lane) {
    const int iv = __builtin_bit_cast(int, v); int r;
    if (M == 1) r = __builtin_amdgcn_mov_dpp(iv, 0xB1, 0xf, 0xf, true);
    else if (M == 2) r = __builtin_amdgcn_mov_dpp(iv, 0x4E, 0xf, 0xf, true);
    else if (M == 4) r = __builtin_amdgcn_ds_swizzle(iv, 0x101F);
    else if (M == 8) r = __builtin_amdgcn_ds_swizzle(iv, 0x201F);
    else if (M == 16) r = __builtin_amdgcn_ds_swizzle(iv, 0x401F);
    else r = __builtin_amdgcn_ds_bpermute((lane ^ M) << 2, iv);
    return __builtin_bit_cast(float, r);
}
__device__ __forceinline__ float bperm(float v, int srclane) { return __builtin_bit_cast(float, __builtin_amdgcn_ds_bpermute(srclane << 2, __builtin_bit_cast(int, v))); }
__device__ __forceinline__ int bpermi(int v, int srclane) { return __builtin_amdgcn_ds_bpermute(srclane << 2, v); }
__device__ __forceinline__ int lane_id_opaque() { unsigned m = ~0u; asm volatile("" : "+s"(m)); return (int)__builtin_amdgcn_mbcnt_hi(m, __builtin_amdgcn_mbcnt_lo(m, 0u)); }

#define EPI_IDS() int frq_ = lane_id_opaque(); fr = frq_ & 15; fq = frq_ >> 4; (void)frq_;     \
        const int row0 = u.pm * BM + wr * 64 + fr, col0 = u.pn * BM + wc * 64 + 16 * fq; (void)row0; (void)col0
constexpr int CBJ = 8;
__device__ __forceinline__ void store_pair(bf16_t* rowp, long offA, long offB, const u32x4 p0, const u32x4 p1, bool up) {
    u32x4 recv, dA, dB;
#pragma unroll
    for (int k = 0; k < 4; ++k) { const unsigned send = up ? p0[k] : p1[k]; recv[k] = (unsigned)__builtin_amdgcn_update_dpp(0, (int)send, 0x128, 0xf, 0xf, true); dA[k] = up ? recv[k] : p0[k]; dB[k] = up ? p1[k] : recv[k]; }
    *(u32x4*)(rowp + offA) = dA; *(u32x4*)(rowp + offB) = dB;
}
#define EPI_PAIR_OFFS(pitch) const bool up_ = (fr & 8) != 0; const long offA_ = up_ ? (long)8 - 8 * (long)(pitch) : 0, offB_ = up_ ? 8 : 8 * (long)(pitch)

struct RangeOrder {
    StaticOrder b; int i0, i1;
    __device__ __forceinline__ bool next(int i, Unit& u) const { return (i + i0 < i1) && b.next(i + i0, u); }
    __device__ __forceinline__ void a_ready(const Unit&) const {}
    __device__ __forceinline__ void done(const Unit&) const {}
};

struct EpiPlain {
    static constexpr bool PERM = true, PERM2 = true, AFTER_DRAIN = false;
    bf16_t* O; int ldc;
    __device__ __forceinline__ void operator()(const f32x4 (&acc)[2][2][4][2], const Unit& u, int wr, int wc, int fr, int fq) const {
        EPI_IDS(); EPI_PAIR_OFFS(ldc);
#pragma unroll
        for (int ai = 0; ai < 2; ++ai)
#pragma unroll
            for (int m = 0; m < 4; ++m) { bf16_t* rowp = O + (size_t)(row0 + ai * HALF + m * 16) * ldc + col0;
                store_pair(rowp, offA_, offB_, pack8(acc[ai][0][m][0], acc[ai][0][m][1]), pack8(acc[ai][1][m][0], acc[ai][1][m][1]), up_); }
    }
};

struct EpiWin {
    static constexpr bool PERM = true, PERM2 = true, AFTER_DRAIN = false;
    bf16_t *U, *Q, *K, *V; unsigned char *SGA, *SGB; float* kmean; const float* rope;
    float qscale;
    __device__ __forceinline__ void operator()(const f32x4 (&acc)[2][2][4][2], const Unit& u, int wr, int wc, int fr, int fq) const {
        EPI_IDS();
        const int pn = u.pn;
        if (pn < 2) {
            const int g = (pn * 256 + wc * 64) / 16 + fq;
#pragma unroll
            for (int ai = 0; ai < 2; ++ai)
#pragma unroll
                for (int m = 0; m < 4; ++m) { const int row = row0 + ai * HALF + m * 16, b = row >> 13, t = row & 8191; bf16_t* up = U + ((size_t)(b * 32 + g) * 8192 + t) * 16;
#pragma unroll
                    for (int bj = 0; bj < 2; ++bj) *(u32x4*)(up + 8 * bj) = pack8(acc[ai][bj][m][0], acc[ai][bj][m][1]); }
        } else if (pn < 6) {
            const bool isq = pn < 4; bf16_t* dst = isq ? Q : K; const int cb = (pn - (isq ? 2 : 4)) * 256 + wc * 64 + 16 * fq;
            const float sc = isq ? qscale : 1.0f;
            float cs[2][8];
#pragma unroll
            for (int bj = 0; bj < 2; ++bj)
#pragma unroll
                for (int i = 0; i < 8; ++i) cs[bj][i] = 0.f;
#pragma unroll
            for (int ai = 0; ai < 2; ++ai)
#pragma unroll
                for (int m = 0; m < 4; ++m) { const int row = row0 + ai * HALF + m * 16;
                    f32x4 v[2][2];
#pragma unroll
                    for (int bj = 0; bj < 2; ++bj) { v[bj][0] = acc[ai][bj][m][0]; v[bj][1] = acc[ai][bj][m][1]; }
                    { const f32x4* cp = (const f32x4*)(rope + (size_t)row * 16);
                      const f32x4 c01 = cp[0], c23 = cp[1], c45 = cp[2], c67 = cp[3];
                      const float co[8] = {c01[0], c01[2], c23[0], c23[2], c45[0], c45[2], c67[0], c67[2]};
                      const float si[8] = {c01[1], c01[3], c23[1], c23[3], c45[1], c45[3], c67[1], c67[3]};
#pragma unroll
                      for (int n = 0; n < 2; ++n)
#pragma unroll
                          for (int e = 0; e < 4; ++e) { const float a = v[0][n][e], b = v[1][n][e];
                              const float ra = a * co[4 * n + e] - b * si[4 * n + e], rb = b * co[4 * n + e] + a * si[4 * n + e];
                              v[0][n][e] = (fq == 0) ? ra : a; v[1][n][e] = (fq == 0) ? rb : b; } }
#pragma unroll
                    for (int bj = 0; bj < 2; ++bj) {
                        if (!isq) {
#pragma unroll
                            for (int n = 0; n < 2; ++n)
#pragma unroll
                                for (int e = 0; e < 4; ++e) cs[bj][4 * n + e] += v[bj][n][e]; } }
                    { EPI_PAIR_OFFS(512); store_pair(dst + (size_t)row * 512 + cb, offA_, offB_, pack8(v[0][0] * sc, v[0][1] * sc), pack8(v[1][0] * sc, v[1][1] * sc), up_); }
                }
            if (!isq) {
#pragma unroll
                for (int bj = 0; bj < 2; ++bj)
#pragma unroll
                    for (int i = 0; i < 8; ++i) { float s = cs[bj][i]; s += shx<1>(s, frq_); s += shx<2>(s, frq_); s += shx<4>(s, frq_); s += shx<8>(s, frq_);
                        if (fr == 0) atomicAdd(kmean + (size_t)u.pm * 512 + cb + bj * CBJ + i, s); }
            }
        } else if (pn < 8) {
            const int cb = (pn - 6) * 256 + wc * 64 + 16 * fq;
#pragma unroll
            for (int ai = 0; ai < 2; ++ai)
#pragma unroll
                for (int m = 0; m < 4; ++m) { const int row = row0 + ai * HALF + m * 16; EPI_PAIR_OFFS(512);
                    store_pair(V + (size_t)row * 512 + cb, offA_, offB_, pack8(acc[ai][0][m][0], acc[ai][0][m][1]), pack8(acc[ai][1][m][0], acc[ai][1][m][1]), up_); }
        } else {
            unsigned char* dst = pn < 12 ? SGA : SGB; const int cb = (pn - (pn < 12 ? 8 : 12)) * 256 + wc * 64 + 16 * fq;
#pragma unroll
            for (int ai = 0; ai < 2; ++ai)
#pragma unroll
                for (int m = 0; m < 4; ++m) { const int row = row0 + ai * HALF + m * 16; u32x4 o8;
#pragma unroll
                    for (int bj = 0; bj < 2; ++bj) { f32x4 a = acc[ai][bj][m][0], b = acc[ai][bj][m][1];
#pragma unroll
                        for (int e = 0; e < 4; ++e) { a[e] = sigmoidf_(a[e]); b[e] = sigmoidf_(b[e]); }
                        o8[2 * bj] = pkf8(a[0], a[1], a[2], a[3]); o8[2 * bj + 1] = pkf8(b[0], b[1], b[2], b[3]); }
                    *(u32x4*)(dst + (size_t)row * 1024 + cb) = o8; }
        }
    }
};

struct EpiGlu {
    static constexpr bool PERM = true, PERM2 = true, AFTER_DRAIN = false;
    const bf16_t* YP; bf16_t* YS;
    __device__ __forceinline__ void operator()(const f32x4 (&acc)[2][2][4][2], const Unit& u, int wr, int wc, int fr, int fq) const {
        EPI_IDS();
#pragma unroll
        for (int ai = 0; ai < 2; ++ai)
#pragma unroll
            for (int m = 0; m < 4; ++m) { const size_t off = (size_t)(row0 + ai * HALF + m * 16) * 512 + col0; u32x4 o8;
#pragma unroll
                for (int bj = 0; bj < 2; ++bj) { const u32x4 w = *(const u32x4*)(YP + off + bj * CBJ); f32x4 ya, yb; unpack8(w, ya, yb);
                    f32x4 a = acc[ai][bj][m][0], b = acc[ai][bj][m][1];
#pragma unroll
                    for (int e = 0; e < 4; ++e) { a[e] = ya[e] * sigmoidf_(a[e]); b[e] = yb[e] * sigmoidf_(b[e]); }
                    o8[2 * bj] = pkf8(a[0], a[1], a[2], a[3]); o8[2 * bj + 1] = pkf8(b[0], b[1], b[2], b[3]); }
                *(u32x4*)((unsigned char*)YS + off) = o8; }
    }
};

template <int MODE> struct EpiMerge {
    static constexpr bool PERM = true, PERM2 = true, AFTER_DRAIN = false;
    const unsigned char* G8; bf16_t* T1; unsigned char* M8;
    __device__ __forceinline__ void operator()(const f32x4 (&acc)[2][2][4][2], const Unit& u, int wr, int wc, int fr, int fq) const {
        EPI_IDS();
#pragma unroll
        for (int ai = 0; ai < 2; ++ai)
#pragma unroll
            for (int m = 0; m < 4; ++m) { const size_t off = (size_t)(row0 + ai * HALF + m * 16) * 1024 + col0; u32x4 o8, pk[2]; EPI_PAIR_OFFS(1024);
                const u32x4 g8 = *(const u32x4*)(G8 + off);
#pragma unroll
                for (int bj = 0; bj < 2; ++bj) { const f32x4 ga = unpk8(g8[2 * bj]), gb = unpk8(g8[2 * bj + 1]);
                    f32x4 a = acc[ai][bj][m][0], b = acc[ai][bj][m][1];
                    if (MODE == 0) { a = ga * a; b = gb * b; pk[bj] = pack8(a, b); }
                    else { const u32x4 w = *(const u32x4*)(T1 + off + bj * CBJ); f32x4 ta, tb; unpack8(w, ta, tb); a = ta + ga * a; b = tb + gb * b;
                        o8[2 * bj] = pkf8(a[0], a[1], a[2], a[3]); o8[2 * bj + 1] = pkf8(b[0], b[1], b[2], b[3]); } }
                if (MODE == 1) *(u32x4*)(M8 + off) = o8; else store_pair(T1 + off, offA_, offB_, pk[0], pk[1], up_); }
    }
};

struct EpiResid {
    static constexpr bool PERM = true, PERM2 = true, AFTER_DRAIN = false;
    const float* X; bf16_t* X1B; float* sumsq;
    __device__ __forceinline__ void operator()(const f32x4 (&acc)[2][2][4][2], const Unit& u, int wr, int wc, int fr, int fq) const {
        EPI_IDS();
#pragma unroll
        for (int ai = 0; ai < 2; ++ai)
#pragma unroll
            for (int m = 0; m < 4; ++m) { const int row = row0 + ai * HALF + m * 16; const size_t off = (size_t)row * 1024 + col0; float ss = 0.f; u32x4 pk[2]; EPI_PAIR_OFFS(1024);
#pragma unroll
                for (int bj = 0; bj < 2; ++bj) { const f32x4 xa = *(const f32x4*)(X + off + bj * CBJ), xb = *(const f32x4*)(X + off + bj * CBJ + 4);
                    const f32x4 a = xa + acc[ai][bj][m][0], b = xb + acc[ai][bj][m][1];
                    pk[bj] = pack8(a, b);
                    ss += (a[0] * a[0] + a[1] * a[1]) + (a[2] * a[2] + a[3] * a[3]) + (b[0] * b[0] + b[1] * b[1]) + (b[2] * b[2] + b[3] * b[3]); }
                store_pair(X1B + off, offA_, offB_, pk[0], pk[1], up_);
                ss += shx<16>(ss, frq_); ss += shx<32>(ss, frq_);
                if (fq == 0) atomicAdd(sumsq + row, ss); }
    }
};

struct EpiScores {
    static constexpr bool PERM = true, PERM2 = true, AFTER_DRAIN = false;
    bf16_t* S; const float* sumsq;
    __device__ __forceinline__ void operator()(const f32x4 (&acc)[2][2][4][2], const Unit& u, int wr, int wc, int fr, int fq) const {
        EPI_IDS(); EPI_PAIR_OFFS(2048);
#pragma unroll
        for (int ai = 0; ai < 2; ++ai)
#pragma unroll
            for (int m = 0; m < 4; ++m) { const int row = row0 + ai * HALF + m * 16; const size_t off = (size_t)row * 2048 + col0;
                const float rs = 1.0f / sqrtf(sumsq[row] * (1.0f / 1024.0f) + 1e-6f);
                store_pair(S + off, offA_, offB_, pack8(acc[ai][0][m][0] * rs, acc[ai][0][m][1] * rs), pack8(acc[ai][1][m][0] * rs, acc[ai][1][m][1] * rs), up_); }
    }
};

struct EpiPle {
    static constexpr bool PERM = true, PERM2 = true, AFTER_DRAIN = false;
    const bf16_t* X2B; bf16_t* E; const float* rs2; float* sumsq;
    __device__ __forceinline__ void operator()(const f32x4 (&acc)[2][2][4][2], const Unit& u, int wr, int wc, int fr, int fq) const {
        EPI_IDS();
#pragma unroll
        for (int ai = 0; ai < 2; ++ai)
#pragma unroll
            for (int m = 0; m < 4; ++m) { const int row = row0 + ai * HALF + m * 16; const size_t off = (size_t)row * 1024 + col0; float ss = 0.f; const float rs = rs2[row]; u32x4 pk[2]; EPI_PAIR_OFFS(1024);
#pragma unroll
                for (int bj = 0; bj < 2; ++bj) { const u32x4 wx = *(const u32x4*)(X2B + off + bj * CBJ); f32x4 xa, xb; unpack8(wx, xa, xb);
                    const u32x4 w = *(const u32x4*)(E + off + bj * CBJ); f32x4 ea, eb; unpack8(w, ea, eb);
                    f32x4 a = acc[ai][bj][m][0], b = acc[ai][bj][m][1];
#pragma unroll
                    for (int e = 0; e < 4; ++e) { a[e] = xa[e] + sigmoidf_(rs * a[e]) * ea[e]; b[e] = xb[e] + sigmoidf_(rs * b[e]) * eb[e]; }
                    pk[bj] = pack8(a, b);
                    ss += (a[0] * a[0] + a[1] * a[1]) + (a[2] * a[2] + a[3] * a[3]) + (b[0] * b[0] + b[1] * b[1]) + (b[2] * b[2] + b[3] * b[3]); }
                store_pair(E + off, offA_, offB_, pk[0], pk[1], up_);
                ss += shx<16>(ss, frq_); ss += shx<32>(ss, frq_);
                if (fq == 0) atomicAdd(sumsq + row, ss); }
    }
};
#undef EPI_IDS
#undef EPI_PAIR_OFFS
typedef int v4i_t __attribute__((ext_vector_type(4)));
constexpr int W8_SHIFT = 6;
template <class Epi, class Sched, bool ALIGN_EPI = false, bool SP2 = false, bool FP8 = false, int KC = 0>
__device__ __forceinline__ void gemm_phase(PG8_LAS unsigned char* lds, const Gemm g, const Sched& S, const Epi& E, const int wave_s) {
    int tid_o = wave_s * 64 + lane_id_opaque(); asm volatile("" : "+v"(tid_o)); const int tid = tid_o, wid = __builtin_amdgcn_readfirstlane(tid >> 6), lane = tid & 63, wr = wid >> 2, wc = wid & 3, fr = lane & 15, fq = lane >> 4;
    const int K = KC ? KC : g.K, nt = FP8 ? K / 128 : K / BK;
    unsigned voffA[2], voffB[2]; int aoff, boff;
#define PG8_LANE_SETUP() do { int t_ = wave_s * 64 + lane_id_opaque(); asm volatile("" : "+v"(t_)); const int l_ = t_ & 63, fr_ = l_ & 15, fq_ = l_ >> 4; \
        _Pragma("unroll") for (int i = 0; i < 2; ++i) { int R, C; stage_rc(t_ * 16 + i * 8192, R, C); const int Rb = Epi::PERM2 ? (64 * (R >> 5) + 16 * ((R >> 2) & 3) + 4 * ((R >> 4) & 1) + (R & 3)) : Epi::PERM ? ((R & ~31) + perm32(R & 31)) : R;     \
            voffA[i] = FP8 ? (unsigned)(R * K + 2 * C) : (unsigned)(R * K + C) * 2u; voffB[i] = FP8 ? (unsigned)(Rb * K + 2 * C) : (unsigned)(Rb * K + C) * 2u; } \
        aoff = lds_byte(wr * 64 + fr_, fq_ * 8); boff = lds_byte(wc * 32 + fr_, fq_ * 8); } while (0)
    PG8_LANE_SETUP();
#if 0
    for (int i = 0; i < 2; ++i) { int R, C; stage_rc(tid * 16 + i * 8192, R, C); const int Rb = Epi::PERM ? ((R & ~31) + perm32(R & 31)) : R;
        voffA[i] = FP8 ? (unsigned)(R * K + 2 * C) : (unsigned)(R * K + C) * 2u; voffB[i] = FP8 ? (unsigned)(Rb * K + 2 * C) : (unsigned)(Rb * K + C) * 2u; }
#endif
    const size_t kstep = (size_t)(BK * 2);
    const size_t hstep = (size_t)HALF * K * (FP8 ? 1 : 2); const size_t hstepB = Epi::PERM2 ? (size_t)8 * K * (FP8 ? 1 : 2) : hstep;
    const size_t tstep = 2 * hstep;
    const unsigned ldsw = (unsigned)wid * 1024u;
#define PG8_SA(b, h) (((b) * 2 + (h)) * HTB)
#define PG8_SB(b, h) ((4 + (b) * 2 + (h)) * HTB)
#define PG8_STAGE(bufoff, gbase, voff) do { const char* gb_ = (const char*)(gbase); asm volatile("" : "+s"(gb_)); _Pragma("unroll") for (int _i = 0; _i < 2; ++_i) \
        __builtin_amdgcn_global_load_lds((const unsigned*)(gb_ + (voff)[_i]), (PG8_LAS unsigned*)(lds + (bufoff) + ldsw + _i * 8192), 16, 0, 0); } while (0)
#define PG8_LDA(dst, b, h) do { _Pragma("unroll") for (int m = 0; m < 4; ++m) _Pragma("unroll") for (int k = 0; k < 2; ++k) dst[m][k] = *(const PG8_LAS bf16x8*)(lds + PG8_SA(b, h) + aoff + m * 2048 + k * 1024); } while (0)
#define PG8_LDB(dst, b, h) do { _Pragma("unroll") for (int n = 0; n < 2; ++n) _Pragma("unroll") for (int k = 0; k < 2; ++k) dst[n][k] = *(const PG8_LAS bf16x8*)(lds + PG8_SB(b, h) + boff + n * 2048 + k * 1024); } while (0)
#define PG8_CAT8(x0, x1) __builtin_shufflevector(__builtin_bit_cast(v4i_t, x0), __builtin_bit_cast(v4i_t, x1), 0, 1, 2, 3, 4, 5, 6, 7)
#define PG8_MMA(ai, bj, At, Bt) do { __builtin_amdgcn_s_setprio(1); _Pragma("unroll") for (int m = 0; m < 4; ++m) _Pragma("unroll") for (int n = 0; n < 2; ++n) { \
        if constexpr (FP8) acc[ai][bj][m][n] = __builtin_amdgcn_mfma_scale_f32_16x16x128_f8f6f4(PG8_CAT8(Bt[n][0], Bt[n][1]), PG8_CAT8(At[m][0], At[m][1]), acc[ai][bj][m][n], 0, 0, 0, 0, 0, 0); \
        else { _Pragma("unroll") for (int k = 0; k < 2; ++k) acc[ai][bj][m][n] = __builtin_amdgcn_mfma_f32_16x16x32_bf16(Bt[n][k], At[m][k], acc[ai][bj][m][n], 0, 0, 0); } } __builtin_amdgcn_s_setprio(0); } while (0)
#define PG8_WAIT_V(n) asm volatile("s_waitcnt vmcnt(" #n ")" ::: "memory")
#define PG8_WAIT_L(n) asm volatile("s_waitcnt lgkmcnt(" #n ")" ::: "memory")
#define PG8_BAR __builtin_amdgcn_s_barrier()
#define PG8_SCHED __builtin_amdgcn_sched_barrier(0)
    Unit cur, nxt; int ui = 0;
    if (!S.next(0, cur)) return;
    f32x4 acc[2][2][4][2];
#pragma unroll
    for (int a = 0; a < 2; ++a)
#pragma unroll
        for (int b = 0; b < 2; ++b)
#pragma unroll
            for (int m = 0; m < 4; ++m)
#pragma unroll
                for (int n = 0; n < 2; ++n) acc[a][b][m][n] = (f32x4){0.f, 0.f, 0.f, 0.f};
    bf16x8 At[4][2], B0[2][2], B1[2][2];
    const char* cA = (const char*)g.A + (size_t)cur.pm * tstep; const char* cB = (const char*)g.Bt + (size_t)cur.pn * tstep;
    S.a_ready(cur);
    if constexpr (SP2) {
        PG8_STAGE(PG8_SB(0, 0), cB, voffB); PG8_STAGE(PG8_SB(0, 1), cB + hstepB, voffB); PG8_STAGE(PG8_SA(0, 0), cA, voffA); PG8_STAGE(PG8_SA(0, 1), cA + hstep, voffA);
        if (wr == 1) PG8_BAR;
        PG8_WAIT_V(2); PG8_BAR;
        PG8_STAGE(PG8_SB(1, 0), cB + kstep, voffB); PG8_STAGE(PG8_SA(1, 0), cA + kstep, voffA); PG8_STAGE(PG8_SB(1, 1), cB + hstepB + kstep, voffB);
        PG8_WAIT_V(6); PG8_BAR;
    } else {
        PG8_STAGE(PG8_SB(0, 0), cB, voffB); PG8_STAGE(PG8_SA(0, 0), cA, voffA); PG8_STAGE(PG8_SB(0, 1), cB + hstepB, voffB); PG8_STAGE(PG8_SA(0, 1), cA + hstep, voffA);
        if (wr == 1) PG8_BAR;
        PG8_WAIT_V(4); PG8_BAR;
        PG8_STAGE(PG8_SB(1, 0), cB + kstep, voffB); PG8_STAGE(PG8_SA(1, 0), cA + kstep, voffA); PG8_STAGE(PG8_SB(1, 1), cB + hstepB + kstep, voffB);
        PG8_WAIT_V(6); PG8_BAR;
    }
    for (;;) {
        const bool has_next = S.next(ui + 1, nxt);
        const char* nA = has_next ? (const char*)g.A + (size_t)nxt.pm * tstep : cA; const char* nB = has_next ? (const char*)g.Bt + (size_t)nxt.pn * tstep : cB;
#pragma nounroll
        for (int t = 0; t < nt; t += 2) {
            const bool last = (t == nt - 2);
            const char* a1 = cA + (size_t)(t + 1) * kstep;
            const char* a2 = last ? nA : cA + (size_t)(t + 2) * kstep; const char* b2 = last ? nB : cB + (size_t)(t + 2) * kstep;
            const char* a3 = a2 + kstep; const char* b3 = b2 + kstep;
            if (last && has_next) S.a_ready(nxt);
            if constexpr (SP2) {
            PG8_LDB(B0, 0, 0); PG8_LDB(B1, 0, 1); PG8_SCHED; PG8_LDA(At, 0, 0); PG8_STAGE(PG8_SA(1, 1), a1 + hstep, voffA);
            PG8_WAIT_V(8); PG8_WAIT_L(0); PG8_BAR; PG8_MMA(0, 0, At, B0); PG8_MMA(0, 1, At, B1); PG8_BAR; PG8_SCHED;
            PG8_LDA(At, 0, 1); PG8_STAGE(PG8_SB(0, 0), b2, voffB); PG8_STAGE(PG8_SB(0, 1), b2 + hstepB, voffB); PG8_STAGE(PG8_SA(0, 0), a2, voffA);
            PG8_WAIT_V(8); PG8_WAIT_L(0); PG8_BAR; PG8_MMA(1, 0, At, B0); PG8_MMA(1, 1, At, B1); PG8_BAR; PG8_SCHED;
            PG8_LDB(B0, 1, 0); PG8_LDB(B1, 1, 1); PG8_SCHED; PG8_LDA(At, 1, 0); PG8_STAGE(PG8_SA(0, 1), a2 + hstep, voffA);
            PG8_WAIT_V(8); PG8_WAIT_L(0); PG8_BAR; PG8_MMA(0, 0, At, B0); PG8_MMA(0, 1, At, B1); PG8_BAR; PG8_SCHED;
            PG8_LDA(At, 1, 1); PG8_STAGE(PG8_SB(1, 0), b3, voffB); PG8_STAGE(PG8_SB(1, 1), b3 + hstepB, voffB); PG8_STAGE(PG8_SA(1, 0), a3, voffA);
            PG8_WAIT_V(8); PG8_WAIT_L(0); PG8_BAR; PG8_MMA(1, 0, At, B0); PG8_MMA(1, 1, At, B1); PG8_BAR; PG8_SCHED;
            } else {
            PG8_LDB(B0, 0, 0); PG8_SCHED; PG8_LDA(At, 0, 0); PG8_STAGE(PG8_SA(1, 1), a1 + hstep, voffA);
            PG8_WAIT_L(8); PG8_BAR; PG8_WAIT_L(0); PG8_MMA(0, 0, At, B0); PG8_BAR; PG8_SCHED;
            PG8_LDB(B1, 0, 1); PG8_STAGE(PG8_SB(0, 0), b2, voffB);
            PG8_BAR; PG8_WAIT_L(0); PG8_MMA(0, 1, At, B1); PG8_BAR;
            PG8_LDA(At, 0, 1); PG8_STAGE(PG8_SA(0, 0), a2, voffA);
            PG8_BAR; PG8_WAIT_L(0); PG8_MMA(1, 0, At, B0); PG8_BAR; PG8_SCHED;
            PG8_STAGE(PG8_SB(0, 1), b2 + hstepB, voffB);
            PG8_WAIT_V(6); PG8_BAR; PG8_MMA(1, 1, At, B1); PG8_BAR;
            PG8_LDB(B0, 1, 0); PG8_SCHED; PG8_LDA(At, 1, 0); PG8_STAGE(PG8_SA(0, 1), a2 + hstep, voffA);
            PG8_WAIT_L(8); PG8_BAR; PG8_WAIT_L(0); PG8_MMA(0, 0, At, B0); PG8_BAR; PG8_SCHED;
            PG8_LDB(B1, 1, 1); PG8_STAGE(PG8_SB(1, 0), b3, voffB);
            PG8_BAR; PG8_WAIT_L(0); PG8_MMA(0, 1, At, B1); PG8_BAR;
            PG8_LDA(At, 1, 1); PG8_STAGE(PG8_SA(1, 0), a3, voffA);
            PG8_BAR; PG8_WAIT_L(0); PG8_MMA(1, 0, At, B0); PG8_BAR; PG8_SCHED;
            PG8_STAGE(PG8_SB(1, 1), b3 + hstepB, voffB);
            PG8_WAIT_V(6); PG8_BAR; PG8_MMA(1, 1, At, B1); PG8_BAR;
            }
        }
        if constexpr (ALIGN_EPI) { if (wr == 0) PG8_BAR; }
        if constexpr (FP8) {
#pragma unroll
            for (int a = 0; a < 2; ++a)
#pragma unroll
                for (int b = 0; b < 2; ++b)
#pragma unroll
                    for (int m = 0; m < 4; ++m)
#pragma unroll
                        for (int n = 0; n < 2; ++n) acc[a][b][m][n] *= (1.0f / (float)(1 << W8_SHIFT)); }
        if constexpr (!Epi::AFTER_DRAIN) { E(acc, cur, wr, wc, fr, fq); S.done(cur); }
        if (!has_next) break;
#pragma unroll
        for (int a = 0; a < 2; ++a)
#pragma unroll
            for (int b = 0; b < 2; ++b)
#pragma unroll
                for (int m = 0; m < 4; ++m)
#pragma unroll
                    for (int n = 0; n < 2; ++n) acc[a][b][m][n] = (f32x4){0.f, 0.f, 0.f, 0.f};
        cur = nxt; cA = nA; cB = nB; ++ui;
        PG8_LANE_SETUP();
        if constexpr (ALIGN_EPI) { if (wr == 1) PG8_BAR; }
    }
    PG8_WAIT_V(0);
    if constexpr (!ALIGN_EPI) { if (wr == 0) PG8_BAR; }
    PG8_BAR;
    if constexpr (Epi::AFTER_DRAIN) { E.fused(acc, cur, wr, wc, fr, fq, lds, wid, lane); S.done(cur); }
#undef PG8_SA
#undef PG8_SB
#undef PG8_STAGE
#undef PG8_LDA
#undef PG8_LDB
#undef PG8_LANE_SETUP
#undef PG8_MMA
#undef PG8_CAT8
#undef PG8_WAIT_V
#undef PG8_WAIT_L
#undef PG8_BAR
#undef PG8_SCHED
}
}

#include <hip/hip_bf16.h>
namespace moba {
using bf16=__hip_bfloat16;
using bf16x8=__attribute__((ext_vector_type(8)))short;
using s16x4=__attribute__((ext_vector_type(4)))short;
using f32x16=__attribute__((ext_vector_type(16)))float;
using u32x4=__attribute__((ext_vector_type(4)))unsigned;
using f32x4_m=__attribute__((ext_vector_type(4)))float;
constexpr int BATCH=4,NHEAD=8,SEQ=8192,D=64,DM=NHEAD*D;
constexpr int NW=8,QBLK=32,QB=QBLK*NW,KVBLK=64,NQB=SEQ/QB;
constexpr int ATTN_PITCH=DM, ATTN_UNIT_ROWS=QB;
__device__ __forceinline__ int crow(int r,int hi){return (r&3)+8*(r>>2)+4*hi;}
#define SBAR() __builtin_amdgcn_sched_barrier(0)
__device__ __forceinline__ void cmask(f32x16&p0,f32x16&p1,int jb,int qrel,int hi){
  const float NEG=-INFINITY; int kb=64*jb+4*hi;
  #pragma unroll
  for(int r=0;r<16;++r){int kv=kb+(r&3)+8*(r>>2); if(kv>qrel)p0[r]=NEG; if(kv+32>qrel)p1[r]=NEG;}
}

constexpr int NSLOT=3, SLOTB=8192;
constexpr int LDS_K=0, LDS_V=NSLOT*SLOTB, LDS_WS=2*NSLOT*SLOTB, LDS_OST=LDS_WS+NW*64*4, LDS_BYTES=LDS_OST+NW*4096;
constexpr float C2=0.125f*1.4426950408889634f;
__device__ __forceinline__ void glds16(const void*gsrc,unsigned lds_dst){unsigned keep;
  asm volatile("s_mov_b32 %0, m0\n\ts_mov_b32 m0, %2\n\ts_nop 0\n\tglobal_load_lds_dwordx4 %1, off\n\ts_mov_b32 m0, %0":"=&s"(keep):"v"(gsrc),"s"(lds_dst):"memory");}
__device__ __forceinline__ float max3f(float a,float b,float c){float r;asm("v_max3_f32 %0, %1, %2, %3":"=v"(r):"v"(a),"v"(b),"v"(c));return r;}
__device__ __forceinline__ float max2f(float a,float b){float r;asm("v_max_f32_e32 %0, %1, %2":"=v"(r):"v"(a),"v"(b));return r;}
__device__ __forceinline__ float fadd_s(float a,float b){float r;asm("v_add_f32_e32 %0, %1, %2":"=v"(r):"v"(a),"v"(b));return r;}
__device__ __forceinline__ float fsub_s(float a,float b){float r;asm("v_sub_f32_e32 %0, %1, %2":"=v"(r):"v"(a),"v"(b));return r;}
typedef float f32x2_t __attribute__((ext_vector_type(2))); typedef __bf16 bf16x2_t __attribute__((ext_vector_type(2)));
__device__ __forceinline__ unsigned cvtpk_s(float lo,float hi){f32x2_t v={lo,hi};bf16x2_t b=__builtin_convertvector(v,bf16x2_t);return __builtin_bit_cast(unsigned,b);}
#define WAIT_BAR(N) asm volatile("s_waitcnt vmcnt(" #N ") lgkmcnt(0)\n\ts_barrier":::"memory")

__device__ __forceinline__ void qkt(f32x16&p0,f32x16&p1,const char*Kslot,const bf16x8*qr,const f32x16&negm,int r32,int hi){
  const char*kb=Kslot+hi*1024+r32*16;
  #pragma unroll
  for(int d0=0;d0<4;++d0){
    const bf16x8 b0=*reinterpret_cast<const bf16x8*>(kb+d0*2048);
    const bf16x8 b1=*reinterpret_cast<const bf16x8*>(kb+d0*2048+512);
    if(d0==0){p0=__builtin_amdgcn_mfma_f32_32x32x16_bf16(b0,qr[0],negm,0,0,0);p1=__builtin_amdgcn_mfma_f32_32x32x16_bf16(b1,qr[0],negm,0,0,0);}
    else{p0=__builtin_amdgcn_mfma_f32_32x32x16_bf16(b0,qr[d0],p0,0,0,0);p1=__builtin_amdgcn_mfma_f32_32x32x16_bf16(b1,qr[d0],p1,0,0,0);}}
}
typedef __attribute__((address_space(3))) const char* lds_cptr;
typedef short v4i16_t __attribute__((ext_vector_type(4)));
__device__ __forceinline__ void kload8(bf16x8*kf,lds_cptr kp){
  kf[0]=*(const __attribute__((address_space(3))) bf16x8*)(kp);      kf[1]=*(const __attribute__((address_space(3))) bf16x8*)(kp+512);
  kf[2]=*(const __attribute__((address_space(3))) bf16x8*)(kp+2048); kf[3]=*(const __attribute__((address_space(3))) bf16x8*)(kp+2560);
  kf[4]=*(const __attribute__((address_space(3))) bf16x8*)(kp+4096); kf[5]=*(const __attribute__((address_space(3))) bf16x8*)(kp+4608);
  kf[6]=*(const __attribute__((address_space(3))) bf16x8*)(kp+6144); kf[7]=*(const __attribute__((address_space(3))) bf16x8*)(kp+6656);
}
__device__ __forceinline__ void kload2(bf16x8*kf,lds_cptr kp,int j){ kf[2*j]=*(const __attribute__((address_space(3))) bf16x8*)(kp+j*2048); kf[2*j+1]=*(const __attribute__((address_space(3))) bf16x8*)(kp+j*2048+512); }
__device__ __forceinline__ s16x4 vtr(lds_cptr p){ return __builtin_bit_cast(s16x4,__builtin_amdgcn_ds_read_tr16_b64_v4i16((__attribute__((address_space(3))) v4i16_t*)p)); }
__device__ __forceinline__ float rowmax(const f32x16&p0,const f32x16&p1){
  float a=max3f(p0[0],p0[1],p1[0]),b=max3f(p0[2],p0[3],p1[1]);a=max3f(a,p1[2],p1[3]);
  #pragma unroll
  for(int r=4;r<16;r+=4){a=max3f(a,p0[r],p0[r+1]);b=max3f(b,p0[r+2],p0[r+3]);a=max3f(a,p1[r],p1[r+1]);b=max3f(b,p1[r+2],p1[r+3]);}
  const float m=max2f(a,b);
  auto rr=__builtin_amdgcn_permlane32_swap(__float_as_uint(m),__float_as_uint(m),false,false);
  return max2f(__uint_as_float(rr[0]),__uint_as_float(rr[1]));
}
__device__ __forceinline__ void pv(f32x16*o,int vb,bf16x8 pa0,bf16x8 pa1,bf16x8 pa2,bf16x8 pa3){
  #pragma unroll
  for(int d0=0;d0<2;++d0){s16x4 lo[4],hi[4];
    #pragma unroll
    for(int ks=0;ks<4;++ks){
      asm volatile("ds_read_b64_tr_b16 %0,%1 offset:%c2":"=&v"(lo[ks]):"v"(vb),"i"(d0*4096+ks*1024):"memory");
      asm volatile("ds_read_b64_tr_b16 %0,%1 offset:%c2":"=&v"(hi[ks]):"v"(vb),"i"(d0*4096+ks*1024+512):"memory");}
    asm volatile("s_waitcnt lgkmcnt(0)":::"memory");SBAR();
    #define PK(k) (bf16x8){lo[k][0],lo[k][1],lo[k][2],lo[k][3],hi[k][0],hi[k][1],hi[k][2],hi[k][3]}
    o[d0]=__builtin_amdgcn_mfma_f32_32x32x16_bf16(pa0,PK(0),o[d0],0,0,0);
    o[d0]=__builtin_amdgcn_mfma_f32_32x32x16_bf16(pa1,PK(1),o[d0],0,0,0);
    o[d0]=__builtin_amdgcn_mfma_f32_32x32x16_bf16(pa2,PK(2),o[d0],0,0,0);
    o[d0]=__builtin_amdgcn_mfma_f32_32x32x16_bf16(pa3,PK(3),o[d0],0,0,0);
    #undef PK
  }
}

#ifndef ATTN_STORE16
#define ATTN_STORE16(p,v) (*(u32x4*)(p)=(v))
#endif
constexpr int QIDX_OFF=86016;
template<int THRL,bool CAUSAL> __device__ __forceinline__ void attn_unit(int b,int h,int kvb,int qoff,const bf16*Q,const bf16*K,const bf16*V,bf16*PART,float*LSE,bf16*O,char*shm,const int wave_s){
  int tid_o=wave_s*64+pg8::lane_id_opaque(); asm volatile("":"+v"(tid_o)); const int tid=tid_o,lane=tid&63,r32=lane&31,hi=lane>>5; const int wid=__builtin_amdgcn_readfirstlane(tid>>6);
  const long rowbase=(long)b*SEQ; const int bh=b*NHEAD+h;
  const __attribute__((address_space(3))) int*qlist=(const __attribute__((address_space(3))) int*)((lds_cptr)shm+qoff);
  const int qent=CAUSAL?((kvb*QB+wid*QBLK+r32)|(3<<16)):qlist[wid*QBLK+r32]; const int qrow=qent<0?kvb*QB:(qent&0xffff);
  const bf16*Qw=Q+(rowbase+qrow)*DM+h*D;
  const bf16*Kh=K+(rowbase+(long)kvb*QB)*DM+h*D,*Vh=V+(rowbase+(long)kvb*QB)*DM+h*D;
  const unsigned lds0=(unsigned)(uintptr_t)shm;
  float*wsf=(float*)(shm+LDS_WS)+wid*64;
  const bf16*ksrc=Kh+(long)lane*DM+wid*8;
  const bf16*vsrc=Vh+(long)(16*(wid&3)+(lane>>2))*DM+(wid>>2)*32+(lane&3)*8;
  const unsigned kdst=lds0+LDS_K+wid*1024, vdst=lds0+LDS_V+wid*1024;
  #define DMA_K(t,slot) glds16(ksrc+(long)(t)*KVBLK*DM,(unsigned)__builtin_amdgcn_readfirstlane(kdst+(slot)))
  #define DMA_V(t,slot) glds16(vsrc+(long)(t)*KVBLK*DM,(unsigned)__builtin_amdgcn_readfirstlane(vdst+(slot)))
  const int vb0=(int)(lds0+LDS_V)+((lane>>4)&1)*32+(lane&3)*8+(4*hi+((lane&15)>>2))*64;
  const char*Kbase=shm+LDS_K; bf16x8 kf[8];
  const lds_cptr shm3=(lds_cptr)shm; const lds_cptr kp0=shm3+LDS_K+hi*1024+r32*16; const lds_cptr vp0=shm3+LDS_V+((lane>>4)&1)*32+(lane&3)*8+(4*hi+((lane&15)>>2))*64;
  constexpr int NT=4;
  DMA_K(0,0);DMA_V(0,0);DMA_K(1,SLOTB);
  bf16x8 qr[4];
  #pragma unroll
  for(int d0=0;d0<4;++d0)qr[d0]=*reinterpret_cast<const bf16x8*>(&Qw[d0*16+hi*8]);
  float mhat=0.f,l_reg=0.f;f32x16 o[2];o[0]=f32x16{};o[1]=f32x16{};f32x16 negm=f32x16{};asm volatile("":"+v"(negm));
  const int qrel=wid*QBLK+r32;
  #define CMASK(P0,P1,t) do{ if(CAUSAL){int jb_=(t)-(NT-4); if(jb_>=0)cmask(P0,P1,jb_,qrel,hi);} }while(0)
  bool resc=false;
  #define START(P0,P1) do{ const float rm=rowmax(P0,P1); resc=false; \
    { const float dl=__builtin_fmaxf(rm,0.f); mhat=fadd_s(mhat,dl); \
      _Pragma("unroll") for(int r=0;r<16;++r){P0[r]=fsub_s(P0[r],dl);P1[r]=fsub_s(P1[r],dl);} \
      _Pragma("unroll") for(int r=0;r<16;++r)negm[r]=-mhat; asm volatile("":"+v"(negm)); } \
    _Pragma("unroll") for(int r=0;r<16;++r)P0[r]=__builtin_amdgcn_exp2f(P0[r]); }while(0)
  #define RESC() do{ if(resc){ asm volatile("s_waitcnt lgkmcnt(0)":::"memory"); \
      _Pragma("unroll") for(int d_=0;d_<2;++d_) _Pragma("unroll") for(int r=0;r<16;++r)o[d_][r]*=wsf[crow(r,hi)]; } }while(0)
  f32x16 pA0,pA1,pB0,pB1;
  int sl_prev=0,sl_cur=0,sl_next=SLOTB;
  #define ROT() do{sl_prev=sl_cur;sl_cur=sl_next;sl_next=(sl_next==(NSLOT-1)*SLOTB)?0:sl_next+SLOTB;}while(0)
  DMA_K(2,2*SLOTB);
  WAIT_BAR(3);
  qkt(pA0,pA1,Kbase,qr,negm,r32,hi);asm volatile("s_nop 15\n\ts_nop 7":"+v"(pA0),"+v"(pA1));CMASK(pA0,pA1,0);
  START(pA0,pA1);
  _Pragma("unroll") for(int r=0;r<16;++r)pA1[r]=__builtin_amdgcn_exp2f(pA1[r]);
  WAIT_BAR(0);
  DMA_K(3,0);DMA_V(1,SLOTB);
  ROT();
  kload8(kf,kp0+sl_cur);
  WAIT_BAR(2);
  s16x4 vlo[8],vhi[8]; u32x4 pw0,pw1,pw2,pw3;
  #define PKW(P,B) cvtpk_s(P[B],P[B+1])
  #define PAF(k) __builtin_bit_cast(bf16x8,pw##k)
  #define VFR(i) (bf16x8){vlo[i][0],vlo[i][1],vlo[i][2],vlo[i][3],vhi[i][0],vhi[i][1],vhi[i][2],vhi[i][3]}
  #define PIN(x) asm volatile("":"+v"(x))
  #define MX3(a,b,c) __builtin_fmaxf(__builtin_fmaxf((a),(b)),(c))
  #define GAPA(MF,A0,A1,A2,A3,W0,W1,PW) do{ MF; sacc+=A0; sacc+=A1; sacc+=A2; sacc+=A3; PIN(sacc); W0; W1; PIN(PW); SBAR(); }while(0)
  #define EX(v) __builtin_amdgcn_exp2f(v)
  #define GAPB(MF,X,B) do{ MF; X[B]=EX(X[B]); X[B+1]=EX(X[B+1]); X[B+2]=EX(X[B+2]); X[B+3]=EX(X[B+3]); PIN(X); SBAR(); }while(0)
  #define VRD(i) do{ vlo[i]=vtr(vp_+(((i)>>2)*4096+((i)&3)*1024)); vhi[i]=vtr(vp_+(((i)>>2)*4096+((i)&3)*1024+512)); }while(0)
  #define KRD(G,j) do{ if(G){ kload2(kf,kp0+sl_next,j); SBAR(); } }while(0)
  #define STEP(C0,C1,P0,P1,t,GK,GV,GL) do{ SBAR(); \
    const lds_cptr vp_=vp0+sl_prev; \
    VRD(0); SBAR(); float sacc=(P0[0]+P0[1]); \
    GAPA(C0=__builtin_amdgcn_mfma_f32_32x32x16_bf16(kf[0],qr[0],negm,0,0,0), P0[2],P0[3],P0[4],P0[5],     pw0[0]=PKW(P0,0), pw0[1]=PKW(P0,2), pw0); \
    VRD(4); SBAR(); GAPA(C1=__builtin_amdgcn_mfma_f32_32x32x16_bf16(kf[1],qr[0],negm,0,0,0), P0[6],P0[7],P0[8],P0[9],     pw0[2]=PKW(P0,4), pw0[3]=PKW(P0,6), pw0); \
    VRD(1); SBAR(); GAPA(C0=__builtin_amdgcn_mfma_f32_32x32x16_bf16(kf[2],qr[1],C0,0,0,0),   P0[10],P0[11],P0[12],P0[13], pw1[0]=PKW(P0,8), pw1[1]=PKW(P0,10), pw1); \
    VRD(5); SBAR(); GAPA(C1=__builtin_amdgcn_mfma_f32_32x32x16_bf16(kf[3],qr[1],C1,0,0,0),   P0[14],P0[15],P1[0],P1[1],   pw1[2]=PKW(P0,12),pw1[3]=PKW(P0,14), pw1); \
    VRD(2); SBAR(); GAPA(C0=__builtin_amdgcn_mfma_f32_32x32x16_bf16(kf[4],qr[2],C0,0,0,0),   P1[2],P1[3],P1[4],P1[5],     pw2[0]=PKW(P1,0), pw2[1]=PKW(P1,2), pw2); \
    VRD(6); SBAR(); GAPA(C1=__builtin_amdgcn_mfma_f32_32x32x16_bf16(kf[5],qr[2],C1,0,0,0),   P1[6],P1[7],P1[8],P1[9],     pw2[2]=PKW(P1,4), pw2[3]=PKW(P1,6), pw2); \
    VRD(3); SBAR(); GAPA(C0=__builtin_amdgcn_mfma_f32_32x32x16_bf16(kf[6],qr[3],C0,0,0,0),   P1[10],P1[11],P1[12],P1[13], pw3[0]=PKW(P1,8), pw3[1]=PKW(P1,10), pw3); \
    VRD(7); SBAR(); GAPA(C1=__builtin_amdgcn_mfma_f32_32x32x16_bf16(kf[7],qr[3],C1,0,0,0),   P1[14],P1[15],0.f,0.f,       pw3[2]=PKW(P1,12),pw3[3]=PKW(P1,14), pw3); \
    l_reg+=sacc; \
    if(GK){DMA_K((t)+3,sl_cur);} if(GV){DMA_V((t)+1,sl_next);} \
    CMASK(C0,C1,t); \
    { float a=MX3(C0[0],C0[1],C1[0]),b=MX3(C0[2],C0[3],C1[1]); a=MX3(a,C1[2],C1[3]); \
      _Pragma("unroll") for(int r=4;r<16;r+=4){a=MX3(a,C0[r],C0[r+1]);b=MX3(b,C0[r+2],C0[r+3]);a=MX3(a,C1[r],C1[r+1]);b=MX3(b,C1[r+2],C1[r+3]);} \
      float rm=__builtin_fmaxf(a,b); { auto rr=__builtin_amdgcn_permlane32_swap(__float_as_uint(rm),__float_as_uint(rm),false,false); rm=__builtin_fmaxf(__uint_as_float(rr[0]),__uint_as_float(rr[1])); } \
      resc=false; \
      if(__builtin_expect(__any(rm>(float)THRL),0)){ const float dl=__builtin_fmaxf(rm,0.f); mhat+=dl; \
        _Pragma("unroll") for(int r=0;r<16;++r){C0[r]-=dl;C1[r]-=dl;} \
        _Pragma("unroll") for(int r=0;r<16;++r)negm[r]=-mhat; asm volatile("":"+v"(negm)); \
        const float f=__builtin_amdgcn_exp2f(-dl); l_reg*=f; if(hi==0)wsf[r32]=f; resc=true; } } \
    SBAR(); \
    GAPB(o[0]=__builtin_amdgcn_mfma_f32_32x32x16_bf16(PAF(0),VFR(0),o[0],0,0,0), C0,0); \
    GAPB(o[1]=__builtin_amdgcn_mfma_f32_32x32x16_bf16(PAF(0),VFR(4),o[1],0,0,0), C0,4); \
    KRD(GL,0); GAPB(o[0]=__builtin_amdgcn_mfma_f32_32x32x16_bf16(PAF(1),VFR(1),o[0],0,0,0), C0,8); \
    KRD(GL,1); GAPB(o[1]=__builtin_amdgcn_mfma_f32_32x32x16_bf16(PAF(1),VFR(5),o[1],0,0,0), C0,12); \
    KRD(GL,2); GAPB(o[0]=__builtin_amdgcn_mfma_f32_32x32x16_bf16(PAF(2),VFR(2),o[0],0,0,0), C1,0); \
    KRD(GL,3); GAPB(o[1]=__builtin_amdgcn_mfma_f32_32x32x16_bf16(PAF(2),VFR(6),o[1],0,0,0), C1,4); \
    GAPB(o[0]=__builtin_amdgcn_mfma_f32_32x32x16_bf16(PAF(3),VFR(3),o[0],0,0,0), C1,8); \
    GAPB(o[1]=__builtin_amdgcn_mfma_f32_32x32x16_bf16(PAF(3),VFR(7),o[1],0,0,0), C1,12); \
    }while(0)
  int t=1;
  #undef CMASK
  #define CMASK(P0,P1,t) do{}while(0)
  for(;t+5<NT;t+=2){
    STEP(pB0,pB1,pA0,pA1,t,true,true,true);     WAIT_BAR(2); RESC(); ROT();
    STEP(pA0,pA1,pB0,pB1,t+1,true,true,true);   WAIT_BAR(2); RESC(); ROT();
  }
  #undef CMASK
  #define CMASK(P0,P1,t) do{ if(CAUSAL){int jb_=(t)-(NT-4); if(jb_>=0)cmask(P0,P1,jb_,qrel,hi);} }while(0)
  #define ENDW(tt) do{ if((tt)+3<NT){WAIT_BAR(2);} else if((tt)+2<NT){WAIT_BAR(1);} else {WAIT_BAR(0);} }while(0)
  for(;t+1<NT;t+=2){
    STEP(pB0,pB1,pA0,pA1,t,(t+3<NT),(t+1<NT),(t+1<NT));       ENDW(t);   RESC(); ROT();
    STEP(pA0,pA1,pB0,pB1,t+1,(t+4<NT),(t+2<NT),(t+2<NT));     ENDW(t+1); RESC(); ROT();
  }
  STEP(pB0,pB1,pA0,pA1,NT-1,false,false,false); RESC();
  { float sacc=pB0[0]+pB0[1]; _Pragma("unroll") for(int r=2;r<16;++r)sacc+=pB0[r]; _Pragma("unroll") for(int r=0;r<16;++r)sacc+=pB1[r]; l_reg+=sacc;
    pw0=(u32x4){PKW(pB0,0),PKW(pB0,2),PKW(pB0,4),PKW(pB0,6)};pw1=(u32x4){PKW(pB0,8),PKW(pB0,10),PKW(pB0,12),PKW(pB0,14)};pw2=(u32x4){PKW(pB1,0),PKW(pB1,2),PKW(pB1,4),PKW(pB1,6)};pw3=(u32x4){PKW(pB1,8),PKW(pB1,10),PKW(pB1,12),PKW(pB1,14)};
    SBAR(); pv(o,vb0+sl_cur,PAF(0),PAF(1),PAF(2),PAF(3)); }
  #undef PKW
  #undef PAF
  #undef VFR
  #undef PIN
  #undef MX3
  #undef GAPA
  #undef GAPB
  #undef EX
  #undef VRD
  #undef KRD
  #undef STEP
  #undef ENDW
  f32x4_m pls[4]; pg8::u32x2 ppv[4][3];
  if(CAUSAL){
    _Pragma("unroll") for(int i=0;i<4;++i){ const size_t rid=(size_t)bh*SEQ+kvb*QB+wid*QBLK+i*8+(lane>>3); pls[i]=*(const f32x4_m*)(LSE+rid*4);
      _Pragma("unroll") for(int s_=0;s_<3;++s_) ppv[i][s_]=*(const pg8::u32x2*)((const unsigned char*)PART+(rid*4+s_)*64+(lane&7)*8); } }
  {auto rr=__builtin_amdgcn_permlane32_swap(__float_as_uint(l_reg),__float_as_uint(l_reg),false,false);l_reg=__uint_as_float(rr[0])+__uint_as_float(rr[1]);}
  if(hi==0)wsf[32+r32]=l_reg;asm volatile("s_waitcnt lgkmcnt(0)":::"memory");
  float rli[16];
  #pragma unroll
  for(int r=0;r<16;++r)rli[r]=__builtin_amdgcn_rcpf(wsf[32+crow(r,hi)]);
  if(CAUSAL){ if(hi==0) wsf[r32]=mhat+__builtin_amdgcn_logf(l_reg); }
  else if(hi==0&&qent>=0) LSE[((size_t)bh*SEQ+qrow)*4+(qent>>16)]=mhat+__builtin_amdgcn_logf(l_reg);
  { bf16*stg=(bf16*)(shm+LDS_OST)+wid*2048;
    #pragma unroll
    for(int r=0;r<16;++r){const int orow=crow(r,hi);
      #pragma unroll
      for(int d0=0;d0<2;++d0)stg[orow*64+d0*32+r32]=__float2bfloat16(o[d0][r]*rli[r]);}
    asm volatile("s_waitcnt lgkmcnt(0)":::"memory");
    #pragma unroll
    for(int i=0;i<4;++i){const int row=i*8+(lane>>3),ch=lane&7; const u32x4 v=*(const u32x4*)(stg+row*64+ch*8); if(CAUSAL){ const int qr_=kvb*QB+wid*QBLK+row; const float lown=wsf[row]; const f32x4_m ls=pls[i];
        const float L=__builtin_fmaxf(__builtin_fmaxf(lown,ls[0]),__builtin_fmaxf(ls[1],ls[2]));
        const float wo=__builtin_amdgcn_exp2f(lown-L),w0=__builtin_amdgcn_exp2f(ls[0]-L),w1=__builtin_amdgcn_exp2f(ls[1]-L),w2=__builtin_amdgcn_exp2f(ls[2]-L); const float inv=__builtin_amdgcn_rcpf(wo+w0+w1+w2);
        float ac[8]; { const float ww=wo*inv; ac[0]=ww*__uint_as_float(v.x<<16); ac[1]=ww*__uint_as_float(v.x&0xffff0000u); ac[2]=ww*__uint_as_float(v.y<<16); ac[3]=ww*__uint_as_float(v.y&0xffff0000u);
          ac[4]=ww*__uint_as_float(v.z<<16); ac[5]=ww*__uint_as_float(v.z&0xffff0000u); ac[6]=ww*__uint_as_float(v.w<<16); ac[7]=ww*__uint_as_float(v.w&0xffff0000u); }
        _Pragma("unroll") for(int s_=0;s_<3;++s_){ const float ws_=(s_==0?w0:s_==1?w1:w2)*inv; const bool on_=ws_>0.f; pg8::u32x2 pv_=ppv[i][s_]; pv_.x=on_?pv_.x:0u; pv_.y=on_?pv_.y:0u;
          const pg8::f32x4 pa_=pg8::unpk8(pv_.x), pb_=pg8::unpk8(pv_.y);
          ac[0]+=ws_*pa_[0]; ac[1]+=ws_*pa_[1]; ac[2]+=ws_*pa_[2]; ac[3]+=ws_*pa_[3]; ac[4]+=ws_*pb_[0]; ac[5]+=ws_*pb_[1]; ac[6]+=ws_*pb_[2]; ac[7]+=ws_*pb_[3]; }
        pg8::u32x2 ov; ov.x=pg8::pkf8(ac[0],ac[1],ac[2],ac[3]); ov.y=pg8::pkf8(ac[4],ac[5],ac[6],ac[7]);
        *(pg8::u32x2*)((unsigned char*)O+(rowbase+qr_)*DM+h*D+ch*8)=ov; }
      else {const int qe=qlist[wid*QBLK+row]; if(qe>=0){ pg8::u32x2 o8_; o8_.x=pg8::pkf8(__uint_as_float(v.x<<16),__uint_as_float(v.x&0xffff0000u),__uint_as_float(v.y<<16),__uint_as_float(v.y&0xffff0000u)); o8_.y=pg8::pkf8(__uint_as_float(v.z<<16),__uint_as_float(v.z&0xffff0000u),__uint_as_float(v.w<<16),__uint_as_float(v.w&0xffff0000u)); *(pg8::u32x2*)((unsigned char*)PART+(((size_t)bh*SEQ+(qe&0xffff))*4+(qe>>16))*64+ch*8)=o8_; } }} }
  asm volatile("s_waitcnt lgkmcnt(0)\n\ts_barrier":::"memory");
  #undef DMA_K
  #undef DMA_V
  #undef CMASK
  #undef START
  #undef RESC
  #undef ROT
}
constexpr int ATTN_LDS_BYTES=LDS_BYTES;

typedef __attribute__((address_space(3))) float lds_f; typedef __attribute__((address_space(3))) unsigned lds_u; typedef __attribute__((address_space(3))) int lds_i; typedef __attribute__((address_space(3))) unsigned short lds_h;
typedef __attribute__((ext_vector_type(4))) float f4_t;
constexpr int SEL_KM = 0, SEL_GT = 8192, SEL_SUB = SEL_GT + 256 * 33 * 4, SEL_CNT = SEL_SUB + 32 * 256 * 2, SEL_END = SEL_CNT + 128;
constexpr int UP_OFF = 88064, QP_OFF = UP_OFF + 1040 * 4, UI_OFF = QP_OFF + 8 * 36 * 4, QL_OFF = 94208, QL_MAX = 32;
static_assert(UI_OFF + 128 <= QL_OFF && QL_OFF + QL_MAX * 1024 <= 131072 && QIDX_OFF + 1024 <= UP_OFF, "moba LDS map");

constexpr int SEL_HALF = 59392;
static_assert(SEL_END <= SEL_HALF && 2 * SEL_HALF <= 131072, "selection LDS map");
__device__ __forceinline__ void select_pair(int uA, int uB, const bf16* Q, const float* kmean, unsigned short* SUB, unsigned* CNT, float* LSE, char* shm, int tid) {
    const int half = tid >> 8, lt = tid & 255, u = half ? uB : uA;
    const int bh = u >> 5, qb = u & 31, b = bh / NHEAD, h = bh % NHEAD;
    const lds_cptr base = (lds_cptr)shm + half * SEL_HALF;
    lds_h* sub = (lds_h*)(base + SEL_SUB); lds_u* cnt = (lds_u*)(base + SEL_CNT);
    const long rowbase = (long)b * SEQ; const int q0 = qb * QB;
    if (lt < 32) cnt[lt] = 0u;
    const int lane = lt & 63, wq = lt >> 6, r32 = lane & 31, hi = lane >> 5;
    bf16x8 af[4];
#pragma unroll
    for (int kk = 0; kk < 4; ++kk) { const float* kp = kmean + ((size_t)(b * 32 + r32)) * 512 + h * 64 + 16 * kk + 8 * hi; const f4_t k0 = *(const f4_t*)kp, k1 = *(const f4_t*)(kp + 4);
        const pg8::u32x4 w = pg8::pack8(__builtin_bit_cast(pg8::f32x4, k0), __builtin_bit_cast(pg8::f32x4, k1)); af[kk] = __builtin_bit_cast(bf16x8, w); }
    __syncthreads();
#pragma unroll
    for (int c = 0; c < 2; ++c) {
        const int ql = 64 * wq + 32 * c + r32;
        const bf16* qp = Q + (rowbase + q0 + ql) * DM + h * D + 8 * hi;
        f32x16 g = f32x16{};
#pragma unroll
        for (int kk = 0; kk < 4; ++kk) { const bf16x8 bq = *reinterpret_cast<const bf16x8*>(qp + 16 * kk); g = __builtin_amdgcn_mfma_f32_32x32x16_bf16(af[kk], bq, g, 0, 0, 0); }
        float v0 = -INFINITY, v1 = -INFINITY, v2 = -INFINITY; int i0 = -1, i1 = -1, i2 = -1;
#pragma unroll
        for (int r = 0; r < 16; ++r) { const int j = (r & 3) + 8 * (r >> 2) + 4 * hi; const float x = j < qb ? g[r] : -INFINITY;
            const bool c0 = x > v0, c1 = x > v1, c2 = x > v2;
            v2 = c1 ? v1 : (c2 ? x : v2); i2 = c1 ? i1 : (c2 ? j : i2);
            v1 = c0 ? v0 : (c1 ? x : v1); i1 = c0 ? i0 : (c1 ? j : i1);
            v0 = c0 ? x : v0; i0 = c0 ? j : i0; }
        { float pv[3]; int pi[3];
          pv[0] = pg8::shx<32>(v0, lane); pv[1] = pg8::shx<32>(v1, lane); pv[2] = pg8::shx<32>(v2, lane);
          pi[0] = __builtin_amdgcn_ds_bpermute((lane ^ 32) << 2, i0); pi[1] = __builtin_amdgcn_ds_bpermute((lane ^ 32) << 2, i1); pi[2] = __builtin_amdgcn_ds_bpermute((lane ^ 32) << 2, i2);
#pragma unroll
          for (int t = 0; t < 3; ++t) { const float x = pv[t]; const int j = pi[t];
              const bool c0 = x > v0 || (x == v0 && j >= 0 && j < i0), c1 = x > v1 || (x == v1 && j >= 0 && j < i1), c2 = x > v2 || (x == v2 && j >= 0 && j < i2);
              v2 = c1 ? v1 : (c2 ? x : v2); i2 = c1 ? i1 : (c2 ? j : i2);
              v1 = c0 ? v0 : (c1 ? x : v1); i1 = c0 ? i0 : (c1 ? j : i1);
              v0 = c0 ? x : v0; i0 = c0 ? j : i0; } }
        if (hi == 0) {
            if (i0 >= 0) { const unsigned p = __hip_atomic_fetch_add(cnt + i0, 1u, __ATOMIC_RELAXED, __HIP_MEMORY_SCOPE_WORKGROUP); sub[i0 * 256 + p] = (unsigned short)(ql | (0 << 8)); }
            if (i1 >= 0) { const unsigned p = __hip_atomic_fetch_add(cnt + i1, 1u, __ATOMIC_RELAXED, __HIP_MEMORY_SCOPE_WORKGROUP); sub[i1 * 256 + p] = (unsigned short)(ql | (1 << 8)); }
            if (i2 >= 0) { const unsigned p = __hip_atomic_fetch_add(cnt + i2, 1u, __ATOMIC_RELAXED, __HIP_MEMORY_SCOPE_WORKGROUP); sub[i2 * 256 + p] = (unsigned short)(ql | (2 << 8)); }
            float* ls = LSE + ((size_t)bh * SEQ + q0 + ql) * 4; *(f4_t*)ls = (f4_t){-INFINITY, -INFINITY, -INFINITY, -INFINITY}; }
    }
    __syncthreads();
    if (lt < 32) CNT[((size_t)bh * 32 + lt) * 32 + qb] = cnt[lt];
    for (int idx = lt; idx < 32 * 256; idx += 256) { const int j = idx >> 8, i = idx & 255; if ((unsigned)i < cnt[j]) SUB[(((size_t)bh * 32 + j) * 32 + qb) * 256 + i] = sub[idx]; }
    __syncthreads();
}

__device__ __forceinline__ void sparse_phase(const bf16* Q, const bf16* K, const bf16* V, const unsigned short* SUB, const unsigned* CNT, bf16* PART, float* LSE, char* shm, int G, int bx, int tid, int wave_s) {
    lds_i* UP = (lds_i*)((lds_cptr)shm + UP_OFF); lds_i* QP = (lds_i*)((lds_cptr)shm + QP_OFF); lds_i* QI = (lds_i*)((lds_cptr)shm + QIDX_OFF);
    for (int it = tid; it < 1024; it += 512) { const unsigned* c = CNT + (size_t)it * 32; unsigned len = 0u;
#pragma unroll 8
        for (int qb = 0; qb < 32; ++qb) len += c[qb];
        UP[it + 1] = (int)((len + 255u) >> 8); }
    if (tid == 0) UP[0] = 0;
    __syncthreads();
    for (int off = 1; off < 1024; off <<= 1) {
        int a0 = 0, a1 = 0; const int i0 = tid + 1, i1 = tid + 513;
        if (i0 > off) a0 = UP[i0 - off]; if (i1 > off) a1 = UP[i1 - off];
        __syncthreads();
        UP[i0] += a0; UP[i1] += a1;
        __syncthreads();
    }
    const int U = UP[1024];
    lds_i* UI = (lds_i*)((lds_cptr)shm + UI_OFF);
    const int lane = tid & 63, wv = __builtin_amdgcn_readfirstlane(tid >> 6);
    int nloc = bx < U ? (U - bx + G - 1) / G : 0; if (nloc > QL_MAX) nloc = QL_MAX;
    for (int k = wv; k < nloc; k += 8) {
        const int u = bx + k * G;
        int lo_ = 0, hi_ = 1024;
        while (hi_ - lo_ > 1) { const int mid = (lo_ + hi_) >> 1; if (UP[mid] <= u) lo_ = mid; else hi_ = mid; }
        const int item = lo_, t = u - UP[item];
        lds_i* QPw = QP + wv * 36;
        { const int qb = lane & 31; int x = (int)CNT[(size_t)item * 32 + qb];
#pragma unroll
          for (int o = 1; o < 32; o <<= 1) { const int y = __builtin_amdgcn_ds_bpermute(((lane & 32) + ((qb - o) & 31)) << 2, x); if (qb >= o) x += y; }
          if (lane < 32) { QPw[qb + 1] = x; if (qb == 0) QPw[0] = 0; } }
        asm volatile("s_waitcnt lgkmcnt(0)" ::: "memory");
        const int len = QPw[32];
        lds_i* ql = (lds_i*)((lds_cptr)shm + QL_OFF) + k * 256;
#pragma unroll
        for (int i = 0; i < 4; ++i) { const int sidx = lane + 64 * i, g = 256 * t + sidx; int ent = -1;
            if (g < len) { int a_ = 0, bnd = 32; while (bnd - a_ > 1) { const int mid = (a_ + bnd) >> 1; if (QPw[mid] <= g) a_ = mid; else bnd = mid; }
                const unsigned e = SUB[((size_t)item * 32 + a_) * 256 + (g - QPw[a_])]; ent = (a_ * 256 + (int)(e & 255u)) | ((int)(e >> 8) << 16); }
            ql[sidx] = ent; }
        if (lane == 0) UI[k] = item;
    }
    __syncthreads();
    for (int k = 0; k < nloc; ++k) { const int item = UI[k], bh = item >> 5, j = item & 31;
        attn_unit<8, false>(bh / NHEAD, bh % NHEAD, j, QL_OFF + k * 1024, Q, K, V, PART, LSE, nullptr, shm, wave_s); }
    for (int u = bx + QL_MAX * G; u < U; u += G) {
        int lo_ = 0, hi_ = 1024; while (hi_ - lo_ > 1) { const int mid = (lo_ + hi_) >> 1; if (UP[mid] <= u) lo_ = mid; else hi_ = mid; }
        const int item = lo_, t = u - UP[item], bh = item >> 5, j = item & 31;
        if (tid < 64) { const int qb = tid & 31; int x = (int)CNT[(size_t)item * 32 + qb];
#pragma unroll
            for (int o = 1; o < 32; o <<= 1) { const int y = __builtin_amdgcn_ds_bpermute(((tid & 32) + ((qb - o) & 31)) << 2, x); if (qb >= o) x += y; }
            if (tid < 32) { QP[qb + 1] = x; if (qb == 0) QP[0] = 0; } }
        __syncthreads();
        if (tid < 256) { const int g = 256 * t + tid; int ent = -1;
            if (g < QP[32]) { int a_ = 0, bnd = 32; while (bnd - a_ > 1) { const int mid = (a_ + bnd) >> 1; if (QP[mid] <= g) a_ = mid; else bnd = mid; }
                const unsigned e = SUB[((size_t)item * 32 + a_) * 256 + (g - QP[a_])]; ent = (a_ * 256 + (int)(e & 255u)) | ((int)(e >> 8) << 16); }
            QI[tid] = ent; }
        __syncthreads();
        attn_unit<8, false>(bh / NHEAD, bh % NHEAD, j, QIDX_OFF, Q, K, V, PART, LSE, nullptr, shm, wave_s);
    }
}

__device__ __forceinline__ void own_phase(const bf16* Q, const bf16* K, const bf16* V, const bf16* PART, const float* LSE, bf16* O, char* shm, int G, int bx, int wave_s) {
    for (int u = bx; u < BATCH * NHEAD * NQB; u += G) { const int bh = u >> 5, qb = u & 31;
        attn_unit<8, true>(bh / NHEAD, bh % NHEAD, qb, 0, Q, K, V, (bf16*)PART, (float*)LSE, O, shm, wave_s); }
}
#undef SBAR
#undef WAIT_BAR
}

constexpr int NWAVES = 8;
constexpr int NB = 4, SEQ = 8192, T = NB * SEQ, D = 1024;
constexpr int D_SSM = 512, NG = 32, NS = 64;
constexpr int D_ATT = 512;
constexpr int D_IN = 4096;
constexpr int PH = 8, PQD = 256, NEXP = 16384;
constexpr int D_PLE = 256;
constexpr float EPS = 1e-6f;

constexpr size_t MiB = 1u << 20, KiB = 1u << 10;
constexpr size_t WS_CTL = 0, CTL_ZERO_BYTES = 1 * MiB;
constexpr int CW_BAR = 4096;
constexpr size_t CTL_KMEAN = 64 * KiB;
constexpr size_t CTL_SS1 = 320 * KiB;
constexpr size_t CTL_SS3 = 448 * KiB;
constexpr size_t WS_WIN = 1 * MiB;
constexpr size_t WS_WGLU = 9 * MiB;
constexpr size_t WS_WPS = 9 * MiB + 512 * KiB;
constexpr size_t WS_WPA = 10 * MiB + 512 * KiB;
constexpr size_t WS_WOUT = 11 * MiB + 512 * KiB;
constexpr size_t WS_WS = 13 * MiB + 512 * KiB;
constexpr size_t WS_WGATE = 17 * MiB + 512 * KiB;
constexpr size_t WS_WPP = 19 * MiB + 512 * KiB;
constexpr size_t WS_ROPE = 20 * MiB;
constexpr size_t WS_S5P = 22 * MiB;
constexpr size_t WS_RS2 = 23 * MiB;
constexpr size_t WS_UT = 24 * MiB;
constexpr size_t WS_S5W = 40 * MiB;
constexpr size_t WS_VT = 40 * MiB;
constexpr size_t WS_SU = 48 * MiB, WS_SV = 48 * MiB + 64 * KiB;
constexpr size_t WS_X8 = 56 * MiB;
constexpr size_t WS_XN = 88 * MiB;
constexpr size_t WS_MSUB = 88 * MiB, WS_MCNT = 104 * MiB, WS_MLSE = 105 * MiB;
constexpr size_t WS_YP = 112 * MiB;
constexpr size_t WS_PB = 152 * MiB;
constexpr size_t WS_E = 168 * MiB;
constexpr size_t WS_U = 232 * MiB;
constexpr size_t WS_Q = 264 * MiB;
constexpr size_t WS_K = 296 * MiB;
constexpr size_t WS_V = 328 * MiB;
constexpr size_t WS_SGA = 360 * MiB;
constexpr size_t WS_SGB = 424 * MiB;
constexpr size_t WS_SC = 232 * MiB;
constexpr size_t WS_HLOC = 488 * MiB;
constexpr size_t WS_END = 496 * MiB;
constexpr size_t S5_ABR = 0, S5_ABI = 8 * KiB, S5_ALR = 16 * KiB, S5_ALI = 24 * KiB;
constexpr size_t S5_BRE = 32 * KiB, S5_BIM = 160 * KiB;
constexpr size_t S5_CM = 288 * KiB;

constexpr int RING_OFF = 0, RING_BYTES = 131072;
constexpr int LDSCTL_OFF = RING_BYTES, MISC_OFF = LDSCTL_OFF + 320;
constexpr int LDS_BYTES = 147456;

#define GAS __attribute__((address_space(1)))
#define LAS __attribute__((address_space(3)))
typedef unsigned short bf16;
typedef unsigned v4u __attribute__((ext_vector_type(4)));
typedef unsigned v2u __attribute__((ext_vector_type(2)));
typedef float f32x4 __attribute__((ext_vector_type(4)));
typedef float f32x2 __attribute__((ext_vector_type(2)));
typedef short bf16x8 __attribute__((ext_vector_type(8)));
using pg8::shx; using pg8::bperm; using pg8::bpermi; using pg8::lane_id_opaque;
using pg8::pkbf; using pg8::bflo; using pg8::bfhi; using pg8::gelu_tanh; using pg8::sigmoidf_;
#define LDS_WAIT() asm volatile("s_waitcnt lgkmcnt(0)" ::: "memory")

#define XB_TMO      128
#define XB_XCNT(j)  (256  + 64 * (j))
#define XB_XSUB(j)  (1280 + 64 * (j))
#define XB_XGEN(j)  (2304 + 64 * (j))
#define XB_TOP      3328
#define XB_TOPGEN   3392
#define XCD_BAR_WORDS 3456
#define XB_SPIN_CAP (1u << 22)
__device__ __forceinline__ unsigned xb_ld(unsigned* p)              { return __hip_atomic_load(p, __ATOMIC_RELAXED, __HIP_MEMORY_SCOPE_AGENT); }
__device__ __forceinline__ unsigned xb_add(unsigned* p, unsigned v) { return __hip_atomic_fetch_add(p, v, __ATOMIC_RELAXED, __HIP_MEMORY_SCOPE_AGENT); }
__device__ __forceinline__ unsigned xb_xcc_id() { return (unsigned)__builtin_amdgcn_s_getreg((3 << 11) | 20) & 0xFu; }
#define XB_SPIN(cond, bar) do { unsigned _sp = 0; while (cond) { __builtin_amdgcn_s_sleep(1); \
    if ((++_sp & 255u) == 0u) { if (xb_ld(&(bar)[XB_TMO])) break; if (_sp > XB_SPIN_CAP) { atomicAdd(&(bar)[XB_TMO], 1u); break; } } } } while (0)
struct XcdBarrier { unsigned* bar; unsigned x; volatile LAS unsigned* st; };
__device__ __forceinline__ bool is_thread0(int wave_s) { return wave_s == 0 && lane_id_opaque() == 0; }
__device__ __forceinline__ XcdBarrier xcd_barrier_post(unsigned* bar, volatile LAS unsigned* st, int wave_s) {
    XcdBarrier b; b.bar = bar; b.x = xb_xcc_id(); b.st = st;
    if (is_thread0(wave_s)) (void)xb_add(&bar[XB_XCNT(b.x)], 1u);
    return b;
}
__device__ __forceinline__ void xcd_barrier_complete(unsigned* bar, unsigned x, unsigned& nloc, unsigned& nx) {
    const unsigned G = gridDim.x * gridDim.y * gridDim.z;
    unsigned sum, cnt, mine, sp = 0u;
    for (;;) {
        sum = 0u; cnt = 0u; mine = 0u;
#pragma unroll
        for (unsigned j = 0; j < 16; ++j) { const unsigned c = xb_ld(&bar[XB_XCNT(j)]); sum += c; cnt += (c > 0u) ? 1u : 0u; mine = (j == x) ? c : mine; }
        if (sum == G) break;
        __builtin_amdgcn_s_sleep(1);
        if ((++sp & 255u) == 0u) { if (xb_ld(&bar[XB_TMO])) break; if (sp > XB_SPIN_CAP) { atomicAdd(&bar[XB_TMO], 1u); break; } }
    }
    nloc = mine > 0u ? mine : 1u; nx = cnt > 0u ? cnt : 1u;
}
__device__ __forceinline__ void xcd_barrier(const XcdBarrier& b, int wave_s) {
    asm volatile("s_waitcnt vmcnt(0)" ::: "memory");
    __syncthreads();
    if (is_thread0(wave_s)) {
        unsigned* bar = b.bar;
        __builtin_amdgcn_s_waitcnt(0);
        unsigned nloc = b.st[0], nx = b.st[1];
        if (nloc == 0u) { xcd_barrier_complete(bar, b.x, nloc, nx); b.st[0] = nloc; b.st[1] = nx; }
        const unsigned old = xb_add(&bar[XB_XSUB(b.x)], 1u);
        const unsigned gen = old / nloc;
        if (old + 1u == (gen + 1u) * nloc) {
            __builtin_amdgcn_fence(__ATOMIC_RELEASE, "agent");
            asm volatile("s_waitcnt vmcnt(0)" ::: "memory");
            const unsigned og = xb_add(&bar[XB_TOP], 1u);
            const unsigned tg = og / nx;
            if (og + 1u == (tg + 1u) * nx) xb_add(&bar[XB_TOPGEN], 1u);
            else XB_SPIN(xb_ld(&bar[XB_TOPGEN]) == tg, bar);
            __builtin_amdgcn_fence(__ATOMIC_ACQUIRE, "agent");
            xb_add(&bar[XB_XGEN(b.x)], 1u);
            asm volatile("s_waitcnt vmcnt(0)" ::: "memory");
        } else {
            XB_SPIN(xb_ld(&bar[XB_XGEN(b.x)]) == gen, bar);
            __builtin_amdgcn_fence(__ATOMIC_ACQUIRE, "agent");
            asm volatile("s_waitcnt vmcnt(0)" ::: "memory");
        }
    }
    __syncthreads();
}

struct Args { const float* in[27]; float* out; unsigned char* ws; };
enum { I_X = 0, I_P, I_POS, I_GMIX, I_WIN, I_LOGDT, I_ARE, I_AIM, I_BRE, I_BIM, I_CRE, I_CIM, I_DSK, I_WGLU, I_WPS, I_WPA, I_WOUT, I_GFFN, I_WQ, I_KEY1, I_KEY2, I_PU, I_PV, I_GPLE, I_WGATE, I_WPP, I_GFIN };

__device__ __forceinline__ float wave_sum(float v, int lane) {
    v += shx<1>(v, lane); v += shx<2>(v, lane); v += shx<4>(v, lane); v += shx<8>(v, lane); v += shx<16>(v, lane); v += shx<32>(v, lane);
    return v;
}

template <bool F8 = false>
__device__ __forceinline__ void p0_transpose_item(const float* W, const float* ks, int K, int N, bf16* WT, LAS float* scr, int item, int lane) {
    const int nblk = N / 32, kb = item / nblk, nb = item % nblk, k0 = 64 * kb, n0 = 32 * nb;
    { f32x4 w4[8]; float sc[8];
#pragma unroll
      for (int i = 0; i < 8; ++i) { const int kk = 8 * i + (lane >> 3); w4[i] = *(const f32x4*)(W + (size_t)(k0 + kk) * N + n0 + 4 * (lane & 7)); sc[i] = ks ? ks[k0 + kk] : 1.0f; }
#pragma unroll
      for (int i = 0; i < 8; ++i) { const int kk = 8 * i + (lane >> 3); LAS float* d = scr + kk * 33 + 4 * (lane & 7); d[0] = w4[i][0] * sc[i]; d[1] = w4[i][1] * sc[i]; d[2] = w4[i][2] * sc[i]; d[3] = w4[i][3] * sc[i]; } }
    LDS_WAIT(); asm volatile("" ::: "memory");
    const int c = lane & 7;
#pragma unroll
    for (int j = 0; j < 4; ++j) { const int n = (lane >> 3) + 8 * j; const LAS float* s = scr + (8 * c) * 33 + n;
        if (F8) { constexpr float sc8 = (float)(1 << pg8::W8_SHIFT); v2u o; o.x = pg8::pkf8(s[0 * 33] * sc8, s[1 * 33] * sc8, s[2 * 33] * sc8, s[3 * 33] * sc8); o.y = pg8::pkf8(s[4 * 33] * sc8, s[5 * 33] * sc8, s[6 * 33] * sc8, s[7 * 33] * sc8);
            *(v2u*)((unsigned char*)WT + (size_t)(n0 + n) * K + k0 + 8 * c) = o; }
        else { v4u o; o.x = pkbf(s[0 * 33], s[1 * 33]); o.y = pkbf(s[2 * 33], s[3 * 33]); o.z = pkbf(s[4 * 33], s[5 * 33]); o.w = pkbf(s[6 * 33], s[7 * 33]);
            *(v4u*)(WT + (size_t)(n0 + n) * K + k0 + 8 * c) = o; } }
    LDS_WAIT(); asm volatile("" ::: "memory");
}

__device__ __forceinline__ void cs_reduced(double ang, float& c, float& s) {
    const double r = ang * 0.15915494309189535; double fr = r - floor(r); if (fr > 0.5) fr -= 1.0;
    const float y = (float)(fr * 6.283185307179586);
    c = cosf(y); s = sinf(y);
}

__device__ __forceinline__ void p0_ws_item(const float* Wq, const float* gffn, const float* key1, const float* key2, bf16* WsT, LAS unsigned char* lds, int item, int tid) {
    constexpr int P = 132;
    LAS float* wq = (LAS float*)lds;
    LAS float* ky = (LAS float*)(lds + 64 * P * 4);
    const int hh = item >> 4, kb = item & 15, h = hh >> 1, half = hh & 1, k0 = 64 * kb;
    const float* keys = (half ? key2 : key1) + (size_t)h * 128 * 128;
#pragma unroll
    for (int i = 0; i < 4; ++i) { const int idx = tid + 512 * i, kk = idx >> 5, d4 = idx & 31;
        f32x4 v = *(const f32x4*)(Wq + (size_t)(k0 + kk) * 2048 + h * 256 + half * 128 + 4 * d4); v = v * gffn[k0 + kk];
        *(LAS f32x4*)(wq + kk * P + 4 * d4) = v; }
#pragma unroll
    for (int i = 0; i < 8; ++i) { const int idx = tid + 512 * i, n = idx >> 5, d4 = idx & 31;
        *(LAS f32x4*)(ky + n * P + 4 * d4) = *(const f32x4*)(keys + (size_t)n * 128 + 4 * d4); }
    __syncthreads();
    const int kq = tid & 15, nq = tid >> 4;
    float acc[4][4];
#pragma unroll
    for (int a = 0; a < 4; ++a)
#pragma unroll
        for (int b = 0; b < 4; ++b) acc[a][b] = 0.f;
    for (int d4 = 0; d4 < 32; ++d4) {
        f32x4 wv[4], kv[4];
#pragma unroll
        for (int a = 0; a < 4; ++a) { wv[a] = *(const LAS f32x4*)(wq + (4 * kq + a) * P + 4 * d4); kv[a] = *(const LAS f32x4*)(ky + (4 * nq + a) * P + 4 * d4); }
#pragma unroll
        for (int a = 0; a < 4; ++a)
#pragma unroll
            for (int b = 0; b < 4; ++b)
                acc[a][b] += (kv[a][0] * wv[b][0] + kv[a][1] * wv[b][1]) + (kv[a][2] * wv[b][2] + kv[a][3] * wv[b][3]);
    }
#pragma unroll
    for (int a = 0; a < 4; ++a) { v2u o; o.x = pkbf(acc[a][0], acc[a][1]); o.y = pkbf(acc[a][2], acc[a][3]);
        *(v2u*)(WsT + (size_t)(h * 256 + half * 128 + 4 * nq + a) * 1024 + k0 + 4 * kq) = o; }
    __syncthreads();
}

namespace s5 {
constexpr long YP8_DELTA = (long)WS_MSUB - (long)WS_YP;
constexpr int L = 64, NCH = SEQ / L, HP = 136, XP = 132;
constexpr int X_BYTES = 16 * XP * 4, WAVE_LDS = X_BYTES + 16 * HP * 2;
constexpr int ITEMS_PER_BG = 8, CH_STRIDE = NCH / ITEMS_PER_BG;

template <int PASS> struct Loads { v4u uf[4]; v2u uw[4]; float hlr[16], hli[16]; };
constexpr size_t HPLANE = (size_t)NB * NG * NCH * 64;

template <int PASS>
__device__ __forceinline__ void issue(Loads<PASS>& ld, const bf16* Ub, const float* Hb, int ch, int q, int nl, int lane) {
#pragma unroll
    for (int blk = 0; blk < 4; ++blk) { ld.uf[blk] = *(const v4u*)(Ub + (blk * 16 + nl) * 16 + 8 * (q & 1));
        if (PASS == 2) ld.uw[blk] = *(const v2u*)(Ub + (blk * 16 + nl) * 16 + 4 * q); }
    if (PASS == 2) {
#pragma unroll
        for (int j = 0; j < 16; ++j) { const int c = ch - 16 + j; const float* hp = Hb + (size_t)(c < 0 ? 0 : c) * 64 + lane; ld.hlr[j] = hp[0]; ld.hli[j] = hp[HPLANE]; }
    }
}

template <int PASS>
__device__ __forceinline__ void run(LAS unsigned char* ldsw, const unsigned char* s5p, const bf16* U, float* Hloc, const float* dskip, bf16* YP, int gw, int ngw, int lane) {
    const int q = lane >> 4, nl = lane & 15;
    LAS float* Xt = (LAS float*)ldsw;
    LAS bf16* Ht = (LAS bf16*)(ldsw + X_BYTES);
    for (int wv = gw; wv < NB * NG * CH_STRIDE; wv += ngw) {
        const int g = wv & 31, b = (wv >> 5) & 3, ch0 = wv >> 7;
        bf16x8 af[8];
#pragma unroll
        for (int j = 0; j < 8; ++j) {
            const float* src = (const float*)(s5p + (j < 4 ? S5_BRE : S5_BIM)) + (size_t)(g * 64 + 16 * (j & 3) + nl) * 16 + 8 * (q & 1);
            const f32x4 a = *(const f32x4*)src, bb = *(const f32x4*)(src + 4);
            v4u w = pg8::pack8(a, bb); if (q >= 2) w = (v4u){0u, 0u, 0u, 0u};
            af[j] = __builtin_bit_cast(bf16x8, w);
        }
        const float ar = ((const float*)(s5p + S5_ABR))[g * 64 + lane], ai = ((const float*)(s5p + S5_ABI))[g * 64 + lane];
        const float aLr = ((const float*)(s5p + S5_ALR))[g * 64 + lane], aLi = ((const float*)(s5p + S5_ALI))[g * 64 + lane];
        bf16x8 cf[4]; float dsk[4];
        if (PASS == 2) {
#pragma unroll
            for (int kk = 0; kk < 4; ++kk) cf[kk] = *(const bf16x8*)((const bf16*)(s5p + S5_CM) + (size_t)(g * 16 + nl) * 128 + 32 * kk + 8 * q);
#pragma unroll
            for (int r = 0; r < 4; ++r) dsk[r] = dskip[g * 16 + 4 * q + r];
        }
        const bf16* Ubg = U + (size_t)(b * 32 + g) * SEQ * 16;
        float* Hbg = Hloc + (size_t)(b * 32 + g) * NCH * 64;
        float cr = 0.f, ci = 0.f;
        Loads<PASS> cur, nxt;
        issue<PASS>(cur, Ubg + (size_t)ch0 * L * 16, Hbg, ch0, q, nl, lane);
#pragma unroll 1
        for (int i = 0; i < ITEMS_PER_BG; ++i) {
            const int ch = ch0 + CH_STRIDE * i;
            if (i + 1 < ITEMS_PER_BG) issue<PASS>(nxt, Ubg + (size_t)(ch + CH_STRIDE) * L * 16, Hbg, ch + CH_STRIDE, q, nl, lane);
            float hr = 0.f, hi = 0.f;
            if (PASS == 2) {
#pragma unroll
                for (int j = 0; j < 16; ++j) { const bool ok = (ch - 16 + j) >= 0; const float lr = ok ? cur.hlr[j] : 0.f, li = ok ? cur.hli[j] : 0.f;
                    const float ncr = fmaf(aLr, cr, fmaf(-aLi, ci, lr)), nci = fmaf(aLr, ci, fmaf(aLi, cr, li)); cr = ok ? ncr : cr; ci = ok ? nci : ci; }
                hr = cr; hi = ci;
            }
#pragma unroll
            for (int blk = 0; blk < L / 16; ++blk) {
                v4u uw4 = cur.uf[blk]; if (q >= 2) uw4 = (v4u){0u, 0u, 0u, 0u};
                const bf16x8 uf = __builtin_bit_cast(bf16x8, uw4);
#pragma unroll
                for (int j = 0; j < 8; ++j) { const f32x4 d = __builtin_amdgcn_mfma_f32_16x16x32_bf16(af[j], uf, (f32x4){0.f, 0.f, 0.f, 0.f}, 0, 0, 0);
                    *(LAS f32x4*)(Xt + nl * XP + 16 * j + 4 * q) = d; }
#pragma unroll
                for (int tt = 0; tt < 16; ++tt) {
                    const float xr = Xt[tt * XP + lane], xi = Xt[tt * XP + 64 + lane];
                    const float nhr = fmaf(ar, hr, fmaf(-ai, hi, xr)), nhi = fmaf(ar, hi, fmaf(ai, hr, xi));
                    hr = nhr; hi = nhi;
                    if (PASS == 2) { const unsigned pw = pkbf(hr, hi); Ht[tt * HP + lane] = (bf16)(pw & 0xffffu); Ht[tt * HP + 64 + lane] = (bf16)(pw >> 16); }
                }
                if (PASS == 2) {
                    f32x4 acc = {0.f, 0.f, 0.f, 0.f};
#pragma unroll
                    for (int kk = 0; kk < 4; ++kk) { const bf16x8 hf = *(const LAS bf16x8*)(Ht + nl * HP + 32 * kk + 8 * q);
                        acc = __builtin_amdgcn_mfma_f32_16x16x32_bf16(cf[kk], hf, acc, 0, 0, 0); }
                    const int tl = blk * 16 + nl;
                    const v2u uw = cur.uw[blk];
                    const float y0 = gelu_tanh(acc[0] + dsk[0] * bflo(uw.x)), y1 = gelu_tanh(acc[1] + dsk[1] * bfhi(uw.x));
                    const float y2 = gelu_tanh(acc[2] + dsk[2] * bflo(uw.y)), y3 = gelu_tanh(acc[3] + dsk[3] * bfhi(uw.y));
                    v2u o; o.x = pkbf(y0, y1); o.y = pkbf(y2, y3);
                    *(v2u*)(YP + ((size_t)b * SEQ + (size_t)ch * L + tl) * 512 + g * 16 + 4 * q) = o;
                    *(unsigned*)((unsigned char*)YP + YP8_DELTA + ((size_t)b * SEQ + (size_t)ch * L + tl) * 512 + g * 16 + 4 * q) = pg8::pkf8(y0, y1, y2, y3);
                }
            }
            if (PASS == 1) { Hbg[(size_t)ch * 64 + lane] = hr; Hbg[HPLANE + (size_t)ch * 64 + lane] = hi; }
            cur = nxt;
        }
    }
}


__device__ __forceinline__ void pass1_gemm(LAS unsigned char* lds, const bf16* W, const bf16* U, float* Hloc, int G, int bx, int tid, int wave) {
    constexpr int PITCH = 528, A_OFF = 0, B_OFF = 128 * PITCH;
    const int lane = tid & 63, fr = lane & 15, fq = lane >> 4;
    for (int task = bx; task < NG * 8; task += G) {
        const int g = task >> 3, c8 = task & 7, b = c8 >> 1, ch0 = 64 * (c8 & 1);
        const bf16* Wg = W + (size_t)g * 128 * 1024;
        const bf16* Ub = U + ((size_t)(b * 32 + g) * SEQ + (size_t)ch0 * L) * 16;
        f32x4 acc[4];
#pragma unroll
        for (int nt = 0; nt < 4; ++nt) acc[nt] = (f32x4){0.f, 0.f, 0.f, 0.f};
#pragma unroll 1
        for (int slab = 0; slab < 4; ++slab) {
            v4u ta[8], tb[4];
#pragma unroll
            for (int i = 0; i < 8; ++i) { const int p = tid + 512 * i; ta[i] = *(const v4u*)((const unsigned char*)Wg + (size_t)(p >> 5) * 2048 + slab * 512 + 16 * (p & 31)); }
#pragma unroll
            for (int i = 0; i < 4; ++i) { const int p = tid + 512 * i; tb[i] = *(const v4u*)((const unsigned char*)Ub + (size_t)(p >> 5) * 2048 + slab * 512 + 16 * (p & 31)); }
            __syncthreads();
#pragma unroll
            for (int i = 0; i < 8; ++i) { const int p = tid + 512 * i; *(LAS v4u*)(lds + A_OFF + (p >> 5) * PITCH + 16 * (p & 31)) = ta[i]; }
#pragma unroll
            for (int i = 0; i < 4; ++i) { const int p = tid + 512 * i; *(LAS v4u*)(lds + B_OFF + (p >> 5) * PITCH + 16 * (p & 31)) = tb[i]; }
            __syncthreads();
#pragma unroll
            for (int kk = 0; kk < 8; ++kk) { const bf16x8 wf = *(const LAS bf16x8*)(lds + A_OFF + (16 * wave + fr) * PITCH + 64 * kk + 16 * fq);
#pragma unroll
                for (int nt = 0; nt < 4; ++nt) { const bf16x8 uf = *(const LAS bf16x8*)(lds + B_OFF + (16 * nt + fr) * PITCH + 64 * kk + 16 * fq); acc[nt] = __builtin_amdgcn_mfma_f32_16x16x32_bf16(wf, uf, acc[nt], 0, 0, 0); } }
        }
        const int np = 16 * wave + 4 * fq;
        float* Hp = Hloc + (size_t)(np >> 6) * HPLANE + ((size_t)(b * 32 + g) * NCH + ch0 + fr) * 64 + (np & 63);
#pragma unroll
        for (int nt = 0; nt < 4; ++nt) *(f32x4*)(Hp + (size_t)(16 * nt) * 64) = acc[nt];
        __syncthreads();
    }
}
}

namespace peer {
template <int M> __device__ __forceinline__ int shxi(int v, int lane) { return __builtin_bit_cast(int, shx<M>(__builtin_bit_cast(float, v), lane)); }
__device__ __forceinline__ float hmax32(float m, int lane) { m = fmaxf(m, shx<1>(m, lane)); m = fmaxf(m, shx<2>(m, lane)); m = fmaxf(m, shx<4>(m, lane)); m = fmaxf(m, shx<8>(m, lane)); m = fmaxf(m, shx<16>(m, lane)); return m; }
__device__ __forceinline__ unsigned f2o(float f) { const unsigned b = __float_as_uint(f); return b ^ ((unsigned)((int)b >> 31) | 0x80000000u); }
__device__ __forceinline__ float o2f(unsigned k) { return __uint_as_float(k ^ ((~(unsigned)((int)k >> 31)) | 0x80000000u)); }
template <int CTRL> __device__ __forceinline__ unsigned dppmax(unsigned x) { const unsigned y = (unsigned)__builtin_amdgcn_update_dpp(0, (int)x, CTRL, 0xf, 0xf, true); return x > y ? x : y; }
__device__ __forceinline__ unsigned rowmax16(unsigned x) { x = dppmax<0xB1>(x); x = dppmax<0x4E>(x); x = dppmax<0x141>(x); x = dppmax<0x140>(x); return x; }
__device__ __forceinline__ unsigned wrlane(unsigned v, unsigned val, int sel) { unsigned keep;
    asm("s_mov_b32 %1, m0\n\ts_mov_b32 m0, %3\n\ts_nop 0\n\tv_writelane_b32 %0, %2, m0\n\ts_mov_b32 m0, %1" : "+v"(v), "=&s"(keep) : "s"(val), "s"(sel)); return v; }
__device__ __forceinline__ void cex(unsigned& a, unsigned& b) { const unsigned hi = a > b ? a : b, lo = a > b ? b : a; a = hi; b = lo; }
__device__ __forceinline__ unsigned qpack4(const f32x4 v, float inv, int ob) { const int a = (int)rintf(v[0] * inv) + ob, b = (int)rintf(v[1] * inv) + ob, c = (int)rintf(v[2] * inv) + ob, d = (int)rintf(v[3] * inv) + ob;
    return ((unsigned)a & 0xffu) | (((unsigned)b & 0xffu) << 8) | (((unsigned)c & 0xffu) << 16) | (((unsigned)d & 0xffu) << 24); }
__device__ __forceinline__ float sel8(const float (&a)[8], int h) { float r = a[0];
#pragma unroll
    for (int q = 1; q < 8; ++q) r = (h == q) ? a[q] : r;
    return r; }
__device__ __forceinline__ unsigned sel8u(const unsigned (&a)[8], int h) { unsigned r = a[0];
#pragma unroll
    for (int q = 1; q < 8; ++q) r = (h == q) ? a[q] : r;
    return r; }

struct Pre { v2u sc[8]; v4u xr[2]; };
__device__ __forceinline__ void load_pre(Pre& p, const float* S, const bf16* XB, int tkn, int lane) {
    const v2u* Sp = (const v2u*)((const bf16*)S + (size_t)tkn * 2048) + lane;
#pragma unroll
    for (int h = 0; h < 8; ++h) p.sc[h] = Sp[64 * h];
    const v4u* xp = (const v4u*)(XB + (size_t)tkn * 1024 + lane * 16);
    p.xr[0] = xp[0]; p.xr[1] = xp[1];
}

struct Row4 { f32x4 v[4]; };
__device__ __forceinline__ void load_row(Row4& r, const float* src, int lane) {
#pragma unroll
    for (int j = 0; j < 4; ++j) r.v[j] = *(const f32x4*)(src + 256 * j + 4 * lane); }
__device__ __forceinline__ void load_row16(Row4& r, const float* src, int lane) {
#pragma unroll
    for (int j = 0; j < 4; ++j) r.v[j] = *(const f32x4*)(src + 16 * lane + 4 * j); }
__device__ __forceinline__ void quant_row(const Row4& r, const f32x4 (&gf)[4], bool use_gf, unsigned char* dst, float* scale_out, bool offset_binary, int lane) {
    f32x4 v[4]; float m = 0.f;
#pragma unroll
    for (int j = 0; j < 4; ++j) { v[j] = r.v[j]; if (use_gf) v[j] = v[j] * gf[j];
        m = fmaxf(fmaxf(m, fmaxf(fabsf(v[j][0]), fabsf(v[j][1]))), fmaxf(fabsf(v[j][2]), fabsf(v[j][3]))); }
    m = hmax32(m, lane); m = fmaxf(m, shx<32>(m, lane));
    const float inv = m > 0.f ? 127.0f / m : 0.f; const int ob = offset_binary ? 128 : 0;
#pragma unroll
    for (int j = 0; j < 4; ++j) *(unsigned*)(dst + 256 * j + 4 * lane) = qpack4(v[j], inv, ob);
    if (lane == 0) *scale_out = m * (1.0f / 127.0f);
}
__device__ __forceinline__ void quant_row4(Row4 r, const f32x4 (&gf)[4], bool use_gf, unsigned char* dst, float* scale_out, int lane, bool signed_hi = false) {
    if (use_gf) {
#pragma unroll
        for (int j = 0; j < 4; ++j) r.v[j] = r.v[j] * gf[j]; }
    float ssq = 0.f;
#pragma unroll
    for (int j = 0; j < 4; ++j) ssq += (r.v[j][0] * r.v[j][0] + r.v[j][1] * r.v[j][1]) + (r.v[j][2] * r.v[j][2] + r.v[j][3] * r.v[j][3]);
    ssq = wave_sum(ssq, lane);
    const float step = 0.3352f * sqrtf(ssq * (1.0f / 1024.0f)), inv = step > 0.f ? 1.0f / step : 0.f;
    v2u o;
#pragma unroll
    for (int g = 0; g < 2; ++g) { unsigned w = 0u;
#pragma unroll
        for (int j = 0; j < 4; ++j) { const int a = (int)floorf(r.v[2 * g][j] * inv) + 8, b = (int)floorf(r.v[2 * g + 1][j] * inv) + 8;
            const unsigned lo4 = (unsigned)(a < 0 ? 0 : a > 15 ? 15 : a); unsigned hi4 = (unsigned)(b < 0 ? 0 : b > 15 ? 15 : b); if (signed_hi) hi4 = (hi4 - 8u) & 15u; w |= (lo4 | (hi4 << 4)) << (8 * j); }
        if (g == 0) o.x = w; else o.y = w; }
    *(v2u*)(dst + 16 * lane) = o;
    if (lane == 0) *scale_out = step;
}
}

namespace peer {
struct TK { unsigned eidP0, eidP1; float cAP0, cAP1, cBP0, cBP1; };

__device__ __forceinline__ void sort8(unsigned (&v)[8]) {
    cex(v[0], v[1]); cex(v[2], v[3]); cex(v[4], v[5]); cex(v[6], v[7]); cex(v[0], v[2]); cex(v[1], v[3]); cex(v[4], v[6]); cex(v[5], v[7]);
    cex(v[1], v[2]); cex(v[5], v[6]); cex(v[0], v[4]); cex(v[3], v[7]); cex(v[1], v[5]); cex(v[2], v[6]); cex(v[1], v[4]); cex(v[3], v[6]); cex(v[2], v[4]); cex(v[3], v[5]); cex(v[3], v[4]);
}
__device__ __forceinline__ float rowsum16(float x) {
#define PEER_RS(CTRL) x += __builtin_bit_cast(float, __builtin_amdgcn_update_dpp(0, __builtin_bit_cast(int, x), CTRL, 0xf, 0xf, true))
    PEER_RS(0xB1); PEER_RS(0x4E); PEER_RS(0x141); PEER_RS(0x140);
#undef PEER_RS
    return x; }
__device__ __forceinline__ void prep_keys(const Pre& pre, unsigned (&kk)[4][8], int hl) {
#pragma unroll
    for (int p = 0; p < 4; ++p) { const v2u wa = pre.sc[2 * p], wb = pre.sc[2 * p + 1];
        const f32x4 sa = {pg8::bflo(wa.x), pg8::bfhi(wa.x), pg8::bflo(wa.y), pg8::bfhi(wa.y)}, sb = {pg8::bflo(wb.x), pg8::bfhi(wb.x), pg8::bflo(wb.y), pg8::bfhi(wb.y)};
#pragma unroll
        for (int e = 0; e < 4; ++e) { const unsigned ka = (f2o(sa[e]) & ~127u) | (unsigned)(4 * hl + e), kb = (f2o(sb[e]) & ~127u) | (unsigned)(4 * hl + e);
            const auto r = __builtin_amdgcn_permlane16_swap(ka, kb, false, false);
            kk[p][e] = (unsigned)r[0]; kk[p][4 + e] = (unsigned)r[1]; }
        sort8(kk[p]); }
}
__device__ __forceinline__ void quant_x(const Pre& pre, v4u& xq, float& sx, int& sumx, int lane) {
    f32x4 xf[4]; pg8::unpack8(pre.xr[0], xf[0], xf[1]); pg8::unpack8(pre.xr[1], xf[2], xf[3]);
    float m = 0.f;
#pragma unroll
    for (int e = 0; e < 4; ++e) m = fmaxf(fmaxf(m, fabsf(xf[0][e])), fmaxf(fmaxf(fabsf(xf[1][e]), fabsf(xf[2][e])), fabsf(xf[3][e])));
    unsigned am = rowmax16(__float_as_uint(m)); am = dppmax<0x142>(am); am = dppmax<0x143>(am);
    m = __uint_as_float((unsigned)__builtin_amdgcn_readlane((int)am, 63));
    sx = m * (1.0f / 127.0f); const float inv = m > 0.f ? 127.0f / m : 0.f;
    xq.x = qpack4(xf[0], inv, 0); xq.y = qpack4(xf[1], inv, 0); xq.z = qpack4(xf[2], inv, 0); xq.w = qpack4(xf[3], inv, 0);
    int t = __builtin_amdgcn_sdot4((int)xq.x, 0x01010101, 0, false); t = __builtin_amdgcn_sdot4((int)xq.y, 0x01010101, t, false); t = __builtin_amdgcn_sdot4((int)xq.z, 0x01010101, t, false); t = __builtin_amdgcn_sdot4((int)xq.w, 0x01010101, t, false);
    t += shxi<1>(t, lane); t += shxi<2>(t, lane); t += shxi<4>(t, lane); t += shxi<8>(t, lane); t += shxi<16>(t, lane); t += shxi<32>(t, lane); sumx = t;
}
__device__ __forceinline__ void s1_round(unsigned (&kk)[4][8], unsigned (&mine)[4], bool sel) {
    unsigned x[4];
#pragma unroll
    for (int p = 0; p < 4; ++p) x[p] = rowmax16(kk[p][0]);
#pragma unroll
    for (int p = 0; p < 4; ++p) { const bool win = kk[p][0] == x[p];
#pragma unroll
        for (int j = 0; j < 7; ++j) kk[p][j] = win ? kk[p][j + 1] : kk[p][j];
        kk[p][7] = win ? 0u : kk[p][7];
        mine[p] = sel ? x[p] : mine[p]; }
}
__device__ __forceinline__ void s2_setup(const unsigned (&mine)[4], unsigned (&MA)[2], unsigned (&MB)[2], unsigned (&ck)[2][4], unsigned (&top)[2], unsigned ciP, unsigned cjP, int li) {
#pragma unroll
    for (int q = 0; q < 2; ++q) { const auto r = __builtin_amdgcn_permlane32_swap(mine[2 * q], mine[2 * q + 1], false, false);
        MA[q] = (unsigned)r[0]; MB[q] = (unsigned)r[1];
#pragma unroll
        for (int k = 0; k < 4; ++k) { const int la = (int)((ciP >> (8 * k)) & 255u), lb = (int)((cjP >> (8 * k)) & 255u);
            const float av = o2f((unsigned)bpermi((int)MA[q], la)), bv = o2f((unsigned)bpermi((int)MB[q], lb));
            const int c = li + 16 * k;
            ck[q][k] = (c < 50) ? ((f2o(av + bv) & ~63u) | (unsigned)c) : 0u; }
        cex(ck[q][0], ck[q][1]); cex(ck[q][2], ck[q][3]); cex(ck[q][0], ck[q][2]); cex(ck[q][1], ck[q][3]); cex(ck[q][1], ck[q][2]);
        top[q] = 0u; }
}
__device__ __forceinline__ void s2_round(unsigned (&ck)[2][4], unsigned (&top)[2], bool sel) {
    unsigned x[2];
#pragma unroll
    for (int q = 0; q < 2; ++q) x[q] = rowmax16(ck[q][0]);
#pragma unroll
    for (int q = 0; q < 2; ++q) { const bool win = ck[q][0] == x[q];
        ck[q][0] = win ? ck[q][1] : ck[q][0]; ck[q][1] = win ? ck[q][2] : ck[q][1]; ck[q][2] = win ? ck[q][3] : ck[q][2]; ck[q][3] = win ? 0u : ck[q][3];
        top[q] = sel ? x[q] : top[q]; }
}
__device__ __forceinline__ void finalize(const unsigned (&top)[2], const unsigned (&MA)[2], const unsigned (&MB)[2], int cij, float rs1, float sx, const float* SU, const float* SV, int lane, TK& o) {
    const int rb = lane & 48;
    unsigned ex_id[2]; float gate[2], su[2], sv[2];
#pragma unroll
    for (int q = 0; q < 2; ++q) { const int c = (int)(top[q] & 63u); const int t = bpermi(cij, c); const int ci = t & 255, cj = t >> 8;
        const unsigned e1 = (unsigned)bpermi((int)MA[q], rb + ci) & 127u, e2 = (unsigned)bpermi((int)MB[q], rb + cj) & 127u; ex_id[q] = e1 * 128u + e2; }
#pragma unroll
    for (int q = 0; q < 2; ++q) { su[q] = SU[ex_id[q]]; sv[q] = SV[ex_id[q]]; }
#pragma unroll
    for (int q = 0; q < 2; ++q) { const float topf = o2f(top[q]), mx = o2f(rowmax16(top[q]));
        const float ex = __expf(topf - mx); const float sm = rowsum16(ex);
        gate[q] = ex * __builtin_amdgcn_rcpf(fmaxf(sm, 1e-30f)); }
    o.eidP0 = ex_id[0]; o.eidP1 = ex_id[1];
    o.cAP0 = 0.5f * rs1 * sx * su[0]; o.cAP1 = 0.5f * rs1 * sx * su[1];
    o.cBP0 = gate[0] * sv[0]; o.cBP1 = gate[1] * sv[1];
}
#define PEER_ROWUV(id) __builtin_amdgcn_raw_buffer_load_b128(rsUV, lo, (int)((id) * 1024u), 0)
__device__ __forceinline__ void load_t_head(v4u (&tq)[16], unsigned esrc, int l0, __amdgpu_buffer_rsrc_t rsUV, int lo) {
#pragma unroll
    for (int e = 0; e < 16; ++e) { const unsigned id = (unsigned)__builtin_amdgcn_readlane((int)esrc, l0 + e); tq[e] = PEER_ROWUV(id); }
}
struct GH { int p[16]; int cq; float cscale; int accI[16]; int sumcq; };
template <bool NEXTU>
__device__ __forceinline__ void gh_a(GH& g, int h, const TK& t, const v4u xq, v4u (&tq)[16], v2u (&vq)[16], __amdgpu_buffer_rsrc_t rsUV, int lo) {
#pragma unroll
    for (int e = 0; e < 16; ++e) { int d = __builtin_amdgcn_sdot4((int)(tq[e].x & 0x0f0f0f0fu), (int)xq.x, 0, false); d = __builtin_amdgcn_sdot4((int)((tq[e].x >> 4) & 0x0f0f0f0fu), (int)xq.y, d, false);
        d = __builtin_amdgcn_sdot4((int)(tq[e].y & 0x0f0f0f0fu), (int)xq.z, d, false); g.p[e] = __builtin_amdgcn_sdot4((int)((tq[e].y >> 4) & 0x0f0f0f0fu), (int)xq.w, d, false);
        vq[e].x = tq[e].z; vq[e].y = tq[e].w; }
    if (NEXTU) { const unsigned en = (h + 1 < 4) ? t.eidP0 : t.eidP1; load_t_head(tq, en, ((h + 1) & 3) * 16, rsUV, lo); }
}
__device__ __forceinline__ void gh_b(GH& g, int h, const TK& t, int lane, int sumx) {
    const float cAh = (h < 4) ? t.cAP0 : t.cAP1, cBh = (h < 4) ? t.cBP0 : t.cBP1; const int l0 = (h & 3) * 16;
    int q8[8], r4[4], s2[2], s1;
#pragma unroll
    for (int e = 0; e < 8; ++e) { const auto r = __builtin_amdgcn_permlane32_swap(g.p[e], g.p[e + 8], false, false); q8[e] = (int)r[0] + (int)r[1]; }
#pragma unroll
    for (int e = 0; e < 4; ++e) { const auto r = __builtin_amdgcn_permlane16_swap(q8[e], q8[e + 4], false, false); r4[e] = (int)r[0] + (int)r[1]; }
    { const bool up = (lane & 8) != 0;
#pragma unroll
      for (int e = 0; e < 2; ++e) { const int send = up ? r4[e] : r4[e + 2], keep = up ? r4[e + 2] : r4[e]; s2[e] = keep + __builtin_amdgcn_update_dpp(0, send, 0x128, 0xf, 0xf, true); } }
    { const bool up = (lane & 4) != 0; const int send = up ? s2[0] : s2[1], keep = up ? s2[1] : s2[0];
      int recv = __builtin_amdgcn_update_dpp(send, send, 0x104, 0xf, 0x5, false); recv = __builtin_amdgcn_update_dpp(recv, send, 0x114, 0xf, 0xa, false);
      s1 = keep + recv; }
    s1 += __builtin_amdgcn_update_dpp(0, s1, 0x4E, 0xf, 0xf, true); s1 += __builtin_amdgcn_update_dpp(0, s1, 0xB1, 0xf, 0xf, true);
    const int eb = lane >> 2;
    const float cf = bperm(cBh, l0 + eb) * gelu_tanh((float)(2 * s1 - 15 * sumx) * bperm(cAh, l0 + eb));
    unsigned am = rowmax16(__float_as_uint(cf) & 0x7fffffffu); am = dppmax<0x142>(am); am = dppmax<0x143>(am);
    const float amax = __uint_as_float((unsigned)__builtin_amdgcn_readlane((int)am, 63));
    const float cinv = amax > 0.f ? 127.0f / amax : 0.f; g.cscale = amax * (1.0f / 127.0f);
    g.cq = (int)rintf(cf * cinv);
#pragma unroll
    for (int i = 0; i < 16; ++i) g.accI[i] = 0;
    g.sumcq = 0;
}
template <int GQ0>
__device__ __forceinline__ void gh_c(GH& g, const v2u (&vq)[16]) {
#pragma unroll
    for (int gq = GQ0; gq < GQ0 + 2; ++gq) {
        const int q0 = __builtin_amdgcn_readlane(g.cq, 16 * gq), q1 = __builtin_amdgcn_readlane(g.cq, 16 * gq + 4), q2 = __builtin_amdgcn_readlane(g.cq, 16 * gq + 8), q3 = __builtin_amdgcn_readlane(g.cq, 16 * gq + 12);
        g.sumcq += (q0 + q1) + (q2 + q3);
        const int cw = (int)(((unsigned)q0 & 0xffu) | (((unsigned)q1 & 0xffu) << 8) | (((unsigned)q2 & 0xffu) << 16) | (((unsigned)q3 & 0xffu) << 24));
#pragma unroll
        for (int wg = 0; wg < 2; ++wg) {
            const unsigned r0 = wg ? vq[4 * gq].y : vq[4 * gq].x, r1 = wg ? vq[4 * gq + 1].y : vq[4 * gq + 1].x, r2 = wg ? vq[4 * gq + 2].y : vq[4 * gq + 2].x, r3 = wg ? vq[4 * gq + 3].y : vq[4 * gq + 3].x;
            const unsigned t0 = __builtin_amdgcn_perm(r1, r0, 0x05010400u), t1 = __builtin_amdgcn_perm(r1, r0, 0x07030602u);
            const unsigned t2 = __builtin_amdgcn_perm(r3, r2, 0x05010400u), t3 = __builtin_amdgcn_perm(r3, r2, 0x07030602u);
            unsigned o[4]; o[0] = __builtin_amdgcn_perm(t2, t0, 0x05040100u); o[1] = __builtin_amdgcn_perm(t2, t0, 0x07060302u);
            o[2] = __builtin_amdgcn_perm(t3, t1, 0x05040100u); o[3] = __builtin_amdgcn_perm(t3, t1, 0x07060302u);
#pragma unroll
            for (int j = 0; j < 4; ++j) {
                g.accI[8 * wg + j] = __builtin_amdgcn_sdot4((int)(o[j] & 0x0f0f0f0fu), cw, g.accI[8 * wg + j], false);
                g.accI[8 * wg + 4 + j] = __builtin_amdgcn_sdot4((int)o[j], cw, g.accI[8 * wg + 4 + j], false);
            }
        }
    }
}
__device__ __forceinline__ void gh_d(const GH& g, float (&acc)[16]) {
    const int offI = 15 * g.sumcq, offH = 8 * g.sumcq;
#pragma unroll
    for (int wg = 0; wg < 2; ++wg)
#pragma unroll
        for (int j = 0; j < 4; ++j) { const int Ls = g.accI[8 * wg + j], Fs = g.accI[8 * wg + 4 + j];
            acc[8 * wg + j] = fmaf((float)(2 * Ls - offI), 0.5f * g.cscale, acc[8 * wg + j]);
            acc[8 * wg + 4 + j] = fmaf((float)(Fs - Ls + offH), 0.0625f * g.cscale, acc[8 * wg + 4 + j]); }
}

template <long X8D>
__device__ __forceinline__ void run_wave(const float* S, bf16* XB, const unsigned char* UQ, const unsigned char* VQ, const float* SU, const float* SV, const float* ss1, float* rs2, int gw, int ngw, int ntok, int lane_in) {
    int lane = lane_in; asm volatile("" : "+v"(lane));
    const int hl = lane & 31, li = lane & 15;
    auto slot_ij = [](int l, int& ci, int& cj) { if (l < 16) { ci = 0; cj = l; } else if (l < 24) { ci = 1; cj = l - 16; } else if (l < 29) { ci = 2; cj = l - 24; } else if (l < 33) { ci = 3; cj = l - 29; }
      else if (l < 36) { ci = 4; cj = l - 33; } else if (l < 42) { ci = 5 + ((l - 36) >> 1); cj = (l - 36) & 1; } else if (l < 50) { ci = 8 + (l - 42); cj = 0; } else { ci = 0; cj = 0; } };
    int cij; unsigned ciP = 0u, cjP = 0u;
    { int ci, cj; slot_ij(lane, ci, cj); cij = ci | (cj << 8);
#pragma unroll
      for (int k = 0; k < 4; ++k) { slot_ij(li + 16 * k, ci, cj); ciP |= (unsigned)((lane & 48) + ci) << (8 * k); cjP |= (unsigned)((lane & 48) + cj) << (8 * k); } }
    const __amdgpu_buffer_rsrc_t rsUV = __builtin_amdgcn_make_buffer_rsrc((void*)UQ, 0, NEXP * 1024, 0x00020000); (void)VQ;
    const int lo = lane * 16;
    if (gw >= ntok) return;
    Pre pre; unsigned kk[4][8], mine[4], MA[2], MB[2], ck[2][4], top[2];
    int sumx_cur = 0, sumx_nxt = 0;
    TK cur, nxt; v4u xq_cur, xq_nxt; float sx;
    load_pre(pre, S, XB, gw, lane);
    prep_keys(pre, kk, hl); quant_x(pre, xq_cur, sx, sumx_cur, lane);
#pragma unroll
    for (int p = 0; p < 4; ++p) mine[p] = 0u;
#pragma unroll 1
    for (int it = 0; it < 16; ++it) s1_round(kk, mine, li == it);
    s2_setup(mine, MA, MB, ck, top, ciP, cjP, li);
#pragma unroll 1
    for (int it = 0; it < 16; ++it) s2_round(ck, top, li == it);
    finalize(top, MA, MB, cij, 1.0f / sqrtf(ss1[gw] * (1.0f / 1024.0f) + EPS), sx, SU, SV, lane, cur);
    { const int t1 = (gw + ngw < ntok) ? gw + ngw : gw; load_pre(pre, S, XB, t1, lane); }
    v4u tq[16]; v2u vq[16];
    load_t_head(tq, cur.eidP0, 0, rsUV, lo);
#define PEER_HEAD(H, VCUR, VNEXT, NEXTU, R0, R1, R2, R3) { GH g; \
        gh_a<NEXTU>(g, H, cur, xq_cur, tq, vq, rsUV, lo); R0; \
        gh_b(g, H, cur, lane, sumx_cur);                          R1; \
        gh_c<0>(g, vq);                                           R2; \
        gh_c<2>(g, vq); gh_d(g, acc);                             R3; }
#pragma unroll 1
    for (int tkn = gw; tkn < ntok; tkn += ngw) {
        asm volatile("" : "+v"(lane)); const int hl = lane & 31, li = lane & 15, lo = lane * 16; (void)hl; (void)li; (void)lo;
        const int tn1 = (tkn + ngw < ntok) ? tkn + ngw : tkn, tn2 = (tn1 + ngw < ntok) ? tn1 + ngw : tn1;
        prep_keys(pre, kk, hl); quant_x(pre, xq_nxt, sx, sumx_nxt, lane);
        const float rs1n = 1.0f / sqrtf(ss1[tn1] * (1.0f / 1024.0f) + EPS);
#pragma unroll
        for (int p = 0; p < 4; ++p) mine[p] = 0u;
        float acc[16];
#pragma unroll
        for (int i = 0; i < 16; ++i) acc[i] = 0.f;
#pragma unroll 1
        for (int hh = 0; hh < 2; ++hh) {
            PEER_HEAD(2 * hh, va, vb, true, s1_round(kk, mine, li == 8 * hh + 0), s1_round(kk, mine, li == 8 * hh + 1), s1_round(kk, mine, li == 8 * hh + 2), s1_round(kk, mine, li == 8 * hh + 3))
            PEER_HEAD(2 * hh + 1, vb, va, true, s1_round(kk, mine, li == 8 * hh + 4), s1_round(kk, mine, li == 8 * hh + 5), s1_round(kk, mine, li == 8 * hh + 6), s1_round(kk, mine, li == 8 * hh + 7))
        }
        s2_setup(mine, MA, MB, ck, top, ciP, cjP, li);
        PEER_HEAD(4, va, vb, true, s2_round(ck, top, li == 0), s2_round(ck, top, li == 1), s2_round(ck, top, li == 2), s2_round(ck, top, li == 3))
        PEER_HEAD(5, vb, va, true, s2_round(ck, top, li == 4), s2_round(ck, top, li == 5), s2_round(ck, top, li == 6), s2_round(ck, top, li == 7))
        PEER_HEAD(6, va, vb, true, s2_round(ck, top, li == 8), s2_round(ck, top, li == 9), s2_round(ck, top, li == 10), s2_round(ck, top, li == 11))
        v4u xr_cur0, xr_cur1; { int lo_ = lane; asm volatile("" : "+v"(lo_)); const v4u* xp_ = (const v4u*)(XB + (size_t)tkn * 1024 + lo_ * 16); xr_cur0 = xp_[0]; xr_cur1 = xp_[1]; }
        { int lp_ = lane; asm volatile("" : "+v"(lp_)); load_pre(pre, S, XB, tn2, lp_); }
        PEER_HEAD(7, vb, va, false, s2_round(ck, top, li == 12), s2_round(ck, top, li == 13), s2_round(ck, top, li == 14), s2_round(ck, top, li == 15))
        finalize(top, MA, MB, cij, rs1n, sx, SU, SV, lane, nxt);
        load_t_head(tq, nxt.eidP0, 0, rsUV, lo);
        { f32x4 xf[4]; pg8::unpack8(xr_cur0, xf[0], xf[1]); pg8::unpack8(xr_cur1, xf[2], xf[3]);
          f32x4 y[4]; float ss = 0.f;
#pragma unroll
          for (int w = 0; w < 4; ++w)
#pragma unroll
              for (int e = 0; e < 4; ++e) { y[w][e] = xf[w][e] + acc[4 * w + e]; ss += y[w][e] * y[w][e]; }
          int lo_ = lane; asm volatile("" : "+v"(lo_));
          bf16* xb = XB + (size_t)tkn * 1024 + lo_ * 16;
          *(v4u*)xb = pg8::pack8(y[0], y[1]); *(v4u*)(xb + 8) = pg8::pack8(y[2], y[3]);
          { v4u o8; o8.x = pg8::pkf8(y[0][0], y[0][1], y[0][2], y[0][3]); o8.y = pg8::pkf8(y[1][0], y[1][1], y[1][2], y[1][3]); o8.z = pg8::pkf8(y[2][0], y[2][1], y[2][2], y[2][3]); o8.w = pg8::pkf8(y[3][0], y[3][1], y[3][2], y[3][3]);
            *(v4u*)((unsigned char*)XB + X8D + (size_t)tkn * 1024 + lo_ * 16) = o8; }
          ss = wave_sum(ss, lane);
          if (lane == 0) rs2[tkn] = 1.0f / sqrtf(ss * (1.0f / 1024.0f) + EPS); }
        cur = nxt; xq_cur = xq_nxt; sumx_cur = sumx_nxt;
    }
}
#undef PEER_HEAD
#undef PEER_ROW
#undef PEER_ROWV
}

__global__ void __launch_bounds__(NWAVES * 64, 2) mk_fwd(Args args) {
    extern __shared__ __attribute__((aligned(16))) unsigned char lds[];
    LAS unsigned char* L = (LAS unsigned char*)lds;
    volatile LAS unsigned* MISC = (volatile LAS unsigned*)(L + MISC_OFF);
    const int G = gridDim.x, bx = blockIdx.x;
    const int wave_s = __builtin_amdgcn_readfirstlane((int)threadIdx.x >> 6);
    const int NGW = G * NWAVES, NGT = G * NWAVES * 64;
#define FRESH_IDS() int tid = wave_s * 64 + lane_id_opaque(); asm volatile("" : "+v"(tid)); const int lane = tid & 63, wave = __builtin_amdgcn_readfirstlane(tid >> 6); \
    const int gw = bx * NWAVES + wave, gtid = bx * (NWAVES * 64) + tid; (void)lane; (void)gw; (void)gtid
    typedef const unsigned char __attribute__((address_space(4))) karg_t;
#define FRESH_ARGS() karg_t* kp_ = (karg_t*)__builtin_amdgcn_kernarg_segment_ptr(); asm volatile("" : "+s"(kp_)); \
    unsigned char* ws = *(unsigned char* const __attribute__((address_space(4)))*)(kp_ + 224); float* out = *(float* const __attribute__((address_space(4)))*)(kp_ + 216); (void)out; (void)ws
#define IN(k) (*(const float* const __attribute__((address_space(4)))*)(kp_ + 8 * (k)))
#define WSP(T_, off) ((T_*)(ws + (off)))
    { FRESH_IDS(); for (int u = tid; u < (LDS_BYTES - LDSCTL_OFF) / 4; u += NWAVES * 64) ((LAS unsigned*)(L + LDSCTL_OFF))[u] = 0u; }
    __syncthreads();
    XcdBarrier bar;
    { FRESH_ARGS(); bar = xcd_barrier_post((unsigned*)(ws + WS_CTL) + CW_BAR, MISC + 8, wave_s); }
#define GRID_BAR() xcd_barrier(bar, wave_s)

    {
        FRESH_IDS(); FRESH_ARGS();
        bf16* WinT = WSP(bf16, WS_WIN); bf16* WgluT = WSP(bf16, WS_WGLU); bf16* WpsT = WSP(bf16, WS_WPS); bf16* WpaT = WSP(bf16, WS_WPA);
        bf16* WoutT = WSP(bf16, WS_WOUT); bf16* WsT = WSP(bf16, WS_WS); bf16* WgateT = WSP(bf16, WS_WGATE); bf16* WppT = WSP(bf16, WS_WPP);
        float* rope = WSP(float, WS_ROPE); unsigned char* s5p = ws + WS_S5P; bf16* XN = WSP(bf16, WS_XN); bf16* PB = WSP(bf16, WS_PB);
        const float* x = IN(I_X);
        {
            LAS float* scr = (LAS float*)(L + RING_OFF + wave * 16384);
            constexpr int I_1 = (1024 / 64) * (4096 / 32), I_7 = (256 / 64) * (1024 / 32);
            for (int it = gw; it < I_1; it += NGW) p0_transpose_item<true>(IN(I_WIN), IN(I_GMIX), 1024, 4096, WinT, scr, it, lane);
            for (int it = gw; it < I_7; it += NGW) p0_transpose_item(IN(I_WPP), nullptr, 256, 1024, WppT, scr, it, lane);
        }
        for (int m0 = gw * 4; m0 < T; m0 += NGW * 4) {
            f32x4 v[4][4];
#pragma unroll
            for (int i = 0; i < 4; ++i) { const f32x4* xr = (const f32x4*)(x + (size_t)(m0 + i) * D) + lane;
#pragma unroll
                for (int j = 0; j < 4; ++j) v[i][j] = xr[64 * j]; }
#pragma unroll
            for (int i = 0; i < 4; ++i) { float s = 0.f;
#pragma unroll
                for (int j = 0; j < 4; ++j) s += (v[i][j].x * v[i][j].x + v[i][j].y * v[i][j].y) + (v[i][j].z * v[i][j].z + v[i][j].w * v[i][j].w);
                const float rs = 1.0f / sqrtf(wave_sum(s, lane) * (1.f / D) + EPS);
                unsigned* o8 = (unsigned*)((unsigned char*)XN + (size_t)(m0 + i) * D) + lane;
#pragma unroll
                for (int j = 0; j < 4; ++j) o8[64 * j] = pg8::pkf8(v[i][j].x * rs, v[i][j].y * rs, v[i][j].z * rs, v[i][j].w * rs); }
        }
        {
            const float* pp = IN(I_P);
            constexpr int NI = T * D_PLE / 8;
            for (int i8 = gtid; i8 < NI; i8 += 4 * NGT) { f32x4 a[4], b[4];
#pragma unroll
                for (int j = 0; j < 4; ++j) { const int ij = i8 + j * NGT; const size_t o = (size_t)(ij < NI ? ij : NI - 1) * 8; a[j] = *(const f32x4*)(pp + o); b[j] = *(const f32x4*)(pp + o + 4); }
#pragma unroll
                for (int j = 0; j < 4; ++j) { const int ij = i8 + j * NGT; if (ij >= NI) break; const size_t o = (size_t)ij * 8; *(v4u*)(PB + o) = pg8::pack8(a[j], b[j]); } }
        }
        {
            const int* pos = (const int*)IN(I_POS);
            for (int i = gtid; i < T * 8; i += NGT) { const int t = i >> 3, k = i & 7;
                const double invf = k == 0 ? 1.0 : k == 1 ? 0.19392274474868576 : k == 2 ? 0.03760603093086393 : k == 3 ? 0.007292664737217109 : k == 4 ? 0.001414213562373095
                                  : k == 5 ? 0.0002742481756762073 : k == 6 ? 5.318295896944988e-05 : 1.031338537721246e-05;
                float c, s; cs_reduced((double)pos[t] * invf, c, s);
                rope[(size_t)t * 16 + 2 * k] = c; rope[(size_t)t * 16 + 2 * k + 1] = s; }
        }
    }
    GRID_BAR();

#define MK_DEFERRED_P0() do { FRESH_IDS(); \
        for (int it = bx; it < 256; it += G) p0_ws_item(IN(I_WQ), IN(I_GFFN), IN(I_KEY1), IN(I_KEY2), WSP(bf16, WS_WS), L + RING_OFF, it, tid); \
        __syncthreads(); \
        { \
            LAS float* scr = (LAS float*)(L + RING_OFF + wave * 16384); \
            constexpr int I_2 = (512 / 64) * (512 / 32), I_3 = (512 / 64) * (1024 / 32), I_4 = I_3, I_5 = (1024 / 64) * (1024 / 32), I_6 = I_5; \
            for (int it = gw; it < I_2 + I_3 + I_4 + I_5 + I_6; it += NGW) { \
                int r = it; \
                if (r < I_2) { p0_transpose_item<true>(IN(I_WGLU), nullptr, 512, 512, WSP(bf16, WS_WGLU), scr, r, lane); continue; } r -= I_2; \
                if (r < I_3) { p0_transpose_item<true>(IN(I_WPS), nullptr, 512, 1024, WSP(bf16, WS_WPS), scr, r, lane); continue; } r -= I_3; \
                if (r < I_4) { p0_transpose_item<true>(IN(I_WPA), nullptr, 512, 1024, WSP(bf16, WS_WPA), scr, r, lane); continue; } r -= I_4; \
                if (r < I_5) { p0_transpose_item<true>(IN(I_WOUT), nullptr, 1024, 1024, WSP(bf16, WS_WOUT), scr, r, lane); continue; } r -= I_5; \
                p0_transpose_item<true>(IN(I_WGATE), IN(I_GPLE), 1024, 1024, WSP(bf16, WS_WGATE), scr, r, lane); \
            } \
        } \
        if (gtid < NG * NS) { \
            const int g = gtid >> 6; \
            const float dt = expf(IN(I_LOGDT)[g]); const float are = IN(I_ARE)[gtid], aim = IN(I_AIM)[gtid]; \
            const double zr = (double)dt * (double)are, th = (double)dt * (double)aim; \
            float c, s; cs_reduced(th, c, s); const float mag = expf((float)zr); \
            const float abr = mag * c, abi = mag * s; \
            float cL, sL; cs_reduced(64.0 * th, cL, sL); const float magL = expf((float)(64.0 * zr)); \
            ((float*)((ws + WS_S5P) + S5_ABR))[gtid] = abr; ((float*)((ws + WS_S5P) + S5_ABI))[gtid] = abi; \
            ((float*)((ws + WS_S5P) + S5_ALR))[gtid] = magL * cL; ((float*)((ws + WS_S5P) + S5_ALI))[gtid] = magL * sL; \
            const float den = are * are + aim * aim, nr = abr - 1.0f, ni = abi; \
            const float fre = (nr * are + ni * aim) / den, fim = (ni * are - nr * aim) / den; \
            const float* br = IN(I_BRE) + (size_t)gtid * 16; const float* bi = IN(I_BIM) + (size_t)gtid * 16; \
            float* obr = (float*)((ws + WS_S5P) + S5_BRE) + (size_t)gtid * 16; float* obi = (float*)((ws + WS_S5P) + S5_BIM) + (size_t)gtid * 16; \
        _Pragma("unroll") \
            for (int cc = 0; cc < 16; ++cc) { obr[cc] = fre * br[cc] - fim * bi[cc]; obi[cc] = fre * bi[cc] + fim * br[cc]; } \
        } \
        for (int i = gtid; i < NG * NS * 64; i += NGT) { const int t = i & 63, gn = i >> 6, g = gn >> 6; \
            const float dt = expf(IN(I_LOGDT)[g]); const float are = IN(I_ARE)[gn], aim = IN(I_AIM)[gn]; \
            const double zr = (double)dt * (double)are, th = (double)dt * (double)aim; \
            float c1, s1; cs_reduced(th, c1, s1); const float mag1 = expf((float)zr); const float abr = mag1 * c1, abi = mag1 * s1; \
            const float den = are * are + aim * aim, nr = abr - 1.0f, ni = abi; \
            const float fre = (nr * are + ni * aim) / den, fim = (ni * are - nr * aim) / den; \
            float cp, sp; cs_reduced((double)(63 - t) * th, cp, sp); const float magp = expf((float)((double)(63 - t) * zr)); const float pr = magp * cp, pi = magp * sp; \
            const float qr = pr * fre - pi * fim, qi = pr * fim + pi * fre; \
            const f32x4* br = (const f32x4*)(IN(I_BRE) + (size_t)gn * 16); const f32x4* bi = (const f32x4*)(IN(I_BIM) + (size_t)gn * 16); \
            bf16* wre = WSP(bf16, WS_S5W) + ((size_t)g * 128 + (gn & 63)) * 1024 + 16 * t; bf16* wim = wre + (size_t)64 * 1024; \
        _Pragma("unroll") \
            for (int h8 = 0; h8 < 2; ++h8) { const f32x4 r0 = br[2 * h8], r1 = br[2 * h8 + 1], i0 = bi[2 * h8], i1 = bi[2 * h8 + 1]; \
                *(v4u*)(wre + 8 * h8) = pg8::pack8(qr * r0 - qi * i0, qr * r1 - qi * i1); *(v4u*)(wim + 8 * h8) = pg8::pack8(qr * i0 + qi * r0, qr * i1 + qi * r1); } } \
        for (int i = gtid; i < NG * 16 * 128; i += NGT) { const int gc = i >> 7, n = i & 127; \
            const float v = n < 64 ? IN(I_CRE)[(size_t)gc * 64 + n] : -IN(I_CIM)[(size_t)gc * 64 + n - 64]; \
            ((bf16*)((ws + WS_S5P) + S5_CM))[i] = (bf16)(pkbf(v, 0.f) & 0xffffu); } \
        __syncthreads(); \
    } while (0)
#define MK_PEER_TABLES() do { FRESH_IDS(); \
        { \
            const float* pu = IN(I_PU); const float* pv = IN(I_PV); const float* gf = IN(I_GFFN); \
            unsigned char* UQ = WSP(unsigned char, WS_UT); unsigned char* VQ = WSP(unsigned char, WS_VT); float* SU = WSP(float, WS_SU); float* SV = WSP(float, WS_SV); \
            f32x4 gf4[4]; \
        _Pragma("unroll") \
            for (int j = 0; j < 4; ++j) gf4[j] = *(const f32x4*)(gf + 16 * lane + 4 * j); \
            for (int r0 = gw * 4; r0 < NEXP; r0 += NGW * 4) { peer::Row4 rw[4]; \
        _Pragma("unroll") \
                for (int i = 0; i < 4; ++i) peer::load_row16(rw[i], pu + (size_t)(r0 + i) * 1024, lane); \
        _Pragma("unroll") \
                for (int i = 0; i < 4; ++i) peer::quant_row4(rw[i], gf4, true, UQ + (size_t)(r0 + i) * 1024, SU + r0 + i, lane); } \
            for (int r0 = gw * 4; r0 < NEXP; r0 += NGW * 4) { peer::Row4 rw[4]; \
        _Pragma("unroll") \
                for (int i = 0; i < 4; ++i) peer::load_row16(rw[i], pv + (size_t)(r0 + i) * 1024, lane); \
        _Pragma("unroll") \
                for (int i = 0; i < 4; ++i) peer::quant_row4(rw[i], gf4, false, UQ + (size_t)(r0 + i) * 1024 + 8, SV + r0 + i, lane, true); } \
        } \
    } while (0)
    {
        FRESH_ARGS();
        bf16* XN = WSP(bf16, WS_XN); bf16* WinT = WSP(bf16, WS_WIN); bf16* PB = WSP(bf16, WS_PB); bf16* WppT = WSP(bf16, WS_WPP); bf16* EB = WSP(bf16, WS_E);
        bf16* Ub = WSP(bf16, WS_U); bf16* Qb = WSP(bf16, WS_Q); bf16* Kb = WSP(bf16, WS_K); bf16* Vb = WSP(bf16, WS_V); unsigned char* SGA = WSP(unsigned char, WS_SGA); unsigned char* SGB = WSP(unsigned char, WS_SGB);
        float* kmean = WSP(float, CTL_KMEAN); float* rope = WSP(float, WS_ROPE);
        const int grp = (bx >> 3) & 3, nrounds = ((T / 256) * (D_IN / 256) + G - 1) / G, rhalf = (nrounds + 1) / 2;
        if (grp == 0) { MK_PEER_TABLES(); MK_DEFERRED_P0(); }
        { pg8::Gemm g{XN, WinT, T, D_IN, D}; pg8::RangeOrder S; S.b.init(T, D_IN, G, bx); S.i0 = 0; S.i1 = rhalf;
          pg8::EpiWin E{Ub, Qb, Kb, Vb, SGA, SGB, kmean, rope, 0.18033688011112042f};
          pg8::gemm_phase<pg8::EpiWin, pg8::RangeOrder, true, true, true, D>(L + RING_OFF, g, S, E, wave_s); }
        if (grp == 1) { MK_PEER_TABLES(); MK_DEFERRED_P0(); }
        { pg8::Gemm g{XN, WinT, T, D_IN, D}; pg8::RangeOrder S; S.b.init(T, D_IN, G, bx); S.i0 = rhalf; S.i1 = nrounds;
          pg8::EpiWin E{Ub, Qb, Kb, Vb, SGA, SGB, kmean, rope, 0.18033688011112042f};
          pg8::gemm_phase<pg8::EpiWin, pg8::RangeOrder, true, true, true, D>(L + RING_OFF, g, S, E, wave_s); }
        if (grp == 2) { MK_PEER_TABLES(); MK_DEFERRED_P0(); }
        { pg8::Gemm g{PB, WppT, T, D, D_PLE}; pg8::StaticOrder S; S.init(T, D, G, bx);
          pg8::EpiPlain E{EB, D};
          pg8::gemm_phase<pg8::EpiPlain, pg8::StaticOrder, true, true, false, D_PLE>(L + RING_OFF, g, S, E, wave_s); }
        if (grp == 3) { MK_PEER_TABLES(); MK_DEFERRED_P0(); }
    }
#undef MK_PEER_TABLES
#undef MK_DEFERRED_P0
    GRID_BAR();

    {
        { FRESH_IDS(); FRESH_ARGS();
          const bf16* Qb = WSP(bf16, WS_Q); const float* kmean = WSP(float, CTL_KMEAN);
          unsigned short* SUB = WSP(unsigned short, WS_MSUB); unsigned* CNT = WSP(unsigned, WS_MCNT); float* LSE = WSP(float, WS_MLSE);
          for (int u = bx; u < 512; u += G) moba::select_pair(u, 1023 - u, (const moba::bf16*)Qb, kmean, SUB, CNT, LSE, (char*)lds + RING_OFF, tid); }
        FRESH_IDS(); FRESH_ARGS();
        __syncthreads();
        s5::pass1_gemm(L + RING_OFF, WSP(bf16, WS_S5W), WSP(bf16, WS_U), WSP(float, WS_HLOC), G, bx, tid, wave);
    }
    GRID_BAR();

    {
        FRESH_IDS(); FRESH_ARGS();
        moba::sparse_phase((const moba::bf16*)WSP(bf16, WS_Q), (const moba::bf16*)WSP(bf16, WS_K), (const moba::bf16*)WSP(bf16, WS_V), WSP(unsigned short, WS_MSUB), WSP(unsigned, WS_MCNT),
                           (moba::bf16*)out, WSP(float, WS_MLSE), (char*)lds + RING_OFF, G, bx, tid, wave_s);
    }
    GRID_BAR();

    {
        { FRESH_ARGS();
          moba::own_phase((const moba::bf16*)WSP(bf16, WS_Q), (const moba::bf16*)WSP(bf16, WS_K), (const moba::bf16*)WSP(bf16, WS_V), (const moba::bf16*)out, WSP(float, WS_MLSE), (moba::bf16*)WSP(bf16, WS_PB),
                          (char*)lds + RING_OFF, G, bx, wave_s); }
        FRESH_IDS(); FRESH_ARGS();
        s5::run<2>(L + RING_OFF + wave * 16384, ws + WS_S5P, WSP(bf16, WS_U), WSP(float, WS_HLOC), IN(I_DSK), WSP(bf16, WS_YP), gw, NGW, lane); }
    GRID_BAR();

    {
        FRESH_ARGS(); bf16* YP = WSP(bf16, WS_YP); bf16* YS = WSP(bf16, WS_V); bf16* WgluT = WSP(bf16, WS_WGLU);
        pg8::Gemm g{WSP(bf16, WS_MSUB), WgluT, T, D_SSM, D_SSM}; pg8::StaticOrder S; S.init(T, D_SSM, G, bx);
        pg8::EpiGlu E{YP, YS};
        pg8::gemm_phase<pg8::EpiGlu, pg8::StaticOrder, true, true, true, D_SSM>(L + RING_OFF, g, S, E, wave_s);
    }
    GRID_BAR();

    {
        FRESH_ARGS(); bf16* YS = WSP(bf16, WS_V); bf16* Qb = WSP(bf16, WS_PB); unsigned char* M8 = WSP(unsigned char, WS_U); bf16* WpsT = WSP(bf16, WS_WPS); bf16* WpaT = WSP(bf16, WS_WPA); const unsigned char* SGA = WSP(unsigned char, WS_SGA); const unsigned char* SGB = WSP(unsigned char, WS_SGB); bf16* T1 = WSP(bf16, WS_Q);
        { pg8::Gemm g{YS, WpsT, T, D, D_SSM}; pg8::StaticOrder S; S.init(T, D, G, bx);
          pg8::EpiMerge<0> E{SGA, T1, nullptr};
          pg8::gemm_phase<pg8::EpiMerge<0>, pg8::StaticOrder, true, true, true, D_SSM>(L + RING_OFF, g, S, E, wave_s); }
        { pg8::Gemm g{Qb, WpaT, T, D, D_ATT}; pg8::StaticOrder S; S.init(T, D, G, bx);
          pg8::EpiMerge<1> E{SGB, T1, M8};
          pg8::gemm_phase<pg8::EpiMerge<1>, pg8::StaticOrder, true, true, true, D_ATT>(L + RING_OFF, g, S, E, wave_s); }
    }
    GRID_BAR();

    {
        FRESH_ARGS(); bf16* SGA = WSP(bf16, WS_U); bf16* WoutT = WSP(bf16, WS_WOUT); bf16* XN = WSP(bf16, WS_XN); float* ss1 = WSP(float, CTL_SS1); const float* x = IN(I_X);
        pg8::Gemm g{SGA, WoutT, T, D, D}; pg8::StaticOrder S; S.init(T, D, G, bx);
        pg8::EpiResid E{x, XN, ss1};
        pg8::gemm_phase<pg8::EpiResid, pg8::StaticOrder, true, true, true, D>(L + RING_OFF, g, S, E, wave_s);
    }
    GRID_BAR();

    {
        FRESH_ARGS(); bf16* XN = WSP(bf16, WS_XN); bf16* WsT = WSP(bf16, WS_WS); float* SC = WSP(float, WS_SC); float* ss1 = WSP(float, CTL_SS1);
        pg8::Gemm g{XN, WsT, T, PH * PQD, D}; pg8::StaticOrder S; S.init(T, PH * PQD, G, bx);
        pg8::EpiScores E{(pg8::bf16_t*)SC, ss1};
        pg8::gemm_phase<pg8::EpiScores, pg8::StaticOrder, true, true, false, D>(L + RING_OFF, g, S, E, wave_s);
    }
    GRID_BAR();

    {
        FRESH_IDS(); FRESH_ARGS();
        float* SC = WSP(float, WS_SC); bf16* XN = WSP(bf16, WS_XN); float* ss1 = WSP(float, CTL_SS1); float* rs2 = WSP(float, WS_RS2);
        const unsigned char* UQ = WSP(unsigned char, WS_UT); const unsigned char* VQ = WSP(unsigned char, WS_VT); const float* SU = WSP(float, WS_SU); const float* SV = WSP(float, WS_SV);
        peer::run_wave<(long)WS_X8 - (long)WS_XN>(SC, XN, UQ, VQ, SU, SV, ss1, rs2, gw, NGW, T, lane);
    }
    GRID_BAR();

    {
        FRESH_ARGS(); bf16* XN = WSP(bf16, WS_XN); bf16* WgateT = WSP(bf16, WS_WGATE); bf16* EB = WSP(bf16, WS_E); float* rs2 = WSP(float, WS_RS2); float* ss3 = WSP(float, CTL_SS3);
        pg8::Gemm g{WSP(bf16, WS_X8), WgateT, T, D, D}; pg8::StaticOrder S; S.init(T, D, G, bx);
        pg8::EpiPle E{XN, EB, rs2, ss3};
        pg8::gemm_phase<pg8::EpiPle, pg8::StaticOrder, true, true, true, D>(L + RING_OFF, g, S, E, wave_s);
    }
    GRID_BAR();

    {
        FRESH_IDS(); FRESH_ARGS();
        const bool bad = xb_ld(&bar.bar[XB_TMO]) != 0u;
        const float* gfin = IN(I_GFIN); float* ss3 = WSP(float, CTL_SS3);
        const f32x4* gp = (const f32x4*)gfin + lane;
        f32x4 g4[4];
#pragma unroll
        for (int j = 0; j < 4; ++j) g4[j] = gp[64 * j];
        const bf16* X3B = WSP(bf16, WS_E);
        for (int m0 = gw * 4; m0 < T; m0 += NGW * 4) {
            v2u v[4][4]; float rs[4];
#pragma unroll
            for (int i = 0; i < 4; ++i) { const v2u* xr = (const v2u*)(X3B + (size_t)(m0 + i) * D) + lane; rs[i] = ss3[m0 + i];
#pragma unroll
                for (int j = 0; j < 4; ++j) v[i][j] = xr[64 * j]; }
#pragma unroll
            for (int i = 0; i < 4; ++i) { const float r_ = 1.0f / sqrtf(rs[i] * (1.f / D) + EPS); f32x4* xo = (f32x4*)(out + (size_t)(m0 + i) * D) + lane;
#pragma unroll
                for (int j = 0; j < 4; ++j) { f32x4 r = (f32x4){bflo(v[i][j].x), bfhi(v[i][j].x), bflo(v[i][j].y), bfhi(v[i][j].y)} * r_ * g4[j]; if (bad) r = (f32x4){__builtin_nanf(""), 0.f, 0.f, 0.f}; xo[64 * j] = r; } }
        }
    }
}

extern "C" void kernel_launch(void* const* d_in, const int* in_sizes, int n_in, void* d_out, int out_size, void* d_ws, size_t ws_size, hipStream_t stream) {
    static int grid = 0;
    if (grid == 0) {
        if (n_in != 27 || in_sizes[0] != T * D || out_size != T * D || ws_size < WS_END) {
            fprintf(stderr, "kernel_launch: built for 27 inputs, x/out of %d floats, >= %zu bytes of workspace; got n_in %d in0 %d out %d ws %zu\n", T * D, (size_t)WS_END, n_in, n_in > 0 ? in_sizes[0] : -1, out_size, ws_size);
            grid = -1; return; }
        int dev = 0, cus = 0, per_cu = 0;
        if (hipGetDevice(&dev) != hipSuccess || hipDeviceGetAttribute(&cus, hipDeviceAttributeMultiprocessorCount, dev) != hipSuccess) { grid = -1; return; }
        if (hipFuncSetAttribute((const void*)mk_fwd, hipFuncAttributeMaxDynamicSharedMemorySize, LDS_BYTES) != hipSuccess) { fprintf(stderr, "kernel_launch: hipFuncSetAttribute failed\n"); grid = -1; return; }
        if (hipOccupancyMaxActiveBlocksPerMultiprocessor(&per_cu, (const void*)mk_fwd, NWAVES * 64, LDS_BYTES) != hipSuccess || per_cu < 1) { fprintf(stderr, "kernel_launch: occupancy query says %d\n", per_cu); per_cu = 1; }
        (void)hipGetLastError();
        grid = cus;
        if (grid % 32 != 0 || grid > 256) grid = (grid / 32) * 32 > 256 ? 256 : (grid / 32) * 32;
        fprintf(stderr, "kernel_launch: cus %d per_cu %d grid %d ws %zu\n", cus, per_cu, grid, ws_size);
    }
    if (grid <= 0) return;
    if (hipMemsetAsync((char*)d_ws + WS_CTL, 0, CTL_ZERO_BYTES, stream) != hipSuccess) { fprintf(stderr, "kernel_launch: memset failed\n"); return; }
    Args a{};
    for (int i = 0; i < 27; ++i) a.in[i] = (const float*)d_in[i];
    a.out = (float*)d_out; a.ws = (unsigned char*)d_ws;
    void* kargs[] = {&a};
    const hipError_t e = hipLaunchCooperativeKernel((const void*)mk_fwd, dim3(grid), dim3(NWAVES * 64), kargs, LDS_BYTES, stream);
    if (e != hipSuccess) fprintf(stderr, "kernel_launch: cooperative launch failed: %s (grid %d)\n", hipGetErrorString(e), grid);
}
```

```cpp
#include <hip/hip_runtime.h>
#include <hip/hip_bf16.h>
#include <cstdio>
#include <cstdint>
#include <cmath>
namespace pg8 {
#define PG8_LAS __attribute__((address_space(3)))
typedef unsigned short bf16_t;
typedef short bf16x8 __attribute__((ext_vector_type(8)));
typedef float f32x4 __attribute__((ext_vector_type(4)));
typedef unsigned u32x4 __attribute__((ext_vector_type(4)));
constexpr int BM = 256, BK = 64, HALF = 128, HTB = HALF * BK * 2  , STAGE_BYTES = 8 * HTB, NXCD = 8, WGM = 8;

__host__ __device__ __forceinline__ int lds_byte(int r, int c) { const int st = (r >> 4) * 2 + (c >> 5), rr = r & 15, cc = c & 31, ob = rr * 64 + cc * 2; return st * 1024 + (ob ^ (((ob >> 9) & 1) << 5)); }
__host__ __device__ __forceinline__ void stage_rc(int b, int& R, int& C) { const int st = b / 1024, sb = b % 1024, swz = sb ^ (((sb >> 9) & 1) << 5); R = (st >> 1) * 16 + swz / 64; C = (st & 1) * 32 + (swz % 64) / 2; }
__host__ __device__ __forceinline__ int perm32(int rho) { const int n = rho >> 4, i = rho & 15; return 8 * (i >> 2) + 4 * n + (i & 3); }

struct Unit { int pm, pn, ph; };
struct Gemm { const bf16_t* A; const bf16_t* Bt; int M, N, K; const bf16_t* A2; const bf16_t* Bt2; };

struct StaticOrder {
    static constexpr bool DUAL = false;
    int nM, nN, nwg, G, c;
    __host__ __device__ void init(int M, int N, int G_, int c_) { nM = M / BM; nN = N / BM; nwg = nM * nN; G = G_; c = c_; }
    __host__ __device__ bool next(int i, Unit& u) const {
        const long L = (long)i * G + c; if (L >= nwg) return false;
        int wgid = (int)L; { const int q = nwg / NXCD, r = nwg % NXCD, xcd = wgid % NXCD, off = wgid / NXCD; wgid = (xcd < r ? xcd * (q + 1) : r * (q + 1) + (xcd - r) * q) + off; }
        const int nig = WGM * nN, gid = wgid / nig, fm = gid * WGM, gsz = (nM - fm) < WGM ? (nM - fm) : WGM;
        u.pm = fm + ((wgid % nig) % gsz); u.pn = (wgid % nig) / gsz; return true;
    }
    __device__ __forceinline__ void a_ready(const Unit&) const {}
    __device__ __forceinline__ void done(const Unit&) const {}
};

__device__ __forceinline__ unsigned cvt_pk_bf16(float lo, float hi) { unsigned r; asm volatile("v_cvt_pk_bf16_f32 %0, %1, %2" : "=v"(r) : "v"(lo), "v"(hi)); return r; }
typedef float f32x2 __attribute__((ext_vector_type(2)));
typedef unsigned u32x2 __attribute__((ext_vector_type(2)));
typedef __bf16 bf16x2_t __attribute__((ext_vector_type(2)));
__device__ __forceinline__ unsigned pkbf(float lo, float hi) { f32x2 v = {lo, hi}; bf16x2_t b = __builtin_convertvector(v, bf16x2_t); return __builtin_bit_cast(unsigned, b); }
__device__ __forceinline__ float bflo(unsigned w) { return __uint_as_float(w << 16); }
__device__ __forceinline__ float bfhi(unsigned w) { return __uint_as_float(w & 0xffff0000u); }
__device__ __forceinline__ unsigned pkf8(float a, float b, float c, float d) {
    a = __builtin_amdgcn_fmed3f(a, -448.f, 448.f); b = __builtin_amdgcn_fmed3f(b, -448.f, 448.f); c = __builtin_amdgcn_fmed3f(c, -448.f, 448.f); d = __builtin_amdgcn_fmed3f(d, -448.f, 448.f);
    int w = __builtin_amdgcn_cvt_pk_fp8_f32(a, b, 0, false); w = __builtin_amdgcn_cvt_pk_fp8_f32(c, d, w, true); return (unsigned)w; }
__device__ __forceinline__ f32x4 unpk8(unsigned w) { const f32x2 lo = __builtin_amdgcn_cvt_pk_f32_fp8((int)w, false), hi = __builtin_amdgcn_cvt_pk_f32_fp8((int)w, true); return (f32x4){lo[0], lo[1], hi[0], hi[1]}; }
__device__ __forceinline__ float sigmoidf_(float x) { return __builtin_amdgcn_rcpf(1.0f + __expf(-x)); }
__device__ __forceinline__ float gelu_tanh(float x) { const float t = 1.5957691216057308f * (x + 0.044715f * x * x * x); return x * __builtin_amdgcn_rcpf(1.0f + __expf(-t)); }
__device__ __forceinline__ u32x4 pack8(const f32x4 a, const f32x4 b) { u32x4 w; w.x = pkbf(a[0], a[1]); w.y = pkbf(a[2], a[3]); w.z = pkbf(b[0], b[1]); w.w = pkbf(b[2], b[3]); return w; }
__device__ __forceinline__ void unpack8(const u32x4 w, f32x4& a, f32x4& b) { a = (f32x4){bflo(w.x), bfhi(w.x), bflo(w.y), bfhi(w.y)}; b = (f32x4){bflo(w.z), bfhi(w.z), bflo(w.w), bfhi(w.w)}; }

template <int M> __device__ __forceinline__ float shx(float v, int lane) {
    const int iv = __builtin_bit_cast(int, v); int r;
    if (M == 1) r = __builtin_amdgcn_mov_dpp(iv, 0xB1, 0xf, 0xf, true);
    else if (M == 2) r = __builtin_amdgcn_mov_dpp(iv, 0x4E, 0xf, 0xf, true);
    else if (M == 4) r = __builtin_amdgcn_ds_swizzle(iv, 0x101F);
    else if (M == 8) r = __builtin_amdgcn_ds_swizzle(iv, 0x201F);
    else if (M == 16) r = __builtin_amdgcn_ds_swizzle(iv, 0x401F);
    else r = __builtin_amdgcn_ds_bpermute((lane ^ M) << 2, iv);
    return __builtin_bit_cast(float, r);
}
__device__ __forceinline__ float bperm(float v, int srclane) { return __builtin_bit_cast(float, __builtin_amdgcn_ds_bpermute(srclane << 2, __builtin_bit_cast(int, v))); }
__device__ __forceinline__ int bpermi(int v, int srclane) { return __builtin_amdgcn_ds_bpermute(srclane << 2, v); }
__device__ __forceinline__ int lane_id_opaque() { unsigned m = ~0u; asm volatile("" : "+s"(m)); return (int)__builtin_amdgcn_mbcnt_hi(m, __builtin_amdgcn_mbcnt_lo(m, 0u)); }

#define EPI_IDS() int frq_ = lane_id_opaque(); fr = frq_ & 15; fq = frq_ >> 4; (void)frq_;     \
        const int row0 = u.pm * BM + wr * 64 + fr, col0 = u.pn * BM + wc * 64 + 16 * fq; (void)row0; (void)col0
constexpr int CBJ = 8;
__device__ __forceinline__ void store_pair(bf16_t* rowp, long offA, long offB, const u32x4 p0, const u32x4 p1, bool up) {
    u32x4 recv, dA, dB;
#pragma unroll
    for (int k = 0; k < 4; ++k) { const unsigned send = up ? p0[k] : p1[k]; recv[k] = (unsigned)__builtin_amdgcn_update_dpp(0, (int)send, 0x128, 0xf, 0xf, true); dA[k] = up ? recv[k] : p0[k]; dB[k] = up ? p1[k] : recv[k]; }
    *(u32x4*)(rowp + offA) = dA; *(u32x4*)(rowp + offB) = dB;
}
#define EPI_PAIR_OFFS(pitch) const bool up_ = (fr & 8) != 0; const long offA_ = up_ ? (long)8 - 8 * (long)(pitch) : 0, offB_ = up_ ? 8 : 8 * (long)(pitch)

struct RangeOrder {
    static constexpr bool DUAL = false;
    StaticOrder b; int i0, i1;
    __device__ __forceinline__ bool next(int i, Unit& u) const { return (i + i0 < i1) && b.next(i + i0, u); }
    __device__ __forceinline__ void a_ready(const Unit&) const {}
    __device__ __forceinline__ void done(const Unit&) const {}
};

struct PairOrder {
    static constexpr bool DUAL = true;
    StaticOrder b;
    __device__ __forceinline__ bool next(int i, Unit& u) const { const bool ok = b.next(i >> 1, u); u.ph = i & 1; return ok; }
    __device__ __forceinline__ void a_ready(const Unit&) const {}
    __device__ __forceinline__ void done(const Unit&) const {}
};

struct EpiPlain {
    static constexpr bool PERM = true, PERM2 = true, AFTER_DRAIN = false;
    bf16_t* O; int ldc;
    __device__ __forceinline__ void operator()(const f32x4 (&acc)[2][2][4][2], const Unit& u, int wr, int wc, int fr, int fq) const {
        EPI_IDS(); EPI_PAIR_OFFS(ldc);
#pragma unroll
        for (int ai = 0; ai < 2; ++ai)
#pragma unroll
            for (int m = 0; m < 4; ++m) { bf16_t* rowp = O + (size_t)(row0 + ai * HALF + m * 16) * ldc + col0;
                store_pair(rowp, offA_, offB_, pack8(acc[ai][0][m][0], acc[ai][0][m][1]), pack8(acc[ai][1][m][0], acc[ai][1][m][1]), up_); }
    }
};

struct EpiWin {
    static constexpr bool PERM = true, PERM2 = true, AFTER_DRAIN = false;
    bf16_t *U, *Q, *K, *V; unsigned char *SGA, *SGB; float* kmean; const float* rope;
    float qscale;
    __device__ __forceinline__ void operator()(const f32x4 (&acc)[2][2][4][2], const Unit& u, int wr, int wc, int fr, int fq) const {
        EPI_IDS();
        const int pn = u.pn;
        if (pn < 2) {
            const int g = (pn * 256 + wc * 64) / 16 + fq;
#pragma unroll
            for (int ai = 0; ai < 2; ++ai)
#pragma unroll
                for (int m = 0; m < 4; ++m) { const int row = row0 + ai * HALF + m * 16, b = row >> 13, t = row & 8191; bf16_t* up = U + ((size_t)(b * 32 + g) * 8192 + t) * 16;
#pragma unroll
                    for (int bj = 0; bj < 2; ++bj) *(u32x4*)(up + 8 * bj) = pack8(acc[ai][bj][m][0], acc[ai][bj][m][1]); }
        } else if (pn < 6) {
            const bool isq = pn < 4; bf16_t* dst = isq ? Q : K; const int cb = (pn - (isq ? 2 : 4)) * 256 + wc * 64 + 16 * fq;
            const float sc = isq ? qscale : 1.0f;
            float cs[2][8];
#pragma unroll
            for (int bj = 0; bj < 2; ++bj)
#pragma unroll
                for (int i = 0; i < 8; ++i) cs[bj][i] = 0.f;
#pragma unroll
            for (int ai = 0; ai < 2; ++ai)
#pragma unroll
                for (int m = 0; m < 4; ++m) { const int row = row0 + ai * HALF + m * 16;
                    f32x4 v[2][2];
#pragma unroll
                    for (int bj = 0; bj < 2; ++bj) { v[bj][0] = acc[ai][bj][m][0]; v[bj][1] = acc[ai][bj][m][1]; }
                    { const f32x4* cp = (const f32x4*)(rope + (size_t)row * 16);
                      const f32x4 c01 = cp[0], c23 = cp[1], c45 = cp[2], c67 = cp[3];
                      const float co[8] = {c01[0], c01[2], c23[0], c23[2], c45[0], c45[2], c67[0], c67[2]};
                      const float si[8] = {c01[1], c01[3], c23[1], c23[3], c45[1], c45[3], c67[1], c67[3]};
#pragma unroll
                      for (int n = 0; n < 2; ++n)
#pragma unroll
                          for (int e = 0; e < 4; ++e) { const float a = v[0][n][e], b = v[1][n][e];
                              const float ra = a * co[4 * n + e] - b * si[4 * n + e], rb = b * co[4 * n + e] + a * si[4 * n + e];
                              v[0][n][e] = (fq == 0) ? ra : a; v[1][n][e] = (fq == 0) ? rb : b; } }
#pragma unroll
                    for (int bj = 0; bj < 2; ++bj) {
                        if (!isq) {
#pragma unroll
                            for (int n = 0; n < 2; ++n)
#pragma unroll
                                for (int e = 0; e < 4; ++e) cs[bj][4 * n + e] += v[bj][n][e]; } }
                    { EPI_PAIR_OFFS(512); store_pair(dst + (size_t)row * 512 + cb, offA_, offB_, pack8(v[0][0] * sc, v[0][1] * sc), pack8(v[1][0] * sc, v[1][1] * sc), up_); }
                }
            if (!isq) {
#pragma unroll
                for (int bj = 0; bj < 2; ++bj)
#pragma unroll
                    for (int i = 0; i < 8; ++i) { float s = cs[bj][i]; s += shx<1>(s, frq_); s += shx<2>(s, frq_); s += shx<4>(s, frq_); s += shx<8>(s, frq_);
                        if (fr == 0) atomicAdd(kmean + (size_t)u.pm * 512 + cb + bj * CBJ + i, s); }
            }
        } else if (pn < 8) {
            const int cb = (pn - 6) * 256 + wc * 64 + 16 * fq;
#pragma unroll
            for (int ai = 0; ai < 2; ++ai)
#pragma unroll
                for (int m = 0; m < 4; ++m) { const int row = row0 + ai * HALF + m * 16; EPI_PAIR_OFFS(512);
                    store_pair(V + (size_t)row * 512 + cb, offA_, offB_, pack8(acc[ai][0][m][0], acc[ai][0][m][1]), pack8(acc[ai][1][m][0], acc[ai][1][m][1]), up_); }
        } else {
            unsigned char* dst = pn < 12 ? SGA : SGB; const int cb = (pn - (pn < 12 ? 8 : 12)) * 256 + wc * 64 + 16 * fq;
#pragma unroll
            for (int ai = 0; ai < 2; ++ai)
#pragma unroll
                for (int m = 0; m < 4; ++m) { const int row = row0 + ai * HALF + m * 16; u32x4 o8;
#pragma unroll
                    for (int bj = 0; bj < 2; ++bj) { f32x4 a = acc[ai][bj][m][0], b = acc[ai][bj][m][1];
#pragma unroll
                        for (int e = 0; e < 4; ++e) { a[e] = sigmoidf_(a[e]); b[e] = sigmoidf_(b[e]); }
                        o8[2 * bj] = pkf8(a[0], a[1], a[2], a[3]); o8[2 * bj + 1] = pkf8(b[0], b[1], b[2], b[3]); }
                    *(u32x4*)(dst + (size_t)row * 1024 + cb) = o8; }
        }
    }
};

struct EpiGlu {
    static constexpr bool PERM = true, PERM2 = true, AFTER_DRAIN = false;
    const bf16_t* YP; bf16_t* YS;
    __device__ __forceinline__ void operator()(const f32x4 (&acc)[2][2][4][2], const Unit& u, int wr, int wc, int fr, int fq) const {
        EPI_IDS();
#pragma unroll
        for (int ai = 0; ai < 2; ++ai)
#pragma unroll
            for (int m = 0; m < 4; ++m) { const size_t off = (size_t)(row0 + ai * HALF + m * 16) * 512 + col0; u32x4 o8;
                const u32x4 y8 = *(const u32x4*)((const unsigned char*)YP + off);
#pragma unroll
                for (int bj = 0; bj < 2; ++bj) { const f32x4 ya = unpk8(y8[2 * bj]), yb = unpk8(y8[2 * bj + 1]);
                    f32x4 a = acc[ai][bj][m][0], b = acc[ai][bj][m][1];
#pragma unroll
                    for (int e = 0; e < 4; ++e) { a[e] = ya[e] * sigmoidf_(a[e]); b[e] = yb[e] * sigmoidf_(b[e]); }
                    o8[2 * bj] = pkf8(a[0], a[1], a[2], a[3]); o8[2 * bj + 1] = pkf8(b[0], b[1], b[2], b[3]); }
                *(u32x4*)((unsigned char*)YS + off) = o8; }
    }
};

template <int MODE> struct EpiMerge {
    static constexpr bool PERM = true, PERM2 = true, AFTER_DRAIN = false;
    const unsigned char* G8; bf16_t* T1; unsigned char* M8;
    __device__ __forceinline__ void operator()(const f32x4 (&acc)[2][2][4][2], const Unit& u, int wr, int wc, int fr, int fq) const {
        EPI_IDS();
#pragma unroll
        for (int ai = 0; ai < 2; ++ai)
#pragma unroll
            for (int m = 0; m < 4; ++m) { const size_t off = (size_t)(row0 + ai * HALF + m * 16) * 1024 + col0; u32x4 o8, pk[2]; EPI_PAIR_OFFS(1024);
                const u32x4 g8 = *(const u32x4*)(G8 + off);
#pragma unroll
                for (int bj = 0; bj < 2; ++bj) { const f32x4 ga = unpk8(g8[2 * bj]), gb = unpk8(g8[2 * bj + 1]);
                    f32x4 a = acc[ai][bj][m][0], b = acc[ai][bj][m][1];
                    if (MODE == 0) { a = ga * a; b = gb * b; pk[bj] = pack8(a, b); }
                    else { const u32x4 w = *(const u32x4*)(T1 + off + bj * CBJ); f32x4 ta, tb; unpack8(w, ta, tb); a = ta + ga * a; b = tb + gb * b;
                        o8[2 * bj] = pkf8(a[0], a[1], a[2], a[3]); o8[2 * bj + 1] = pkf8(b[0], b[1], b[2], b[3]); } }
                if (MODE == 1) *(u32x4*)(M8 + off) = o8; else store_pair(T1 + off, offA_, offB_, pk[0], pk[1], up_); }
    }
};

struct EpiMerge2 {
    static constexpr bool PERM = true, PERM2 = true, AFTER_DRAIN = false;
    const unsigned char* GA; const unsigned char* GB; unsigned char* M8;
    __device__ __forceinline__ void operator()(const f32x4 (&acc_)[2][2][4][2], const Unit& u, int wr, int wc, int fr, int fq) const {
        f32x4 (&acc)[2][2][4][2] = const_cast<f32x4 (&)[2][2][4][2]>(acc_);
        EPI_IDS();
#pragma unroll
        for (int ai = 0; ai < 2; ++ai)
#pragma unroll
            for (int m = 0; m < 4; ++m) { const size_t off = (size_t)(row0 + ai * HALF + m * 16) * 1024 + col0; u32x4 o8;
                const u32x4 gb8 = *(const u32x4*)(GB + off);
                if (u.ph == 0) { const u32x4 ga8 = *(const u32x4*)(GA + off);
#pragma unroll
                    for (int bj = 0; bj < 2; ++bj)
#pragma unroll
                        for (int n = 0; n < 2; ++n) { const f32x4 ga = unpk8(ga8[2 * bj + n]), gb = unpk8(gb8[2 * bj + n]); f32x4 a = acc[ai][bj][m][n];
#pragma unroll
                            for (int e = 0; e < 4; ++e) a[e] = 64.0f   * ga[e] * a[e] * __builtin_amdgcn_rcpf(gb[e] > 0.f ? gb[e] : 0.000244140625f);
                            acc[ai][bj][m][n] = a; } }
                else {
#pragma unroll
                    for (int bj = 0; bj < 2; ++bj) { const f32x4 g0 = unpk8(gb8[2 * bj]), g1 = unpk8(gb8[2 * bj + 1]); f32x4 a = acc[ai][bj][m][0], b = acc[ai][bj][m][1];
#pragma unroll
                        for (int e = 0; e < 4; ++e) { a[e] *= (g0[e] > 0.f ? g0[e] : 0.000244140625f); b[e] *= (g1[e] > 0.f ? g1[e] : 0.000244140625f); }
                        o8[2 * bj] = pkf8(a[0], a[1], a[2], a[3]); o8[2 * bj + 1] = pkf8(b[0], b[1], b[2], b[3]); }
                    *(u32x4*)(M8 + off) = o8; } }
    }
};

struct EpiResid {
    static constexpr bool PERM = true, PERM2 = true, AFTER_DRAIN = false;
    const float* X; bf16_t* X1B; float* sumsq;
    __device__ __forceinline__ void operator()(const f32x4 (&acc)[2][2][4][2], const Unit& u, int wr, int wc, int fr, int fq) const {
        EPI_IDS();
#pragma unroll
        for (int ai = 0; ai < 2; ++ai)
#pragma unroll
            for (int m = 0; m < 4; ++m) { const int row = row0 + ai * HALF + m * 16; const size_t off = (size_t)row * 1024 + col0; float ss = 0.f; u32x4 pk[2]; EPI_PAIR_OFFS(1024);
#pragma unroll
                for (int bj = 0; bj < 2; ++bj) { const f32x4 xa = *(const f32x4*)(X + off + bj * CBJ), xb = *(const f32x4*)(X + off + bj * CBJ + 4);
                    const f32x4 a = xa + acc[ai][bj][m][0], b = xb + acc[ai][bj][m][1];
                    pk[bj] = pack8(a, b);
                    ss += (a[0] * a[0] + a[1] * a[1]) + (a[2] * a[2] + a[3] * a[3]) + (b[0] * b[0] + b[1] * b[1]) + (b[2] * b[2] + b[3] * b[3]); }
                store_pair(X1B + off, offA_, offB_, pk[0], pk[1], up_);
                ss += shx<16>(ss, frq_); ss += shx<32>(ss, frq_);
                if (fq == 0) atomicAdd(sumsq + row, ss); }
    }
};

struct EpiScores {
    static constexpr bool PERM = true, PERM2 = true, AFTER_DRAIN = false;
    bf16_t* S; const float* sumsq;
    __device__ __forceinline__ void operator()(const f32x4 (&acc)[2][2][4][2], const Unit& u, int wr, int wc, int fr, int fq) const {
        EPI_IDS(); EPI_PAIR_OFFS(2048);
#pragma unroll
        for (int ai = 0; ai < 2; ++ai)
#pragma unroll
            for (int m = 0; m < 4; ++m) { const int row = row0 + ai * HALF + m * 16; const size_t off = (size_t)row * 2048 + col0;
                const float rs = 1.0f / sqrtf(sumsq[row] * (1.0f / 1024.0f) + 1e-6f);
                store_pair(S + off, offA_, offB_, pack8(acc[ai][0][m][0] * rs, acc[ai][0][m][1] * rs), pack8(acc[ai][1][m][0] * rs, acc[ai][1][m][1] * rs), up_); }
    }
};

struct EpiPle {
    static constexpr bool PERM = true, PERM2 = true, AFTER_DRAIN = false;
    const bf16_t* X2B; bf16_t* E; const float* rs2; float* sumsq;
    __device__ __forceinline__ void operator()(const f32x4 (&acc)[2][2][4][2], const Unit& u, int wr, int wc, int fr, int fq) const {
        EPI_IDS();
#pragma unroll
        for (int ai = 0; ai < 2; ++ai)
#pragma unroll
            for (int m = 0; m < 4; ++m) { const int row = row0 + ai * HALF + m * 16; const size_t off = (size_t)row * 1024 + col0; float ss = 0.f; const float rs = rs2[row]; u32x4 pk[2]; EPI_PAIR_OFFS(1024);
#pragma unroll
                for (int bj = 0; bj < 2; ++bj) { const u32x4 wx = *(const u32x4*)(X2B + off + bj * CBJ); f32x4 xa, xb; unpack8(wx, xa, xb);
                    const u32x4 w = *(const u32x4*)(E + off + bj * CBJ); f32x4 ea, eb; unpack8(w, ea, eb);
                    f32x4 a = acc[ai][bj][m][0], b = acc[ai][bj][m][1];
#pragma unroll
                    for (int e = 0; e < 4; ++e) { a[e] = xa[e] + sigmoidf_(rs * a[e]) * ea[e]; b[e] = xb[e] + sigmoidf_(rs * b[e]) * eb[e]; }
                    pk[bj] = pack8(a, b);
                    ss += (a[0] * a[0] + a[1] * a[1]) + (a[2] * a[2] + a[3] * a[3]) + (b[0] * b[0] + b[1] * b[1]) + (b[2] * b[2] + b[3] * b[3]); }
                store_pair(E + off, offA_, offB_, pk[0], pk[1], up_);
                ss += shx<16>(ss, frq_); ss += shx<32>(ss, frq_);
                if (fq == 0) atomicAdd(sumsq + row, ss); }
    }
};
struct EpiPleNorm {
    static constexpr bool PERM = true, PERM2 = true, AFTER_DRAIN = false;
    const bf16_t* X2B; const bf16_t* E; const float* rs2; float* sumsq; unsigned* pcnt; const float* gfin; float* OUT; unsigned* tmo;
    __device__ __forceinline__ void operator()(const f32x4 (&acc_)[2][2][4][2], const Unit& u, int wr, int wc, int fr, int fq) const {
        f32x4 (&acc)[2][2][4][2] = const_cast<f32x4 (&)[2][2][4][2]>(acc_);
        EPI_IDS();
        float dep = 0.f;
#pragma unroll
        for (int ai = 0; ai < 2; ++ai)
#pragma unroll
            for (int m = 0; m < 4; ++m) { const int row = row0 + ai * HALF + m * 16; const size_t off = (size_t)row * 1024 + col0; float ss = 0.f; const float rs = rs2[row];
#pragma unroll
                for (int bj = 0; bj < 2; ++bj) { const u32x4 wx = *(const u32x4*)(X2B + off + bj * CBJ); f32x4 xa, xb; unpack8(wx, xa, xb);
                    const u32x4 w = *(const u32x4*)(E + off + bj * CBJ); f32x4 ea, eb; unpack8(w, ea, eb);
                    f32x4 a = acc[ai][bj][m][0], b = acc[ai][bj][m][1];
#pragma unroll
                    for (int e = 0; e < 4; ++e) { a[e] = xa[e] + sigmoidf_(rs * a[e]) * ea[e]; b[e] = xb[e] + sigmoidf_(rs * b[e]) * eb[e]; }
                    acc[ai][bj][m][0] = a; acc[ai][bj][m][1] = b;
                    ss += (a[0] * a[0] + a[1] * a[1]) + (a[2] * a[2] + a[3] * a[3]) + (b[0] * b[0] + b[1] * b[1]) + (b[2] * b[2] + b[3] * b[3]); }
                ss += shx<16>(ss, frq_); ss += shx<32>(ss, frq_);
                if (fq == 0) dep += __hip_atomic_fetch_add(sumsq + row, ss, __ATOMIC_RELAXED, __HIP_MEMORY_SCOPE_AGENT); }
        asm volatile("s_waitcnt vmcnt(0)" : "+v"(dep) :: "memory");
        unsigned* pc = pcnt + 32 * u.pm;
        if (frq_ == 0) (void)__hip_atomic_fetch_add(pc, 1u, __ATOMIC_RELAXED, __HIP_MEMORY_SCOPE_AGENT);
        { unsigned sp = 0u; while (__hip_atomic_load(pc, __ATOMIC_RELAXED, __HIP_MEMORY_SCOPE_AGENT) < 32u) { __builtin_amdgcn_s_sleep(4);
              if ((++sp & 255u) == 0u) { if (__hip_atomic_load(tmo, __ATOMIC_RELAXED, __HIP_MEMORY_SCOPE_AGENT)) break; if (sp > (1u << 22)) { atomicAdd(tmo, 1u); break; } } } }
        asm volatile("" ::: "memory");
        const bool bad = __hip_atomic_load(tmo, __ATOMIC_RELAXED, __HIP_MEMORY_SCOPE_AGENT) != 0u;
        const int cb = col0 - 16 * fq;
        const bool upf_ = (fr & 8) != 0;
        f32x4 g4[4];
#pragma unroll
        for (int j = 0; j < 4; ++j) g4[j] = *(const f32x4*)(gfin + cb + 16 * j + 4 * fq);
#pragma unroll
        for (int ai = 0; ai < 2; ++ai)
#pragma unroll
            for (int m = 0; m < 4; ++m) { const int row = row0 + ai * HALF + m * 16; const size_t off = (size_t)row * 1024 + cb + 4 * fq;
                const float sq = __hip_atomic_load(sumsq + row, __ATOMIC_RELAXED, __HIP_MEMORY_SCOPE_AGENT);
                float r_ = 1.0f / sqrtf(sq * (1.0f / 1024.0f) + 1e-6f); if (bad) r_ = __builtin_nanf("");
                f32x4 R[4] = {acc[ai][0][m][0], acc[ai][0][m][1], acc[ai][1][m][0], acc[ai][1][m][1]};
#pragma unroll
                for (int e = 0; e < 4; ++e) {
                    { auto t = __builtin_amdgcn_permlane32_swap(__float_as_uint(R[0][e]), __float_as_uint(R[2][e]), false, false); R[0][e] = __uint_as_float(t[0]); R[2][e] = __uint_as_float(t[1]); }
                    { auto t = __builtin_amdgcn_permlane32_swap(__float_as_uint(R[1][e]), __float_as_uint(R[3][e]), false, false); R[1][e] = __uint_as_float(t[0]); R[3][e] = __uint_as_float(t[1]); }
                    { auto t = __builtin_amdgcn_permlane16_swap(__float_as_uint(R[0][e]), __float_as_uint(R[1][e]), false, false); R[0][e] = __uint_as_float(t[0]); R[1][e] = __uint_as_float(t[1]); }
                    { auto t = __builtin_amdgcn_permlane16_swap(__float_as_uint(R[2][e]), __float_as_uint(R[3][e]), false, false); R[2][e] = __uint_as_float(t[0]); R[3][e] = __uint_as_float(t[1]); } }
#pragma unroll
                for (int k = 0; k < 2; ++k) { const f32x4 p0 = R[2 * k] * r_ * g4[2 * k], p1 = R[2 * k + 1] * r_ * g4[2 * k + 1]; f32x4 dA, dB;
#pragma unroll
                    for (int e = 0; e < 4; ++e) { const float send = upf_ ? p0[e] : p1[e]; const float recv = __builtin_bit_cast(float, __builtin_amdgcn_update_dpp(0, __builtin_bit_cast(int, send), 0x128, 0xf, 0xf, true));
                        dA[e] = upf_ ? recv : p0[e]; dB[e] = upf_ ? p1[e] : recv; }
                    float* rp = OUT + off + 32 * k; *(f32x4*)(rp + (upf_ ? 16 - 8 * 1024 : 0)) = dA; *(f32x4*)(rp + (upf_ ? 16 : 8 * 1024)) = dB; } }
    }
};
#undef EPI_IDS
#undef EPI_PAIR_OFFS
typedef int v4i_t __attribute__((ext_vector_type(4)));
constexpr int W8_SHIFT = 6;
template <class Epi, class Sched, bool ALIGN_EPI = false, bool SP2 = false, bool FP8 = false, int KC = 0>
__device__ __forceinline__ void gemm_phase(PG8_LAS unsigned char* lds, const Gemm g, const Sched& S, const Epi& E, const int wave_s) {
    int tid_o = wave_s * 64 + lane_id_opaque(); asm volatile("" : "+v"(tid_o)); const int tid = tid_o, wid = __builtin_amdgcn_readfirstlane(tid >> 6), lane = tid & 63, wr = wid >> 2, wc = wid & 3, fr = lane & 15, fq = lane >> 4;
    const int K = KC ? KC : g.K, nt = FP8 ? K / 128 : K / BK;
    unsigned voffA[2], voffB[2]; int aoff, boff;
#define PG8_LANE_SETUP() do { int t_ = wave_s * 64 + lane_id_opaque(); asm volatile("" : "+v"(t_)); const int l_ = t_ & 63, fr_ = l_ & 15, fq_ = l_ >> 4; \
        _Pragma("unroll") for (int i = 0; i < 2; ++i) { int R, C; stage_rc(t_ * 16 + i * 8192, R, C); const int Rb = Epi::PERM2 ? (64 * (R >> 5) + 16 * ((R >> 2) & 3) + 4 * ((R >> 4) & 1) + (R & 3)) : Epi::PERM ? ((R & ~31) + perm32(R & 31)) : R;     \
            voffA[i] = FP8 ? (unsigned)(R * K + 2 * C) : (unsigned)(R * K + C) * 2u; voffB[i] = FP8 ? (unsigned)(Rb * K + 2 * C) : (unsigned)(Rb * K + C) * 2u; } \
        aoff = lds_byte(wr * 64 + fr_, fq_ * 8); boff = lds_byte(wc * 32 + fr_, fq_ * 8); } while (0)
    PG8_LANE_SETUP();
#if 0
    for (int i = 0; i < 2; ++i) { int R, C; stage_rc(tid * 16 + i * 8192, R, C); const int Rb = Epi::PERM ? ((R & ~31) + perm32(R & 31)) : R;
        voffA[i] = FP8 ? (unsigned)(R * K + 2 * C) : (unsigned)(R * K + C) * 2u; voffB[i] = FP8 ? (unsigned)(Rb * K + 2 * C) : (unsigned)(Rb * K + C) * 2u; }
#endif
    const size_t kstep = (size_t)(BK * 2);
    const size_t hstep = (size_t)HALF * K * (FP8 ? 1 : 2); const size_t hstepB = Epi::PERM2 ? (size_t)8 * K * (FP8 ? 1 : 2) : hstep;
    const size_t tstep = 2 * hstep;
    const unsigned ldsw = (unsigned)wid * 1024u;
#define PG8_SA(b, h) (((b) * 2 + (h)) * HTB)
#define PG8_SB(b, h) ((4 + (b) * 2 + (h)) * HTB)
#define PG8_STAGE(bufoff, gbase, voff) do { const char* gb_ = (const char*)(gbase); asm volatile("" : "+s"(gb_)); _Pragma("unroll") for (int _i = 0; _i < 2; ++_i) \
        __builtin_amdgcn_global_load_lds((const unsigned*)(gb_ + (voff)[_i]), (PG8_LAS unsigned*)(lds + (bufoff) + ldsw + _i * 8192), 16, 0, 0); } while (0)
#define PG8_LDA(dst, b, h) do { _Pragma("unroll") for (int m = 0; m < 4; ++m) _Pragma("unroll") for (int k = 0; k < 2; ++k) dst[m][k] = *(const PG8_LAS bf16x8*)(lds + PG8_SA(b, h) + aoff + m * 2048 + k * 1024); } while (0)
#define PG8_LDB(dst, b, h) do { _Pragma("unroll") for (int n = 0; n < 2; ++n) _Pragma("unroll") for (int k = 0; k < 2; ++k) dst[n][k] = *(const PG8_LAS bf16x8*)(lds + PG8_SB(b, h) + boff + n * 2048 + k * 1024); } while (0)
#define PG8_CAT8(x0, x1) __builtin_shufflevector(__builtin_bit_cast(v4i_t, x0), __builtin_bit_cast(v4i_t, x1), 0, 1, 2, 3, 4, 5, 6, 7)
#define PG8_MMA(ai, bj, At, Bt) do { __builtin_amdgcn_s_setprio(1); _Pragma("unroll") for (int m = 0; m < 4; ++m) _Pragma("unroll") for (int n = 0; n < 2; ++n) { \
        if constexpr (FP8) acc[ai][bj][m][n] = __builtin_amdgcn_mfma_scale_f32_16x16x128_f8f6f4(PG8_CAT8(Bt[n][0], Bt[n][1]), PG8_CAT8(At[m][0], At[m][1]), acc[ai][bj][m][n], 0, 0, 0, 0, 0, 0); \
        else { _Pragma("unroll") for (int k = 0; k < 2; ++k) acc[ai][bj][m][n] = __builtin_amdgcn_mfma_f32_16x16x32_bf16(Bt[n][k], At[m][k], acc[ai][bj][m][n], 0, 0, 0); } } __builtin_amdgcn_s_setprio(0); } while (0)
#define PG8_WAIT_V(n) asm volatile("s_waitcnt vmcnt(" #n ")" ::: "memory")
#define PG8_WAIT_L(n) asm volatile("s_waitcnt lgkmcnt(" #n ")" ::: "memory")
#define PG8_BAR __builtin_amdgcn_s_barrier()
#define PG8_SCHED __builtin_amdgcn_sched_barrier(0)
    Unit cur, nxt; int ui = 0;
    if (!S.next(0, cur)) return;
    f32x4 acc[2][2][4][2];
#pragma unroll
    for (int a = 0; a < 2; ++a)
#pragma unroll
        for (int b = 0; b < 2; ++b)
#pragma unroll
            for (int m = 0; m < 4; ++m)
#pragma unroll
                for (int n = 0; n < 2; ++n) acc[a][b][m][n] = (f32x4){0.f, 0.f, 0.f, 0.f};
    bf16x8 At[4][2], B0[2][2], B1[2][2];
    auto baseA_ = [&](const Unit& u_) -> const char* { if constexpr (Sched::DUAL) return (const char*)(u_.ph ? g.A2 : g.A); else return (const char*)g.A; };
    auto baseB_ = [&](const Unit& u_) -> const char* { if constexpr (Sched::DUAL) return (const char*)(u_.ph ? g.Bt2 : g.Bt); else return (const char*)g.Bt; };
    const char* cA = baseA_(cur) + (size_t)cur.pm * tstep; const char* cB = baseB_(cur) + (size_t)cur.pn * tstep;
    S.a_ready(cur);
    if constexpr (SP2) {
        PG8_STAGE(PG8_SB(0, 0), cB, voffB); PG8_STAGE(PG8_SB(0, 1), cB + hstepB, voffB); PG8_STAGE(PG8_SA(0, 0), cA, voffA); PG8_STAGE(PG8_SA(0, 1), cA + hstep, voffA);
        if (wr == 1) PG8_BAR;
        PG8_WAIT_V(2); PG8_BAR;
        PG8_STAGE(PG8_SB(1, 0), cB + kstep, voffB); PG8_STAGE(PG8_SA(1, 0), cA + kstep, voffA); PG8_STAGE(PG8_SB(1, 1), cB + hstepB + kstep, voffB);
        PG8_WAIT_V(6); PG8_BAR;
    } else {
        PG8_STAGE(PG8_SB(0, 0), cB, voffB); PG8_STAGE(PG8_SA(0, 0), cA, voffA); PG8_STAGE(PG8_SB(0, 1), cB + hstepB, voffB); PG8_STAGE(PG8_SA(0, 1), cA + hstep, voffA);
        if (wr == 1) PG8_BAR;
        PG8_WAIT_V(4); PG8_BAR;
        PG8_STAGE(PG8_SB(1, 0), cB + kstep, voffB); PG8_STAGE(PG8_SA(1, 0), cA + kstep, voffA); PG8_STAGE(PG8_SB(1, 1), cB + hstepB + kstep, voffB);
        PG8_WAIT_V(6); PG8_BAR;
    }
    for (;;) {
        const bool has_next = S.next(ui + 1, nxt);
        const char* nA = has_next ? baseA_(nxt) + (size_t)nxt.pm * tstep : cA; const char* nB = has_next ? baseB_(nxt) + (size_t)nxt.pn * tstep : cB;
#pragma nounroll
        for (int t = 0; t < nt; t += 2) {
            const bool last = (t == nt - 2);
            const char* a1 = cA + (size_t)(t + 1) * kstep;
            const char* a2 = last ? nA : cA + (size_t)(t + 2) * kstep; const char* b2 = last ? nB : cB + (size_t)(t + 2) * kstep;
            const char* a3 = a2 + kstep; const char* b3 = b2 + kstep;
            if (last && has_next) S.a_ready(nxt);
            if constexpr (SP2) {
            PG8_LDB(B0, 0, 0); PG8_LDB(B1, 0, 1); PG8_SCHED; PG8_LDA(At, 0, 0); PG8_STAGE(PG8_SA(1, 1), a1 + hstep, voffA);
            PG8_WAIT_V(8); PG8_WAIT_L(0); PG8_BAR; PG8_MMA(0, 0, At, B0); PG8_MMA(0, 1, At, B1); PG8_BAR; PG8_SCHED;
            PG8_LDA(At, 0, 1); PG8_STAGE(PG8_SB(0, 0), b2, voffB); PG8_STAGE(PG8_SB(0, 1), b2 + hstepB, voffB); PG8_STAGE(PG8_SA(0, 0), a2, voffA);
            PG8_WAIT_V(8); PG8_WAIT_L(0); PG8_BAR; PG8_MMA(1, 0, At, B0); PG8_MMA(1, 1, At, B1); PG8_BAR; PG8_SCHED;
            PG8_LDB(B0, 1, 0); PG8_LDB(B1, 1, 1); PG8_SCHED; PG8_LDA(At, 1, 0); PG8_STAGE(PG8_SA(0, 1), a2 + hstep, voffA);
            PG8_WAIT_V(8); PG8_WAIT_L(0); PG8_BAR; PG8_MMA(0, 0, At, B0); PG8_MMA(0, 1, At, B1); PG8_BAR; PG8_SCHED;
            PG8_LDA(At, 1, 1); PG8_STAGE(PG8_SB(1, 0), b3, voffB); PG8_STAGE(PG8_SB(1, 1), b3 + hstepB, voffB); PG8_STAGE(PG8_SA(1, 0), a3, voffA);
            PG8_WAIT_V(8); PG8_WAIT_L(0); PG8_BAR; PG8_MMA(1, 0, At, B0); PG8_MMA(1, 1, At, B1); PG8_BAR; PG8_SCHED;
            } else {
            PG8_LDB(B0, 0, 0); PG8_SCHED; PG8_LDA(At, 0, 0); PG8_STAGE(PG8_SA(1, 1), a1 + hstep, voffA);
            PG8_WAIT_L(8); PG8_BAR; PG8_WAIT_L(0); PG8_MMA(0, 0, At, B0); PG8_BAR; PG8_SCHED;
            PG8_LDB(B1, 0, 1); PG8_STAGE(PG8_SB(0, 0), b2, voffB);
            PG8_BAR; PG8_WAIT_L(0); PG8_MMA(0, 1, At, B1); PG8_BAR;
            PG8_LDA(At, 0, 1); PG8_STAGE(PG8_SA(0, 0), a2, voffA);
            PG8_BAR; PG8_WAIT_L(0); PG8_MMA(1, 0, At, B0); PG8_BAR; PG8_SCHED;
            PG8_STAGE(PG8_SB(0, 1), b2 + hstepB, voffB);
            PG8_WAIT_V(6); PG8_BAR; PG8_MMA(1, 1, At, B1); PG8_BAR;
            PG8_LDB(B0, 1, 0); PG8_SCHED; PG8_LDA(At, 1, 0); PG8_STAGE(PG8_SA(0, 1), a2 + hstep, voffA);
            PG8_WAIT_L(8); PG8_BAR; PG8_WAIT_L(0); PG8_MMA(0, 0, At, B0); PG8_BAR; PG8_SCHED;
            PG8_LDB(B1, 1, 1); PG8_STAGE(PG8_SB(1, 0), b3, voffB);
            PG8_BAR; PG8_WAIT_L(0); PG8_MMA(0, 1, At, B1); PG8_BAR;
            PG8_LDA(At, 1, 1); PG8_STAGE(PG8_SA(1, 0), a3, voffA);
            PG8_BAR; PG8_WAIT_L(0); PG8_MMA(1, 0, At, B0); PG8_BAR; PG8_SCHED;
            PG8_STAGE(PG8_SB(1, 1), b3 + hstepB, voffB);
            PG8_WAIT_V(6); PG8_BAR; PG8_MMA(1, 1, At, B1); PG8_BAR;
            }
        }
        if constexpr (ALIGN_EPI) { if (wr == 0) PG8_BAR; }
        if constexpr (FP8) {
#pragma unroll
            for (int a = 0; a < 2; ++a)
#pragma unroll
                for (int b = 0; b < 2; ++b)
#pragma unroll
                    for (int m = 0; m < 4; ++m)
#pragma unroll
                        for (int n = 0; n < 2; ++n) acc[a][b][m][n] *= (1.0f / (float)(1 << W8_SHIFT)); }
        if constexpr (!Epi::AFTER_DRAIN) { E(acc, cur, wr, wc, fr, fq); S.done(cur); }
        if (!has_next) break;
        bool carry_ = false; if constexpr (Sched::DUAL) carry_ = nxt.ph != 0;
        if (!carry_) {
#pragma unroll
        for (int a = 0; a < 2; ++a)
#pragma unroll
            for (int b = 0; b < 2; ++b)
#pragma unroll
                for (int m = 0; m < 4; ++m)
#pragma unroll
                    for (int n = 0; n < 2; ++n) acc[a][b][m][n] = (f32x4){0.f, 0.f, 0.f, 0.f};
        }
        cur = nxt; cA = nA; cB = nB; ++ui;
        PG8_LANE_SETUP();
        if constexpr (ALIGN_EPI) { if (wr == 1) PG8_BAR; }
    }
    PG8_WAIT_V(0);
    if constexpr (!ALIGN_EPI) { if (wr == 0) PG8_BAR; }
    PG8_BAR;
    if constexpr (Epi::AFTER_DRAIN) { E.fused(acc, cur, wr, wc, fr, fq, lds, wid, lane); S.done(cur); }
#undef PG8_SA
#undef PG8_SB
#undef PG8_STAGE
#undef PG8_LDA
#undef PG8_LDB
#undef PG8_LANE_SETUP
#undef PG8_MMA
#undef PG8_CAT8
#undef PG8_WAIT_V
#undef PG8_WAIT_L
#undef PG8_BAR
#undef PG8_SCHED
}
}

#include <hip/hip_bf16.h>
namespace moba {
using bf16=__hip_bfloat16;
using bf16x8=__attribute__((ext_vector_type(8)))short;
using s16x4=__attribute__((ext_vector_type(4)))short;
using f32x16=__attribute__((ext_vector_type(16)))float;
using u32x4=__attribute__((ext_vector_type(4)))unsigned;
using f32x4_m=__attribute__((ext_vector_type(4)))float;
constexpr int BATCH=4,NHEAD=8,SEQ=8192,D=64,DM=NHEAD*D;
constexpr int NW=8,QBLK=32,QB=QBLK*NW,KVBLK=64,NQB=SEQ/QB;
constexpr int ATTN_PITCH=DM, ATTN_UNIT_ROWS=QB;
__device__ __forceinline__ int crow(int r,int hi){return (r&3)+8*(r>>2)+4*hi;}
#define SBAR() __builtin_amdgcn_sched_barrier(0)
__device__ __forceinline__ void cmask(f32x16&p0,f32x16&p1,int jb,int qrel,int hi){
  const float NEG=-INFINITY; int kb=64*jb+4*hi;
  #pragma unroll
  for(int r=0;r<16;++r){int kv=kb+(r&3)+8*(r>>2); if(kv>qrel)p0[r]=NEG; if(kv+32>qrel)p1[r]=NEG;}
}

constexpr int NSLOT=3, SLOTB=8192;
constexpr int LDS_K=0, LDS_V=NSLOT*SLOTB, LDS_WS=2*NSLOT*SLOTB, LDS_OST=LDS_WS+NW*64*4, LDS_BYTES=LDS_OST+NW*4096;
constexpr float C2=0.125f*1.4426950408889634f;
__device__ __forceinline__ void glds16(const void*gsrc,unsigned lds_dst){unsigned keep;
  asm volatile("s_mov_b32 %0, m0\n\ts_mov_b32 m0, %2\n\ts_nop 0\n\tglobal_load_lds_dwordx4 %1, off\n\ts_mov_b32 m0, %0":"=&s"(keep):"v"(gsrc),"s"(lds_dst):"memory");}
__device__ __forceinline__ float max3f(float a,float b,float c){float r;asm("v_max3_f32 %0, %1, %2, %3":"=v"(r):"v"(a),"v"(b),"v"(c));return r;}
__device__ __forceinline__ float max2f(float a,float b){float r;asm("v_max_f32_e32 %0, %1, %2":"=v"(r):"v"(a),"v"(b));return r;}
__device__ __forceinline__ float fadd_s(float a,float b){float r;asm("v_add_f32_e32 %0, %1, %2":"=v"(r):"v"(a),"v"(b));return r;}
__device__ __forceinline__ float fsub_s(float a,float b){float r;asm("v_sub_f32_e32 %0, %1, %2":"=v"(r):"v"(a),"v"(b));return r;}
typedef float f32x2_t __attribute__((ext_vector_type(2))); typedef __bf16 bf16x2_t __attribute__((ext_vector_type(2)));
__device__ __forceinline__ unsigned cvtpk_s(float lo,float hi){f32x2_t v={lo,hi};bf16x2_t b=__builtin_convertvector(v,bf16x2_t);return __builtin_bit_cast(unsigned,b);}
#define WAIT_BAR(N) asm volatile("s_waitcnt vmcnt(" #N ") lgkmcnt(0)\n\ts_barrier":::"memory")

__device__ __forceinline__ void qkt(f32x16&p0,f32x16&p1,const char*Kslot,const bf16x8*qr,const f32x16&negm,int r32,int hi){
  const char*kb=Kslot+hi*1024+r32*16;
  #pragma unroll
  for(int d0=0;d0<4;++d0){
    const bf16x8 b0=*reinterpret_cast<const bf16x8*>(kb+d0*2048);
    const bf16x8 b1=*reinterpret_cast<const bf16x8*>(kb+d0*2048+512);
    if(d0==0){p0=__builtin_amdgcn_mfma_f32_32x32x16_bf16(b0,qr[0],negm,0,0,0);p1=__builtin_amdgcn_mfma_f32_32x32x16_bf16(b1,qr[0],negm,0,0,0);}
    else{p0=__builtin_amdgcn_mfma_f32_32x32x16_bf16(b0,qr[d0],p0,0,0,0);p1=__builtin_amdgcn_mfma_f32_32x32x16_bf16(b1,qr[d0],p1,0,0,0);}}
}
typedef __attribute__((address_space(3))) const char* lds_cptr;
typedef short v4i16_t __attribute__((ext_vector_type(4)));
__device__ __forceinline__ void kload8(bf16x8*kf,lds_cptr kp){
  kf[0]=*(const __attribute__((address_space(3))) bf16x8*)(kp);      kf[1]=*(const __attribute__((address_space(3))) bf16x8*)(kp+512);
  kf[2]=*(const __attribute__((address_space(3))) bf16x8*)(kp+2048); kf[3]=*(const __attribute__((address_space(3))) bf16x8*)(kp+2560);
  kf[4]=*(const __attribute__((address_space(3))) bf16x8*)(kp+4096); kf[5]=*(const __attribute__((address_space(3))) bf16x8*)(kp+4608);
  kf[6]=*(const __attribute__((address_space(3))) bf16x8*)(kp+6144); kf[7]=*(const __attribute__((address_space(3))) bf16x8*)(kp+6656);
}
__device__ __forceinline__ void kload2(bf16x8*kf,lds_cptr kp,int j){ kf[2*j]=*(const __attribute__((address_space(3))) bf16x8*)(kp+j*2048); kf[2*j+1]=*(const __attribute__((address_space(3))) bf16x8*)(kp+j*2048+512); }
__device__ __forceinline__ s16x4 vtr(lds_cptr p){ return __builtin_bit_cast(s16x4,__builtin_amdgcn_ds_read_tr16_b64_v4i16((__attribute__((address_space(3))) v4i16_t*)p)); }
__device__ __forceinline__ float rowmax(const f32x16&p0,const f32x16&p1){
  float a=max3f(p0[0],p0[1],p1[0]),b=max3f(p0[2],p0[3],p1[1]);a=max3f(a,p1[2],p1[3]);
  #pragma unroll
  for(int r=4;r<16;r+=4){a=max3f(a,p0[r],p0[r+1]);b=max3f(b,p0[r+2],p0[r+3]);a=max3f(a,p1[r],p1[r+1]);b=max3f(b,p1[r+2],p1[r+3]);}
  const float m=max2f(a,b);
  auto rr=__builtin_amdgcn_permlane32_swap(__float_as_uint(m),__float_as_uint(m),false,false);
  return max2f(__uint_as_float(rr[0]),__uint_as_float(rr[1]));
}
__device__ __forceinline__ void pv(f32x16*o,int vb,bf16x8 pa0,bf16x8 pa1,bf16x8 pa2,bf16x8 pa3){
  #pragma unroll
  for(int d0=0;d0<2;++d0){s16x4 lo[4],hi[4];
    #pragma unroll
    for(int ks=0;ks<4;++ks){
      asm volatile("ds_read_b64_tr_b16 %0,%1 offset:%c2":"=&v"(lo[ks]):"v"(vb),"i"(d0*4096+ks*1024):"memory");
      asm volatile("ds_read_b64_tr_b16 %0,%1 offset:%c2":"=&v"(hi[ks]):"v"(vb),"i"(d0*4096+ks*1024+512):"memory");}
    asm volatile("s_waitcnt lgkmcnt(0)":::"memory");SBAR();
    #define PK(k) (bf16x8){lo[k][0],lo[k][1],lo[k][2],lo[k][3],hi[k][0],hi[k][1],hi[k][2],hi[k][3]}
    o[d0]=__builtin_amdgcn_mfma_f32_32x32x16_bf16(pa0,PK(0),o[d0],0,0,0);
    o[d0]=__builtin_amdgcn_mfma_f32_32x32x16_bf16(pa1,PK(1),o[d0],0,0,0);
    o[d0]=__builtin_amdgcn_mfma_f32_32x32x16_bf16(pa2,PK(2),o[d0],0,0,0);
    o[d0]=__builtin_amdgcn_mfma_f32_32x32x16_bf16(pa3,PK(3),o[d0],0,0,0);
    #undef PK
  }
}

#ifndef ATTN_STORE16
#define ATTN_STORE16(p,v) (*(u32x4*)(p)=(v))
#endif
constexpr int QIDX_OFF=86016;
template<int THRL,bool CAUSAL> __device__ __forceinline__ void attn_unit(int b,int h,int kvb,int qoff,const bf16*Q,const bf16*K,const bf16*V,bf16*PART,float*LSE,bf16*O,char*shm,const int wave_s,bf16x8(&qr)[4],const bool first,const bool has_next,const int nb,const int nh,const int nkvb,const int nqoff){
  int tid_o=wave_s*64+pg8::lane_id_opaque(); asm volatile("":"+v"(tid_o)); const int tid=tid_o,lane=tid&63,r32=lane&31,hi=lane>>5; const int wid=__builtin_amdgcn_readfirstlane(tid>>6);
  const long rowbase=(long)b*SEQ; const int bh=b*NHEAD+h;
  const __attribute__((address_space(3))) int*qlist=(const __attribute__((address_space(3))) int*)((lds_cptr)shm+qoff);
  const int qent=CAUSAL?((kvb*QB+wid*QBLK+r32)|(3<<16)):qlist[wid*QBLK+r32]; const int qrow=qent<0?kvb*QB:(qent&0xffff);
  const bf16*Qw=Q+(rowbase+qrow)*DM+h*D;
  const bf16*Kh=K+(rowbase+(long)kvb*QB)*DM+h*D,*Vh=V+(rowbase+(long)kvb*QB)*DM+h*D;
  const unsigned lds0=(unsigned)(uintptr_t)shm;
  float*wsf=(float*)(shm+LDS_WS)+wid*64;
  const bf16*ksrc=Kh+(long)lane*DM+wid*8;
  const bf16*vsrc=Vh+(long)(16*(wid&3)+(lane>>2))*DM+(wid>>2)*32+(lane&3)*8;
  const unsigned kdst=lds0+LDS_K+wid*1024, vdst=lds0+LDS_V+wid*1024;
  #define DMA_K(t,slot) glds16(ksrc+(long)(t)*KVBLK*DM,(unsigned)__builtin_amdgcn_readfirstlane(kdst+(slot)))
  #define DMA_V(t,slot) glds16(vsrc+(long)(t)*KVBLK*DM,(unsigned)__builtin_amdgcn_readfirstlane(vdst+(slot)))
  const int vb0=(int)(lds0+LDS_V)+((lane>>4)&1)*32+(lane&3)*8+(4*hi+((lane&15)>>2))*64;
  const char*Kbase=shm+LDS_K; bf16x8 kf[8];
  const lds_cptr shm3=(lds_cptr)shm; const lds_cptr kp0=shm3+LDS_K+hi*1024+r32*16; const lds_cptr vp0=shm3+LDS_V+((lane>>4)&1)*32+(lane&3)*8+(4*hi+((lane&15)>>2))*64;
  constexpr int NT=4;
  #define ISSUE_UNIT(QW_,KS_,VS_) do{ glds16((KS_),(unsigned)__builtin_amdgcn_readfirstlane(kdst)); glds16((VS_),(unsigned)__builtin_amdgcn_readfirstlane(vdst)); glds16((KS_)+(long)KVBLK*DM,(unsigned)__builtin_amdgcn_readfirstlane(kdst+SLOTB)); \
    _Pragma("unroll") for(int d0=0;d0<4;++d0)qr[d0]=*reinterpret_cast<const bf16x8*>(&(QW_)[d0*16+hi*8]); \
    glds16((KS_)+(long)2*KVBLK*DM,(unsigned)__builtin_amdgcn_readfirstlane(kdst+2*SLOTB)); }while(0)
  if(first) ISSUE_UNIT(Qw,ksrc,vsrc);
  float mhat=0.f,l_reg=0.f;f32x16 o[2];o[0]=f32x16{};o[1]=f32x16{};f32x16 negm=f32x16{};asm volatile("":"+v"(negm));
  const int qrel=wid*QBLK+r32;
  #define CMASK(P0,P1,t) do{ if(CAUSAL){int jb_=(t)-(NT-4); if(jb_>=0)cmask(P0,P1,jb_,qrel,hi);} }while(0)
  bool resc=false;
  #define START(P0,P1) do{ const float rm=rowmax(P0,P1); resc=false; \
    { const float dl=__builtin_fmaxf(rm,0.f); mhat=fadd_s(mhat,dl); \
      _Pragma("unroll") for(int r=0;r<16;++r){P0[r]=fsub_s(P0[r],dl);P1[r]=fsub_s(P1[r],dl);} \
      _Pragma("unroll") for(int r=0;r<16;++r)negm[r]=-mhat; asm volatile("":"+v"(negm)); } \
    _Pragma("unroll") for(int r=0;r<16;++r)P0[r]=__builtin_amdgcn_exp2f(P0[r]); }while(0)
  #define RESC() do{ if(resc){ asm volatile("s_waitcnt lgkmcnt(0)":::"memory"); \
      _Pragma("unroll") for(int d_=0;d_<2;++d_) _Pragma("unroll") for(int r=0;r<16;++r)o[d_][r]*=wsf[crow(r,hi)]; } }while(0)
  f32x16 pA0,pA1,pB0,pB1;
  int sl_prev=0,sl_cur=0,sl_next=SLOTB;
  #define ROT() do{sl_prev=sl_cur;sl_cur=sl_next;sl_next=(sl_next==(NSLOT-1)*SLOTB)?0:sl_next+SLOTB;}while(0)
  WAIT_BAR(3);
  qkt(pA0,pA1,Kbase,qr,negm,r32,hi);asm volatile("s_nop 15\n\ts_nop 7":"+v"(pA0),"+v"(pA1));CMASK(pA0,pA1,0);
  START(pA0,pA1);
  _Pragma("unroll") for(int r=0;r<16;++r)pA1[r]=__builtin_amdgcn_exp2f(pA1[r]);
  WAIT_BAR(0);
  DMA_K(3,0);DMA_V(1,SLOTB);
  ROT();
  kload8(kf,kp0+sl_cur);
  WAIT_BAR(2);
  s16x4 vlo[8],vhi[8]; u32x4 pw0,pw1,pw2,pw3;
  #define PKW(P,B) cvtpk_s(P[B],P[B+1])
  #define PAF(k) __builtin_bit_cast(bf16x8,pw##k)
  #define VFR(i) (bf16x8){vlo[i][0],vlo[i][1],vlo[i][2],vlo[i][3],vhi[i][0],vhi[i][1],vhi[i][2],vhi[i][3]}
  #define PIN(x) asm volatile("":"+v"(x))
  #define MX3(a,b,c) __builtin_fmaxf(__builtin_fmaxf((a),(b)),(c))
  #define GAPA(MF,A0,A1,A2,A3,W0,W1,PW) do{ MF; sacc+=A0; sacc+=A1; sacc+=A2; sacc+=A3; PIN(sacc); W0; W1; PIN(PW); SBAR(); }while(0)
  #define EX(v) __builtin_amdgcn_exp2f(v)
  #define GAPB(MF,X,B) do{ MF; X[B]=EX(X[B]); X[B+1]=EX(X[B+1]); X[B+2]=EX(X[B+2]); X[B+3]=EX(X[B+3]); PIN(X); SBAR(); }while(0)
  #define VRD(i) do{ vlo[i]=vtr(vp_+(((i)>>2)*4096+((i)&3)*1024)); vhi[i]=vtr(vp_+(((i)>>2)*4096+((i)&3)*1024+512)); }while(0)
  #define KRD(G,j) do{ if(G){ kload2(kf,kp0+sl_next,j); SBAR(); } }while(0)
  #define STEP(C0,C1,P0,P1,t,GK,GV,GL) do{ SBAR(); \
    const lds_cptr vp_=vp0+sl_prev; \
    VRD(0); SBAR(); float sacc=(P0[0]+P0[1]); \
    GAPA(C0=__builtin_amdgcn_mfma_f32_32x32x16_bf16(kf[0],qr[0],negm,0,0,0), P0[2],P0[3],P0[4],P0[5],     pw0[0]=PKW(P0,0), pw0[1]=PKW(P0,2), pw0); \
    VRD(4); SBAR(); GAPA(C1=__builtin_amdgcn_mfma_f32_32x32x16_bf16(kf[1],qr[0],negm,0,0,0), P0[6],P0[7],P0[8],P0[9],     pw0[2]=PKW(P0,4), pw0[3]=PKW(P0,6), pw0); \
    VRD(1); SBAR(); GAPA(C0=__builtin_amdgcn_mfma_f32_32x32x16_bf16(kf[2],qr[1],C0,0,0,0),   P0[10],P0[11],P0[12],P0[13], pw1[0]=PKW(P0,8), pw1[1]=PKW(P0,10), pw1); \
    VRD(5); SBAR(); GAPA(C1=__builtin_amdgcn_mfma_f32_32x32x16_bf16(kf[3],qr[1],C1,0,0,0),   P0[14],P0[15],P1[0],P1[1],   pw1[2]=PKW(P0,12),pw1[3]=PKW(P0,14), pw1); \
    VRD(2); SBAR(); GAPA(C0=__builtin_amdgcn_mfma_f32_32x32x16_bf16(kf[4],qr[2],C0,0,0,0),   P1[2],P1[3],P1[4],P1[5],     pw2[0]=PKW(P1,0), pw2[1]=PKW(P1,2), pw2); \
    VRD(6); SBAR(); GAPA(C1=__builtin_amdgcn_mfma_f32_32x32x16_bf16(kf[5],qr[2],C1,0,0,0),   P1[6],P1[7],P1[8],P1[9],     pw2[2]=PKW(P1,4), pw2[3]=PKW(P1,6), pw2); \
    VRD(3); SBAR(); GAPA(C0=__builtin_amdgcn_mfma_f32_32x32x16_bf16(kf[6],qr[3],C0,0,0,0),   P1[10],P1[11],P1[12],P1[13], pw3[0]=PKW(P1,8), pw3[1]=PKW(P1,10), pw3); \
    VRD(7); SBAR(); GAPA(C1=__builtin_amdgcn_mfma_f32_32x32x16_bf16(kf[7],qr[3],C1,0,0,0),   P1[14],P1[15],0.f,0.f,       pw3[2]=PKW(P1,12),pw3[3]=PKW(P1,14), pw3); \
    l_reg+=sacc; \
    if(GK){DMA_K((t)+3,sl_cur);} if(GV){DMA_V((t)+1,sl_next);} \
    CMASK(C0,C1,t); \
    { float a=MX3(C0[0],C0[1],C1[0]),b=MX3(C0[2],C0[3],C1[1]); a=MX3(a,C1[2],C1[3]); \
      _Pragma("unroll") for(int r=4;r<16;r+=4){a=MX3(a,C0[r],C0[r+1]);b=MX3(b,C0[r+2],C0[r+3]);a=MX3(a,C1[r],C1[r+1]);b=MX3(b,C1[r+2],C1[r+3]);} \
      float rm=__builtin_fmaxf(a,b); { auto rr=__builtin_amdgcn_permlane32_swap(__float_as_uint(rm),__float_as_uint(rm),false,false); rm=__builtin_fmaxf(__uint_as_float(rr[0]),__uint_as_float(rr[1])); } \
      resc=false; \
      if(__builtin_expect(__any(rm>(float)THRL),0)){ const float dl=__builtin_fmaxf(rm,0.f); mhat+=dl; \
        _Pragma("unroll") for(int r=0;r<16;++r){C0[r]-=dl;C1[r]-=dl;} \
        _Pragma("unroll") for(int r=0;r<16;++r)negm[r]=-mhat; asm volatile("":"+v"(negm)); \
        const float f=__builtin_amdgcn_exp2f(-dl); l_reg*=f; if(hi==0)wsf[r32]=f; resc=true; } } \
    SBAR(); \
    GAPB(o[0]=__builtin_amdgcn_mfma_f32_32x32x16_bf16(PAF(0),VFR(0),o[0],0,0,0), C0,0); \
    GAPB(o[1]=__builtin_amdgcn_mfma_f32_32x32x16_bf16(PAF(0),VFR(4),o[1],0,0,0), C0,4); \
    KRD(GL,0); GAPB(o[0]=__builtin_amdgcn_mfma_f32_32x32x16_bf16(PAF(1),VFR(1),o[0],0,0,0), C0,8); \
    KRD(GL,1); GAPB(o[1]=__builtin_amdgcn_mfma_f32_32x32x16_bf16(PAF(1),VFR(5),o[1],0,0,0), C0,12); \
    KRD(GL,2); GAPB(o[0]=__builtin_amdgcn_mfma_f32_32x32x16_bf16(PAF(2),VFR(2),o[0],0,0,0), C1,0); \
    KRD(GL,3); GAPB(o[1]=__builtin_amdgcn_mfma_f32_32x32x16_bf16(PAF(2),VFR(6),o[1],0,0,0), C1,4); \
    GAPB(o[0]=__builtin_amdgcn_mfma_f32_32x32x16_bf16(PAF(3),VFR(3),o[0],0,0,0), C1,8); \
    GAPB(o[1]=__builtin_amdgcn_mfma_f32_32x32x16_bf16(PAF(3),VFR(7),o[1],0,0,0), C1,12); \
    }while(0)
  int t=1;
  #undef CMASK
  #define CMASK(P0,P1,t) do{}while(0)
  for(;t+5<NT;t+=2){
    STEP(pB0,pB1,pA0,pA1,t,true,true,true);     WAIT_BAR(2); RESC(); ROT();
    STEP(pA0,pA1,pB0,pB1,t+1,true,true,true);   WAIT_BAR(2); RESC(); ROT();
  }
  #undef CMASK
  #define CMASK(P0,P1,t) do{ if(CAUSAL){int jb_=(t)-(NT-4); if(jb_>=0)cmask(P0,P1,jb_,qrel,hi);} }while(0)
  #define ENDW(tt) do{ if((tt)+3<NT){WAIT_BAR(2);} else if((tt)+2<NT){WAIT_BAR(1);} else {WAIT_BAR(0);} }while(0)
  for(;t+1<NT;t+=2){
    STEP(pB0,pB1,pA0,pA1,t,(t+3<NT),(t+1<NT),(t+1<NT));       ENDW(t);   RESC(); ROT();
    STEP(pA0,pA1,pB0,pB1,t+1,(t+4<NT),(t+2<NT),(t+2<NT));     ENDW(t+1); RESC(); ROT();
  }
  STEP(pB0,pB1,pA0,pA1,NT-1,false,false,false); RESC();
  { float sacc=pB0[0]+pB0[1]; _Pragma("unroll") for(int r=2;r<16;++r)sacc+=pB0[r]; _Pragma("unroll") for(int r=0;r<16;++r)sacc+=pB1[r]; l_reg+=sacc;
    pw0=(u32x4){PKW(pB0,0),PKW(pB0,2),PKW(pB0,4),PKW(pB0,6)};pw1=(u32x4){PKW(pB0,8),PKW(pB0,10),PKW(pB0,12),PKW(pB0,14)};pw2=(u32x4){PKW(pB1,0),PKW(pB1,2),PKW(pB1,4),PKW(pB1,6)};pw3=(u32x4){PKW(pB1,8),PKW(pB1,10),PKW(pB1,12),PKW(pB1,14)};
    SBAR(); pv(o,vb0+sl_cur,PAF(0),PAF(1),PAF(2),PAF(3)); }
  asm volatile("s_waitcnt lgkmcnt(0)\n\ts_barrier":::"memory");
  if(has_next){ const __attribute__((address_space(3))) int*nql=(const __attribute__((address_space(3))) int*)((lds_cptr)shm+nqoff);
    const int nqe=CAUSAL?(nkvb*QB+wid*QBLK+r32):nql[wid*QBLK+r32]; const int nqrow=nqe<0?nkvb*QB:(nqe&0xffff); const long nrb=(long)nb*SEQ;
    const bf16*nQw=Q+(nrb+nqrow)*DM+nh*D; const bf16*nKh=K+(nrb+(long)nkvb*QB)*DM+nh*D,*nVh=V+(nrb+(long)nkvb*QB)*DM+nh*D;
    const bf16*nks=nKh+(long)lane*DM+wid*8; const bf16*nvs=nVh+(long)(16*(wid&3)+(lane>>2))*DM+(wid>>2)*32+(lane&3)*8;
    ISSUE_UNIT(nQw,nks,nvs); }
  #undef PKW
  #undef PAF
  #undef VFR
  #undef PIN
  #undef MX3
  #undef GAPA
  #undef GAPB
  #undef EX
  #undef VRD
  #undef KRD
  #undef STEP
  #undef ENDW
  f32x4_m pls[4]; pg8::u32x2 ppv[4][3];
  if(CAUSAL){
    _Pragma("unroll") for(int i=0;i<4;++i){ const size_t rid=(size_t)bh*SEQ+kvb*QB+wid*QBLK+i*8+(lane>>3); pls[i]=*(const f32x4_m*)(LSE+rid*4);
      _Pragma("unroll") for(int s_=0;s_<3;++s_) ppv[i][s_]=*(const pg8::u32x2*)((const unsigned char*)PART+(rid*4+s_)*64+(lane&7)*8); } }
  {auto rr=__builtin_amdgcn_permlane32_swap(__float_as_uint(l_reg),__float_as_uint(l_reg),false,false);l_reg=__uint_as_float(rr[0])+__uint_as_float(rr[1]);}
  if(hi==0)wsf[32+r32]=l_reg;asm volatile("s_waitcnt lgkmcnt(0)":::"memory");
  float rli[16];
  #pragma unroll
  for(int r=0;r<16;++r)rli[r]=__builtin_amdgcn_rcpf(wsf[32+crow(r,hi)]);
  if(CAUSAL){ if(hi==0) wsf[r32]=mhat+__builtin_amdgcn_logf(l_reg); }
  else if(hi==0&&qent>=0) LSE[((size_t)bh*SEQ+qrow)*4+(qent>>16)]=mhat+__builtin_amdgcn_logf(l_reg);
  { bf16*stg=(bf16*)(shm+LDS_OST)+wid*2048;
    #pragma unroll
    for(int r=0;r<16;++r){const int orow=crow(r,hi);
      #pragma unroll
      for(int d0=0;d0<2;++d0)stg[orow*64+d0*32+r32]=__float2bfloat16(o[d0][r]*rli[r]);}
    asm volatile("s_waitcnt lgkmcnt(0)":::"memory");
    #pragma unroll
    for(int i=0;i<4;++i){const int row=i*8+(lane>>3),ch=lane&7; const u32x4 v=*(const u32x4*)(stg+row*64+ch*8); if(CAUSAL){ const int qr_=kvb*QB+wid*QBLK+row; const float lown=wsf[row]; const f32x4_m ls=pls[i];
        const float L=__builtin_fmaxf(__builtin_fmaxf(lown,ls[0]),__builtin_fmaxf(ls[1],ls[2]));
        const float wo=__builtin_amdgcn_exp2f(lown-L),w0=__builtin_amdgcn_exp2f(ls[0]-L),w1=__builtin_amdgcn_exp2f(ls[1]-L),w2=__builtin_amdgcn_exp2f(ls[2]-L); const float inv=__builtin_amdgcn_rcpf(wo+w0+w1+w2);
        float ac[8]; { const float ww=wo*inv; ac[0]=ww*__uint_as_float(v.x<<16); ac[1]=ww*__uint_as_float(v.x&0xffff0000u); ac[2]=ww*__uint_as_float(v.y<<16); ac[3]=ww*__uint_as_float(v.y&0xffff0000u);
          ac[4]=ww*__uint_as_float(v.z<<16); ac[5]=ww*__uint_as_float(v.z&0xffff0000u); ac[6]=ww*__uint_as_float(v.w<<16); ac[7]=ww*__uint_as_float(v.w&0xffff0000u); }
        _Pragma("unroll") for(int s_=0;s_<3;++s_){ const float ws_=(s_==0?w0:s_==1?w1:w2)*inv; const bool on_=ws_>0.f; pg8::u32x2 pv_=ppv[i][s_]; pv_.x=on_?pv_.x:0u; pv_.y=on_?pv_.y:0u;
          const pg8::f32x4 pa_=pg8::unpk8(pv_.x), pb_=pg8::unpk8(pv_.y);
          ac[0]+=ws_*pa_[0]; ac[1]+=ws_*pa_[1]; ac[2]+=ws_*pa_[2]; ac[3]+=ws_*pa_[3]; ac[4]+=ws_*pb_[0]; ac[5]+=ws_*pb_[1]; ac[6]+=ws_*pb_[2]; ac[7]+=ws_*pb_[3]; }
        pg8::u32x2 ov; ov.x=pg8::pkf8(ac[0],ac[1],ac[2],ac[3]); ov.y=pg8::pkf8(ac[4],ac[5],ac[6],ac[7]);
        *(pg8::u32x2*)((unsigned char*)O+(rowbase+qr_)*DM+h*D+ch*8)=ov; }
      else {const int qe=qlist[wid*QBLK+row]; if(qe>=0){ pg8::u32x2 o8_; o8_.x=pg8::pkf8(__uint_as_float(v.x<<16),__uint_as_float(v.x&0xffff0000u),__uint_as_float(v.y<<16),__uint_as_float(v.y&0xffff0000u)); o8_.y=pg8::pkf8(__uint_as_float(v.z<<16),__uint_as_float(v.z&0xffff0000u),__uint_as_float(v.w<<16),__uint_as_float(v.w&0xffff0000u)); *(pg8::u32x2*)((unsigned char*)PART+(((size_t)bh*SEQ+(qe&0xffff))*4+(qe>>16))*64+ch*8)=o8_; } }} }
  if(!has_next) asm volatile("s_waitcnt lgkmcnt(0)\n\ts_barrier":::"memory");
  #undef ISSUE_UNIT
  #undef DMA_K
  #undef DMA_V
  #undef CMASK
  #undef START
  #undef RESC
  #undef ROT
}
constexpr int ATTN_LDS_BYTES=LDS_BYTES;

typedef __attribute__((address_space(3))) float lds_f; typedef __attribute__((address_space(3))) unsigned lds_u; typedef __attribute__((address_space(3))) int lds_i; typedef __attribute__((address_space(3))) unsigned short lds_h;
typedef __attribute__((ext_vector_type(4))) float f4_t;
constexpr int SEL_KM = 0, SEL_GT = 8192, SEL_SUB = SEL_GT + 256 * 33 * 4, SEL_CNT = SEL_SUB + 32 * 256 * 2, SEL_END = SEL_CNT + 128;
constexpr int UP_OFF = 88064, QP_OFF = UP_OFF + 1040 * 4, UI_OFF = QP_OFF + 8 * 36 * 4, QL_OFF = 94208, QL_MAX = 32;
static_assert(UI_OFF + 128 <= QL_OFF && QL_OFF + QL_MAX * 1024 <= 131072 && QIDX_OFF + 1024 <= UP_OFF, "moba LDS map");

constexpr int SEL_HALF = 59392;
static_assert(SEL_END <= SEL_HALF && 2 * SEL_HALF <= 131072, "selection LDS map");
__device__ __forceinline__ void select_pair(int uA, int uB, const bf16* Q, const float* kmean, unsigned short* SUB, unsigned* CNT, float* LSE, char* shm, int tid) {
    const int half = tid >> 8, lt = tid & 255, u = half ? uB : uA;
    const int bh = u >> 5, qb = u & 31, b = bh / NHEAD, h = bh % NHEAD;
    const lds_cptr base = (lds_cptr)shm + half * SEL_HALF;
    lds_h* sub = (lds_h*)(base + SEL_SUB); lds_u* cnt = (lds_u*)(base + SEL_CNT);
    const long rowbase = (long)b * SEQ; const int q0 = qb * QB;
    if (lt < 32) cnt[lt] = 0u;
    const int lane = lt & 63, wq = lt >> 6, r32 = lane & 31, hi = lane >> 5;
    bf16x8 af[4];
#pragma unroll
    for (int kk = 0; kk < 4; ++kk) { const float* kp = kmean + ((size_t)(b * 32 + r32)) * 512 + h * 64 + 16 * kk + 8 * hi; const f4_t k0 = *(const f4_t*)kp, k1 = *(const f4_t*)(kp + 4);
        const pg8::u32x4 w = pg8::pack8(__builtin_bit_cast(pg8::f32x4, k0), __builtin_bit_cast(pg8::f32x4, k1)); af[kk] = __builtin_bit_cast(bf16x8, w); }
    __syncthreads();
#pragma unroll
    for (int c = 0; c < 2; ++c) {
        const int ql = 64 * wq + 32 * c + r32;
        const bf16* qp = Q + (rowbase + q0 + ql) * DM + h * D + 8 * hi;
        f32x16 g = f32x16{};
#pragma unroll
        for (int kk = 0; kk < 4; ++kk) { const bf16x8 bq = *reinterpret_cast<const bf16x8*>(qp + 16 * kk); g = __builtin_amdgcn_mfma_f32_32x32x16_bf16(af[kk], bq, g, 0, 0, 0); }
        float v0 = -INFINITY, v1 = -INFINITY, v2 = -INFINITY; int i0 = -1, i1 = -1, i2 = -1;
#pragma unroll
        for (int r = 0; r < 16; ++r) { const int j = (r & 3) + 8 * (r >> 2) + 4 * hi; const float x = j < qb ? g[r] : -INFINITY;
            const bool c0 = x > v0, c1 = x > v1, c2 = x > v2;
            v2 = c1 ? v1 : (c2 ? x : v2); i2 = c1 ? i1 : (c2 ? j : i2);
            v1 = c0 ? v0 : (c1 ? x : v1); i1 = c0 ? i0 : (c1 ? j : i1);
            v0 = c0 ? x : v0; i0 = c0 ? j : i0; }
        { float pv[3]; int pi[3];
          pv[0] = pg8::shx<32>(v0, lane); pv[1] = pg8::shx<32>(v1, lane); pv[2] = pg8::shx<32>(v2, lane);
          pi[0] = __builtin_amdgcn_ds_bpermute((lane ^ 32) << 2, i0); pi[1] = __builtin_amdgcn_ds_bpermute((lane ^ 32) << 2, i1); pi[2] = __builtin_amdgcn_ds_bpermute((lane ^ 32) << 2, i2);
#pragma unroll
          for (int t = 0; t < 3; ++t) { const float x = pv[t]; const int j = pi[t];
              const bool c0 = x > v0 || (x == v0 && j >= 0 && j < i0), c1 = x > v1 || (x == v1 && j >= 0 && j < i1), c2 = x > v2 || (x == v2 && j >= 0 && j < i2);
              v2 = c1 ? v1 : (c2 ? x : v2); i2 = c1 ? i1 : (c2 ? j : i2);
              v1 = c0 ? v0 : (c1 ? x : v1); i1 = c0 ? i0 : (c1 ? j : i1);
              v0 = c0 ? x : v0; i0 = c0 ? j : i0; } }
        if (hi == 0) {
            if (i0 >= 0) { const unsigned p = __hip_atomic_fetch_add(cnt + i0, 1u, __ATOMIC_RELAXED, __HIP_MEMORY_SCOPE_WORKGROUP); sub[i0 * 256 + p] = (unsigned short)(ql | (0 << 8)); }
            if (i1 >= 0) { const unsigned p = __hip_atomic_fetch_add(cnt + i1, 1u, __ATOMIC_RELAXED, __HIP_MEMORY_SCOPE_WORKGROUP); sub[i1 * 256 + p] = (unsigned short)(ql | (1 << 8)); }
            if (i2 >= 0) { const unsigned p = __hip_atomic_fetch_add(cnt + i2, 1u, __ATOMIC_RELAXED, __HIP_MEMORY_SCOPE_WORKGROUP); sub[i2 * 256 + p] = (unsigned short)(ql | (2 << 8)); }
            float* ls = LSE + ((size_t)bh * SEQ + q0 + ql) * 4; *(f4_t*)ls = (f4_t){-INFINITY, -INFINITY, -INFINITY, -INFINITY}; }
    }
    __syncthreads();
    if (lt < 32) CNT[((size_t)bh * 32 + lt) * 32 + qb] = cnt[lt];
    for (int idx = lt; idx < 32 * 256; idx += 256) { const int j = idx >> 8, i = idx & 255; if ((unsigned)i < cnt[j]) SUB[(((size_t)bh * 32 + j) * 32 + qb) * 256 + i] = sub[idx]; }
    __syncthreads();
}

__device__ __forceinline__ void sparse_phase(const bf16* Q, const bf16* K, const bf16* V, const unsigned short* SUB, const unsigned* CNT, bf16* PART, float* LSE, char* shm, int G, int bx, int tid, int wave_s) {
    lds_i* UP = (lds_i*)((lds_cptr)shm + UP_OFF); lds_i* QP = (lds_i*)((lds_cptr)shm + QP_OFF); lds_i* QI = (lds_i*)((lds_cptr)shm + QIDX_OFF);
    for (int it = tid; it < 1024; it += 512) { const unsigned* c = CNT + (size_t)it * 32; unsigned len = 0u;
#pragma unroll 8
        for (int qb = 0; qb < 32; ++qb) len += c[qb];
        UP[it + 1] = (int)((len + 255u) >> 8); }
    if (tid == 0) UP[0] = 0;
    __syncthreads();
    for (int off = 1; off < 1024; off <<= 1) {
        int a0 = 0, a1 = 0; const int i0 = tid + 1, i1 = tid + 513;
        if (i0 > off) a0 = UP[i0 - off]; if (i1 > off) a1 = UP[i1 - off];
        __syncthreads();
        UP[i0] += a0; UP[i1] += a1;
        __syncthreads();
    }
    const int U = UP[1024];
    lds_i* UI = (lds_i*)((lds_cptr)shm + UI_OFF);
    const int lane = tid & 63, wv = __builtin_amdgcn_readfirstlane(tid >> 6);
    int nloc = bx < U ? (U - bx + G - 1) / G : 0; if (nloc > QL_MAX) nloc = QL_MAX;
    for (int k = wv; k < nloc; k += 8) {
        const int u = bx + k * G;
        int lo_ = 0, hi_ = 1024;
        while (hi_ - lo_ > 1) { const int mid = (lo_ + hi_) >> 1; if (UP[mid] <= u) lo_ = mid; else hi_ = mid; }
        const int item = lo_, t = u - UP[item];
        lds_i* QPw = QP + wv * 36;
        { const int qb = lane & 31; int x = (int)CNT[(size_t)item * 32 + qb];
#pragma unroll
          for (int o = 1; o < 32; o <<= 1) { const int y = __builtin_amdgcn_ds_bpermute(((lane & 32) + ((qb - o) & 31)) << 2, x); if (qb >= o) x += y; }
          if (lane < 32) { QPw[qb + 1] = x; if (qb == 0) QPw[0] = 0; } }
        asm volatile("s_waitcnt lgkmcnt(0)" ::: "memory");
        const int len = QPw[32];
        lds_i* ql = (lds_i*)((lds_cptr)shm + QL_OFF) + k * 256;
#pragma unroll
        for (int i = 0; i < 4; ++i) { const int sidx = lane + 64 * i, g = 256 * t + sidx; int ent = -1;
            if (g < len) { int a_ = 0, bnd = 32; while (bnd - a_ > 1) { const int mid = (a_ + bnd) >> 1; if (QPw[mid] <= g) a_ = mid; else bnd = mid; }
                const unsigned e = SUB[((size_t)item * 32 + a_) * 256 + (g - QPw[a_])]; ent = (a_ * 256 + (int)(e & 255u)) | ((int)(e >> 8) << 16); }
            ql[sidx] = ent; }
        if (lane == 0) UI[k] = item;
    }
    __syncthreads();
    bf16x8 qr[4];
    for (int k = 0; k < nloc; ++k) { const int item = UI[k], bh = item >> 5, j = item & 31; const bool hn = k + 1 < nloc; const int nit = hn ? UI[k + 1] : item, nbh = nit >> 5;
        attn_unit<8, false>(bh / NHEAD, bh % NHEAD, j, QL_OFF + k * 1024, Q, K, V, PART, LSE, nullptr, shm, wave_s, qr, k == 0, hn, nbh / NHEAD, nbh % NHEAD, nit & 31, QL_OFF + (k + 1) * 1024); }
    for (int u = bx + QL_MAX * G; u < U; u += G) {
        int lo_ = 0, hi_ = 1024; while (hi_ - lo_ > 1) { const int mid = (lo_ + hi_) >> 1; if (UP[mid] <= u) lo_ = mid; else hi_ = mid; }
        const int item = lo_, t = u - UP[item], bh = item >> 5, j = item & 31;
        if (tid < 64) { const int qb = tid & 31; int x = (int)CNT[(size_t)item * 32 + qb];
#pragma unroll
            for (int o = 1; o < 32; o <<= 1) { const int y = __builtin_amdgcn_ds_bpermute(((tid & 32) + ((qb - o) & 31)) << 2, x); if (qb >= o) x += y; }
            if (tid < 32) { QP[qb + 1] = x; if (qb == 0) QP[0] = 0; } }
        __syncthreads();
        if (tid < 256) { const int g = 256 * t + tid; int ent = -1;
            if (g < QP[32]) { int a_ = 0, bnd = 32; while (bnd - a_ > 1) { const int mid = (a_ + bnd) >> 1; if (QP[mid] <= g) a_ = mid; else bnd = mid; }
                const unsigned e = SUB[((size_t)item * 32 + a_) * 256 + (g - QP[a_])]; ent = (a_ * 256 + (int)(e & 255u)) | ((int)(e >> 8) << 16); }
            QI[tid] = ent; }
        __syncthreads();
        attn_unit<8, false>(bh / NHEAD, bh % NHEAD, j, QIDX_OFF, Q, K, V, PART, LSE, nullptr, shm, wave_s, qr, true, false, 0, 0, 0, 0);
    }
}

__device__ __forceinline__ void own_phase(const bf16* Q, const bf16* K, const bf16* V, const bf16* PART, const float* LSE, bf16* O, char* shm, int G, int bx, int wave_s) {
    bf16x8 qr[4];
    for (int u = bx; u < BATCH * NHEAD * NQB; u += G) { const int bh = u >> 5, qb = u & 31; const bool hn = u + G < BATCH * NHEAD * NQB; const int nu = hn ? u + G : u, nbh = nu >> 5;
        attn_unit<8, true>(bh / NHEAD, bh % NHEAD, qb, 0, Q, K, V, (bf16*)PART, (float*)LSE, O, shm, wave_s, qr, u == bx, hn, nbh / NHEAD, nbh % NHEAD, nu & 31, 0); }
}
#undef SBAR
#undef WAIT_BAR
}

constexpr int NWAVES = 8;
constexpr int NB = 4, SEQ = 8192, T = NB * SEQ, D = 1024;
constexpr int D_SSM = 512, NG = 32, NS = 64;
constexpr int D_ATT = 512;
constexpr int D_IN = 4096;
constexpr int PH = 8, PQD = 256, NEXP = 16384;
constexpr int D_PLE = 256;
constexpr float EPS = 1e-6f;

constexpr size_t MiB = 1u << 20, KiB = 1u << 10;
constexpr size_t WS_CTL = 0, CTL_ZERO_BYTES = 1 * MiB;
constexpr int CW_BAR = 4096;
constexpr size_t CTL_KMEAN = 64 * KiB;
constexpr size_t CTL_SS1 = 320 * KiB;
constexpr size_t CTL_SS3 = 448 * KiB;
constexpr size_t CTL_PCNT = 600 * KiB;
constexpr size_t WS_WIN = 1 * MiB;
constexpr size_t WS_WGLU = 9 * MiB;
constexpr size_t WS_WPS = 9 * MiB + 512 * KiB;
constexpr size_t WS_WPA = 10 * MiB + 512 * KiB;
constexpr size_t WS_WOUT = 11 * MiB + 512 * KiB;
constexpr size_t WS_WS = 13 * MiB + 512 * KiB;
constexpr size_t WS_WGATE = 17 * MiB + 512 * KiB;
constexpr size_t WS_WPP = 19 * MiB + 512 * KiB;
constexpr size_t WS_ROPE = 20 * MiB;
constexpr size_t WS_S5P = 22 * MiB;
constexpr size_t WS_RS2 = 23 * MiB;
constexpr size_t WS_UT = 24 * MiB;
constexpr size_t WS_S5W = 40 * MiB;
constexpr size_t WS_VT = 40 * MiB;
constexpr size_t WS_SU = 48 * MiB, WS_SV = 48 * MiB + 64 * KiB;
constexpr size_t WS_X8 = 56 * MiB;
constexpr size_t WS_XN = 88 * MiB;
constexpr size_t WS_MSUB = 88 * MiB, WS_MCNT = 104 * MiB, WS_MLSE = 105 * MiB;
constexpr size_t WS_YP = 112 * MiB;
constexpr size_t WS_PB = 152 * MiB;
constexpr size_t WS_E = 168 * MiB;
constexpr size_t WS_U = 232 * MiB;
constexpr size_t WS_Q = 264 * MiB;
constexpr size_t WS_K = 296 * MiB;
constexpr size_t WS_V = 328 * MiB;
constexpr size_t WS_SGA = 360 * MiB;
constexpr size_t WS_SGB = 424 * MiB;
constexpr size_t WS_SC = 232 * MiB;
constexpr size_t WS_HLOC = 488 * MiB;
constexpr size_t WS_END = 496 * MiB;
constexpr size_t S5_ABR = 0, S5_ABI = 8 * KiB, S5_ALR = 16 * KiB, S5_ALI = 24 * KiB;
constexpr size_t S5_BRE = 32 * KiB, S5_BIM = 160 * KiB;
constexpr size_t S5_CM = 288 * KiB;

constexpr int RING_OFF = 0, RING_BYTES = 131072;
constexpr int LDSCTL_OFF = RING_BYTES, MISC_OFF = LDSCTL_OFF + 320;
constexpr int LDS_BYTES = 147456;

#define GAS __attribute__((address_space(1)))
#define LAS __attribute__((address_space(3)))
typedef unsigned short bf16;
typedef unsigned v4u __attribute__((ext_vector_type(4)));
typedef unsigned v2u __attribute__((ext_vector_type(2)));
typedef float f32x4 __attribute__((ext_vector_type(4)));
typedef float f32x2 __attribute__((ext_vector_type(2)));
typedef short bf16x8 __attribute__((ext_vector_type(8)));
using pg8::shx; using pg8::bperm; using pg8::bpermi; using pg8::lane_id_opaque;
using pg8::pkbf; using pg8::bflo; using pg8::bfhi; using pg8::gelu_tanh; using pg8::sigmoidf_;
#define LDS_WAIT() asm volatile("s_waitcnt lgkmcnt(0)" ::: "memory")

#define XB_TMO      128
#define XB_XCNT(j)  (256  + 64 * (j))
#define XB_XSUB(j)  (1280 + 64 * (j))
#define XB_XGEN(j)  (2304 + 64 * (j))
#define XB_TOP      3328
#define XB_TOPGEN   3392
#define XCD_BAR_WORDS 3456
#define XB_SPIN_CAP (1u << 22)
__device__ __forceinline__ unsigned xb_ld(unsigned* p)              { return __hip_atomic_load(p, __ATOMIC_RELAXED, __HIP_MEMORY_SCOPE_AGENT); }
__device__ __forceinline__ unsigned xb_add(unsigned* p, unsigned v) { return __hip_atomic_fetch_add(p, v, __ATOMIC_RELAXED, __HIP_MEMORY_SCOPE_AGENT); }
__device__ __forceinline__ unsigned xb_xcc_id() { return (unsigned)__builtin_amdgcn_s_getreg((3 << 11) | 20) & 0xFu; }
#define XB_SPIN(cond, bar) do { unsigned _sp = 0; while (cond) { __builtin_amdgcn_s_sleep(1); \
    if ((++_sp & 255u) == 0u) { if (xb_ld(&(bar)[XB_TMO])) break; if (_sp > XB_SPIN_CAP) { atomicAdd(&(bar)[XB_TMO], 1u); break; } } } } while (0)
struct XcdBarrier { unsigned* bar; unsigned x; volatile LAS unsigned* st; };
__device__ __forceinline__ bool is_thread0(int wave_s) { return wave_s == 0 && lane_id_opaque() == 0; }
__device__ __forceinline__ XcdBarrier xcd_barrier_post(unsigned* bar, volatile LAS unsigned* st, int wave_s) {
    XcdBarrier b; b.bar = bar; b.x = xb_xcc_id(); b.st = st;
    if (is_thread0(wave_s)) (void)xb_add(&bar[XB_XCNT(b.x)], 1u);
    return b;
}
__device__ __forceinline__ void xcd_barrier_complete(unsigned* bar, unsigned x, unsigned& nloc, unsigned& nx) {
    const unsigned G = gridDim.x * gridDim.y * gridDim.z;
    unsigned sum, cnt, mine, sp = 0u;
    for (;;) {
        sum = 0u; cnt = 0u; mine = 0u;
#pragma unroll
        for (unsigned j = 0; j < 16; ++j) { const unsigned c = xb_ld(&bar[XB_XCNT(j)]); sum += c; cnt += (c > 0u) ? 1u : 0u; mine = (j == x) ? c : mine; }
        if (sum == G) break;
        __builtin_amdgcn_s_sleep(1);
        if ((++sp & 255u) == 0u) { if (xb_ld(&bar[XB_TMO])) break; if (sp > XB_SPIN_CAP) { atomicAdd(&bar[XB_TMO], 1u); break; } }
    }
    nloc = mine > 0u ? mine : 1u; nx = cnt > 0u ? cnt : 1u;
}
__device__ __forceinline__ void xcd_barrier(const XcdBarrier& b, int wave_s) {
    asm volatile("s_waitcnt vmcnt(0)" ::: "memory");
    __syncthreads();
    if (is_thread0(wave_s)) {
        unsigned* bar = b.bar;
        __builtin_amdgcn_s_waitcnt(0);
        unsigned nloc = b.st[0], nx = b.st[1];
        if (nloc == 0u) { xcd_barrier_complete(bar, b.x, nloc, nx); b.st[0] = nloc; b.st[1] = nx; }
        const unsigned old = xb_add(&bar[XB_XSUB(b.x)], 1u);
        const unsigned gen = old / nloc;
        if (old + 1u == (gen + 1u) * nloc) {
            __builtin_amdgcn_fence(__ATOMIC_RELEASE, "agent");
            asm volatile("s_waitcnt vmcnt(0)" ::: "memory");
            const unsigned og = xb_add(&bar[XB_TOP], 1u);
            const unsigned tg = og / nx;
            if (og + 1u == (tg + 1u) * nx) xb_add(&bar[XB_TOPGEN], 1u);
            else XB_SPIN(xb_ld(&bar[XB_TOPGEN]) == tg, bar);
            __builtin_amdgcn_fence(__ATOMIC_ACQUIRE, "agent");
            xb_add(&bar[XB_XGEN(b.x)], 1u);
            asm volatile("s_waitcnt vmcnt(0)" ::: "memory");
        } else {
            XB_SPIN(xb_ld(&bar[XB_XGEN(b.x)]) == gen, bar);
            __builtin_amdgcn_fence(__ATOMIC_ACQUIRE, "agent");
            asm volatile("s_waitcnt vmcnt(0)" ::: "memory");
        }
    }
    __syncthreads();
}

struct Args { const float* in[27]; float* out; unsigned char* ws; };
enum { I_X = 0, I_P, I_POS, I_GMIX, I_WIN, I_LOGDT, I_ARE, I_AIM, I_BRE, I_BIM, I_CRE, I_CIM, I_DSK, I_WGLU, I_WPS, I_WPA, I_WOUT, I_GFFN, I_WQ, I_KEY1, I_KEY2, I_PU, I_PV, I_GPLE, I_WGATE, I_WPP, I_GFIN };

__device__ __forceinline__ float wave_sum(float v, int lane) {
    v += shx<1>(v, lane); v += shx<2>(v, lane); v += shx<4>(v, lane); v += shx<8>(v, lane); v += shx<16>(v, lane); v += shx<32>(v, lane);
    return v;
}

template <bool F8 = false>
__device__ __forceinline__ void p0_transpose_item(const float* W, const float* ks, int K, int N, bf16* WT, LAS float* scr, int item, int lane) {
    const int nblk = N / 32, kb = item / nblk, nb = item % nblk, k0 = 64 * kb, n0 = 32 * nb;
    { f32x4 w4[8]; float sc[8];
#pragma unroll
      for (int i = 0; i < 8; ++i) { const int kk = 8 * i + (lane >> 3); w4[i] = *(const f32x4*)(W + (size_t)(k0 + kk) * N + n0 + 4 * (lane & 7)); sc[i] = ks ? ks[k0 + kk] : 1.0f; }
#pragma unroll
      for (int i = 0; i < 8; ++i) { const int kk = 8 * i + (lane >> 3); LAS float* d = scr + kk * 33 + 4 * (lane & 7); d[0] = w4[i][0] * sc[i]; d[1] = w4[i][1] * sc[i]; d[2] = w4[i][2] * sc[i]; d[3] = w4[i][3] * sc[i]; } }
    LDS_WAIT(); asm volatile("" ::: "memory");
    const int c = lane & 7;
#pragma unroll
    for (int j = 0; j < 4; ++j) { const int n = (lane >> 3) + 8 * j; const LAS float* s = scr + (8 * c) * 33 + n;
        if (F8) { constexpr float sc8 = (float)(1 << pg8::W8_SHIFT); v2u o; o.x = pg8::pkf8(s[0 * 33] * sc8, s[1 * 33] * sc8, s[2 * 33] * sc8, s[3 * 33] * sc8); o.y = pg8::pkf8(s[4 * 33] * sc8, s[5 * 33] * sc8, s[6 * 33] * sc8, s[7 * 33] * sc8);
            *(v2u*)((unsigned char*)WT + (size_t)(n0 + n) * K + k0 + 8 * c) = o; }
        else { v4u o; o.x = pkbf(s[0 * 33], s[1 * 33]); o.y = pkbf(s[2 * 33], s[3 * 33]); o.z = pkbf(s[4 * 33], s[5 * 33]); o.w = pkbf(s[6 * 33], s[7 * 33]);
            *(v4u*)(WT + (size_t)(n0 + n) * K + k0 + 8 * c) = o; } }
    LDS_WAIT(); asm volatile("" ::: "memory");
}

__device__ __forceinline__ void cs_reduced(double ang, float& c, float& s) {
    const double r = ang * 0.15915494309189535; double fr = r - floor(r); if (fr > 0.5) fr -= 1.0;
    const float y = (float)(fr * 6.283185307179586);
    c = cosf(y); s = sinf(y);
}

__device__ __forceinline__ void p0_ws_item(const float* Wq, const float* gffn, const float* key1, const float* key2, bf16* WsT, LAS unsigned char* lds, int item, int tid) {
    constexpr int P = 132;
    LAS float* wq = (LAS float*)lds;
    LAS float* ky = (LAS float*)(lds + 64 * P * 4);
    const int hh = item >> 4, kb = item & 15, h = hh >> 1, half = hh & 1, k0 = 64 * kb;
    const float* keys = (half ? key2 : key1) + (size_t)h * 128 * 128;
#pragma unroll
    for (int i = 0; i < 4; ++i) { const int idx = tid + 512 * i, kk = idx >> 5, d4 = idx & 31;
        f32x4 v = *(const f32x4*)(Wq + (size_t)(k0 + kk) * 2048 + h * 256 + half * 128 + 4 * d4); v = v * gffn[k0 + kk];
        *(LAS f32x4*)(wq + kk * P + 4 * d4) = v; }
#pragma unroll
    for (int i = 0; i < 8; ++i) { const int idx = tid + 512 * i, n = idx >> 5, d4 = idx & 31;
        *(LAS f32x4*)(ky + n * P + 4 * d4) = *(const f32x4*)(keys + (size_t)n * 128 + 4 * d4); }
    __syncthreads();
    const int kq = tid & 15, nq = tid >> 4;
    float acc[4][4];
#pragma unroll
    for (int a = 0; a < 4; ++a)
#pragma unroll
        for (int b = 0; b < 4; ++b) acc[a][b] = 0.f;
    for (int d4 = 0; d4 < 32; ++d4) {
        f32x4 wv[4], kv[4];
#pragma unroll
        for (int a = 0; a < 4; ++a) { wv[a] = *(const LAS f32x4*)(wq + (4 * kq + a) * P + 4 * d4); kv[a] = *(const LAS f32x4*)(ky + (4 * nq + a) * P + 4 * d4); }
#pragma unroll
        for (int a = 0; a < 4; ++a)
#pragma unroll
            for (int b = 0; b < 4; ++b)
                acc[a][b] += (kv[a][0] * wv[b][0] + kv[a][1] * wv[b][1]) + (kv[a][2] * wv[b][2] + kv[a][3] * wv[b][3]);
    }
#pragma unroll
    for (int a = 0; a < 4; ++a) { v2u o; o.x = pkbf(acc[a][0], acc[a][1]); o.y = pkbf(acc[a][2], acc[a][3]);
        *(v2u*)(WsT + (size_t)(h * 256 + half * 128 + 4 * nq + a) * 1024 + k0 + 4 * kq) = o; }
    __syncthreads();
}

namespace s5 {
constexpr long YP8_DELTA = (long)WS_MSUB - (long)WS_YP;
constexpr int L = 64, NCH = SEQ / L, HP = 136, XP = 132;
constexpr int X_BYTES = 16 * XP * 4, WAVE_LDS = X_BYTES + 16 * HP * 2;
constexpr int ITEMS_PER_BG = 8, CH_STRIDE = NCH / ITEMS_PER_BG;

template <int PASS> struct Loads { v4u uf[4]; v2u uw[4]; float hinr, hini; };
constexpr size_t HPLANE = (size_t)NB * NG * NCH * 64;

template <int PASS>
__device__ __forceinline__ void issue(Loads<PASS>& ld, const bf16* Ub, const float* Hb, int ch, int q, int nl, int lane) {
#pragma unroll
    for (int blk = 0; blk < 4; ++blk) { ld.uf[blk] = *(const v4u*)(Ub + (blk * 16 + nl) * 16 + 8 * (q & 1));
        if (PASS == 2) ld.uw[blk] = *(const v2u*)(Ub + (blk * 16 + nl) * 16 + 4 * q); }
    if (PASS == 2) { const float* hp = Hb + (size_t)ch * 64 + lane; ld.hinr = hp[0]; ld.hini = hp[HPLANE]; }
}

template <int PASS>
__device__ __forceinline__ void run(LAS unsigned char* ldsw, const unsigned char* s5p, const bf16* U, float* Hloc, const float* dskip, bf16* YP, int gw, int ngw, int lane) {
    const int q = lane >> 4, nl = lane & 15;
    LAS float* Xt = (LAS float*)ldsw;
    LAS bf16* Ht = (LAS bf16*)(ldsw + X_BYTES);
    for (int wv = gw; wv < NB * NG * CH_STRIDE; wv += ngw) {
        const int g = wv & 31, b = (wv >> 5) & 3, ch0 = wv >> 7;
        bf16x8 af[8];
#pragma unroll
        for (int j = 0; j < 8; ++j) {
            const float* src = (const float*)(s5p + (j < 4 ? S5_BRE : S5_BIM)) + (size_t)(g * 64 + 16 * (j & 3) + nl) * 16 + 8 * (q & 1);
            const f32x4 a = *(const f32x4*)src, bb = *(const f32x4*)(src + 4);
            v4u w = pg8::pack8(a, bb); if (q >= 2) w = (v4u){0u, 0u, 0u, 0u};
            af[j] = __builtin_bit_cast(bf16x8, w);
        }
        const float ar = ((const float*)(s5p + S5_ABR))[g * 64 + lane], ai = ((const float*)(s5p + S5_ABI))[g * 64 + lane];
        const float aLr = ((const float*)(s5p + S5_ALR))[g * 64 + lane], aLi = ((const float*)(s5p + S5_ALI))[g * 64 + lane];
        bf16x8 cf[4]; float dsk[4];
        if (PASS == 2) {
#pragma unroll
            for (int kk = 0; kk < 4; ++kk) cf[kk] = *(const bf16x8*)((const bf16*)(s5p + S5_CM) + (size_t)(g * 16 + nl) * 128 + 32 * kk + 8 * q);
#pragma unroll
            for (int r = 0; r < 4; ++r) dsk[r] = dskip[g * 16 + 4 * q + r];
        }
        const bf16* Ubg = U + (size_t)(b * 32 + g) * SEQ * 16;
        float* Hbg = Hloc + (size_t)(b * 32 + g) * NCH * 64;
        float cr = 0.f, ci = 0.f;
        Loads<PASS> cur, nxt;
        issue<PASS>(cur, Ubg + (size_t)ch0 * L * 16, Hbg, ch0, q, nl, lane);
#pragma unroll 1
        for (int i = 0; i < ITEMS_PER_BG; ++i) {
            const int ch = ch0 + CH_STRIDE * i;
            if (i + 1 < ITEMS_PER_BG) issue<PASS>(nxt, Ubg + (size_t)(ch + CH_STRIDE) * L * 16, Hbg, ch + CH_STRIDE, q, nl, lane);
            float hr = 0.f, hi = 0.f;
            if (PASS == 2) { hr = cur.hinr; hi = cur.hini; }
#pragma unroll
            for (int blk = 0; blk < L / 16; ++blk) {
                v4u uw4 = cur.uf[blk]; if (q >= 2) uw4 = (v4u){0u, 0u, 0u, 0u};
                const bf16x8 uf = __builtin_bit_cast(bf16x8, uw4);
#pragma unroll
                for (int j = 0; j < 8; ++j) { const f32x4 d = __builtin_amdgcn_mfma_f32_16x16x32_bf16(af[j], uf, (f32x4){0.f, 0.f, 0.f, 0.f}, 0, 0, 0);
                    *(LAS f32x4*)(Xt + nl * XP + 16 * j + 4 * q) = d; }
#pragma unroll
                for (int tt = 0; tt < 16; ++tt) {
                    const float xr = Xt[tt * XP + lane], xi = Xt[tt * XP + 64 + lane];
                    const float nhr = fmaf(ar, hr, fmaf(-ai, hi, xr)), nhi = fmaf(ar, hi, fmaf(ai, hr, xi));
                    hr = nhr; hi = nhi;
                    if (PASS == 2) { *(LAS unsigned*)(Ht + tt * HP + 2 * lane) = pkbf(hr, hi); }
                }
                if (PASS == 2) {
                    f32x4 acc = {0.f, 0.f, 0.f, 0.f};
#pragma unroll
                    for (int kk = 0; kk < 4; ++kk) { const bf16x8 hf = *(const LAS bf16x8*)(Ht + nl * HP + 32 * kk + 8 * q);
                        acc = __builtin_amdgcn_mfma_f32_16x16x32_bf16(cf[kk], hf, acc, 0, 0, 0); }
                    const int tl = blk * 16 + nl;
                    const v2u uw = cur.uw[blk];
                    const float y0 = gelu_tanh(acc[0] + dsk[0] * bflo(uw.x)), y1 = gelu_tanh(acc[1] + dsk[1] * bfhi(uw.x));
                    const float y2 = gelu_tanh(acc[2] + dsk[2] * bflo(uw.y)), y3 = gelu_tanh(acc[3] + dsk[3] * bfhi(uw.y));
                    *(unsigned*)((unsigned char*)YP + YP8_DELTA + ((size_t)b * SEQ + (size_t)ch * L + tl) * 512 + g * 16 + 4 * q) = pg8::pkf8(y0, y1, y2, y3);
                }
            }
            if (PASS == 1) { Hbg[(size_t)ch * 64 + lane] = hr; Hbg[HPLANE + (size_t)ch * 64 + lane] = hi; }
            cur = nxt;
        }
    }
}


__device__ __forceinline__ void carry_prefix(const unsigned char* s5p, const float* Hloc, float* Hin, int task, int lane) {
    const int g = task & 31, b = task >> 5;
    const float aLr = ((const float*)(s5p + S5_ALR))[g * 64 + lane], aLi = ((const float*)(s5p + S5_ALI))[g * 64 + lane];
    const float* Hb = Hloc + (size_t)(b * 32 + g) * NCH * 64 + lane; float* Ho = Hin + (size_t)(b * 32 + g) * NCH * 64 + lane;
    float cr = 0.f, ci = 0.f;
#pragma unroll 1
    for (int c = 0; c < NCH; c += 8) { float lr[8], li[8];
#pragma unroll
        for (int k = 0; k < 8; ++k) { lr[k] = Hb[(size_t)(c + k) * 64]; li[k] = Hb[HPLANE + (size_t)(c + k) * 64]; }
#pragma unroll
        for (int k = 0; k < 8; ++k) { Ho[(size_t)(c + k) * 64] = cr; Ho[HPLANE + (size_t)(c + k) * 64] = ci;
            const float ncr = fmaf(aLr, cr, fmaf(-aLi, ci, lr[k])), nci = fmaf(aLr, ci, fmaf(aLi, cr, li[k])); cr = ncr; ci = nci; } }
}

__device__ __forceinline__ void pass1_gemm(LAS unsigned char* lds, const bf16* W, const bf16* U, float* Hloc, int G, int bx, int tid, int wave) {
    constexpr int PITCH = 528, A_OFF = 0, B_OFF = 128 * PITCH;
    const int lane = tid & 63, fr = lane & 15, fq = lane >> 4;
    for (int task = bx; task < NG * 8; task += G) {
        const int g = task >> 3, c8 = task & 7, b = c8 >> 1, ch0 = 64 * (c8 & 1);
        const bf16* Wg = W + (size_t)g * 128 * 1024;
        const bf16* Ub = U + ((size_t)(b * 32 + g) * SEQ + (size_t)ch0 * L) * 16;
        f32x4 acc[4];
#pragma unroll
        for (int nt = 0; nt < 4; ++nt) acc[nt] = (f32x4){0.f, 0.f, 0.f, 0.f};
#pragma unroll 1
        for (int slab = 0; slab < 4; ++slab) {
            v4u ta[8], tb[4];
#pragma unroll
            for (int i = 0; i < 8; ++i) { const int p = tid + 512 * i; ta[i] = *(const v4u*)((const unsigned char*)Wg + (size_t)(p >> 5) * 2048 + slab * 512 + 16 * (p & 31)); }
#pragma unroll
            for (int i = 0; i < 4; ++i) { const int p = tid + 512 * i; tb[i] = *(const v4u*)((const unsigned char*)Ub + (size_t)(p >> 5) * 2048 + slab * 512 + 16 * (p & 31)); }
            __syncthreads();
#pragma unroll
            for (int i = 0; i < 8; ++i) { const int p = tid + 512 * i; *(LAS v4u*)(lds + A_OFF + (p >> 5) * PITCH + 16 * (p & 31)) = ta[i]; }
#pragma unroll
            for (int i = 0; i < 4; ++i) { const int p = tid + 512 * i; *(LAS v4u*)(lds + B_OFF + (p >> 5) * PITCH + 16 * (p & 31)) = tb[i]; }
            __syncthreads();
#pragma unroll
            for (int kk = 0; kk < 8; ++kk) { const bf16x8 wf = *(const LAS bf16x8*)(lds + A_OFF + (16 * wave + fr) * PITCH + 64 * kk + 16 * fq);
#pragma unroll
                for (int nt = 0; nt < 4; ++nt) { const bf16x8 uf = *(const LAS bf16x8*)(lds + B_OFF + (16 * nt + fr) * PITCH + 64 * kk + 16 * fq); acc[nt] = __builtin_amdgcn_mfma_f32_16x16x32_bf16(wf, uf, acc[nt], 0, 0, 0); } }
        }
        const int np = 16 * wave + 4 * fq;
        float* Hp = Hloc + (size_t)(np >> 6) * HPLANE + ((size_t)(b * 32 + g) * NCH + ch0 + fr) * 64 + (np & 63);
#pragma unroll
        for (int nt = 0; nt < 4; ++nt) *(f32x4*)(Hp + (size_t)(16 * nt) * 64) = acc[nt];
        __syncthreads();
    }
}
}

namespace peer {
template <int M> __device__ __forceinline__ int shxi(int v, int lane) { return __builtin_bit_cast(int, shx<M>(__builtin_bit_cast(float, v), lane)); }
__device__ __forceinline__ float hmax32(float m, int lane) { m = fmaxf(m, shx<1>(m, lane)); m = fmaxf(m, shx<2>(m, lane)); m = fmaxf(m, shx<4>(m, lane)); m = fmaxf(m, shx<8>(m, lane)); m = fmaxf(m, shx<16>(m, lane)); return m; }
__device__ __forceinline__ unsigned f2o(float f) { const unsigned b = __float_as_uint(f); return b ^ ((unsigned)((int)b >> 31) | 0x80000000u); }
__device__ __forceinline__ float o2f(unsigned k) { return __uint_as_float(k ^ ((~(unsigned)((int)k >> 31)) | 0x80000000u)); }
template <int CTRL> __device__ __forceinline__ unsigned dppmax(unsigned x) { const unsigned y = (unsigned)__builtin_amdgcn_update_dpp(0, (int)x, CTRL, 0xf, 0xf, true); return x > y ? x : y; }
__device__ __forceinline__ unsigned rowmax16(unsigned x) { x = dppmax<0xB1>(x); x = dppmax<0x4E>(x); x = dppmax<0x141>(x); x = dppmax<0x140>(x); return x; }
__device__ __forceinline__ unsigned wrlane(unsigned v, unsigned val, int sel) { unsigned keep;
    asm("s_mov_b32 %1, m0\n\ts_mov_b32 m0, %3\n\ts_nop 0\n\tv_writelane_b32 %0, %2, m0\n\ts_mov_b32 m0, %1" : "+v"(v), "=&s"(keep) : "s"(val), "s"(sel)); return v; }
__device__ __forceinline__ void cex(unsigned& a, unsigned& b) { const unsigned hi = a > b ? a : b, lo = a > b ? b : a; a = hi; b = lo; }
__device__ __forceinline__ unsigned qpack4(const f32x4 v, float inv, int ob) { const int a = (int)rintf(v[0] * inv) + ob, b = (int)rintf(v[1] * inv) + ob, c = (int)rintf(v[2] * inv) + ob, d = (int)rintf(v[3] * inv) + ob;
    return ((unsigned)a & 0xffu) | (((unsigned)b & 0xffu) << 8) | (((unsigned)c & 0xffu) << 16) | (((unsigned)d & 0xffu) << 24); }
__device__ __forceinline__ float sel8(const float (&a)[8], int h) { float r = a[0];
#pragma unroll
    for (int q = 1; q < 8; ++q) r = (h == q) ? a[q] : r;
    return r; }
__device__ __forceinline__ unsigned sel8u(const unsigned (&a)[8], int h) { unsigned r = a[0];
#pragma unroll
    for (int q = 1; q < 8; ++q) r = (h == q) ? a[q] : r;
    return r; }

struct Pre { v2u sc[8]; v4u xr[2]; };
__device__ __forceinline__ void load_pre(Pre& p, const float* S, const bf16* XB, int tkn, int lane) {
    const v2u* Sp = (const v2u*)((const bf16*)S + (size_t)tkn * 2048) + lane;
#pragma unroll
    for (int h = 0; h < 8; ++h) p.sc[h] = Sp[64 * h];
    const v4u* xp = (const v4u*)(XB + (size_t)tkn * 1024 + lane * 16);
    p.xr[0] = xp[0]; p.xr[1] = xp[1];
}

struct Row4 { f32x4 v[4]; };
__device__ __forceinline__ void load_row(Row4& r, const float* src, int lane) {
#pragma unroll
    for (int j = 0; j < 4; ++j) r.v[j] = *(const f32x4*)(src + 256 * j + 4 * lane); }
__device__ __forceinline__ void load_row16(Row4& r, const float* src, int lane) {
#pragma unroll
    for (int j = 0; j < 4; ++j) r.v[j] = *(const f32x4*)(src + 16 * lane + 4 * j); }
__device__ __forceinline__ void quant_row(const Row4& r, const f32x4 (&gf)[4], bool use_gf, unsigned char* dst, float* scale_out, bool offset_binary, int lane) {
    f32x4 v[4]; float m = 0.f;
#pragma unroll
    for (int j = 0; j < 4; ++j) { v[j] = r.v[j]; if (use_gf) v[j] = v[j] * gf[j];
        m = fmaxf(fmaxf(m, fmaxf(fabsf(v[j][0]), fabsf(v[j][1]))), fmaxf(fabsf(v[j][2]), fabsf(v[j][3]))); }
    m = hmax32(m, lane); m = fmaxf(m, shx<32>(m, lane));
    const float inv = m > 0.f ? 127.0f / m : 0.f; const int ob = offset_binary ? 128 : 0;
#pragma unroll
    for (int j = 0; j < 4; ++j) *(unsigned*)(dst + 256 * j + 4 * lane) = qpack4(v[j], inv, ob);
    if (lane == 0) *scale_out = m * (1.0f / 127.0f);
}
__device__ __forceinline__ void quant_row4(Row4 r, const f32x4 (&gf)[4], bool use_gf, unsigned char* dst, float* scale_out, int lane, bool signed_hi = false) {
    if (use_gf) {
#pragma unroll
        for (int j = 0; j < 4; ++j) r.v[j] = r.v[j] * gf[j]; }
    float ssq = 0.f;
#pragma unroll
    for (int j = 0; j < 4; ++j) ssq += (r.v[j][0] * r.v[j][0] + r.v[j][1] * r.v[j][1]) + (r.v[j][2] * r.v[j][2] + r.v[j][3] * r.v[j][3]);
    ssq = wave_sum(ssq, lane);
    const float step = 0.3352f * sqrtf(ssq * (1.0f / 1024.0f)), inv = step > 0.f ? 1.0f / step : 0.f;
    v2u o;
#pragma unroll
    for (int g = 0; g < 2; ++g) { unsigned w = 0u;
#pragma unroll
        for (int j = 0; j < 4; ++j) { const int a = (int)floorf(r.v[2 * g][j] * inv) + 8, b = (int)floorf(r.v[2 * g + 1][j] * inv) + 8;
            const unsigned lo4 = (unsigned)(a < 0 ? 0 : a > 15 ? 15 : a); unsigned hi4 = (unsigned)(b < 0 ? 0 : b > 15 ? 15 : b); if (signed_hi) hi4 = (hi4 - 8u) & 15u; w |= (lo4 | (hi4 << 4)) << (8 * j); }
        if (g == 0) o.x = w; else o.y = w; }
    *(v2u*)(dst + 16 * lane) = o;
    if (lane == 0) *scale_out = step;
}
}

namespace peer {
struct TK { unsigned eidP0, eidP1; float cAP0, cAP1, cBP0, cBP1; };

__device__ __forceinline__ void sort8(unsigned (&v)[8]) {
    cex(v[0], v[1]); cex(v[2], v[3]); cex(v[4], v[5]); cex(v[6], v[7]); cex(v[0], v[2]); cex(v[1], v[3]); cex(v[4], v[6]); cex(v[5], v[7]);
    cex(v[1], v[2]); cex(v[5], v[6]); cex(v[0], v[4]); cex(v[3], v[7]); cex(v[1], v[5]); cex(v[2], v[6]); cex(v[1], v[4]); cex(v[3], v[6]); cex(v[2], v[4]); cex(v[3], v[5]); cex(v[3], v[4]);
}
__device__ __forceinline__ float rowsum16(float x) {
#define PEER_RS(CTRL) x += __builtin_bit_cast(float, __builtin_amdgcn_update_dpp(0, __builtin_bit_cast(int, x), CTRL, 0xf, 0xf, true))
    PEER_RS(0xB1); PEER_RS(0x4E); PEER_RS(0x141); PEER_RS(0x140);
#undef PEER_RS
    return x; }
__device__ __forceinline__ void prep_keys(const Pre& pre, unsigned (&kk)[4][8], int hl) {
#pragma unroll
    for (int p = 0; p < 4; ++p) { const v2u wa = pre.sc[2 * p], wb = pre.sc[2 * p + 1];
        const f32x4 sa = {pg8::bflo(wa.x), pg8::bfhi(wa.x), pg8::bflo(wa.y), pg8::bfhi(wa.y)}, sb = {pg8::bflo(wb.x), pg8::bfhi(wb.x), pg8::bflo(wb.y), pg8::bfhi(wb.y)};
#pragma unroll
        for (int e = 0; e < 4; ++e) { const unsigned ka = (f2o(sa[e]) & ~127u) | (unsigned)(4 * hl + e), kb = (f2o(sb[e]) & ~127u) | (unsigned)(4 * hl + e);
            const auto r = __builtin_amdgcn_permlane16_swap(ka, kb, false, false);
            kk[p][e] = (unsigned)r[0]; kk[p][4 + e] = (unsigned)r[1]; }
        sort8(kk[p]); }
}
__device__ __forceinline__ void quant_x(const Pre& pre, v4u& xq, float& sx, int& sumx, int lane) {
    f32x4 xf[4]; pg8::unpack8(pre.xr[0], xf[0], xf[1]); pg8::unpack8(pre.xr[1], xf[2], xf[3]);
    float m = 0.f;
#pragma unroll
    for (int e = 0; e < 4; ++e) m = fmaxf(fmaxf(m, fabsf(xf[0][e])), fmaxf(fmaxf(fabsf(xf[1][e]), fabsf(xf[2][e])), fabsf(xf[3][e])));
    unsigned am = rowmax16(__float_as_uint(m)); am = dppmax<0x142>(am); am = dppmax<0x143>(am);
    m = __uint_as_float((unsigned)__builtin_amdgcn_readlane((int)am, 63));
    sx = m * (1.0f / 127.0f); const float inv = m > 0.f ? 127.0f / m : 0.f;
    xq.x = qpack4(xf[0], inv, 0); xq.y = qpack4(xf[1], inv, 0); xq.z = qpack4(xf[2], inv, 0); xq.w = qpack4(xf[3], inv, 0);
    int t = __builtin_amdgcn_sdot4((int)xq.x, 0x01010101, 0, false); t = __builtin_amdgcn_sdot4((int)xq.y, 0x01010101, t, false); t = __builtin_amdgcn_sdot4((int)xq.z, 0x01010101, t, false); t = __builtin_amdgcn_sdot4((int)xq.w, 0x01010101, t, false);
    t += shxi<1>(t, lane); t += shxi<2>(t, lane); t += shxi<4>(t, lane); t += shxi<8>(t, lane); t += shxi<16>(t, lane); t += shxi<32>(t, lane); sumx = t;
}
__device__ __forceinline__ void s1_round(unsigned (&kk)[4][8], unsigned (&mine)[4], bool sel) {
    unsigned x[4];
#pragma unroll
    for (int p = 0; p < 4; ++p) x[p] = rowmax16(kk[p][0]);
#pragma unroll
    for (int p = 0; p < 4; ++p) { const bool win = kk[p][0] == x[p];
#pragma unroll
        for (int j = 0; j < 7; ++j) kk[p][j] = win ? kk[p][j + 1] : kk[p][j];
        kk[p][7] = win ? 0u : kk[p][7];
        mine[p] = sel ? x[p] : mine[p]; }
}
__device__ __forceinline__ void s2_setup(const unsigned (&mine)[4], unsigned (&MA)[2], unsigned (&MB)[2], unsigned (&ck)[2][4], unsigned (&top)[2], unsigned ciP, unsigned cjP, int li) {
#pragma unroll
    for (int q = 0; q < 2; ++q) { const auto r = __builtin_amdgcn_permlane32_swap(mine[2 * q], mine[2 * q + 1], false, false);
        MA[q] = (unsigned)r[0]; MB[q] = (unsigned)r[1];
#pragma unroll
        for (int k = 0; k < 4; ++k) { const int la = (int)((ciP >> (8 * k)) & 255u), lb = (int)((cjP >> (8 * k)) & 255u);
            const float av = o2f((unsigned)bpermi((int)MA[q], la)), bv = o2f((unsigned)bpermi((int)MB[q], lb));
            const int c = li + 16 * k;
            ck[q][k] = (c < 50) ? ((f2o(av + bv) & ~63u) | (unsigned)c) : 0u; }
        cex(ck[q][0], ck[q][1]); cex(ck[q][2], ck[q][3]); cex(ck[q][0], ck[q][2]); cex(ck[q][1], ck[q][3]); cex(ck[q][1], ck[q][2]);
        top[q] = 0u; }
}
__device__ __forceinline__ void s2_round(unsigned (&ck)[2][4], unsigned (&top)[2], bool sel) {
    unsigned x[2];
#pragma unroll
    for (int q = 0; q < 2; ++q) x[q] = rowmax16(ck[q][0]);
#pragma unroll
    for (int q = 0; q < 2; ++q) { const bool win = ck[q][0] == x[q];
        ck[q][0] = win ? ck[q][1] : ck[q][0]; ck[q][1] = win ? ck[q][2] : ck[q][1]; ck[q][2] = win ? ck[q][3] : ck[q][2]; ck[q][3] = win ? 0u : ck[q][3];
        top[q] = sel ? x[q] : top[q]; }
}
__device__ __forceinline__ void finalize(const unsigned (&top)[2], const unsigned (&MA)[2], const unsigned (&MB)[2], int cij, float rs1, float sx, const float* SU, const float* SV, int lane, TK& o) {
    const int rb = lane & 48;
    unsigned ex_id[2]; float gate[2], su[2], sv[2];
#pragma unroll
    for (int q = 0; q < 2; ++q) { const int c = (int)(top[q] & 63u); const int t = bpermi(cij, c); const int ci = t & 255, cj = t >> 8;
        const unsigned e1 = (unsigned)bpermi((int)MA[q], rb + ci) & 127u, e2 = (unsigned)bpermi((int)MB[q], rb + cj) & 127u; ex_id[q] = e1 * 128u + e2; }
#pragma unroll
    for (int q = 0; q < 2; ++q) { su[q] = SU[ex_id[q]]; sv[q] = SV[ex_id[q]]; }
#pragma unroll
    for (int q = 0; q < 2; ++q) { const float topf = o2f(top[q]), mx = o2f(rowmax16(top[q]));
        const float ex = __expf(topf - mx); const float sm = rowsum16(ex);
        gate[q] = ex * __builtin_amdgcn_rcpf(fmaxf(sm, 1e-30f)); }
    o.eidP0 = ex_id[0]; o.eidP1 = ex_id[1];
    o.cAP0 = 0.5f * rs1 * sx * su[0]; o.cAP1 = 0.5f * rs1 * sx * su[1];
    o.cBP0 = gate[0] * sv[0]; o.cBP1 = gate[1] * sv[1];
}
#define PEER_ROWUV(id) __builtin_amdgcn_raw_buffer_load_b128(rsUV, lo, (int)((id) * 1024u), 0)
__device__ __forceinline__ void load_t_head(v4u (&tq)[16], unsigned esrc, int l0, __amdgpu_buffer_rsrc_t rsUV, int lo) {
#pragma unroll
    for (int e = 0; e < 16; ++e) { const unsigned id = (unsigned)__builtin_amdgcn_readlane((int)esrc, l0 + e); tq[e] = PEER_ROWUV(id); }
}
struct GH { int p[16]; int cq; float cscale; int accI[16]; int sumcq; };
template <bool NEXTU>
__device__ __forceinline__ void gh_a(GH& g, int h, const TK& t, const v4u xq, v4u (&tq)[16], v2u (&vq)[16], __amdgpu_buffer_rsrc_t rsUV, int lo) {
#pragma unroll
    for (int e = 0; e < 16; ++e) { int d = __builtin_amdgcn_sdot4((int)(tq[e].x & 0x0f0f0f0fu), (int)xq.x, 0, false); d = __builtin_amdgcn_sdot4((int)((tq[e].x >> 4) & 0x0f0f0f0fu), (int)xq.y, d, false);
        d = __builtin_amdgcn_sdot4((int)(tq[e].y & 0x0f0f0f0fu), (int)xq.z, d, false); g.p[e] = __builtin_amdgcn_sdot4((int)((tq[e].y >> 4) & 0x0f0f0f0fu), (int)xq.w, d, false);
        vq[e].x = tq[e].z; vq[e].y = tq[e].w; }
    if (NEXTU) { const unsigned en = (h + 1 < 4) ? t.eidP0 : t.eidP1; load_t_head(tq, en, ((h + 1) & 3) * 16, rsUV, lo); }
}
__device__ __forceinline__ void gh_b(GH& g, int h, const TK& t, int lane, int sumx) {
    const float cAh = (h < 4) ? t.cAP0 : t.cAP1, cBh = (h < 4) ? t.cBP0 : t.cBP1; const int l0 = (h & 3) * 16;
    int q8[8], r4[4], s2[2], s1;
#pragma unroll
    for (int e = 0; e < 8; ++e) { const auto r = __builtin_amdgcn_permlane32_swap(g.p[e], g.p[e + 8], false, false); q8[e] = (int)r[0] + (int)r[1]; }
#pragma unroll
    for (int e = 0; e < 4; ++e) { const auto r = __builtin_amdgcn_permlane16_swap(q8[e], q8[e + 4], false, false); r4[e] = (int)r[0] + (int)r[1]; }
    { const bool up = (lane & 8) != 0;
#pragma unroll
      for (int e = 0; e < 2; ++e) { const int send = up ? r4[e] : r4[e + 2], keep = up ? r4[e + 2] : r4[e]; s2[e] = keep + __builtin_amdgcn_update_dpp(0, send, 0x128, 0xf, 0xf, true); } }
    { const bool up = (lane & 4) != 0; const int send = up ? s2[0] : s2[1], keep = up ? s2[1] : s2[0];
      int recv = __builtin_amdgcn_update_dpp(send, send, 0x104, 0xf, 0x5, false); recv = __builtin_amdgcn_update_dpp(recv, send, 0x114, 0xf, 0xa, false);
      s1 = keep + recv; }
    s1 += __builtin_amdgcn_update_dpp(0, s1, 0x4E, 0xf, 0xf, true); s1 += __builtin_amdgcn_update_dpp(0, s1, 0xB1, 0xf, 0xf, true);
    const int eb = lane >> 2;
    const float cf = bperm(cBh, l0 + eb) * gelu_tanh((float)(2 * s1 - 15 * sumx) * bperm(cAh, l0 + eb));
    unsigned am = rowmax16(__float_as_uint(cf) & 0x7fffffffu); am = dppmax<0x142>(am); am = dppmax<0x143>(am);
    const float amax = __uint_as_float((unsigned)__builtin_amdgcn_readlane((int)am, 63));
    const float cinv = amax > 0.f ? 127.0f / amax : 0.f; g.cscale = amax * (1.0f / 127.0f);
    g.cq = (int)rintf(cf * cinv);
#pragma unroll
    for (int i = 0; i < 16; ++i) g.accI[i] = 0;
    g.sumcq = 0;
}
template <int GQ0>
__device__ __forceinline__ void gh_c(GH& g, const v2u (&vq)[16]) {
#pragma unroll
    for (int gq = GQ0; gq < GQ0 + 2; ++gq) {
        const int q0 = __builtin_amdgcn_readlane(g.cq, 16 * gq), q1 = __builtin_amdgcn_readlane(g.cq, 16 * gq + 4), q2 = __builtin_amdgcn_readlane(g.cq, 16 * gq + 8), q3 = __builtin_amdgcn_readlane(g.cq, 16 * gq + 12);
        g.sumcq += (q0 + q1) + (q2 + q3);
        const int cw = (int)(((unsigned)q0 & 0xffu) | (((unsigned)q1 & 0xffu) << 8) | (((unsigned)q2 & 0xffu) << 16) | (((unsigned)q3 & 0xffu) << 24));
#pragma unroll
        for (int wg = 0; wg < 2; ++wg) {
            const unsigned r0 = wg ? vq[4 * gq].y : vq[4 * gq].x, r1 = wg ? vq[4 * gq + 1].y : vq[4 * gq + 1].x, r2 = wg ? vq[4 * gq + 2].y : vq[4 * gq + 2].x, r3 = wg ? vq[4 * gq + 3].y : vq[4 * gq + 3].x;
            const unsigned t0 = __builtin_amdgcn_perm(r1, r0, 0x05010400u), t1 = __builtin_amdgcn_perm(r1, r0, 0x07030602u);
            const unsigned t2 = __builtin_amdgcn_perm(r3, r2, 0x05010400u), t3 = __builtin_amdgcn_perm(r3, r2, 0x07030602u);
            unsigned o[4]; o[0] = __builtin_amdgcn_perm(t2, t0, 0x05040100u); o[1] = __builtin_amdgcn_perm(t2, t0, 0x07060302u);
            o[2] = __builtin_amdgcn_perm(t3, t1, 0x05040100u); o[3] = __builtin_amdgcn_perm(t3, t1, 0x07060302u);
#pragma unroll
            for (int j = 0; j < 4; ++j) {
                g.accI[8 * wg + j] = __builtin_amdgcn_sdot4((int)(o[j] & 0x0f0f0f0fu), cw, g.accI[8 * wg + j], false);
                g.accI[8 * wg + 4 + j] = __builtin_amdgcn_sdot4((int)o[j], cw, g.accI[8 * wg + 4 + j], false);
            }
        }
    }
}
__device__ __forceinline__ void gh_d(const GH& g, float (&acc)[16]) {
    const int offI = 15 * g.sumcq, offH = 8 * g.sumcq;
#pragma unroll
    for (int wg = 0; wg < 2; ++wg)
#pragma unroll
        for (int j = 0; j < 4; ++j) { const int Ls = g.accI[8 * wg + j], Fs = g.accI[8 * wg + 4 + j];
            acc[8 * wg + j] = fmaf((float)(2 * Ls - offI), 0.5f * g.cscale, acc[8 * wg + j]);
            acc[8 * wg + 4 + j] = fmaf((float)(Fs - Ls + offH), 0.0625f * g.cscale, acc[8 * wg + 4 + j]); }
}

template <long X8D>
__device__ __forceinline__ void run_wave(const float* S, bf16* XB, const unsigned char* UQ, const unsigned char* VQ, const float* SU, const float* SV, const float* ss1, float* rs2, int gw, int ngw, int ntok, int lane_in) {
    int lane = lane_in; asm volatile("" : "+v"(lane));
    const int hl = lane & 31, li = lane & 15;
    auto slot_ij = [](int l, int& ci, int& cj) { if (l < 16) { ci = 0; cj = l; } else if (l < 24) { ci = 1; cj = l - 16; } else if (l < 29) { ci = 2; cj = l - 24; } else if (l < 33) { ci = 3; cj = l - 29; }
      else if (l < 36) { ci = 4; cj = l - 33; } else if (l < 42) { ci = 5 + ((l - 36) >> 1); cj = (l - 36) & 1; } else if (l < 50) { ci = 8 + (l - 42); cj = 0; } else { ci = 0; cj = 0; } };
    int cij; unsigned ciP = 0u, cjP = 0u;
    { int ci, cj; slot_ij(lane, ci, cj); cij = ci | (cj << 8);
#pragma unroll
      for (int k = 0; k < 4; ++k) { slot_ij(li + 16 * k, ci, cj); ciP |= (unsigned)((lane & 48) + ci) << (8 * k); cjP |= (unsigned)((lane & 48) + cj) << (8 * k); } }
    const __amdgpu_buffer_rsrc_t rsUV = __builtin_amdgcn_make_buffer_rsrc((void*)UQ, 0, NEXP * 1024, 0x00020000); (void)VQ;
    const int lo = lane * 16;
    if (gw >= ntok) return;
    Pre pre; unsigned kk[4][8], mine[4], MA[2], MB[2], ck[2][4], top[2];
    int sumx_cur = 0, sumx_nxt = 0;
    TK cur, nxt; v4u xq_cur, xq_nxt; float sx;
    load_pre(pre, S, XB, gw, lane);
    prep_keys(pre, kk, hl); quant_x(pre, xq_cur, sx, sumx_cur, lane);
#pragma unroll
    for (int p = 0; p < 4; ++p) mine[p] = 0u;
#pragma unroll 1
    for (int it = 0; it < 16; ++it) s1_round(kk, mine, li == it);
    s2_setup(mine, MA, MB, ck, top, ciP, cjP, li);
#pragma unroll 1
    for (int it = 0; it < 16; ++it) s2_round(ck, top, li == it);
    finalize(top, MA, MB, cij, 1.0f / sqrtf(ss1[gw] * (1.0f / 1024.0f) + EPS), sx, SU, SV, lane, cur);
    { const int t1 = (gw + ngw < ntok) ? gw + ngw : gw; load_pre(pre, S, XB, t1, lane); }
    v4u tq[16]; v2u vq[16];
    load_t_head(tq, cur.eidP0, 0, rsUV, lo);
#define PEER_HEAD(H, VCUR, VNEXT, NEXTU, R0, R1, R2, R3) { GH g; \
        gh_a<NEXTU>(g, H, cur, xq_cur, tq, vq, rsUV, lo); R0; \
        gh_b(g, H, cur, lane, sumx_cur);                          R1; \
        gh_c<0>(g, vq);                                           R2; \
        gh_c<2>(g, vq); gh_d(g, acc);                             R3; }
#pragma unroll 1
    for (int tkn = gw; tkn < ntok; tkn += ngw) {
        asm volatile("" : "+v"(lane)); const int hl = lane & 31, li = lane & 15, lo = lane * 16; (void)hl; (void)li; (void)lo;
        const int tn1 = (tkn + ngw < ntok) ? tkn + ngw : tkn, tn2 = (tn1 + ngw < ntok) ? tn1 + ngw : tn1;
        prep_keys(pre, kk, hl); quant_x(pre, xq_nxt, sx, sumx_nxt, lane);
        const float rs1n = 1.0f / sqrtf(ss1[tn1] * (1.0f / 1024.0f) + EPS);
#pragma unroll
        for (int p = 0; p < 4; ++p) mine[p] = 0u;
        float acc[16];
#pragma unroll
        for (int i = 0; i < 16; ++i) acc[i] = 0.f;
#pragma unroll 1
        for (int hh = 0; hh < 2; ++hh) {
            PEER_HEAD(2 * hh, va, vb, true, s1_round(kk, mine, li == 8 * hh + 0), s1_round(kk, mine, li == 8 * hh + 1), s1_round(kk, mine, li == 8 * hh + 2), s1_round(kk, mine, li == 8 * hh + 3))
            PEER_HEAD(2 * hh + 1, vb, va, true, s1_round(kk, mine, li == 8 * hh + 4), s1_round(kk, mine, li == 8 * hh + 5), s1_round(kk, mine, li == 8 * hh + 6), s1_round(kk, mine, li == 8 * hh + 7))
        }
        s2_setup(mine, MA, MB, ck, top, ciP, cjP, li);
        PEER_HEAD(4, va, vb, true, s2_round(ck, top, li == 0), s2_round(ck, top, li == 1), s2_round(ck, top, li == 2), s2_round(ck, top, li == 3))
        PEER_HEAD(5, vb, va, true, s2_round(ck, top, li == 4), s2_round(ck, top, li == 5), s2_round(ck, top, li == 6), s2_round(ck, top, li == 7))
        PEER_HEAD(6, va, vb, true, s2_round(ck, top, li == 8), s2_round(ck, top, li == 9), s2_round(ck, top, li == 10), s2_round(ck, top, li == 11))
        v4u xr_cur0, xr_cur1; { int lo_ = lane; asm volatile("" : "+v"(lo_)); const v4u* xp_ = (const v4u*)(XB + (size_t)tkn * 1024 + lo_ * 16); xr_cur0 = xp_[0]; xr_cur1 = xp_[1]; }
        { int lp_ = lane; asm volatile("" : "+v"(lp_)); load_pre(pre, S, XB, tn2, lp_); }
        PEER_HEAD(7, vb, va, false, s2_round(ck, top, li == 12), s2_round(ck, top, li == 13), s2_round(ck, top, li == 14), s2_round(ck, top, li == 15))
        finalize(top, MA, MB, cij, rs1n, sx, SU, SV, lane, nxt);
        load_t_head(tq, nxt.eidP0, 0, rsUV, lo);
        { f32x4 xf[4]; pg8::unpack8(xr_cur0, xf[0], xf[1]); pg8::unpack8(xr_cur1, xf[2], xf[3]);
          f32x4 y[4]; float ss = 0.f;
#pragma unroll
          for (int w = 0; w < 4; ++w)
#pragma unroll
              for (int e = 0; e < 4; ++e) { y[w][e] = xf[w][e] + acc[4 * w + e]; ss += y[w][e] * y[w][e]; }
          int lo_ = lane; asm volatile("" : "+v"(lo_));
          bf16* xb = XB + (size_t)tkn * 1024 + lo_ * 16;
          *(v4u*)xb = pg8::pack8(y[0], y[1]); *(v4u*)(xb + 8) = pg8::pack8(y[2], y[3]);
          { v4u o8; o8.x = pg8::pkf8(y[0][0], y[0][1], y[0][2], y[0][3]); o8.y = pg8::pkf8(y[1][0], y[1][1], y[1][2], y[1][3]); o8.z = pg8::pkf8(y[2][0], y[2][1], y[2][2], y[2][3]); o8.w = pg8::pkf8(y[3][0], y[3][1], y[3][2], y[3][3]);
            *(v4u*)((unsigned char*)XB + X8D + (size_t)tkn * 1024 + lo_ * 16) = o8; }
          ss = wave_sum(ss, lane);
          if (lane == 0) rs2[tkn] = 1.0f / sqrtf(ss * (1.0f / 1024.0f) + EPS); }
        cur = nxt; xq_cur = xq_nxt; sumx_cur = sumx_nxt;
    }
}
#undef PEER_HEAD
#undef PEER_ROW
#undef PEER_ROWV
}

__global__ void __launch_bounds__(NWAVES * 64, 2) mk_fwd(Args args) {
    extern __shared__ __attribute__((aligned(16))) unsigned char lds[];
    LAS unsigned char* L = (LAS unsigned char*)lds;
    volatile LAS unsigned* MISC = (volatile LAS unsigned*)(L + MISC_OFF);
    const int G = gridDim.x, bx = blockIdx.x;
    const int wave_s = __builtin_amdgcn_readfirstlane((int)threadIdx.x >> 6);
    const int NGW = G * NWAVES, NGT = G * NWAVES * 64;
#define FRESH_IDS() int tid = wave_s * 64 + lane_id_opaque(); asm volatile("" : "+v"(tid)); const int lane = tid & 63, wave = __builtin_amdgcn_readfirstlane(tid >> 6); \
    const int gw = bx * NWAVES + wave, gtid = bx * (NWAVES * 64) + tid; (void)lane; (void)gw; (void)gtid
    typedef const unsigned char __attribute__((address_space(4))) karg_t;
#define FRESH_ARGS() karg_t* kp_ = (karg_t*)__builtin_amdgcn_kernarg_segment_ptr(); asm volatile("" : "+s"(kp_)); \
    unsigned char* ws = *(unsigned char* const __attribute__((address_space(4)))*)(kp_ + 224); float* out = *(float* const __attribute__((address_space(4)))*)(kp_ + 216); (void)out; (void)ws
#define IN(k) (*(const float* const __attribute__((address_space(4)))*)(kp_ + 8 * (k)))
#define WSP(T_, off) ((T_*)(ws + (off)))
    { FRESH_IDS(); for (int u = tid; u < (LDS_BYTES - LDSCTL_OFF) / 4; u += NWAVES * 64) ((LAS unsigned*)(L + LDSCTL_OFF))[u] = 0u; }
    __syncthreads();
    XcdBarrier bar;
    { FRESH_ARGS(); bar = xcd_barrier_post((unsigned*)(ws + WS_CTL) + CW_BAR, MISC + 8, wave_s); }
#define GRID_BAR() xcd_barrier(bar, wave_s)

    {
        FRESH_IDS(); FRESH_ARGS();
        bf16* WinT = WSP(bf16, WS_WIN); bf16* WgluT = WSP(bf16, WS_WGLU); bf16* WpsT = WSP(bf16, WS_WPS); bf16* WpaT = WSP(bf16, WS_WPA);
        bf16* WoutT = WSP(bf16, WS_WOUT); bf16* WsT = WSP(bf16, WS_WS); bf16* WgateT = WSP(bf16, WS_WGATE); bf16* WppT = WSP(bf16, WS_WPP);
        float* rope = WSP(float, WS_ROPE); unsigned char* s5p = ws + WS_S5P; bf16* XN = WSP(bf16, WS_XN); bf16* PB = WSP(bf16, WS_PB);
        const float* x = IN(I_X);
        {
            LAS float* scr = (LAS float*)(L + RING_OFF + wave * 16384);
            constexpr int I_1 = (1024 / 64) * (4096 / 32), I_7 = (256 / 64) * (1024 / 32);
            for (int it = gw; it < I_1; it += NGW) p0_transpose_item<true>(IN(I_WIN), IN(I_GMIX), 1024, 4096, WinT, scr, it, lane);
            for (int it = gw; it < I_7; it += NGW) p0_transpose_item(IN(I_WPP), nullptr, 256, 1024, WppT, scr, it, lane);
        }
        for (int m0 = gw * 4; m0 < T; m0 += NGW * 4) {
            f32x4 v[4][4];
#pragma unroll
            for (int i = 0; i < 4; ++i) { const f32x4* xr = (const f32x4*)(x + (size_t)(m0 + i) * D) + lane;
#pragma unroll
                for (int j = 0; j < 4; ++j) v[i][j] = xr[64 * j]; }
#pragma unroll
            for (int i = 0; i < 4; ++i) { float s = 0.f;
#pragma unroll
                for (int j = 0; j < 4; ++j) s += (v[i][j].x * v[i][j].x + v[i][j].y * v[i][j].y) + (v[i][j].z * v[i][j].z + v[i][j].w * v[i][j].w);
                const float rs = 1.0f / sqrtf(wave_sum(s, lane) * (1.f / D) + EPS);
                unsigned* o8 = (unsigned*)((unsigned char*)XN + (size_t)(m0 + i) * D) + lane;
#pragma unroll
                for (int j = 0; j < 4; ++j) o8[64 * j] = pg8::pkf8(v[i][j].x * rs, v[i][j].y * rs, v[i][j].z * rs, v[i][j].w * rs); }
        }
        {
            const float* pp = IN(I_P);
            constexpr int NI = T * D_PLE / 8;
            for (int i8 = gtid; i8 < NI; i8 += 4 * NGT) { f32x4 a[4], b[4];
#pragma unroll
                for (int j = 0; j < 4; ++j) { const int ij = i8 + j * NGT; const size_t o = (size_t)(ij < NI ? ij : NI - 1) * 8; a[j] = *(const f32x4*)(pp + o); b[j] = *(const f32x4*)(pp + o + 4); }
#pragma unroll
                for (int j = 0; j < 4; ++j) { const int ij = i8 + j * NGT; if (ij >= NI) break; const size_t o = (size_t)ij * 8; *(v4u*)(PB + o) = pg8::pack8(a[j], b[j]); } }
        }
        {
            const int* pos = (const int*)IN(I_POS);
            for (int i = gtid; i < T * 8; i += NGT) { const int t = i >> 3, k = i & 7;
                const double invf = k == 0 ? 1.0 : k == 1 ? 0.19392274474868576 : k == 2 ? 0.03760603093086393 : k == 3 ? 0.007292664737217109 : k == 4 ? 0.001414213562373095
                                  : k == 5 ? 0.0002742481756762073 : k == 6 ? 5.318295896944988e-05 : 1.031338537721246e-05;
                float c, s; cs_reduced((double)pos[t] * invf, c, s);
                rope[(size_t)t * 16 + 2 * k] = c; rope[(size_t)t * 16 + 2 * k + 1] = s; }
        }
    }
    GRID_BAR();

#define MK_DEFERRED_P0() do { FRESH_IDS(); \
        for (int it = bx; it < 256; it += G) p0_ws_item(IN(I_WQ), IN(I_GFFN), IN(I_KEY1), IN(I_KEY2), WSP(bf16, WS_WS), L + RING_OFF, it, tid); \
        __syncthreads(); \
        { \
            LAS float* scr = (LAS float*)(L + RING_OFF + wave * 16384); \
            constexpr int I_2 = (512 / 64) * (512 / 32), I_3 = (512 / 64) * (1024 / 32), I_4 = I_3, I_5 = (1024 / 64) * (1024 / 32), I_6 = I_5; \
            for (int it = gw; it < I_2 + I_3 + I_4 + I_5 + I_6; it += NGW) { \
                int r = it; \
                if (r < I_2) { p0_transpose_item<true>(IN(I_WGLU), nullptr, 512, 512, WSP(bf16, WS_WGLU), scr, r, lane); continue; } r -= I_2; \
                if (r < I_3) { p0_transpose_item<true>(IN(I_WPS), nullptr, 512, 1024, WSP(bf16, WS_WPS), scr, r, lane); continue; } r -= I_3; \
                if (r < I_4) { p0_transpose_item<true>(IN(I_WPA), nullptr, 512, 1024, WSP(bf16, WS_WPA), scr, r, lane); continue; } r -= I_4; \
                if (r < I_5) { p0_transpose_item<true>(IN(I_WOUT), nullptr, 1024, 1024, WSP(bf16, WS_WOUT), scr, r, lane); continue; } r -= I_5; \
                p0_transpose_item<true>(IN(I_WGATE), IN(I_GPLE), 1024, 1024, WSP(bf16, WS_WGATE), scr, r, lane); \
            } \
        } \
        if (gtid < NG * NS) { \
            const int g = gtid >> 6; \
            const float dt = expf(IN(I_LOGDT)[g]); const float are = IN(I_ARE)[gtid], aim = IN(I_AIM)[gtid]; \
            const double zr = (double)dt * (double)are, th = (double)dt * (double)aim; \
            float c, s; cs_reduced(th, c, s); const float mag = expf((float)zr); \
            const float abr = mag * c, abi = mag * s; \
            float cL, sL; cs_reduced(64.0 * th, cL, sL); const float magL = expf((float)(64.0 * zr)); \
            ((float*)((ws + WS_S5P) + S5_ABR))[gtid] = abr; ((float*)((ws + WS_S5P) + S5_ABI))[gtid] = abi; \
            ((float*)((ws + WS_S5P) + S5_ALR))[gtid] = magL * cL; ((float*)((ws + WS_S5P) + S5_ALI))[gtid] = magL * sL; \
            const float den = are * are + aim * aim, nr = abr - 1.0f, ni = abi; \
            const float fre = (nr * are + ni * aim) / den, fim = (ni * are - nr * aim) / den; \
            const float* br = IN(I_BRE) + (size_t)gtid * 16; const float* bi = IN(I_BIM) + (size_t)gtid * 16; \
            float* obr = (float*)((ws + WS_S5P) + S5_BRE) + (size_t)gtid * 16; float* obi = (float*)((ws + WS_S5P) + S5_BIM) + (size_t)gtid * 16; \
        _Pragma("unroll") \
            for (int cc = 0; cc < 16; ++cc) { obr[cc] = fre * br[cc] - fim * bi[cc]; obi[cc] = fre * bi[cc] + fim * br[cc]; } \
        } \
        for (int i = gtid; i < NG * NS * 64; i += NGT) { const int t = i & 63, gn = i >> 6, g = gn >> 6; \
            const float dt = expf(IN(I_LOGDT)[g]); const float are = IN(I_ARE)[gn], aim = IN(I_AIM)[gn]; \
            const double zr = (double)dt * (double)are, th = (double)dt * (double)aim; \
            float c1, s1; cs_reduced(th, c1, s1); const float mag1 = expf((float)zr); const float abr = mag1 * c1, abi = mag1 * s1; \
            const float den = are * are + aim * aim, nr = abr - 1.0f, ni = abi; \
            const float fre = (nr * are + ni * aim) / den, fim = (ni * are - nr * aim) / den; \
            float cp, sp; cs_reduced((double)(63 - t) * th, cp, sp); const float magp = expf((float)((double)(63 - t) * zr)); const float pr = magp * cp, pi = magp * sp; \
            const float qr = pr * fre - pi * fim, qi = pr * fim + pi * fre; \
            const f32x4* br = (const f32x4*)(IN(I_BRE) + (size_t)gn * 16); const f32x4* bi = (const f32x4*)(IN(I_BIM) + (size_t)gn * 16); \
            bf16* wre = WSP(bf16, WS_S5W) + ((size_t)g * 128 + (gn & 63)) * 1024 + 16 * t; bf16* wim = wre + (size_t)64 * 1024; \
        _Pragma("unroll") \
            for (int h8 = 0; h8 < 2; ++h8) { const f32x4 r0 = br[2 * h8], r1 = br[2 * h8 + 1], i0 = bi[2 * h8], i1 = bi[2 * h8 + 1]; \
                *(v4u*)(wre + 8 * h8) = pg8::pack8(qr * r0 - qi * i0, qr * r1 - qi * i1); *(v4u*)(wim + 8 * h8) = pg8::pack8(qr * i0 + qi * r0, qr * i1 + qi * r1); } } \
        for (int i = gtid; i < NG * 16 * 128; i += NGT) { const int gc = i >> 7, n = i & 127; \
            const float v = (n & 1) ? -IN(I_CIM)[(size_t)gc * 64 + (n >> 1)] : IN(I_CRE)[(size_t)gc * 64 + (n >> 1)];     \
            ((bf16*)((ws + WS_S5P) + S5_CM))[i] = (bf16)(pkbf(v, 0.f) & 0xffffu); } \
        __syncthreads(); \
    } while (0)
#define MK_PEER_TABLES() do { FRESH_IDS(); \
        { \
            const float* pu = IN(I_PU); const float* pv = IN(I_PV); const float* gf = IN(I_GFFN); \
            unsigned char* UQ = WSP(unsigned char, WS_UT); unsigned char* VQ = WSP(unsigned char, WS_VT); float* SU = WSP(float, WS_SU); float* SV = WSP(float, WS_SV); \
            f32x4 gf4[4]; \
        _Pragma("unroll") \
            for (int j = 0; j < 4; ++j) gf4[j] = *(const f32x4*)(gf + 16 * lane + 4 * j); \
            for (int r0 = gw * 4; r0 < NEXP; r0 += NGW * 4) { peer::Row4 rw[4]; \
        _Pragma("unroll") \
                for (int i = 0; i < 4; ++i) peer::load_row16(rw[i], pu + (size_t)(r0 + i) * 1024, lane); \
        _Pragma("unroll") \
                for (int i = 0; i < 4; ++i) peer::quant_row4(rw[i], gf4, true, UQ + (size_t)(r0 + i) * 1024, SU + r0 + i, lane); } \
            for (int r0 = gw * 4; r0 < NEXP; r0 += NGW * 4) { peer::Row4 rw[4]; \
        _Pragma("unroll") \
                for (int i = 0; i < 4; ++i) peer::load_row16(rw[i], pv + (size_t)(r0 + i) * 1024, lane); \
        _Pragma("unroll") \
                for (int i = 0; i < 4; ++i) peer::quant_row4(rw[i], gf4, false, UQ + (size_t)(r0 + i) * 1024 + 8, SV + r0 + i, lane, true); } \
        } \
    } while (0)
    {
        FRESH_ARGS();
        bf16* XN = WSP(bf16, WS_XN); bf16* WinT = WSP(bf16, WS_WIN); bf16* PB = WSP(bf16, WS_PB); bf16* WppT = WSP(bf16, WS_WPP); bf16* EB = WSP(bf16, WS_E);
        bf16* Ub = WSP(bf16, WS_U); bf16* Qb = WSP(bf16, WS_Q); bf16* Kb = WSP(bf16, WS_K); bf16* Vb = WSP(bf16, WS_V); unsigned char* SGA = WSP(unsigned char, WS_SGA); unsigned char* SGB = WSP(unsigned char, WS_SGB);
        float* kmean = WSP(float, CTL_KMEAN); float* rope = WSP(float, WS_ROPE);
        const int grp = (bx >> 3) & 3, nrounds = ((T / 256) * (D_IN / 256) + G - 1) / G, rhalf = (nrounds + 1) / 2;
        if (grp == 0) { MK_PEER_TABLES(); MK_DEFERRED_P0(); }
        { pg8::Gemm g{XN, WinT, T, D_IN, D}; pg8::RangeOrder S; S.b.init(T, D_IN, G, bx); S.i0 = 0; S.i1 = rhalf;
          pg8::EpiWin E{Ub, Qb, Kb, Vb, SGA, SGB, kmean, rope, 0.18033688011112042f};
          pg8::gemm_phase<pg8::EpiWin, pg8::RangeOrder, true, true, true, D>(L + RING_OFF, g, S, E, wave_s); }
        if (grp == 1) { MK_PEER_TABLES(); MK_DEFERRED_P0(); }
        { pg8::Gemm g{XN, WinT, T, D_IN, D}; pg8::RangeOrder S; S.b.init(T, D_IN, G, bx); S.i0 = rhalf; S.i1 = nrounds;
          pg8::EpiWin E{Ub, Qb, Kb, Vb, SGA, SGB, kmean, rope, 0.18033688011112042f};
          pg8::gemm_phase<pg8::EpiWin, pg8::RangeOrder, true, true, true, D>(L + RING_OFF, g, S, E, wave_s); }
        if (grp == 2) { MK_PEER_TABLES(); MK_DEFERRED_P0(); }
        { pg8::Gemm g{PB, WppT, T, D, D_PLE}; pg8::StaticOrder S; S.init(T, D, G, bx);
          pg8::EpiPlain E{EB, D};
          pg8::gemm_phase<pg8::EpiPlain, pg8::StaticOrder, true, true, false, D_PLE>(L + RING_OFF, g, S, E, wave_s); }
        if (grp == 3) { MK_PEER_TABLES(); MK_DEFERRED_P0(); }
    }
#undef MK_PEER_TABLES
#undef MK_DEFERRED_P0
    GRID_BAR();

    {
        { FRESH_IDS(); FRESH_ARGS();
          const bf16* Qb = WSP(bf16, WS_Q); const float* kmean = WSP(float, CTL_KMEAN);
          unsigned short* SUB = WSP(unsigned short, WS_MSUB); unsigned* CNT = WSP(unsigned, WS_MCNT); float* LSE = WSP(float, WS_MLSE);
          for (int u = bx; u < 512; u += G) moba::select_pair(u, 1023 - u, (const moba::bf16*)Qb, kmean, SUB, CNT, LSE, (char*)lds + RING_OFF, tid); }
        FRESH_IDS(); FRESH_ARGS();
        __syncthreads();
        s5::pass1_gemm(L + RING_OFF, WSP(bf16, WS_S5W), WSP(bf16, WS_U), WSP(float, WS_HLOC), G, bx, tid, wave);
    }
    GRID_BAR();

    {
        FRESH_IDS(); FRESH_ARGS();
        for (int task = (G - 1 - bx) * NWAVES + wave; task < NB * NG; task += G * NWAVES) s5::carry_prefix(ws + WS_S5P, WSP(float, WS_HLOC), WSP(float, WS_X8), task, lane);
        moba::sparse_phase((const moba::bf16*)WSP(bf16, WS_Q), (const moba::bf16*)WSP(bf16, WS_K), (const moba::bf16*)WSP(bf16, WS_V), WSP(unsigned short, WS_MSUB), WSP(unsigned, WS_MCNT),
                           (moba::bf16*)out, WSP(float, WS_MLSE), (char*)lds + RING_OFF, G, bx, tid, wave_s);
    }
    GRID_BAR();

    {
        { FRESH_ARGS();
          moba::own_phase((const moba::bf16*)WSP(bf16, WS_Q), (const moba::bf16*)WSP(bf16, WS_K), (const moba::bf16*)WSP(bf16, WS_V), (const moba::bf16*)out, WSP(float, WS_MLSE), (moba::bf16*)WSP(bf16, WS_PB),
                          (char*)lds + RING_OFF, G, bx, wave_s); }
        FRESH_IDS(); FRESH_ARGS();
        s5::run<2>(L + RING_OFF + wave * 16384, ws + WS_S5P, WSP(bf16, WS_U), WSP(float, WS_X8)  , IN(I_DSK), WSP(bf16, WS_YP), gw, NGW, lane); }
    GRID_BAR();

    {
        FRESH_ARGS(); bf16* YP = WSP(bf16, WS_YP); bf16* YS = WSP(bf16, WS_V); bf16* WgluT = WSP(bf16, WS_WGLU);
        pg8::Gemm g{WSP(bf16, WS_MSUB), WgluT, T, D_SSM, D_SSM}; pg8::StaticOrder S; S.init(T, D_SSM, G, bx);
        pg8::EpiGlu E{WSP(bf16, WS_MSUB), YS}; (void)YP;
        pg8::gemm_phase<pg8::EpiGlu, pg8::StaticOrder, true, true, true, D_SSM>(L + RING_OFF, g, S, E, wave_s);
    }
    GRID_BAR();

    {
        FRESH_ARGS(); bf16* YS = WSP(bf16, WS_V); bf16* Qb = WSP(bf16, WS_PB); unsigned char* M8 = WSP(unsigned char, WS_U); bf16* WpsT = WSP(bf16, WS_WPS); bf16* WpaT = WSP(bf16, WS_WPA); const unsigned char* SGA = WSP(unsigned char, WS_SGA); const unsigned char* SGB = WSP(unsigned char, WS_SGB); bf16* T1 = WSP(bf16, WS_Q);
        static_assert(D_SSM == D_ATT, "the two chained GEMMs share one K");
        { pg8::Gemm g{YS, WpsT, T, D, D_SSM, Qb, WpaT}; pg8::PairOrder S; S.b.init(T, D, G, bx);
          pg8::EpiMerge2 E{SGA, SGB, M8}; (void)T1;
          pg8::gemm_phase<pg8::EpiMerge2, pg8::PairOrder, true, true, true, D_SSM>(L + RING_OFF, g, S, E, wave_s); }
    }
    GRID_BAR();

    {
        FRESH_ARGS(); bf16* SGA = WSP(bf16, WS_U); bf16* WoutT = WSP(bf16, WS_WOUT); bf16* XN = WSP(bf16, WS_XN); float* ss1 = WSP(float, CTL_SS1); const float* x = IN(I_X);
        pg8::Gemm g{SGA, WoutT, T, D, D}; pg8::StaticOrder S; S.init(T, D, G, bx);
        pg8::EpiResid E{x, XN, ss1};
        pg8::gemm_phase<pg8::EpiResid, pg8::StaticOrder, true, true, true, D>(L + RING_OFF, g, S, E, wave_s);
    }
    GRID_BAR();

    {
        FRESH_ARGS(); bf16* XN = WSP(bf16, WS_XN); bf16* WsT = WSP(bf16, WS_WS); float* SC = WSP(float, WS_SC); float* ss1 = WSP(float, CTL_SS1);
        pg8::Gemm g{XN, WsT, T, PH * PQD, D}; pg8::StaticOrder S; S.init(T, PH * PQD, G, bx);
        pg8::EpiScores E{(pg8::bf16_t*)SC, ss1};
        pg8::gemm_phase<pg8::EpiScores, pg8::StaticOrder, true, true, false, D>(L + RING_OFF, g, S, E, wave_s);
    }
    GRID_BAR();

    {
        FRESH_IDS(); FRESH_ARGS();
        float* SC = WSP(float, WS_SC); bf16* XN = WSP(bf16, WS_XN); float* ss1 = WSP(float, CTL_SS1); float* rs2 = WSP(float, WS_RS2);
        const unsigned char* UQ = WSP(unsigned char, WS_UT); const unsigned char* VQ = WSP(unsigned char, WS_VT); const float* SU = WSP(float, WS_SU); const float* SV = WSP(float, WS_SV);
        peer::run_wave<(long)WS_X8 - (long)WS_XN>(SC, XN, UQ, VQ, SU, SV, ss1, rs2, gw, NGW, T, lane);
    }
    GRID_BAR();

    if (G == 256) {
        FRESH_ARGS(); bf16* XN = WSP(bf16, WS_XN); bf16* WgateT = WSP(bf16, WS_WGATE); bf16* EB = WSP(bf16, WS_E); float* rs2 = WSP(float, WS_RS2); float* ss3 = WSP(float, CTL_SS3);
        pg8::Gemm g{WSP(bf16, WS_X8), WgateT, T, D, D}; pg8::StaticOrder S; S.init(T, D, G, bx);
        pg8::EpiPleNorm E{XN, EB, rs2, ss3, WSP(unsigned, CTL_PCNT), IN(I_GFIN), out, &bar.bar[XB_TMO]};
        pg8::gemm_phase<pg8::EpiPleNorm, pg8::StaticOrder, true, true, true, D>(L + RING_OFF, g, S, E, wave_s);
        return;
    }
    {
        FRESH_ARGS(); bf16* XN = WSP(bf16, WS_XN); bf16* WgateT = WSP(bf16, WS_WGATE); bf16* EB = WSP(bf16, WS_E); float* rs2 = WSP(float, WS_RS2); float* ss3 = WSP(float, CTL_SS3);
        pg8::Gemm g{WSP(bf16, WS_X8), WgateT, T, D, D}; pg8::StaticOrder S; S.init(T, D, G, bx);
        pg8::EpiPle E{XN, EB, rs2, ss3};
        pg8::gemm_phase<pg8::EpiPle, pg8::StaticOrder, true, true, true, D>(L + RING_OFF, g, S, E, wave_s);
    }
    GRID_BAR();

    {
        FRESH_IDS(); FRESH_ARGS();
        const bool bad = xb_ld(&bar.bar[XB_TMO]) != 0u;
        const float* gfin = IN(I_GFIN); float* ss3 = WSP(float, CTL_SS3);
        const f32x4* gp = (const f32x4*)gfin + lane;
        f32x4 g4[4];
#pragma unroll
        for (int j = 0; j < 4; ++j) g4[j] = gp[64 * j];
        const bf16* X3B = WSP(bf16, WS_E);
        for (int m0 = gw * 4; m0 < T; m0 += NGW * 4) {
            v2u v[4][4]; float rs[4];
#pragma unroll
            for (int i = 0; i < 4; ++i) { const v2u* xr = (const v2u*)(X3B + (size_t)(m0 + i) * D) + lane; rs[i] = ss3[m0 + i];
#pragma unroll
                for (int j = 0; j < 4; ++j) v[i][j] = xr[64 * j]; }
#pragma unroll
            for (int i = 0; i < 4; ++i) { const float r_ = 1.0f / sqrtf(rs[i] * (1.f / D) + EPS); f32x4* xo = (f32x4*)(out + (size_t)(m0 + i) * D) + lane;
#pragma unroll
                for (int j = 0; j < 4; ++j) { f32x4 r = (f32x4){bflo(v[i][j].x), bfhi(v[i][j].x), bflo(v[i][j].y), bfhi(v[i][j].y)} * r_ * g4[j]; if (bad) r = (f32x4){__builtin_nanf(""), 0.f, 0.f, 0.f}; xo[64 * j] = r; } }
        }
    }
}

extern "C" void kernel_launch(void* const* d_in, const int* in_sizes, int n_in, void* d_out, int out_size, void* d_ws, size_t ws_size, hipStream_t stream) {
    static int grid = 0;
    if (grid == 0) {
        if (n_in != 27 || in_sizes[0] != T * D || out_size != T * D || ws_size < WS_END) {
            fprintf(stderr, "kernel_launch: built for 27 inputs, x/out of %d floats, >= %zu bytes of workspace; got n_in %d in0 %d out %d ws %zu\n", T * D, (size_t)WS_END, n_in, n_in > 0 ? in_sizes[0] : -1, out_size, ws_size);
            grid = -1; return; }
        int dev = 0, cus = 0, per_cu = 0;
        if (hipGetDevice(&dev) != hipSuccess || hipDeviceGetAttribute(&cus, hipDeviceAttributeMultiprocessorCount, dev) != hipSuccess) { grid = -1; return; }
        if (hipFuncSetAttribute((const void*)mk_fwd, hipFuncAttributeMaxDynamicSharedMemorySize, LDS_BYTES) != hipSuccess) { fprintf(stderr, "kernel_launch: hipFuncSetAttribute failed\n"); grid = -1; return; }
        if (hipOccupancyMaxActiveBlocksPerMultiprocessor(&per_cu, (const void*)mk_fwd, NWAVES * 64, LDS_BYTES) != hipSuccess || per_cu < 1) { fprintf(stderr, "kernel_launch: occupancy query says %d\n", per_cu); per_cu = 1; }
        (void)hipGetLastError();
        grid = cus;
        if (grid % 32 != 0 || grid > 256) grid = (grid / 32) * 32 > 256 ? 256 : (grid / 32) * 32;
        fprintf(stderr, "kernel_launch: cus %d per_cu %d grid %d ws %zu\n", cus, per_cu, grid, ws_size);
    }
    if (grid <= 0) return;
    if (hipMemsetAsync((char*)d_ws + WS_CTL, 0, CTL_ZERO_BYTES, stream) != hipSuccess) { fprintf(stderr, "kernel_launch: memset failed\n"); return; }
    Args a{};
    for (int i = 0; i < 27; ++i) a.in[i] = (const float*)d_in[i];
    a.out = (float*)d_out; a.ws = (unsigned char*)d_ws;
    void* kargs[] = {&a};
    const hipError_t e = hipLaunchCooperativeKernel((const void*)mk_fwd, dim3(grid), dim3(NWAVES * 64), kargs, LDS_BYTES, stream);
    if (e != hipSuccess) fprintf(stderr, "kernel_launch: cooperative launch failed: %s (grid %d)\n", hipGetErrorString(e), grid);
}
```
